# Optimizing an MI355X kernel written in HIP

```python
import math
import jax
import jax.numpy as jnp
from jax import lax
import numpy as np

D_MODEL = 1024
BATCH = 8
SEQ = 4096
DEPTH = 1

CHUNK = 64
EPS = 1e-6
A_HEADS = 16
A_HEAD_DIM = 64
A_WIDTH = A_HEADS * A_HEAD_DIM
LEFT_CHUNKS = 8
BAND = (LEFT_CHUNKS + 1) * CHUNK
REL_CLIP = 128
SSM_INNER = 2 * D_MODEL
SSM_HEAD_DIM = 64
SSM_HEADS = SSM_INNER // SSM_HEAD_DIM
SSM_GROUPS = 4
SSM_HPG = SSM_HEADS // SSM_GROUPS
SSM_STATE = 128
CONV_WIDTH = 4
CONV_CH = SSM_INNER + 2 * SSM_GROUPS * SSM_STATE
DT_MIN = 0.001
DT_MAX = 0.1
MEM_LEN = 256
X_HEADS = 4
X_HEAD_DIM = 256
X_WIDTH = X_HEADS * X_HEAD_DIM
N_BRANCH = 3
IN_SPLITS = (
    A_WIDTH,
    2 * A_WIDTH,
    3 * A_WIDTH,
    3 * A_WIDTH + SSM_INNER,
    3 * A_WIDTH + SSM_INNER + CONV_CH,
    3 * A_WIDTH + SSM_INNER + CONV_CH + SSM_HEADS,
    3 * A_WIDTH + SSM_INNER + CONV_CH + SSM_HEADS + X_WIDTH,
)
IN_COLS = 3 * A_WIDTH + SSM_INNER + CONV_CH + SSM_HEADS + X_WIDTH + N_BRANCH * D_MODEL
N_EXPERTS = 32
TOP_K = 4
D_EXPERT = D_MODEL
SWIGLU_LIMIT = 7.0
SWIGLU_ALPHA = 1.702
MOE_BLOCK = 128

kernel_name = "hybrid_chunk_attn_ssd_memxattn_moe"


def rms_norm(x, gain):
    xf = x.astype(jnp.float32)
    y = xf * lax.rsqrt(jnp.mean(xf * xf, axis=-1, keepdims=True) + EPS)
    return (y * gain.astype(jnp.float32)).astype(x.dtype)


def chunk_attention(q, k, v, q_gain, k_gain, rel_bias):
    b, s = q.shape[0], q.shape[1]
    n_chunks = s // CHUNK
    left = LEFT_CHUNKS * CHUNK
    q = rms_norm(q.reshape(b, s, A_HEADS, A_HEAD_DIM), q_gain)
    k = rms_norm(k.reshape(b, s, A_HEADS, A_HEAD_DIM), k_gain)
    v = v.reshape(b, s, A_HEADS, A_HEAD_DIM)
    kp = jnp.pad(k, ((0, 0), (left, 0), (0, 0), (0, 0)))
    vp = jnp.pad(v, ((0, 0), (left, 0), (0, 0), (0, 0)))
    rel = jnp.arange(CHUNK)[:, None] + left - jnp.arange(BAND)[None, :]
    bias = rel_bias[:, jnp.clip(rel, -REL_CLIP, REL_CLIP) + REL_CLIP].astype(jnp.float32)
    qc = q.reshape(b, n_chunks, CHUNK, A_HEADS, A_HEAD_DIM).transpose(1, 0, 2, 3, 4)
    scale = A_HEAD_DIM ** -0.5

    def one_chunk(args):
        qb, c = args
        start = c * CHUNK
        kb = lax.dynamic_slice_in_dim(kp, start, BAND, axis=1)
        vb = lax.dynamic_slice_in_dim(vp, start, BAND, axis=1)
        sc = jnp.einsum("bqhd,bkhd->bhqk", qb, kb).astype(jnp.float32) * scale + bias
        valid = (start - left + jnp.arange(BAND)) >= 0
        sc = jnp.where(valid, sc, -jnp.inf)
        p = jax.nn.softmax(sc, axis=-1).astype(vb.dtype)
        return jnp.einsum("bhqk,bkhd->bqhd", p, vb)

    out = lax.map(one_chunk, (qc, jnp.arange(n_chunks)))
    return out.transpose(1, 0, 2, 3, 4).reshape(b, s, A_WIDTH)


def segsum(a):
    n = a.shape[-1]
    cs = jnp.cumsum(a, axis=-1)
    diff = cs[..., :, None] - cs[..., None, :]
    return jnp.where(jnp.tril(jnp.ones((n, n), dtype=bool)), diff, -jnp.inf)


def mamba2_branch(z, xbc, dt_raw, conv_w, conv_b, dt_bias, a_log, d_skip, norm_gain):
    f32 = jnp.float32
    b, s = xbc.shape[0], xbc.shape[1]
    n_chunks = s // CHUNK
    xpad = jnp.pad(xbc, ((0, 0), (CONV_WIDTH - 1, 0), (0, 0)))
    conv = conv_b + xpad[:, 0:s] * conv_w[0]
    for i in range(1, CONV_WIDTH):
        conv = conv + xpad[:, i:i + s] * conv_w[i]
    xbc = jax.nn.silu(conv)
    xs, bm, cm = jnp.split(xbc, [SSM_INNER, SSM_INNER + SSM_GROUPS * SSM_STATE], axis=-1)
    x6 = xs.astype(f32).reshape(b, n_chunks, CHUNK, SSM_GROUPS, SSM_HPG, SSM_HEAD_DIM)
    bc = bm.astype(f32).reshape(b, n_chunks, CHUNK, SSM_GROUPS, SSM_STATE)
    cc = cm.astype(f32).reshape(b, n_chunks, CHUNK, SSM_GROUPS, SSM_STATE)
    dt = jax.nn.softplus(dt_raw.astype(f32) + dt_bias.astype(f32))
    dt5 = dt.reshape(b, n_chunks, CHUNK, SSM_GROUPS, SSM_HPG)
    a_head = -jnp.exp(a_log.astype(f32)).reshape(SSM_GROUPS, SSM_HPG)
    a = (dt5 * a_head).transpose(0, 1, 3, 4, 2)
    a_cs = jnp.cumsum(a, axis=-1)
    xdt = x6 * dt5[..., None]
    decay_in = jnp.exp(segsum(a))
    cb = jnp.einsum("bclgn,bcsgn->bcgls", cc, bc)
    y_diag = jnp.einsum("bcgls,bcgrls,bcsgrp->bclgrp", cb, decay_in, xdt)
    decay_to_end = jnp.exp(a_cs[..., -1:] - a_cs)
    states = jnp.einsum("bclgn,bcgrl,bclgrp->bcgrpn", bc, decay_to_end, xdt)
    chunk_decay = jnp.exp(a_cs[..., -1])

    def step(state, inp):
        dec, st = inp
        return dec[..., None, None] * state + st, state

    init = jnp.zeros((b, SSM_GROUPS, SSM_HPG, SSM_HEAD_DIM, SSM_STATE), f32)
    _, prev = lax.scan(step, init, (jnp.moveaxis(chunk_decay, 1, 0), jnp.moveaxis(states, 1, 0)))
    prev = jnp.moveaxis(prev, 0, 1)
    y_off = jnp.einsum("bclgn,bcgrpn,bcgrl->bclgrp", cc, prev, jnp.exp(a_cs))
    y = (y_diag + y_off).reshape(b, s, SSM_HEADS, SSM_HEAD_DIM)
    y = y + d_skip.astype(f32)[:, None] * xs.astype(f32).reshape(b, s, SSM_HEADS, SSM_HEAD_DIM)
    yz = y.reshape(b, s, SSM_INNER) * jax.nn.silu(z.astype(f32))
    yz = rms_norm(yz.reshape(b, s, SSM_GROUPS, SSM_INNER // SSM_GROUPS),
                  norm_gain.reshape(SSM_GROUPS, SSM_INNER // SSM_GROUPS))
    return yz.reshape(b, s, SSM_INNER).astype(z.dtype)


def memory_attention(q, mem, mem_gain, w_mem_kv, q_gain, k_gain):
    b, s = q.shape[0], q.shape[1]
    m = mem.shape[1]
    kv = rms_norm(mem, mem_gain) @ w_mem_kv
    k, v = jnp.split(kv, 2, axis=-1)
    q = rms_norm(q.reshape(b, s, X_HEADS, X_HEAD_DIM), q_gain)
    k = rms_norm(k.reshape(b, m, X_HEADS, X_HEAD_DIM), k_gain)
    v = v.reshape(b, m, X_HEADS, X_HEAD_DIM)
    sc = jnp.einsum("bshd,bmhd->bhsm", q, k).astype(jnp.float32) * (X_HEAD_DIM ** -0.5)
    p = jax.nn.softmax(sc, axis=-1).astype(v.dtype)
    return jnp.einsum("bhsm,bmhd->bshd", p, v).reshape(b, s, X_WIDTH)


def moe_ffn(h, w_router, b_router, w_gate, b_gate, w_up, b_up, w_down, b_down):
    b, s, d = h.shape
    t = b * s
    xt = h.reshape(t, d)
    logits = (xt @ w_router + b_router).astype(jnp.float32)
    top_val, top_idx = lax.top_k(logits, TOP_K)
    wts = jax.nn.softmax(top_val, axis=-1)
    n_assign = t * TOP_K
    e_flat = top_idx.reshape(-1)
    tok_flat = jnp.arange(n_assign, dtype=jnp.int32) // TOP_K
    w_flat = wts.reshape(-1)
    order = jnp.argsort(e_flat)
    e_s, tok_s, w_s = e_flat[order], tok_flat[order], w_flat[order]
    counts = jnp.bincount(e_flat, length=N_EXPERTS)
    starts = jnp.cumsum(counts) - counts
    padded = (counts + MOE_BLOCK - 1) // MOE_BLOCK * MOE_BLOCK
    pad_ends = jnp.cumsum(padded)
    pad_starts = pad_ends - padded
    dest = pad_starts[e_s] + jnp.arange(n_assign, dtype=jnp.int32) - starts[e_s]
    n_rows = n_assign + N_EXPERTS * MOE_BLOCK
    row_tok = jnp.full((n_rows,), t, jnp.int32).at[dest].set(tok_s)
    row_w = jnp.zeros((n_rows,), jnp.float32).at[dest].set(w_s)
    n_blocks = n_rows // MOE_BLOCK
    block_start = jnp.arange(n_blocks, dtype=jnp.int32) * MOE_BLOCK
    block_exp = jnp.minimum(jnp.searchsorted(pad_ends, block_start, side="right"), N_EXPERTS - 1)
    x_pad = jnp.concatenate([xt, jnp.zeros((1, d), xt.dtype)], axis=0)
    xb = x_pad[row_tok].reshape(n_blocks, MOE_BLOCK, d)

    def expert_block(args):
        xblk, e = args
        g = xblk @ w_gate[e] + b_gate[e]
        u = xblk @ w_up[e] + b_up[e]
        g = jnp.minimum(g, SWIGLU_LIMIT)
        u = jnp.clip(u, -SWIGLU_LIMIT, SWIGLU_LIMIT)
        act = (u + 1.0) * g * jax.nn.sigmoid(SWIGLU_ALPHA * g)
        return act @ w_down[e] + b_down[e]

    yb = lax.map(expert_block, (xb, block_exp)).reshape(n_rows, d)
    y = jax.ops.segment_sum(yb * row_w[:, None].astype(yb.dtype), row_tok, num_segments=t + 1)[:t]
    return y.reshape(b, s, d)


def setup_inputs(seed: int = 0) -> dict:
    key = jax.random.key(seed)
    ks = jax.random.split(key, 32)
    f32 = jnp.float32
    L = DEPTH

    def normal(k, shape, scale):
        return jax.random.normal(k, shape, f32) * scale

    def gain(k, shape):
        return 1.0 + 0.05 * jax.random.normal(k, shape, f32)

    dt = jnp.exp(jax.random.uniform(ks[8], (L, SSM_HEADS), f32, math.log(DT_MIN), math.log(DT_MAX)))
    dt_bias = dt + jnp.log(-jnp.expm1(-dt))
    a_log = jnp.log(jax.random.uniform(ks[9], (L, SSM_HEADS), f32, 1.0, 16.0))
    return {
        "x": normal(ks[0], (BATCH, SEQ, D_MODEL), 1.0),
        "mem": normal(ks[1], (BATCH, MEM_LEN, D_MODEL), 1.0),
        "norm_mix": gain(ks[2], (L, D_MODEL)),
        "w_in": normal(ks[3], (L, D_MODEL, IN_COLS), D_MODEL ** -0.5),
        "a_q_gain": gain(ks[4], (L, A_HEAD_DIM)),
        "a_k_gain": gain(ks[5], (L, A_HEAD_DIM)),
        "a_rel_bias": normal(ks[6], (L, A_HEADS, 2 * REL_CLIP + 1), 0.1),
        "conv_w": normal(ks[7], (L, CONV_WIDTH, CONV_CH), CONV_WIDTH ** -0.5),
        "conv_b": normal(ks[10], (L, CONV_CH), 0.01),
        "dt_bias": dt_bias,
        "a_log": a_log,
        "d_skip": gain(ks[11], (L, SSM_HEADS)),
        "ssm_norm": gain(ks[12], (L, SSM_INNER)),
        "norm_mem": gain(ks[13], (L, D_MODEL)),
        "w_mem_kv": normal(ks[14], (L, D_MODEL, 2 * X_WIDTH), D_MODEL ** -0.5),
        "x_q_gain": gain(ks[15], (L, X_HEAD_DIM)),
        "x_k_gain": gain(ks[16], (L, X_HEAD_DIM)),
        "w_br_a": normal(ks[17], (L, A_WIDTH, D_MODEL), A_WIDTH ** -0.5),
        "w_br_b": normal(ks[18], (L, SSM_INNER, D_MODEL), SSM_INNER ** -0.5),
        "w_br_c": normal(ks[19], (L, X_WIDTH, D_MODEL), X_WIDTH ** -0.5),
        "w_out": normal(ks[20], (L, D_MODEL, D_MODEL), D_MODEL ** -0.5),
        "norm_ffn": gain(ks[21], (L, D_MODEL)),
        "w_router": normal(ks[22], (L, D_MODEL, N_EXPERTS), D_MODEL ** -0.5),
        "b_router": normal(ks[23], (L, N_EXPERTS), 0.01),
        "w_gate": normal(ks[24], (L, N_EXPERTS, D_MODEL, D_EXPERT), D_MODEL ** -0.5),
        "b_gate": normal(ks[25], (L, N_EXPERTS, D_EXPERT), 0.01),
        "w_up": normal(ks[26], (L, N_EXPERTS, D_MODEL, D_EXPERT), D_MODEL ** -0.5),
        "b_up": normal(ks[27], (L, N_EXPERTS, D_EXPERT), 0.01),
        "w_down": normal(ks[28], (L, N_EXPERTS, D_EXPERT, D_MODEL), D_EXPERT ** -0.5),
        "b_down": normal(ks[29], (L, N_EXPERTS, D_MODEL), 0.01),
    }


def reference(x, mem, norm_mix, w_in, a_q_gain, a_k_gain, a_rel_bias, conv_w, conv_b, dt_bias, a_log,
              d_skip, ssm_norm, norm_mem, w_mem_kv, x_q_gain, x_k_gain, w_br_a, w_br_b, w_br_c, w_out,
              norm_ffn, w_router, b_router, w_gate, b_gate, w_up, b_up, w_down, b_down):
    b, s, d = x.shape
    for l in range(DEPTH):
        h = rms_norm(x, norm_mix[l])
        proj = h @ w_in[l]
        q_a, k_a, v_a, z, xbc, dt_raw, q_x, gate_logits = jnp.split(proj, IN_SPLITS, axis=-1)
        y_a = chunk_attention(q_a, k_a, v_a, a_q_gain[l], a_k_gain[l], a_rel_bias[l])
        y_b = mamba2_branch(z, xbc, dt_raw, conv_w[l], conv_b[l], dt_bias[l], a_log[l], d_skip[l], ssm_norm[l])
        y_c = memory_attention(q_x, mem, norm_mem[l], w_mem_kv[l], x_q_gain[l], x_k_gain[l])
        gates = jax.nn.sigmoid(gate_logits.astype(jnp.float32)).astype(x.dtype).reshape(b, s, N_BRANCH, d)
        merged = (gates[:, :, 0] * (y_a @ w_br_a[l])
                  + gates[:, :, 1] * (y_b @ w_br_b[l])
                  + gates[:, :, 2] * (y_c @ w_br_c[l]))
        x = x + merged @ w_out[l]
        x = x + moe_ffn(rms_norm(x, norm_ffn[l]), w_router[l], b_router[l], w_gate[l], b_gate[l],
                        w_up[l], b_up[l], w_down[l], b_down[l])
    return x
```

```cpp
#include <hip/hip_runtime.h>
#include <hip/hip_cooperative_groups.h>
#include <cstdio>
#include <cstdint>
namespace cg = cooperative_groups;

#define LAS __attribute__((address_space(3)))
#define GAS __attribute__((address_space(1)))
#define DI __device__ __forceinline__
typedef unsigned short bf16_t;
typedef short bf16x8 __attribute__((ext_vector_type(8)));
typedef short s16x4 __attribute__((ext_vector_type(4)));
typedef float f32x2 __attribute__((ext_vector_type(2)));
typedef float f32x4 __attribute__((ext_vector_type(4)));
typedef float f32x16 __attribute__((ext_vector_type(16)));
typedef unsigned u32x2 __attribute__((ext_vector_type(2)));
typedef unsigned u32x4 __attribute__((ext_vector_type(4)));
typedef __bf16 bf16x2_t __attribute__((ext_vector_type(2)));
typedef short v4i16_t __attribute__((ext_vector_type(4)));

DI unsigned pk2(float lo, float hi) { f32x2 v = {lo, hi}; bf16x2_t b = __builtin_convertvector(v, bf16x2_t); return __builtin_bit_cast(unsigned, b); }
DI float bf_lo(unsigned w) { return __uint_as_float(w << 16); }
DI float bf_hi(unsigned w) { return __uint_as_float(w & 0xffff0000u); }
DI float bf2f(bf16_t b) { return __uint_as_float(((unsigned)b) << 16); }
DI float wave_sum(float v) {
#pragma unroll
    for (int o = 1; o < 64; o <<= 1) v += __shfl_xor(v, o);
    return v;
}
DI float fast_exp2(float x) { return __builtin_amdgcn_exp2f(x); }
DI float fast_rcp(float x) { return __builtin_amdgcn_rcpf(x); }
DI float sigmoidf_(float x) { return fast_rcp(1.0f + fast_exp2(-1.4426950408889634f * x)); }

constexpr int NBATCH = 8, SEQ = 4096, T = NBATCH * SEQ, DM = 1024;
constexpr int NWIN_TILES = 49, NWIN = NWIN_TILES * 256;
constexpr int IN_COLS = 12320;
constexpr float EPS = 1e-6f;
constexpr float LOG2E = 1.4426950408889634f;
constexpr int NEXP = 32, TOPK = 4;
constexpr int MEMLEN = 256;
constexpr int ACT_P = 4096;
constexpr int TL_Q = 0, TL_K = 4, TL_V = 8, TL_Z = 12, TL_XBC = 20, TL_DT = 32, TL_QX = 33, TL_G = 37;

constexpr size_t MiB = (size_t)1 << 20;
constexpr size_t WS_CTL = 0, CTL_BYTES = 1 * MiB;
constexpr size_t WS_WIN = 1 * MiB, WS_WCAT = 26 * MiB, WS_WOUT = 34 * MiB, WS_WMEM = 36 * MiB;
constexpr size_t WS_DT = 40 * MiB, WS_SSQ = 44 * MiB, WS_RSTD = 48 * MiB, WS_KX = 49 * MiB, WS_MEMKV = 53 * MiB;
constexpr size_t WS_XN = 61 * MiB, WS_MEMN = 125 * MiB, WS_ACT = 129 * MiB, WS_BUF = 385 * MiB, WS_MIX_END = 577 * MiB;
constexpr size_t WS_KA = WS_BUF, WS_VA = WS_BUF + 64 * MiB, WS_XBC = WS_BUF, WS_GATES = WS_BUF, WS_MERGED = WS_XN;
constexpr int MOE_TILE_CAP = 280;
constexpr size_t MOE_H2 = 1 * MiB, MOE_WGU = 65 * MiB, MOE_WD = 193 * MiB, MOE_ACTM = 257 * MiB, MOE_Y = 397 * MiB;
constexpr size_t MOE_SELE = 537 * MiB, MOE_SELR = 537 * MiB + 512 * 1024, MOE_SELW = 538 * MiB, MOE_TOKL = 539 * MiB, WS_END = 543 * MiB;
constexpr int CW_CNT = 64;

namespace pg8 {
constexpr int BM = 256, BK = 64, HALF = 128, HTB = HALF * BK * 2, STAGE_BYTES = 8 * HTB;
__host__ __device__ __forceinline__ int lds_byte(int r, int c) { const int st = (r >> 4) * 2 + (c >> 5), rr = r & 15, cc = c & 31, ob = rr * 64 + cc * 2; return st * 1024 + (ob ^ (((ob >> 9) & 1) << 5)); }
__host__ __device__ __forceinline__ void stage_rc(int b, int& R, int& C) { const int st = b / 1024, sb = b % 1024, swz = sb ^ (((sb >> 9) & 1) << 5); R = (st >> 1) * 16 + swz / 64; C = (st & 1) * 32 + (swz % 64) / 2; }
__host__ __device__ __forceinline__ int perm32(int rho) { const int n = rho >> 4, i = rho & 15; return 8 * (i >> 2) + 4 * n + (i & 3); }

struct Unit { int kind, pm, pn, aux; };

typedef f32x4 Acc[2][2][4][2];

template <class Epi, class Sched>
DI void gemm_phase(LAS unsigned char* lds, const char* Abase, const int K, const int ldb, const Sched& S, const Epi& E) {
    const int tid = threadIdx.x, wid = __builtin_amdgcn_readfirstlane(tid >> 6), lane = tid & 63, wr = wid >> 2, wc = wid & 3, fr = lane & 15, fq = lane >> 4;
    const int nt = K / BK;
    int Rr[2], Cc2[2]; unsigned voffB[2];
#pragma unroll
    for (int i = 0; i < 2; ++i) { int R, C; stage_rc(tid * 16 + i * 8192, R, C); Rr[i] = R; Cc2[i] = C * 2; const int Rb = (R & ~31) + perm32(R & 31); voffB[i] = (unsigned)(Rb * ldb + C) * 2u; }
    const size_t kstep = (size_t)(BK * 2);
    const size_t hstepB = (size_t)HALF * ldb * 2;
    const unsigned ldsw = (unsigned)wid * 1024u;
    const int aoff = lds_byte(wr * 64 + fr, fq * 8), boff = lds_byte(wc * 32 + fr, fq * 8);
#define PG8_SA(b, h) (((b) * 2 + (h)) * HTB)
#define PG8_SB(b, h) ((4 + (b) * 2 + (h)) * HTB)
#define PG8_GLDS(src, dstoff) __builtin_amdgcn_global_load_lds((const unsigned*)(src), (LAS unsigned*)(lds + (dstoff)), 16, 0, 0)
#define PG8_STAGE_B(bufoff, ptr) do { _Pragma("unroll") for (int _i = 0; _i < 2; ++_i) PG8_GLDS((const char*)(ptr) + voffB[_i], (bufoff) + ldsw + _i * 8192); } while (0)
#define PG8_STAGE_A(bufoff, kb, v0, v1) do { PG8_GLDS(Abase + (size_t)(v0) + (kb), (bufoff) + ldsw); PG8_GLDS(Abase + (size_t)(v1) + (kb), (bufoff) + ldsw + 8192); } while (0)
#define PG8_LDA(dst, b, h) do { _Pragma("unroll") for (int m = 0; m < 4; ++m) _Pragma("unroll") for (int k = 0; k < 2; ++k) dst[m][k] = *(const LAS bf16x8*)(lds + PG8_SA(b, h) + aoff + m * 2048 + k * 1024); } while (0)
#define PG8_LDB(dst, b, h) do { _Pragma("unroll") for (int n = 0; n < 2; ++n) _Pragma("unroll") for (int k = 0; k < 2; ++k) dst[n][k] = *(const LAS bf16x8*)(lds + PG8_SB(b, h) + boff + n * 2048 + k * 1024); } while (0)
#define PG8_MMA(ai, bj, At, Bt) do { __builtin_amdgcn_s_setprio(1); _Pragma("unroll") for (int m = 0; m < 4; ++m) _Pragma("unroll") for (int n = 0; n < 2; ++n) _Pragma("unroll") for (int k = 0; k < 2; ++k) \
        acc[ai][bj][m][n] = __builtin_amdgcn_mfma_f32_16x16x32_bf16(Bt[n][k], At[m][k], acc[ai][bj][m][n], 0, 0, 0); __builtin_amdgcn_s_setprio(0); } while (0)
#define PG8_WAIT_V(n) asm volatile("s_waitcnt vmcnt(" #n ")" ::: "memory")
#define PG8_WAIT_L(n) asm volatile("s_waitcnt lgkmcnt(" #n ")" ::: "memory")
#define PG8_BAR __builtin_amdgcn_s_barrier()
#define PG8_SCHED __builtin_amdgcn_sched_barrier(0)
    Unit cur, nxt; int ui = 0;
    if (!S.next(0, cur)) return;
    Acc acc;
#pragma unroll
    for (int a = 0; a < 2; ++a)
#pragma unroll
        for (int b = 0; b < 2; ++b)
#pragma unroll
            for (int m = 0; m < 4; ++m)
#pragma unroll
                for (int n = 0; n < 2; ++n) acc[a][b][m][n] = (f32x4){0.f, 0.f, 0.f, 0.f};
    bf16x8 At[4][2], B0[2][2], B1[2][2];
    unsigned vA00 = S.arow(cur, Rr[0]) + Cc2[0], vA01 = S.arow(cur, Rr[1]) + Cc2[1], vA10 = S.arow(cur, HALF + Rr[0]) + Cc2[0], vA11 = S.arow(cur, HALF + Rr[1]) + Cc2[1];
    const char* cB = S.bptr(cur);
    PG8_STAGE_B(PG8_SB(0, 0), cB); PG8_STAGE_B(PG8_SB(0, 1), cB + hstepB); PG8_STAGE_A(PG8_SA(0, 0), 0, vA00, vA01); PG8_STAGE_A(PG8_SA(0, 1), 0, vA10, vA11);
    if (wr == 1) PG8_BAR;
    PG8_WAIT_V(2); PG8_BAR;
    PG8_STAGE_B(PG8_SB(1, 0), cB + kstep); PG8_STAGE_A(PG8_SA(1, 0), kstep, vA00, vA01); PG8_STAGE_B(PG8_SB(1, 1), cB + hstepB + kstep);
    PG8_WAIT_V(6); PG8_BAR;
    for (;;) {
        const bool has_next = S.next(ui + 1, nxt);
        const char* nB = has_next ? S.bptr(nxt) : cB;
        for (int t = 0; t < nt; t += 2) {
            const bool last = (t == nt - 2);
            if constexpr (Epi::SEGMENTED) { if (t > 0 && E.boundary(t)) E.rescale(acc, cur, t, wr, wc, fr, fq); }
            const size_t k1 = (size_t)(t + 1) * kstep;
            const size_t k2 = last ? 0 : (size_t)(t + 2) * kstep, k3 = k2 + kstep;
            const char* b2 = last ? nB : cB + (size_t)(t + 2) * kstep; const char* b3 = b2 + kstep;
            unsigned w00 = vA00, w01 = vA01, w10 = vA10, w11 = vA11;
            if (last && has_next) { w00 = S.arow(nxt, Rr[0]) + Cc2[0]; w01 = S.arow(nxt, Rr[1]) + Cc2[1]; w10 = S.arow(nxt, HALF + Rr[0]) + Cc2[0]; w11 = S.arow(nxt, HALF + Rr[1]) + Cc2[1]; }
            PG8_LDB(B0, 0, 0); PG8_LDB(B1, 0, 1); PG8_SCHED; PG8_LDA(At, 0, 0); PG8_STAGE_A(PG8_SA(1, 1), k1, vA10, vA11);
            PG8_WAIT_V(8); PG8_WAIT_L(0); PG8_BAR; PG8_MMA(0, 0, At, B0); PG8_MMA(0, 1, At, B1); PG8_BAR; PG8_SCHED;
            PG8_LDA(At, 0, 1); PG8_STAGE_B(PG8_SB(0, 0), b2); PG8_STAGE_B(PG8_SB(0, 1), b2 + hstepB); PG8_STAGE_A(PG8_SA(0, 0), k2, w00, w01);
            PG8_WAIT_V(8); PG8_WAIT_L(0); PG8_BAR; PG8_MMA(1, 0, At, B0); PG8_MMA(1, 1, At, B1); PG8_BAR; PG8_SCHED;
            PG8_LDB(B0, 1, 0); PG8_LDB(B1, 1, 1); PG8_SCHED; PG8_LDA(At, 1, 0); PG8_STAGE_A(PG8_SA(0, 1), k2, w10, w11);
            PG8_WAIT_V(8); PG8_WAIT_L(0); PG8_BAR; PG8_MMA(0, 0, At, B0); PG8_MMA(0, 1, At, B1); PG8_BAR; PG8_SCHED;
            PG8_LDA(At, 1, 1); PG8_STAGE_B(PG8_SB(1, 0), b3); PG8_STAGE_B(PG8_SB(1, 1), b3 + hstepB); PG8_STAGE_A(PG8_SA(1, 0), k3, w00, w01);
            PG8_WAIT_V(8); PG8_WAIT_L(0); PG8_BAR; PG8_MMA(1, 0, At, B0); PG8_MMA(1, 1, At, B1); PG8_BAR; PG8_SCHED;
            if (last) { vA00 = w00; vA01 = w01; vA10 = w10; vA11 = w11; }
        }
        if (wr == 0) PG8_BAR;
        E(acc, cur, wr, wc, fr, fq);
        if (!has_next) break;
#pragma unroll
        for (int a = 0; a < 2; ++a)
#pragma unroll
            for (int b = 0; b < 2; ++b)
#pragma unroll
                for (int m = 0; m < 4; ++m)
#pragma unroll
                    for (int n = 0; n < 2; ++n) acc[a][b][m][n] = (f32x4){0.f, 0.f, 0.f, 0.f};
        cur = nxt; cB = nB; ++ui;
        if (wr == 1) PG8_BAR;
    }
    PG8_WAIT_V(0);
    PG8_BAR;
#undef PG8_SA
#undef PG8_SB
#undef PG8_GLDS
#undef PG8_STAGE_A
#undef PG8_STAGE_B
#undef PG8_LDA
#undef PG8_LDB
#undef PG8_MMA
#undef PG8_WAIT_V
#undef PG8_WAIT_L
#undef PG8_BAR
#undef PG8_SCHED
}

DI bool static_tile(int L, int nM, int nN, int& pm, int& pn) {
    const int nwg = nM * nN; if (L >= nwg) return false;
    int wgid = L; { const int q = nwg / 8, r = nwg % 8, xcd = wgid % 8, off = wgid / 8; wgid = (xcd < r ? xcd * (q + 1) : r * (q + 1) + (xcd - r) * q) + off; }
    const int nig = 8 * nN, gid = wgid / nig, fm = gid * 8, gsz = (nM - fm) < 8 ? (nM - fm) : 8;
    pm = fm + ((wgid % nig) % gsz); pn = (wgid % nig) / gsz; return true;
}
}
using pg8::Unit; using pg8::Acc;

DI float silu_(float v) { return v * sigmoidf_(v); }
DI float softplus_(float x) { return fmaxf(x, 0.f) + __logf(1.0f + __expf(-fabsf(x))); }

struct SchedIn {
    int G, c, ncol, t0, nsplit, t1, nextra; const char* win; const char* wmem;
    DI bool next(int i, Unit& u) const {
        const int L = i * G + c; int pm, pn;
        if (pg8::static_tile(L, T / 256, ncol, pm, pn)) { u.kind = 0; u.pm = pm; u.pn = pn < nsplit ? t0 + pn : t1 + (pn - nsplit); u.aux = 0; return true; }
        const int j = L - (T / 256) * ncol; if (j < nextra) { u.kind = 1; u.pm = j >> 3; u.pn = j & 7; u.aux = 0; return true; }
        return false;
    }
    DI unsigned arow(const Unit& u, int r) const { return (u.kind == 0 ? 0u : (unsigned)(WS_MEMN - WS_XN)) + (unsigned)(u.pm * 256 + r) * 2048u; }
    DI const char* bptr(const Unit& u) const { return (u.kind == 0 ? win : wmem) + (size_t)u.pn * (256 * 1024 * 2); }
};

struct EpiIn {
    static constexpr bool SEGMENTED = false;
    bf16_t *act, *ka, *va, *xbc, *gates, *memkv; float* dt; const float *qgain, *kgain, *dtbias;
    template <int OP> DI void ew(const Acc& acc, bf16_t* dst, size_t pitch, int col0, int row0, int wc, int fq) const {
#pragma unroll
        for (int ai = 0; ai < 2; ++ai)
#pragma unroll
            for (int m = 0; m < 4; ++m) { bf16_t* rowp = dst + (size_t)(row0 + ai * 128 + m * 16) * pitch + col0 + wc * 32 + 8 * fq;
#pragma unroll
                for (int bj = 0; bj < 2; ++bj) { f32x4 v0 = acc[ai][bj][m][0], v1 = acc[ai][bj][m][1];
                    if (OP == 1) { for (int e = 0; e < 4; ++e) { v0[e] = silu_(v0[e]); v1[e] = silu_(v1[e]); } }
                    if (OP == 2) { for (int e = 0; e < 4; ++e) { v0[e] = sigmoidf_(fminf(fmaxf(v0[e], -30.f), 30.f)); v1[e] = sigmoidf_(fminf(fmaxf(v1[e], -30.f), 30.f)); } }
                    u32x4 w; w.x = pk2(v0[0], v0[1]); w.y = pk2(v0[2], v0[3]); w.z = pk2(v1[0], v1[1]); w.w = pk2(v1[2], v1[3]);
                    *(u32x4*)(rowp + bj * 128) = w; }
                asm volatile("" ::: "memory"); }
    }
    DI void headnorm(const Acc& acc, bf16_t* dst, size_t pitch, int col0, int row0, int wc, int fq, const float* gain, float mul) const {
#pragma unroll
        for (int ai = 0; ai < 2; ++ai)
#pragma unroll
            for (int m = 0; m < 4; ++m) {
                float ss = 0.f;
#pragma unroll
                for (int bj = 0; bj < 2; ++bj)
#pragma unroll
                    for (int n = 0; n < 2; ++n) { const f32x4 x = acc[ai][bj][m][n]; ss += (x[0] * x[0] + x[1] * x[1]) + (x[2] * x[2] + x[3] * x[3]); }
                ss += __shfl_xor(ss, 16); ss += __shfl_xor(ss, 32);
                const float rs = __builtin_amdgcn_rsqf(ss * (1.0f / 64.0f) + EPS) * mul;
                bf16_t* rowp = dst + (size_t)(row0 + ai * 128 + m * 16) * pitch + col0 + wc * 64 + 8 * fq;
#pragma unroll
                for (int bj = 0; bj < 2; ++bj) { const f32x4 g0 = *(const f32x4*)(gain + 32 * bj + 8 * fq), g1 = *(const f32x4*)(gain + 32 * bj + 8 * fq + 4);
                    const f32x4 v0 = acc[ai][bj][m][0] * rs * g0, v1 = acc[ai][bj][m][1] * rs * g1;
                    u32x4 w; w.x = pk2(v0[0], v0[1]); w.y = pk2(v0[2], v0[3]); w.z = pk2(v1[0], v1[1]); w.w = pk2(v1[2], v1[3]);
                    *(u32x4*)(rowp + bj * 32) = w; }
                asm volatile("" ::: "memory"); }
    }
    DI void operator()(const Acc& acc, const Unit& u, int wr, int wc, int fr, int fq) const {
        const int row0 = u.pm * 256 + wr * 64 + fr;
        if (u.kind == 1) { ew<0>(acc, memkv, 2048, u.pn * 256, row0, wc, fq); return; }
        const int tl = u.pn;
        if (tl < TL_K) headnorm(acc, act, ACT_P, (tl - TL_Q) * 256, row0, wc, fq, qgain, 0.125f * LOG2E);
        else if (tl < TL_V) headnorm(acc, ka, 1024, (tl - TL_K) * 256, row0, wc, fq, kgain, 1.0f);
        else if (tl < TL_Z) ew<0>(acc, va, 1024, (tl - TL_V) * 256, row0, wc, fq);
        else if (tl < TL_XBC) ew<1>(acc, act, ACT_P, 1024 + (tl - TL_Z) * 256, row0, wc, fq);
        else if (tl < TL_DT) ew<0>(acc, xbc, 3072, (tl - TL_XBC) * 256, row0, wc, fq);
        else if (tl == TL_DT) {
            if (wc == 0) {
                f32x4 b0 = *(const f32x4*)(dtbias + 8 * fq), b1 = *(const f32x4*)(dtbias + 8 * fq + 4);
#pragma unroll
                for (int ai = 0; ai < 2; ++ai)
#pragma unroll
                    for (int m = 0; m < 4; ++m) { float* rowp = dt + (size_t)(row0 + ai * 128 + m * 16) * 32 + 8 * fq;
                        f32x4 v0 = acc[ai][0][m][0] + b0, v1 = acc[ai][0][m][1] + b1;
                        for (int e = 0; e < 4; ++e) { v0[e] = softplus_(v0[e]); v1[e] = softplus_(v1[e]); }
                        *(f32x4*)rowp = v0; *(f32x4*)(rowp + 4) = v1; }
            }
        }
        else if (tl < TL_G) ew<0>(acc, act, ACT_P, 3072 + (tl - TL_QX) * 256, row0, wc, fq);
        else ew<2>(acc, gates, 3072, (tl - TL_G) * 256, row0, wc, fq);
    }
};

struct SchedDense {
    int G, c, nM, nN, K; const char* bbase;
    DI bool next(int i, Unit& u) const { u.kind = 0; u.aux = 0; return pg8::static_tile(i * G + c, nM, nN, u.pm, u.pn); }
    DI unsigned arow(const Unit& u, int r) const { return (unsigned)(u.pm * 256 + r) * (unsigned)(K * 2); }
    DI const char* bptr(const Unit& u) const { return bbase + (size_t)u.pn * 256 * K * 2; }
};

struct EpiMerge {
    static constexpr bool SEGMENTED = true;
    const bf16_t* gates; const float* rstd; bf16_t* merged; int last_seg;
    DI bool boundary(int t) const { return t == 16 || t == 24 || t == 32 || t == 40 || t == 48; }
    DI void load8(const bf16_t* p, float (&g)[8]) const { const u32x4 w = *(const u32x4*)p; g[0] = bf_lo(w.x); g[1] = bf_hi(w.x); g[2] = bf_lo(w.y); g[3] = bf_hi(w.y); g[4] = bf_lo(w.z); g[5] = bf_hi(w.z); g[6] = bf_lo(w.w); g[7] = bf_hi(w.w); }
    DI void rescale(Acc& acc, const Unit& u, int t, int wr, int wc, int fr, int fq) const {
        int row0 = u.pm * 256 + wr * 64 + fr, col0 = u.pn * 256 + wc * 32 + 8 * fq;
        asm volatile("" : "+v"(row0), "+v"(col0));
#pragma unroll
        for (int ai = 0; ai < 2; ++ai)
#pragma unroll
            for (int m = 0; m < 4; ++m) { const int row = row0 + ai * 128 + m * 16; const f32x4 rs = *(const f32x4*)(rstd + (size_t)row * 4);
                if (t == 16 || t == 48) {
                    const bf16_t* gp = gates + (size_t)row * 3072 + col0;
#pragma unroll
                    for (int bj = 0; bj < 2; ++bj) { float ga[8], gb[8]; float f[8];
                        if (t == 16) { load8(gp + bj * 128, ga); load8(gp + 1024 + bj * 128, gb); for (int j = 0; j < 8; ++j) f[j] = ga[j] * fast_rcp(gb[j] * rs[0]); }
                        else { load8(gp + 1024 + bj * 128, ga); load8(gp + 2048 + bj * 128, gb); for (int j = 0; j < 8; ++j) f[j] = ga[j] * rs[3] * fast_rcp(gb[j]); }
                        for (int e = 0; e < 4; ++e) { acc[ai][bj][m][0][e] *= f[e]; acc[ai][bj][m][1][e] *= f[4 + e]; } }
                } else {
                    const float f = (t == 24) ? rs[0] * fast_rcp(rs[1]) : (t == 32) ? rs[1] * fast_rcp(rs[2]) : rs[2] * fast_rcp(rs[3]);
#pragma unroll
                    for (int bj = 0; bj < 2; ++bj) { acc[ai][bj][m][0] *= f; acc[ai][bj][m][1] *= f; }
                }
                asm volatile("" ::: "memory"); }
    }
    DI void operator()(const Acc& acc, const Unit& u, int wr, int wc, int fr, int fq) const {
        const int row0 = u.pm * 256 + wr * 64 + fr, col0 = u.pn * 256 + wc * 32 + 8 * fq;
#pragma unroll
        for (int ai = 0; ai < 2; ++ai)
#pragma unroll
            for (int m = 0; m < 4; ++m) { const int row = row0 + ai * 128 + m * 16; const float r3 = rstd[(size_t)row * 4 + 3];
                const bf16_t* gp = gates + (size_t)row * 3072 + col0 + last_seg * 1024; bf16_t* op = merged + (size_t)row * 1024 + col0;
#pragma unroll
                for (int bj = 0; bj < 2; ++bj) { float g[8]; load8(gp + bj * 128, g); const float s = (last_seg == 1) ? r3 : 1.0f;
                    f32x4 v0 = acc[ai][bj][m][0], v1 = acc[ai][bj][m][1];
                    u32x4 w; w.x = pk2(v0[0] * g[0] * s, v0[1] * g[1] * s); w.y = pk2(v0[2] * g[2] * s, v0[3] * g[3] * s); w.z = pk2(v1[0] * g[4] * s, v1[1] * g[5] * s); w.w = pk2(v1[2] * g[6] * s, v1[3] * g[7] * s);
                    *(u32x4*)(op + bj * 128) = w; }
                asm volatile("" ::: "memory"); }
    }
};

struct EpiOut {
    static constexpr bool SEGMENTED = false;
    const float* x; float* out;
    DI void operator()(const Acc& acc, const Unit& u, int wr, int wc, int fr, int fq) const {
        const int row0 = u.pm * 256 + wr * 64 + fr, col0 = u.pn * 256 + wc * 32 + 8 * fq;
#pragma unroll
        for (int ai = 0; ai < 2; ++ai)
#pragma unroll
            for (int m = 0; m < 4; ++m) { const size_t off = (size_t)(row0 + ai * 128 + m * 16) * 1024 + col0;
#pragma unroll
                for (int bj = 0; bj < 2; ++bj) { const f32x4 x0 = *(const f32x4*)(x + off + bj * 128), x1 = *(const f32x4*)(x + off + bj * 128 + 4);
                    *(f32x4*)(out + off + bj * 128) = x0 + acc[ai][bj][m][0]; *(f32x4*)(out + off + bj * 128 + 4) = x1 + acc[ai][bj][m][1]; } }
    }
};

struct SchedMoE {
    int G, c, NC, tlo, thi; const LAS int* tstart; const LAS int* cnt; const int* tokl; const char* wbase; size_t wexp;
    DI bool next(int i, Unit& u) const {
        const int n = (thi - tlo) * NC; int L = i * G + c; if (L >= n) return false;
        { const int q = n / 8, r = n % 8, xcd = L % 8, off = L / 8; L = (xcd < r ? xcd * (q + 1) : r * (q + 1) + (xcd - r) * q) + off; }
        const int rt = tlo + L / NC; u.pn = L % NC; u.pm = rt; int e = 0;
        for (int j = 1; j < NEXP; ++j) e += (tstart[j] <= rt) ? 1 : 0;
        u.aux = __builtin_amdgcn_readfirstlane(e); u.kind = 0; return true;
    }
    DI unsigned arow(const Unit& u, int r) const {
        if (tokl) { const int e = u.aux, idx = (u.pm - tstart[e]) * 256 + r; const int tok = idx < cnt[e] ? tokl[(size_t)e * T + idx] : 0; return (unsigned)tok * 2048u; }
        return (unsigned)((u.pm - tlo) * 256 + r) * 2048u;
    }
    DI const char* bptr(const Unit& u) const { return wbase + (size_t)u.aux * wexp + (size_t)u.pn * (256 * 1024 * 2); }
};
struct EpiGU {
    static constexpr bool SEGMENTED = false;
    bf16_t* actm; const float *bg, *bu; int tlo;
    DI void operator()(const Acc& acc, const Unit& u, int wr, int wc, int fr, int fq) const {
        const int row0 = (u.pm - tlo) * 256 + wr * 64 + fr, col = u.pn * 128 + wc * 32 + 8 * fq; const size_t eb = (size_t)u.aux * 1024 + col;
        const f32x4 g0 = *(const f32x4*)(bg + eb), g1 = *(const f32x4*)(bg + eb + 4), u0 = *(const f32x4*)(bu + eb), u1 = *(const f32x4*)(bu + eb + 4);
#pragma unroll
        for (int ai = 0; ai < 2; ++ai)
#pragma unroll
            for (int m = 0; m < 4; ++m) { f32x4 a0 = acc[ai][0][m][0] + g0, a1 = acc[ai][0][m][1] + g1, b0 = acc[ai][1][m][0] + u0, b1 = acc[ai][1][m][1] + u1;
                for (int e = 0; e < 4; ++e) { float g = fminf(a0[e], 7.f), uu = fminf(fmaxf(b0[e], -7.f), 7.f); a0[e] = (uu + 1.f) * g * sigmoidf_(1.702f * g);
                                              g = fminf(a1[e], 7.f); uu = fminf(fmaxf(b1[e], -7.f), 7.f); a1[e] = (uu + 1.f) * g * sigmoidf_(1.702f * g); }
                u32x4 w; w.x = pk2(a0[0], a0[1]); w.y = pk2(a0[2], a0[3]); w.z = pk2(a1[0], a1[1]); w.w = pk2(a1[2], a1[3]);
                *(u32x4*)(actm + (size_t)(row0 + ai * 128 + m * 16) * 1024 + col) = w; }
    }
};
struct EpiDown {
    static constexpr bool SEGMENTED = false;
    bf16_t* y; const float* bd; int tlo;
    DI void operator()(const Acc& acc, const Unit& u, int wr, int wc, int fr, int fq) const {
        const int row0 = (u.pm - tlo) * 256 + wr * 64 + fr, col0 = u.pn * 256 + wc * 32 + 8 * fq; const float* bp = bd + (size_t)u.aux * 1024 + col0;
        f32x4 bv[2][2];
#pragma unroll
        for (int bj = 0; bj < 2; ++bj) { bv[bj][0] = *(const f32x4*)(bp + bj * 128); bv[bj][1] = *(const f32x4*)(bp + bj * 128 + 4); }
#pragma unroll
        for (int ai = 0; ai < 2; ++ai)
#pragma unroll
            for (int m = 0; m < 4; ++m) { bf16_t* rowp = y + (size_t)(row0 + ai * 128 + m * 16) * 1024 + col0;
#pragma unroll
                for (int bj = 0; bj < 2; ++bj) { const f32x4 v0 = acc[ai][bj][m][0] + bv[bj][0], v1 = acc[ai][bj][m][1] + bv[bj][1];
                    u32x4 w; w.x = pk2(v0[0], v0[1]); w.y = pk2(v0[2], v0[3]); w.z = pk2(v1[0], v1[1]); w.w = pk2(v1[2], v1[3]);
                    *(u32x4*)(rowp + bj * 128) = w; } }
    }
};
DI void transpose_item(const float* W, int Ns, int k0, int sc, bf16_t* dst, int dpitch, const float* kscale, LAS float* scr, int lane) {
#pragma unroll 8
    for (int i = 0; i < 32; ++i) { const int kk = 2 * i + (lane >> 5); float v = 0.f; if (sc >= 0) v = W[(size_t)(k0 + kk) * Ns + sc + (lane & 31)]; if (kscale) v *= kscale[k0 + kk]; scr[kk * 33 + (lane & 31)] = v; }
    asm volatile("s_waitcnt lgkmcnt(0)" ::: "memory");
    const int c = lane & 7;
#pragma unroll
    for (int j = 0; j < 4; ++j) { const int n = (lane >> 3) + 8 * j; const LAS float* s = scr + (8 * c) * 33 + n;
        u32x4 o; o.x = pk2(s[0 * 33], s[1 * 33]); o.y = pk2(s[2 * 33], s[3 * 33]); o.z = pk2(s[4 * 33], s[5 * 33]); o.w = pk2(s[6 * 33], s[7 * 33]);
        *(u32x4*)(dst + (size_t)n * dpitch + 8 * c) = o; }
    asm volatile("s_waitcnt lgkmcnt(0)" ::: "memory");
}
DI int win_src_col(int nb) {
    const int tile = nb >> 3, sub = nb & 7;
    if (tile < TL_V) { const int base = tile < TL_K ? 256 * tile : 1024 + 256 * (tile - TL_K); return base + 32 * (2 * (sub & 3) + (sub >> 2)); }
    if (tile < TL_Z) return 2048 + 256 * (tile - TL_V) + 32 * sub;
    if (tile < TL_XBC) return 3072 + 256 * (tile - TL_Z) + 32 * sub;
    if (tile < TL_DT) return 5120 + 256 * (tile - TL_XBC) + 32 * sub;
    if (tile == TL_DT) return sub == 0 ? 8192 : -1;
    if (tile < TL_G) return 8224 + 256 * (tile - TL_QX) + 32 * sub;
    return 9248 + 256 * (tile - TL_G) + 32 * sub;
}
DI void rms_row_to_bf16(const float* xrow, const float* gain, bf16_t* orow, int lane) {
    const f32x4* xr = (const f32x4*)xrow + lane; const f32x4* gr = (const f32x4*)gain + lane;
    f32x4 v[4]; float s = 0.f;
#pragma unroll
    for (int j = 0; j < 4; ++j) { v[j] = xr[64 * j]; s += (v[j].x * v[j].x + v[j].y * v[j].y) + (v[j].z * v[j].z + v[j].w * v[j].w); }
    const float rstd = __builtin_amdgcn_rsqf(wave_sum(s) * (1.f / 1024.f) + EPS);
    u32x2* o8 = (u32x2*)orow + lane;
#pragma unroll
    for (int j = 0; j < 4; ++j) { const f32x4 g = gr[64 * j]; u32x2 w; w.x = pk2(v[j].x * rstd * g.x, v[j].y * rstd * g.y); w.y = pk2(v[j].z * rstd * g.z, v[j].w * rstd * g.w); o8[64 * j] = w; }
}

DI int crow(int r, int hi) { return (r & 3) + 8 * (r >> 2) + 4 * hi; }
DI s16x4 vtr(const LAS unsigned char* p) { return __builtin_bit_cast(s16x4, __builtin_amdgcn_ds_read_tr16_b64_v4i16((LAS v4i16_t*)p)); }
#define MFMA32(a, b, c) __builtin_amdgcn_mfma_f32_32x32x16_bf16((a), (b), (c), 0, 0, 0)
#define MFMA16(a, b, c) __builtin_amdgcn_mfma_f32_16x16x32_bf16((a), (b), (c), 0, 0, 0)
DI void tile_load(u32x4 (&r)[4], const bf16_t* g, size_t pitch, int tid) {
#pragma unroll
    for (int i = 0; i < 4; ++i) { const int q = tid + 512 * i, row = q >> 5, ch = q & 31; r[i] = *(const u32x4*)(g + (size_t)row * pitch + ch * 8); }
}
DI void tile_store_k(LAS unsigned char* dst, const u32x4 (&r)[4], int tid) {
#pragma unroll
    for (int i = 0; i < 4; ++i) { const int q = tid + 512 * i, row = q >> 5, ch = q & 31; *(LAS u32x4*)(dst + row * 512 + ((ch ^ (row & 15)) << 4)) = r[i]; }
}
DI void tile_store_v(LAS unsigned char* dst, const u32x4 (&r)[4], int tid) {
#pragma unroll
    for (int i = 0; i < 4; ++i) { const int q = tid + 512 * i, row = q >> 5, ch = q & 31; *(LAS u32x4*)(dst + row * 512 + ((((ch >> 2) ^ (row & 3)) * 4 + (ch & 3)) << 4)) = r[i]; }
}
constexpr int AT_K = 0, AT_V = 32768, AT_BIAS = 65536, AT_BIAS_STRIDE = 260;

DI float softmax_tile(f32x16& s0, f32x16& s1, float& m, float& l, bf16x8 (&pa)[4]) {
    float mx = fmaxf(s0[0], s1[0]);
#pragma unroll
    for (int r = 1; r < 16; ++r) mx = fmaxf(mx, fmaxf(s0[r], s1[r]));
    mx = fmaxf(mx, __shfl_xor(mx, 32));
    const float mn = fmaxf(m, mx), alpha = fast_exp2(m - mn);
    float sum = 0.f;
#pragma unroll
    for (int r = 0; r < 16; ++r) { s0[r] = fast_exp2(s0[r] - mn); s1[r] = fast_exp2(s1[r] - mn); sum += s0[r] + s1[r]; }
    l = l * alpha + sum; m = mn;
    u32x4 w;
    w.x = pk2(s0[0], s0[1]); w.y = pk2(s0[2], s0[3]); w.z = pk2(s0[4], s0[5]); w.w = pk2(s0[6], s0[7]); pa[0] = __builtin_bit_cast(bf16x8, w);
    w.x = pk2(s0[8], s0[9]); w.y = pk2(s0[10], s0[11]); w.z = pk2(s0[12], s0[13]); w.w = pk2(s0[14], s0[15]); pa[1] = __builtin_bit_cast(bf16x8, w);
    w.x = pk2(s1[0], s1[1]); w.y = pk2(s1[2], s1[3]); w.z = pk2(s1[4], s1[5]); w.w = pk2(s1[6], s1[7]); pa[2] = __builtin_bit_cast(bf16x8, w);
    w.x = pk2(s1[8], s1[9]); w.y = pk2(s1[10], s1[11]); w.z = pk2(s1[12], s1[13]); w.w = pk2(s1[14], s1[15]); pa[3] = __builtin_bit_cast(bf16x8, w);
    return alpha;
}
DI bf16x8 v_frag(const LAS unsigned char* vt, int s, int colbyte0, int lane) {
    const int hi = lane >> 5, q_ = (lane & 15) >> 2, p_ = lane & 3, blk = (lane >> 4) & 1;
    const int cb = colbyte0 + blk * 32 + p_ * 8, u = cb >> 6, within = cb & 63;
    const int R = 16 * s + 4 * hi + q_;
    const s16x4 lo = vtr(vt + R * 512 + ((u ^ q_) << 6) + within);
    const s16x4 h4 = vtr(vt + (R + 8) * 512 + ((u ^ q_) << 6) + within);
    return __builtin_shufflevector(lo, h4, 0, 1, 2, 3, 4, 5, 6, 7);
}

DI void attnA_unit(LAS unsigned char* lds, int b, int c, int hq, bf16_t* act, const bf16_t* ka, const bf16_t* va) {
    const int tid = threadIdx.x, lane = tid & 63, wid = __builtin_amdgcn_readfirstlane(tid >> 6), hl = wid >> 1, qh = wid & 1, head = 4 * hq + hl, l31 = lane & 31, hi = lane >> 5;
    const size_t trow = (size_t)b * SEQ + 64 * c + 32 * qh + l31;
    bf16_t* qp = act + trow * ACT_P + 64 * head;
    bf16x8 qf[4];
#pragma unroll
    for (int d0 = 0; d0 < 4; ++d0) qf[d0] = *(const bf16x8*)(qp + 16 * d0 + 8 * hi);
    f32x16 o0, o1;
#pragma unroll
    for (int r = 0; r < 16; ++r) { o0[r] = 0.f; o1[r] = 0.f; }
    float m = -1e30f, l = 0.f;
    const int kc0 = c < 8 ? 0 : c - 8;
    const LAS float* bias = (const LAS float*)(lds + AT_BIAS) + head * AT_BIAS_STRIDE;
    const float b256 = bias[256];
    u32x4 rk[4], rv[4];
    const bf16_t* kb = ka + ((size_t)b * SEQ + 64 * kc0) * 1024 + 256 * hq; const bf16_t* vb = va + ((size_t)b * SEQ + 64 * kc0) * 1024 + 256 * hq;
    tile_load(rk, kb, 1024, tid); tile_load(rv, vb, 1024, tid);
    const int qi = 32 * qh + l31;
    for (int kc = kc0; kc <= c; ++kc) {
        __syncthreads();
        tile_store_k(lds + AT_K, rk, tid); tile_store_v(lds + AT_V, rv, tid);
        if (kc < c) { kb += 64 * 1024; vb += 64 * 1024; tile_load(rk, kb, 1024, tid); tile_load(rv, vb, 1024, tid); }
        __syncthreads();
        const int j = c - kc;
        f32x16 s0, s1;
        if (j >= 3) {
#pragma unroll
            for (int r = 0; r < 16; ++r) { s0[r] = b256; s1[r] = b256; }
        } else {
#pragma unroll
            for (int r = 0; r < 16; ++r) { const int rel0 = 64 * j + qi - crow(r, hi); s0[r] = bias[min(rel0, 128) + 128]; s1[r] = bias[min(rel0 - 32, 128) + 128]; }
        }
#pragma unroll
        for (int d0 = 0; d0 < 4; ++d0) {
            const int ch = 8 * hl + 2 * d0 + hi;
            const bf16x8 k0 = *(const LAS bf16x8*)(lds + AT_K + l31 * 512 + ((ch ^ (l31 & 15)) << 4));
            const bf16x8 k1 = *(const LAS bf16x8*)(lds + AT_K + (32 + l31) * 512 + ((ch ^ (l31 & 15)) << 4));
            s0 = MFMA32(k0, qf[d0], s0); s1 = MFMA32(k1, qf[d0], s1);
        }
        bf16x8 pa[4];
        const float alpha = softmax_tile(s0, s1, m, l, pa);
#pragma unroll
        for (int r = 0; r < 16; ++r) { o0[r] *= alpha; o1[r] *= alpha; }
#pragma unroll
        for (int s = 0; s < 4; ++s) {
            const bf16x8 v0 = v_frag(lds + AT_V, s, (64 * hl) * 2, lane), v1 = v_frag(lds + AT_V, s, (64 * hl + 32) * 2, lane);
            o0 = MFMA32(v0, pa[s], o0); o1 = MFMA32(v1, pa[s], o1);
        }
    }
    const float lt = l + __shfl_xor(l, 32), inv = fast_rcp(lt);
#pragma unroll
    for (int rg = 0; rg < 4; ++rg) {
        u32x2 w0, w1; w0.x = pk2(o0[4 * rg] * inv, o0[4 * rg + 1] * inv); w0.y = pk2(o0[4 * rg + 2] * inv, o0[4 * rg + 3] * inv);
        w1.x = pk2(o1[4 * rg] * inv, o1[4 * rg + 1] * inv); w1.y = pk2(o1[4 * rg + 2] * inv, o1[4 * rg + 3] * inv);
        *(u32x2*)(qp + 8 * rg + 4 * hi) = w0; *(u32x2*)(qp + 32 + 8 * rg + 4 * hi) = w1;
    }
}

DI void attnC_unit(LAS unsigned char* lds, int b, int hx, int rb, bf16_t* act, const bf16_t* kx, const bf16_t* memkv) {
    const int tid = threadIdx.x, lane = tid & 63, wid = __builtin_amdgcn_readfirstlane(tid >> 6), rg = wid >> 1, dh = wid & 1, l31 = lane & 31, hi = lane >> 5;
    const size_t trow = (size_t)b * SEQ + 128 * rb + 32 * rg + l31;
    bf16_t* qp = act + trow * ACT_P + 3072 + 256 * hx;
    float ssq = 0.f;
#pragma unroll
    for (int d0 = 0; d0 < 16; ++d0) { const bf16x8 q = *(const bf16x8*)(qp + 16 * d0 + 8 * hi);
#pragma unroll
        for (int e = 0; e < 8; ++e) { const float v = bf2f((bf16_t)q[e]); ssq += v * v; } }
    ssq += __shfl_xor(ssq, 32);
    const float rstd = __builtin_amdgcn_rsqf(ssq * (1.f / 256.f) + EPS);
    f32x16 o[4];
#pragma unroll
    for (int i = 0; i < 4; ++i)
#pragma unroll
        for (int r = 0; r < 16; ++r) o[i][r] = 0.f;
    float m = -1e30f, l = 0.f;
    for (int j = 0; j < 4; ++j) {
        u32x4 rk[4], rv[4];
        tile_load(rk, kx + ((size_t)b * MEMLEN + 64 * j) * 1024 + 256 * hx, 1024, tid);
        tile_load(rv, memkv + ((size_t)b * MEMLEN + 64 * j) * 2048 + 1024 + 256 * hx, 2048, tid);
        __syncthreads();
        tile_store_k(lds + AT_K, rk, tid); tile_store_v(lds + AT_V, rv, tid);
        __syncthreads();
        f32x16 s0, s1;
#pragma unroll
        for (int r = 0; r < 16; ++r) { s0[r] = 0.f; s1[r] = 0.f; }
#pragma unroll
        for (int d0 = 0; d0 < 16; ++d0) {
            const int ch = 2 * d0 + hi;
            const bf16x8 qfr = *(const bf16x8*)(qp + 16 * d0 + 8 * hi);
            const bf16x8 k0 = *(const LAS bf16x8*)(lds + AT_K + l31 * 512 + ((ch ^ (l31 & 15)) << 4));
            const bf16x8 k1 = *(const LAS bf16x8*)(lds + AT_K + (32 + l31) * 512 + ((ch ^ (l31 & 15)) << 4));
            s0 = MFMA32(k0, qfr, s0); s1 = MFMA32(k1, qfr, s1);
        }
#pragma unroll
        for (int r = 0; r < 16; ++r) { s0[r] *= rstd; s1[r] *= rstd; }
        bf16x8 pa[4];
        const float alpha = softmax_tile(s0, s1, m, l, pa);
#pragma unroll
        for (int i = 0; i < 4; ++i)
#pragma unroll
            for (int r = 0; r < 16; ++r) o[i][r] *= alpha;
#pragma unroll
        for (int s = 0; s < 4; ++s)
#pragma unroll
            for (int i = 0; i < 4; ++i) { const bf16x8 vf = v_frag(lds + AT_V, s, (128 * dh + 32 * i) * 2, lane); o[i] = MFMA32(vf, pa[s], o[i]); }
    }
    const float lt = l + __shfl_xor(l, 32), inv = fast_rcp(lt);
    __syncthreads();
#pragma unroll
    for (int i = 0; i < 4; ++i)
#pragma unroll
        for (int g4 = 0; g4 < 4; ++g4) { u32x2 w; w.x = pk2(o[i][4 * g4] * inv, o[i][4 * g4 + 1] * inv); w.y = pk2(o[i][4 * g4 + 2] * inv, o[i][4 * g4 + 3] * inv);
            *(u32x2*)(qp + 128 * dh + 32 * i + 8 * g4 + 4 * hi) = w; }
}

constexpr int MB_XS = 0, MB_XDT = 8192, MB_XDTW = 16384, MB_BM = 24576, MB_CM = 40960, MB_YD = 57344, MB_YO = 74752, MB_ACS = 92160, MB_DTL = 92416, MB_YSTR = 272;
DI bf16x8 tr_pair(const LAS unsigned char* base, int rowbytes, int row_lo, int row_hi, int col0, int lane) {
    const int i = lane & 15; const int off = (i >> 2) * rowbytes + (col0 + 4 * (i & 3)) * 2;
    const s16x4 lo = vtr(base + row_lo * rowbytes + off), h4 = vtr(base + row_hi * rowbytes + off);
    return __builtin_shufflevector(lo, h4, 0, 1, 2, 3, 4, 5, 6, 7);
}
DI void mamba_unit(LAS unsigned char* lds, int b, int h, const bf16_t* xbc, const float* dtp, bf16_t* act, float* ssq_out,
                   const float* conv_w, const float* conv_b, const float* a_log, const float* d_skip) {
    const int tid = threadIdx.x, lane = tid & 63, wid = __builtin_amdgcn_readfirstlane(tid >> 6), fr = lane & 15, fq = lane >> 4, g = h >> 3;
    const float A_h = -__expf(a_log[h]), D_h = d_skip[h];
    const int cc = tid % 40, lr = tid / 40; const bool conv_on = tid < 320;
    const int gcol = cc < 8 ? 64 * h + 8 * cc : (cc < 24 ? 2048 + 128 * g + 8 * (cc - 8) : 2560 + 128 * g + 8 * (cc - 24));
    float cw[4][8], cbias[8];
    if (conv_on) {
#pragma unroll
        for (int e = 0; e < 8; ++e) { cbias[e] = conv_b[gcol + e];
#pragma unroll
            for (int i = 0; i < 4; ++i) cw[i][e] = conv_w[i * 3072 + gcol + e]; }
    }
    LAS unsigned char* cdst = cc < 8 ? lds + MB_XS + cc * 16 : (cc < 24 ? lds + MB_BM + (cc - 8) * 16 : lds + MB_CM + (cc - 24) * 16);
    const int cstride = cc < 8 ? 128 : 256;
    f32x4 Z[8];
#pragma unroll
    for (int i = 0; i < 8; ++i) Z[i] = (f32x4){0.f, 0.f, 0.f, 0.f};
    LAS float* acs = (LAS float*)(lds + MB_ACS); LAS float* dtl = (LAS float*)(lds + MB_DTL);
    for (int c = 0; c < 64; ++c) {
        const size_t t0 = (size_t)b * SEQ + 64 * c;
        __syncthreads();
        if (conv_on) {
            float win[3][8]; const int l0 = 8 * lr;
#pragma unroll
            for (int e = 0; e < 8; ++e) { win[0][e] = 0.f; win[1][e] = 0.f; win[2][e] = 0.f; }
#pragma unroll
            for (int k = 0; k < 11; ++k) {
                const int pos = 64 * c + l0 - 3 + k; float cur[8];
                if (pos >= 0) { const u32x4 w = *(const u32x4*)(xbc + ((size_t)b * SEQ + pos) * 3072 + gcol);
                    cur[0] = bf_lo(w.x); cur[1] = bf_hi(w.x); cur[2] = bf_lo(w.y); cur[3] = bf_hi(w.y); cur[4] = bf_lo(w.z); cur[5] = bf_hi(w.z); cur[6] = bf_lo(w.w); cur[7] = bf_hi(w.w); }
                else {
#pragma unroll
                    for (int e = 0; e < 8; ++e) cur[e] = 0.f; }
                if (k >= 3) { float o[8];
#pragma unroll
                    for (int e = 0; e < 8; ++e) { const float v = cbias[e] + cw[0][e] * win[0][e] + cw[1][e] * win[1][e] + cw[2][e] * win[2][e] + cw[3][e] * cur[e]; o[e] = silu_(v); }
                    u32x4 w; w.x = pk2(o[0], o[1]); w.y = pk2(o[2], o[3]); w.z = pk2(o[4], o[5]); w.w = pk2(o[6], o[7]);
                    *(LAS u32x4*)(cdst + (l0 + k - 3) * cstride) = w; }
#pragma unroll
                for (int e = 0; e < 8; ++e) { win[0][e] = win[1][e]; win[1][e] = win[2][e]; win[2][e] = cur[e]; }
            }
        }
        if (wid == 7) {
            const float dtv = dtp[(t0 + lane) * 32 + h]; float a = dtv * A_h;
#pragma unroll
            for (int o = 1; o < 64; o <<= 1) { const float u = __shfl_up(a, o); if (lane >= o) a += u; }
            acs[lane] = a; dtl[lane] = dtv;
        }
        __syncthreads();
        { const int l = tid >> 3, pc = tid & 7; const u32x4 w = *(const LAS u32x4*)(lds + MB_XS + l * 128 + pc * 16);
          const float d = dtl[l], dw = d * __expf(acs[63] - acs[l]);
          u32x4 a, bw; a.x = pk2(bf_lo(w.x) * d, bf_hi(w.x) * d); a.y = pk2(bf_lo(w.y) * d, bf_hi(w.y) * d); a.z = pk2(bf_lo(w.z) * d, bf_hi(w.z) * d); a.w = pk2(bf_lo(w.w) * d, bf_hi(w.w) * d);
          bw.x = pk2(bf_lo(w.x) * dw, bf_hi(w.x) * dw); bw.y = pk2(bf_lo(w.y) * dw, bf_hi(w.y) * dw); bw.z = pk2(bf_lo(w.z) * dw, bf_hi(w.z) * dw); bw.w = pk2(bf_lo(w.w) * dw, bf_hi(w.w) * dw);
          *(LAS u32x4*)(lds + MB_XDT + l * 128 + pc * 16) = a; *(LAS u32x4*)(lds + MB_XDTW + l * 128 + pc * 16) = bw; }
        __syncthreads();
        if (wid >= 4) {
            const int d = wid - 4; const float la = acs[16 * d + fr];
            f32x4 X[4];
#pragma unroll
            for (int si = 0; si < 4; ++si) { X[si] = (f32x4){0.f, 0.f, 0.f, 0.f};
                if (si <= d) {
#pragma unroll
                    for (int ks = 0; ks < 4; ++ks) { const bf16x8 a = *(const LAS bf16x8*)(lds + MB_BM + (16 * si + fr) * 256 + (32 * ks + 8 * fq) * 2);
                        const bf16x8 bb = *(const LAS bf16x8*)(lds + MB_CM + (16 * d + fr) * 256 + (32 * ks + 8 * fq) * 2); X[si] = MFMA16(a, bb, X[si]); }
                    const f32x4 sa = *(const LAS f32x4*)(acs + 16 * si + 4 * fq);
#pragma unroll
                    for (int r = 0; r < 4; ++r) { const int s_abs = 16 * si + 4 * fq + r, l_abs = 16 * d + fr; X[si][r] = (s_abs <= l_abs) ? X[si][r] * __expf(la - sa[r]) : 0.f; }
                } }
            bf16x8 Xp[2];
#pragma unroll
            for (int sb = 0; sb < 2; ++sb) { u32x4 w; w.x = pk2(X[2 * sb][0], X[2 * sb][1]); w.y = pk2(X[2 * sb][2], X[2 * sb][3]); w.z = pk2(X[2 * sb + 1][0], X[2 * sb + 1][1]); w.w = pk2(X[2 * sb + 1][2], X[2 * sb + 1][3]); Xp[sb] = __builtin_bit_cast(bf16x8, w); }
#pragma unroll
            for (int pt = 0; pt < 4; ++pt) { f32x4 y = (f32x4){0.f, 0.f, 0.f, 0.f};
#pragma unroll
                for (int sb = 0; sb < 2; ++sb) { if (2 * sb <= d) { const bf16x8 a = tr_pair(lds + MB_XDT, 128, 32 * sb + 4 * fq, 32 * sb + 16 + 4 * fq, 16 * pt, lane); y = MFMA16(a, Xp[sb], y); } }
                *(LAS f32x4*)(lds + MB_YD + (16 * d + fr) * MB_YSTR + (16 * pt + 4 * fq) * 4) = y; }
        } else {
            const int pw = wid;
            bf16x8 Zp[4];
#pragma unroll
            for (int nb = 0; nb < 4; ++nb) { u32x4 w; w.x = pk2(Z[2 * nb][0], Z[2 * nb][1]); w.y = pk2(Z[2 * nb][2], Z[2 * nb][3]); w.z = pk2(Z[2 * nb + 1][0], Z[2 * nb + 1][1]); w.w = pk2(Z[2 * nb + 1][2], Z[2 * nb + 1][3]); Zp[nb] = __builtin_bit_cast(bf16x8, w); }
#pragma unroll
            for (int lt = 0; lt < 4; ++lt) { f32x4 y = (f32x4){0.f, 0.f, 0.f, 0.f};
#pragma unroll
                for (int nb = 0; nb < 4; ++nb) { const LAS unsigned char* cp = lds + MB_CM + (16 * lt + fr) * 256 + (32 * nb + 4 * fq) * 2;
                    const s16x4 lo = *(const LAS s16x4*)cp, h4 = *(const LAS s16x4*)(cp + 32); const bf16x8 bfr = __builtin_shufflevector(lo, h4, 0, 1, 2, 3, 4, 5, 6, 7);
                    y = MFMA16(Zp[nb], bfr, y); }
                const float ea = __expf(acs[16 * lt + fr]); y *= ea;
                *(LAS f32x4*)(lds + MB_YO + (16 * lt + fr) * MB_YSTR + (16 * pw + 4 * fq) * 4) = y; }
            const float dec = __expf(acs[63]);
            bf16x8 xw[2];
#pragma unroll
            for (int lb = 0; lb < 2; ++lb) xw[lb] = tr_pair(lds + MB_XDTW, 128, 32 * lb + 8 * fq, 32 * lb + 8 * fq + 4, 16 * pw, lane);
#pragma unroll
            for (int nt = 0; nt < 8; ++nt) { Z[nt] *= dec;
#pragma unroll
                for (int lb = 0; lb < 2; ++lb) { const bf16x8 a = tr_pair(lds + MB_BM, 256, 32 * lb + 8 * fq, 32 * lb + 8 * fq + 4, 16 * nt, lane); Z[nt] = MFMA16(a, xw[lb], Z[nt]); } }
        }
        __syncthreads();
        { const int l = tid >> 3, pc = tid & 7;
          const f32x4 a0 = *(const LAS f32x4*)(lds + MB_YD + l * MB_YSTR + pc * 32), a1 = *(const LAS f32x4*)(lds + MB_YD + l * MB_YSTR + pc * 32 + 16);
          const f32x4 b0 = *(const LAS f32x4*)(lds + MB_YO + l * MB_YSTR + pc * 32), b1 = *(const LAS f32x4*)(lds + MB_YO + l * MB_YSTR + pc * 32 + 16);
          const u32x4 xw_ = *(const LAS u32x4*)(lds + MB_XS + l * 128 + pc * 16);
          bf16_t* zp = act + (t0 + l) * ACT_P + 1024 + 64 * h + 8 * pc; const u32x4 zw = *(const u32x4*)zp;
          float y[8];
          y[0] = (a0[0] + b0[0] + D_h * bf_lo(xw_.x)) * bf_lo(zw.x); y[1] = (a0[1] + b0[1] + D_h * bf_hi(xw_.x)) * bf_hi(zw.x);
          y[2] = (a0[2] + b0[2] + D_h * bf_lo(xw_.y)) * bf_lo(zw.y); y[3] = (a0[3] + b0[3] + D_h * bf_hi(xw_.y)) * bf_hi(zw.y);
          y[4] = (a1[0] + b1[0] + D_h * bf_lo(xw_.z)) * bf_lo(zw.z); y[5] = (a1[1] + b1[1] + D_h * bf_hi(xw_.z)) * bf_hi(zw.z);
          y[6] = (a1[2] + b1[2] + D_h * bf_lo(xw_.w)) * bf_lo(zw.w); y[7] = (a1[3] + b1[3] + D_h * bf_hi(xw_.w)) * bf_hi(zw.w);
          float ss = 0.f;
#pragma unroll
          for (int e = 0; e < 8; ++e) ss += y[e] * y[e];
          ss += __shfl_xor(ss, 1); ss += __shfl_xor(ss, 2); ss += __shfl_xor(ss, 4);
          if (pc == 0) ssq_out[(t0 + l) * 32 + h] = ss;
          u32x4 w; w.x = pk2(y[0], y[1]); w.y = pk2(y[2], y[3]); w.z = pk2(y[4], y[5]); w.w = pk2(y[6], y[7]); *(u32x4*)zp = w; }
    }
}
constexpr int RT_W = 0, RT_CNT = 131072, RT_BASE = 131072 + 128;
constexpr int MO_TS = 131072 + 256, MO_CNT = 131072 + 512;

DI void router_phase(LAS unsigned char* lds, int vcu, int G, const float* x1, const float* norm_ffn, const float* w_router, const float* b_router,
                     bf16_t* h2, int* sel_e, int* sel_r, float* sel_w, int* tokl, unsigned* gcnt) {
    const int tid = threadIdx.x, lane = tid & 63, wid = __builtin_amdgcn_readfirstlane(tid >> 6), l31 = lane & 31, hi = lane >> 5;
    LAS float* Wl = (LAS float*)(lds + RT_W); LAS unsigned* lcnt = (LAS unsigned*)(lds + RT_CNT); LAS unsigned* lbase = (LAS unsigned*)(lds + RT_BASE);
    for (int idx = tid; idx < 1024 * 32; idx += 512) Wl[idx] = w_router[idx] * norm_ffn[idx >> 5];
    if (tid < 32) lcnt[tid] = 0u;
    __syncthreads();
    f32x4 gn[4];
#pragma unroll
    for (int i = 0; i < 4; ++i) gn[i] = *(const f32x4*)(norm_ffn + 4 * lane + 256 * i);
    for (int tile = vcu + G * wid; tile < T / 32; tile += G * 8) {
        const int t0 = tile * 32;
        f32x16 acc;
#pragma unroll
        for (int r = 0; r < 16; ++r) acc[r] = 0.f;
        float ssq = 0.f;
        const float* xr = x1 + (size_t)(t0 + l31) * 1024 + 4 * hi;
#pragma unroll 4
        for (int c = 0; c < 128; ++c) {
            const f32x4 xv = *(const f32x4*)(xr + 8 * c);
            ssq += (xv[0] * xv[0] + xv[1] * xv[1]) + (xv[2] * xv[2] + xv[3] * xv[3]);
#pragma unroll
            for (int u = 0; u < 4; ++u) { const float a = Wl[(8 * c + 4 * hi + u) * 32 + l31]; acc = __builtin_amdgcn_mfma_f32_32x32x2f32(a, xv[u], acc, 0, 0, 0); }
        }
        ssq += __shfl_xor(ssq, 32);
        const float rstd = __builtin_amdgcn_rsqf(ssq * (1.f / 1024.f) + EPS);
        float lg[16];
#pragma unroll
        for (int r = 0; r < 16; ++r) lg[r] = acc[r] * rstd + b_router[crow(r, hi)];
        float sv[4]; int si[4];
#pragma unroll
        for (int k = 0; k < 4; ++k) {
            float bv = lg[0]; int bi = crow(0, hi);
#pragma unroll
            for (int r = 1; r < 16; ++r) { const int id = crow(r, hi); if (lg[r] > bv) { bv = lg[r]; bi = id; } }
            const float pv = __shfl_xor(bv, 32); const int pi = __shfl_xor(bi, 32);
            if (pv > bv || (pv == bv && pi < bi)) { bv = pv; bi = pi; }
            sv[k] = bv; si[k] = bi;
#pragma unroll
            for (int r = 0; r < 16; ++r) if (crow(r, hi) == bi) lg[r] = -INFINITY;
        }
        const float e1 = __expf(sv[1] - sv[0]), e2 = __expf(sv[2] - sv[0]), e3 = __expf(sv[3] - sv[0]), inv = 1.0f / (1.0f + e1 + e2 + e3);
        if (hi == 0) {
            const int t = t0 + l31; const float wv[4] = {inv, e1 * inv, e2 * inv, e3 * inv};
#pragma unroll
            for (int k = 0; k < 4; ++k) { const unsigned lr = atomicAdd((unsigned*)&lcnt[si[k]], 1u); sel_e[t * 4 + k] = si[k]; sel_r[t * 4 + k] = (int)lr; sel_w[t * 4 + k] = wv[k]; }
        }
        for (int rr = 0; rr < 32; ++rr) {
            const float rs = __shfl(rstd, rr);
            const f32x4* xrow = (const f32x4*)(x1 + (size_t)(t0 + rr) * 1024) + lane; u32x2* orow = (u32x2*)(h2 + (size_t)(t0 + rr) * 1024) + lane;
#pragma unroll
            for (int i = 0; i < 4; ++i) { const f32x4 v = xrow[64 * i]; u32x2 w; w.x = pk2(v.x * rs * gn[i].x, v.y * rs * gn[i].y); w.y = pk2(v.z * rs * gn[i].z, v.w * rs * gn[i].w); orow[64 * i] = w; }
        }
    }
    __syncthreads();
    if (tid < 32) lbase[tid] = atomicAdd(&gcnt[tid], lcnt[tid]);
    __syncthreads();
    for (int tile = vcu + G * wid; tile < T / 32; tile += G * 8) {
        if (hi == 0) { const int t = tile * 32 + l31;
#pragma unroll
            for (int k = 0; k < 4; ++k) { const int e = sel_e[t * 4 + k]; const int r = sel_r[t * 4 + k] + (int)lbase[e]; sel_r[t * 4 + k] = r; tokl[(size_t)e * T + r] = t; } }
    }
}

DI int moe_tables(LAS unsigned char* lds, const unsigned* gcnt) {
    LAS int* ts = (LAS int*)(lds + MO_TS); LAS int* cn = (LAS int*)(lds + MO_CNT);
    __syncthreads();
    if (threadIdx.x < 32) cn[threadIdx.x] = (int)gcnt[threadIdx.x];
    __syncthreads();
    if (threadIdx.x == 0) { int s = 0; for (int e = 0; e < NEXP; ++e) { ts[e] = s; s += (cn[e] + 255) >> 8; } ts[NEXP] = s; }
    __syncthreads();
    return ts[NEXP];
}

DI void combine_phase(LAS unsigned char* lds, int vcu, int G, int tlo, int thi, const bf16_t* y, const int* sel_e, const int* sel_r, const float* sel_w, float* out) {
    const int lane = threadIdx.x & 63, wid = threadIdx.x >> 6; const LAS int* ts = (const LAS int*)(lds + MO_TS);
    for (int t = vcu * 8 + wid; t < T; t += G * 8) {
        f32x4 a[4]; float* op = out + (size_t)t * 1024 + 8 * lane;
        a[0] = *(const f32x4*)op; a[1] = *(const f32x4*)(op + 4); a[2] = *(const f32x4*)(op + 512); a[3] = *(const f32x4*)(op + 516);
        bool any = false;
#pragma unroll
        for (int k = 0; k < 4; ++k) {
            const int e = sel_e[t * 4 + k], r = sel_r[t * 4 + k]; const int row = ts[e] * 256 + r, tile = row >> 8;
            if (tile >= tlo && tile < thi) { any = true; const float w = sel_w[t * 4 + k]; const bf16_t* yp = y + (size_t)(row - tlo * 256) * 1024 + 8 * lane;
                const u32x4 v0 = *(const u32x4*)yp, v1 = *(const u32x4*)(yp + 512);
                a[0][0] += w * bf_lo(v0.x); a[0][1] += w * bf_hi(v0.x); a[0][2] += w * bf_lo(v0.y); a[0][3] += w * bf_hi(v0.y);
                a[1][0] += w * bf_lo(v0.z); a[1][1] += w * bf_hi(v0.z); a[1][2] += w * bf_lo(v0.w); a[1][3] += w * bf_hi(v0.w);
                a[2][0] += w * bf_lo(v1.x); a[2][1] += w * bf_hi(v1.x); a[2][2] += w * bf_lo(v1.y); a[2][3] += w * bf_hi(v1.y);
                a[3][0] += w * bf_lo(v1.z); a[3][1] += w * bf_hi(v1.z); a[3][2] += w * bf_lo(v1.w); a[3][3] += w * bf_hi(v1.w); }
        }
        if (any) { *(f32x4*)op = a[0]; *(f32x4*)(op + 4) = a[1]; *(f32x4*)(op + 512) = a[2]; *(f32x4*)(op + 516) = a[3]; }
    }
}
#ifndef MK_N_LAUNCHES
#define MK_N_LAUNCHES 1
#endif
#ifndef MK_BRANCHES
#define MK_BRANCHES 15
#endif
constexpr int N_PHASES = 15;
constexpr int LDS_BYTES = 147456;
constexpr int NTHREADS = 512;

struct Args { const float* in[30]; float* out; unsigned char* ws; int ph_lo, ph_hi; };
enum { I_x = 0, I_mem = 1, I_norm_mix = 2, I_w_in = 3, I_a_q_gain = 4, I_a_k_gain = 5, I_a_rel_bias = 6, I_conv_w = 7, I_conv_b = 8, I_dt_bias = 9, I_a_log = 10, I_d_skip = 11, I_ssm_norm = 12, I_norm_mem = 13, I_w_mem_kv = 14, I_x_q_gain = 15, I_x_k_gain = 16, I_w_br_a = 17, I_w_br_b = 18, I_w_br_c = 19, I_w_out = 20, I_norm_ffn = 21, I_w_router = 22, I_b_router = 23, I_w_gate = 24, I_b_gate = 25, I_w_up = 26, I_b_up = 27, I_w_down = 28, I_b_down = 29 };

#define WIN WSP(bf16_t, WS_WIN)
#define WCAT WSP(bf16_t, WS_WCAT)
#define WOUT WSP(bf16_t, WS_WOUT)
#define WMEM WSP(bf16_t, WS_WMEM)
#define DTB WSP(float, WS_DT)
#define SSQ WSP(float, WS_SSQ)
#define RSTD WSP(float, WS_RSTD)
#define KX WSP(bf16_t, WS_KX)
#define MEMKV WSP(bf16_t, WS_MEMKV)
#define XN WSP(bf16_t, WS_XN)
#define MEMN WSP(bf16_t, WS_MEMN)
#define ACT WSP(bf16_t, WS_ACT)
#define KA WSP(bf16_t, WS_KA)
#define VA WSP(bf16_t, WS_VA)
#define XBC WSP(bf16_t, WS_XBC)
#define GATES WSP(bf16_t, WS_GATES)
#define MERGED WSP(bf16_t, WS_MERGED)
#define H2 WSP(bf16_t, MOE_H2)
#define WGU WSP(bf16_t, MOE_WGU)
#define WD WSP(bf16_t, MOE_WD)
#define ACTM WSP(bf16_t, MOE_ACTM)
#define YB WSP(bf16_t, MOE_Y)
#define SELE WSP(int, MOE_SELE)
#define SELR WSP(int, MOE_SELR)
#define SELW WSP(float, MOE_SELW)
#define TOKL WSP(int, MOE_TOKL)
#define GCNT (WSP(unsigned, WS_CTL) + CW_CNT)
#define EI_INIT const EpiIn EI{ACT, KA, VA, XBC, GATES, MEMKV, DTB, AP(a_q_gain), AP(a_k_gain), AP(dt_bias)}
typedef const __attribute__((address_space(4))) unsigned long long* KW;
DI KW launder(KW p) { asm volatile("" : "+s"(p)); return p; }
#define AP(name) ((const float*)kq[I_##name])
#define PHASE_ARGS const KW kq = launder(kp); unsigned char* const ws = (unsigned char*)kq[31]; (void)ws
#define WSP(type, off) ((type*)(ws + (off)))
__global__ void __launch_bounds__(NTHREADS, 2) mega_fwd(Args a_unused) {
    extern __shared__ __attribute__((aligned(16))) unsigned char lds_raw[];
    LAS unsigned char* lds = (LAS unsigned char*)lds_raw;
    const KW kp = (KW)__builtin_amdgcn_kernarg_segment_ptr();
    const int tid = threadIdx.x, lane = tid & 63, wid = __builtin_amdgcn_readfirstlane(tid >> 6);
    const int G = gridDim.x, bx = blockIdx.x, vcu = (G % 8 == 0) ? (bx % 8) * (G / 8) + bx / 8 : bx;
    const int lo = (int)(unsigned)kp[32], hi = (int)(kp[32] >> 32);
#ifndef MK_PHASE_MASK
#define MK_PHASE_MASK 0x7fff
#endif
#define IN(k) (((MK_PHASE_MASK >> (k)) & 1) && lo <= (k) && (k) < hi)
#define SEAM(k) do { if (IN(k) && IN((k) + 1)) { cg::this_grid().sync(); } } while (0)
    const int gw = vcu * 8 + wid, NGW = G * 8;
    LAS float* scr = (LAS float*)(lds + wid * 16384);

    if (IN(0)) { PHASE_ARGS;
        constexpr int I_IN = 16 * 392, I_MEM = 16 * 64, I_A = 16 * 32, I_B = 32 * 32, I_C = 16 * 32, I_O = 16 * 32, NIT = I_IN + I_MEM + I_A + I_B + I_C + I_O;
        for (int it = gw; it < NIT; it += NGW) {
            int r = it;
            if (r < I_IN) { const int kb = r / 392, nb = r % 392; transpose_item(AP(w_in), IN_COLS, 64 * kb, win_src_col(nb), WIN + (size_t)(32 * nb) * 1024 + 64 * kb, 1024, nullptr, scr, lane); continue; } r -= I_IN;
            if (r < I_MEM) { const int kb = r / 64, nb = r % 64; transpose_item(AP(w_mem_kv), 2048, 64 * kb, 32 * nb, WMEM + (size_t)(32 * nb) * 1024 + 64 * kb, 1024, nullptr, scr, lane); continue; } r -= I_MEM;
            if (r < I_A) { const int kb = r / 32, nb = r % 32; transpose_item(AP(w_br_a), 1024, 64 * kb, 32 * nb, WCAT + (size_t)(32 * nb) * 4096 + 64 * kb, 4096, nullptr, scr, lane); continue; } r -= I_A;
            if (r < I_B) { const int kb = r / 32, nb = r % 32; transpose_item(AP(w_br_b), 1024, 64 * kb, 32 * nb, WCAT + (size_t)(32 * nb) * 4096 + 1024 + 64 * kb, 4096, AP(ssm_norm), scr, lane); continue; } r -= I_B;
            if (r < I_C) { const int kb = r / 32, nb = r % 32; transpose_item(AP(w_br_c), 1024, 64 * kb, 32 * nb, WCAT + (size_t)(32 * nb) * 4096 + 3072 + 64 * kb, 4096, nullptr, scr, lane); continue; } r -= I_C;
            { const int kb = r / 32, nb = r % 32; transpose_item(AP(w_out), 1024, 64 * kb, 32 * nb, WOUT + (size_t)(32 * nb) * 1024 + 64 * kb, 1024, nullptr, scr, lane); }
        }
        for (int m = gw; m < T; m += NGW) rms_row_to_bf16(AP(x) + (size_t)m * 1024, AP(norm_mix), XN + (size_t)m * 1024, lane);
        for (int m = gw; m < NBATCH * MEMLEN; m += NGW) rms_row_to_bf16(AP(mem) + (size_t)m * 1024, AP(norm_mem), MEMN + (size_t)m * 1024, lane);
    }
    SEAM(0);
    if (IN(1)) { PHASE_ARGS; EI_INIT;
        const SchedIn S{G, bx, 16, TL_Q, 12, TL_QX, 64, (const char*)WIN, (const char*)WMEM};
        pg8::gemm_phase(lds, (const char*)XN, 1024, 1024, S, EI);
    }
    SEAM(1);
    if (IN(2)) { PHASE_ARGS;
        for (int w = gw; w < NBATCH * MEMLEN * 4; w += NGW) {
            const int row = w >> 2, hx = w & 3; const u32x2 kv = *(const u32x2*)(MEMKV + (size_t)row * 2048 + 256 * hx + 4 * lane);
            const float k0 = bf_lo(kv.x), k1 = bf_hi(kv.x), k2 = bf_lo(kv.y), k3 = bf_hi(kv.y);
            const float rs = __builtin_amdgcn_rsqf(wave_sum(k0 * k0 + k1 * k1 + k2 * k2 + k3 * k3) * (1.f / 256.f) + EPS) * (0.0625f * LOG2E);
            const f32x4 gk = *(const f32x4*)(AP(x_k_gain) + 4 * lane), gq = *(const f32x4*)(AP(x_q_gain) + 4 * lane);
            u32x2 o; o.x = pk2(k0 * rs * gk.x * gq.x, k1 * rs * gk.y * gq.y); o.y = pk2(k2 * rs * gk.z * gq.z, k3 * rs * gk.w * gq.w);
            *(u32x2*)(KX + (size_t)row * 1024 + 256 * hx + 4 * lane) = o;
        }
        if (MK_BRANCHES & 1) {
            LAS float* bl = (LAS float*)(lds + AT_BIAS);
            for (int i = tid; i < 16 * 257; i += NTHREADS) bl[(i / 257) * AT_BIAS_STRIDE + (i % 257)] = AP(a_rel_bias)[i] * LOG2E;
            __syncthreads();
            for (int u = vcu; u < 4 * NBATCH * 64; u += G) { const int c = u & 63, b = (u >> 6) & 7, hq = u >> 9; attnA_unit(lds, b, c, hq, ACT, KA, VA); }
        }
    }
    SEAM(2);
    if (IN(3)) { PHASE_ARGS; EI_INIT;
        const SchedIn S{G, bx, 21, TL_Z, 21, 0, 0, (const char*)WIN, (const char*)WMEM};
        pg8::gemm_phase(lds, (const char*)XN, 1024, 1024, S, EI);
    }
    SEAM(3);
    if (IN(4)) { PHASE_ARGS;
        if (MK_BRANCHES & 2) for (int u = vcu; u < NBATCH * 32; u += G) mamba_unit(lds, u >> 5, u & 31, XBC, DTB, ACT, SSQ, AP(conv_w), AP(conv_b), AP(a_log), AP(d_skip));
        if (MK_BRANCHES & 4) for (int u = vcu; u < NBATCH * 4 * 32; u += G) { const int rb = u & 31, hx = (u >> 5) & 3, b = u >> 7; attnC_unit(lds, b, hx, rb, ACT, KX, MEMKV); }
    }
    SEAM(4);
    if (IN(5)) { PHASE_ARGS; EI_INIT;
        for (int idx = vcu * NTHREADS + tid; idx < T * 4; idx += G * NTHREADS) { const int t = idx >> 2, g = idx & 3; const f32x4 s0 = *(const f32x4*)(SSQ + (size_t)t * 32 + 8 * g), s1 = *(const f32x4*)(SSQ + (size_t)t * 32 + 8 * g + 4);
            RSTD[idx] = __builtin_amdgcn_rsqf(((s0[0] + s0[1]) + (s0[2] + s0[3]) + (s1[0] + s1[1]) + (s1[2] + s1[3])) * (1.f / 512.f) + EPS); }
        const SchedIn S{G, bx, 12, TL_G, 12, 0, 0, (const char*)WIN, (const char*)WMEM};
        pg8::gemm_phase(lds, (const char*)XN, 1024, 1024, S, EI);
    }
    SEAM(5);
    if (IN(6)) { PHASE_ARGS;
        constexpr int LASTSEG = (MK_BRANCHES & 4) ? 2 : ((MK_BRANCHES & 2) ? 1 : 0);
        constexpr int KM = LASTSEG == 2 ? 4096 : (LASTSEG == 1 ? 3072 : 1024);
        const SchedDense S{G, bx, T / 256, 4, 4096, (const char*)WCAT};
        const EpiMerge E{GATES, RSTD, MERGED, LASTSEG};
        pg8::gemm_phase(lds, (const char*)ACT, KM, 4096, S, E);
    }
    SEAM(6);
    if (IN(7)) { PHASE_ARGS;
        const SchedDense S{G, bx, T / 256, 4, 1024, (const char*)WOUT};
        const EpiOut E{AP(x), ((float*)kq[30])};
        pg8::gemm_phase(lds, (const char*)MERGED, 1024, 1024, S, E);
    }
    SEAM(7);
    if (IN(8) && (MK_BRANCHES & 8)) { PHASE_ARGS;
        router_phase(lds, vcu, G, ((float*)kq[30]), AP(norm_ffn), AP(w_router), AP(b_router), H2, SELE, SELR, SELW, TOKL, GCNT);
        __syncthreads();
        for (int it = gw; it < NEXP * 1536; it += NGW) {
            const int e = it / 1536, r = it % 1536, which = r >> 9, kb = (r & 511) >> 5, nbs = r & 31;
            const float* src = (which == 0 ? AP(w_gate) : which == 1 ? AP(w_up) : AP(w_down)) + (size_t)e * 1024 * 1024;
            bf16_t* dst = which == 2 ? WD + ((size_t)e * 1024 + 32 * nbs) * 1024 + 64 * kb : WGU + ((size_t)e * 2048 + 256 * (nbs >> 2) + 128 * which + 32 * (nbs & 3)) * 1024 + 64 * kb;
            transpose_item(src, 1024, 64 * kb, 32 * nbs, dst, 1024, nullptr, scr, lane);
        }
    }
    SEAM(8);
#pragma unroll 1
    for (int g = 0; g < 2; ++g) {
        const int p0 = 9 + 3 * g;
        if ((MK_BRANCHES & 8) && (IN(p0) || IN(p0 + 1) || IN(p0 + 2))) { PHASE_ARGS;
            const int total = moe_tables(lds, GCNT), half = (total + 1) >> 1, tlo = g ? half : 0, thi = g ? total : half;
            const LAS int* ts = (const LAS int*)(lds + MO_TS); const LAS int* cn = (const LAS int*)(lds + MO_CNT);
            if (IN(p0)) { const SchedMoE S{G, bx, 8, tlo, thi, ts, cn, TOKL, (const char*)WGU, (size_t)2048 * 1024 * 2}; const EpiGU E{ACTM, AP(b_gate), AP(b_up), tlo};
                pg8::gemm_phase(lds, (const char*)H2, 1024, 1024, S, E); }
            SEAM(p0);
            if (IN(p0 + 1)) { const SchedMoE S{G, bx, 4, tlo, thi, ts, cn, nullptr, (const char*)WD, (size_t)1024 * 1024 * 2}; const EpiDown E{YB, AP(b_down), tlo};
                pg8::gemm_phase(lds, (const char*)ACTM, 1024, 1024, S, E); }
            SEAM(p0 + 1);
            if (IN(p0 + 2)) combine_phase(lds, vcu, G, tlo, thi, YB, SELE, SELR, SELW, ((float*)kq[30]));
            SEAM(p0 + 2);
        } else { SEAM(p0); SEAM(p0 + 1); SEAM(p0 + 2); }
    }
#undef IN
#undef SEAM
}

extern "C" void kernel_launch(void* const* d_in, const int* in_sizes, int n_in, void* d_out, int out_size, void* d_ws, size_t ws_size, hipStream_t stream) {
    static int grid = 0;
    if (grid == 0) {
        if (n_in != 30 || ws_size < WS_MIX_END || ws_size < WS_END) { fprintf(stderr, "kernel_launch: unexpected n_in %d / ws_size %zu\n", n_in, ws_size); grid = -1; return; }
        int dev = 0, cus = 0, per_cu = 0;
        (void)hipGetDevice(&dev); (void)hipDeviceGetAttribute(&cus, hipDeviceAttributeMultiprocessorCount, dev);
        (void)hipFuncSetAttribute((const void*)mega_fwd, hipFuncAttributeMaxDynamicSharedMemorySize, LDS_BYTES);
        (void)hipOccupancyMaxActiveBlocksPerMultiprocessor(&per_cu, (const void*)mega_fwd, NTHREADS, LDS_BYTES);
        if (per_cu < 1) { fprintf(stderr, "kernel_launch: occupancy query reports %d blocks per CU\n", per_cu); grid = -1; return; }
        grid = cus;
    }
    if (grid < 0) return;
    (void)hipMemsetAsync((char*)d_ws + WS_CTL, 0, 4096, stream);
    Args a{};
    for (int i = 0; i < 30; ++i) a.in[i] = (const float*)d_in[i];
    a.out = (float*)d_out; a.ws = (unsigned char*)d_ws;
    if (MK_N_LAUNCHES == 1) {
        a.ph_lo = 0; a.ph_hi = N_PHASES;
        void* args[] = {&a};
        hipError_t e = hipLaunchCooperativeKernel((void*)mega_fwd, dim3(grid), dim3(NTHREADS), args, LDS_BYTES, stream);
        if (e != hipSuccess) fprintf(stderr, "cooperative launch failed: %s (grid %d)\n", hipGetErrorString(e), grid);
    } else {
        for (int ph = 0; ph < N_PHASES; ++ph) { a.ph_lo = ph; a.ph_hi = ph + 1; hipLaunchKernelGGL(mega_fwd, dim3(grid), dim3(NTHREADS), LDS_BYTES, stream, a); }
    }
}
```

```cpp
#include <hip/hip_runtime.h>
#include <hip/hip_cooperative_groups.h>
#include <cstdio>
#include <cstdint>
namespace cg = cooperative_groups;

#define LAS __attribute__((address_space(3)))
#define GAS __attribute__((address_space(1)))
#define DI __device__ __forceinline__
typedef unsigned short bf16_t;
typedef short bf16x8 __attribute__((ext_vector_type(8)));
typedef short s16x4 __attribute__((ext_vector_type(4)));
typedef float f32x2 __attribute__((ext_vector_type(2)));
typedef float f32x4 __attribute__((ext_vector_type(4)));
typedef float f32x16 __attribute__((ext_vector_type(16)));
typedef unsigned u32x2 __attribute__((ext_vector_type(2)));
typedef unsigned u32x4 __attribute__((ext_vector_type(4)));
typedef __bf16 bf16x2_t __attribute__((ext_vector_type(2)));
typedef short v4i16_t __attribute__((ext_vector_type(4)));

DI unsigned pk2(float lo, float hi) { f32x2 v = {lo, hi}; bf16x2_t b = __builtin_convertvector(v, bf16x2_t); return __builtin_bit_cast(unsigned, b); }
DI float bf_lo(unsigned w) { return __uint_as_float(w << 16); }
DI float bf_hi(unsigned w) { return __uint_as_float(w & 0xffff0000u); }
DI float bf2f(bf16_t b) { return __uint_as_float(((unsigned)b) << 16); }
DI float wave_sum(float v) {
#pragma unroll
    for (int o = 1; o < 64; o <<= 1) v += __shfl_xor(v, o);
    return v;
}
DI float fast_exp2(float x) { return __builtin_amdgcn_exp2f(x); }
DI float fast_rcp(float x) { return __builtin_amdgcn_rcpf(x); }
DI float sigmoidf_(float x) { return fast_rcp(1.0f + fast_exp2(-1.4426950408889634f * x)); }

constexpr int NBATCH = 8, SEQ = 4096, T = NBATCH * SEQ, DM = 1024;
constexpr int NWIN_TILES = 49, NWIN = NWIN_TILES * 256;
constexpr int IN_COLS = 12320;
constexpr float EPS = 1e-6f;
constexpr float LOG2E = 1.4426950408889634f;
constexpr int NEXP = 32, TOPK = 4;
constexpr int MEMLEN = 256;
constexpr int ACT_P = 4096;
constexpr int TL_Q = 0, TL_K = 4, TL_V = 8, TL_Z = 12, TL_XBC = 20, TL_DT = 32, TL_QX = 33, TL_G = 37;

constexpr size_t MiB = (size_t)1 << 20;
constexpr size_t WS_CTL = 0, CTL_BYTES = 1 * MiB;
constexpr size_t WS_WIN = 1 * MiB, WS_WCAT = 26 * MiB, WS_WOUT = 34 * MiB, WS_WMEM = 36 * MiB;
constexpr size_t WS_DT = 40 * MiB, WS_SSQ = 44 * MiB, WS_RSTD = 48 * MiB, WS_KX = 49 * MiB, WS_MEMKV = 53 * MiB;
constexpr size_t WS_XN = 61 * MiB, WS_MEMN = 125 * MiB, WS_ACT = 129 * MiB, WS_BUF = 385 * MiB, WS_MIX_END = 577 * MiB;
constexpr size_t WS_KA = WS_BUF, WS_VA = WS_BUF + 64 * MiB, WS_XBC = WS_BUF, WS_GATES = WS_BUF, WS_MERGED = WS_XN;
constexpr int MOE_TILE_CAP = 280;
constexpr size_t MOE_H2 = 1 * MiB, MOE_WGU = 65 * MiB, MOE_WD = 193 * MiB, MOE_ACTM = 257 * MiB, MOE_Y = 397 * MiB;
constexpr size_t MOE_SELE = 537 * MiB, MOE_SELR = 537 * MiB + 512 * 1024, MOE_SELW = 538 * MiB, MOE_TOKL = 539 * MiB, WS_END = 543 * MiB;
constexpr int CW_CNT = 64;

namespace pg8 {
constexpr int BM = 256, BK = 64, HALF = 128, HTB = HALF * BK * 2, STAGE_BYTES = 8 * HTB;
__host__ __device__ __forceinline__ int lds_byte(int r, int c) { const int st = (r >> 4) * 2 + (c >> 5), rr = r & 15, cc = c & 31, ob = rr * 64 + cc * 2; return st * 1024 + (ob ^ (((ob >> 9) & 1) << 5)); }
__host__ __device__ __forceinline__ void stage_rc(int b, int& R, int& C) { const int st = b / 1024, sb = b % 1024, swz = sb ^ (((sb >> 9) & 1) << 5); R = (st >> 1) * 16 + swz / 64; C = (st & 1) * 32 + (swz % 64) / 2; }
__host__ __device__ __forceinline__ int perm32(int rho) { const int n = rho >> 4, i = rho & 15; return 8 * (i >> 2) + 4 * n + (i & 3); }

struct Unit { int kind, pm, pn, aux; };

typedef f32x4 Acc[2][2][4][2];

template <class Epi, class Sched>
DI void gemm_phase(LAS unsigned char* lds, const char* Abase, const int K, const int ldb, const Sched& S, const Epi& E) {
    const int tid = threadIdx.x, wid = __builtin_amdgcn_readfirstlane(tid >> 6), lane = tid & 63, wr = wid >> 2, wc = wid & 3, fr = lane & 15, fq = lane >> 4;
    const int nt = K / BK;
    int Rr[2], Cc2[2]; unsigned voffB[2];
#pragma unroll
    for (int i = 0; i < 2; ++i) { int R, C; stage_rc(tid * 16 + i * 8192, R, C); Rr[i] = R; Cc2[i] = C * 2; const int Rb = (R & ~31) + perm32(R & 31); voffB[i] = (unsigned)(Rb * ldb + C) * 2u; }
    const size_t kstep = (size_t)(BK * 2);
    const size_t hstepB = (size_t)HALF * ldb * 2;
    const unsigned ldsw = (unsigned)wid * 1024u;
    const int aoff = lds_byte(wr * 64 + fr, fq * 8), boff = lds_byte(wc * 32 + fr, fq * 8);
#define PG8_SA(b, h) (((b) * 2 + (h)) * HTB)
#define PG8_SB(b, h) ((4 + (b) * 2 + (h)) * HTB)
#define PG8_GLDS(src, dstoff) __builtin_amdgcn_global_load_lds((const unsigned*)(src), (LAS unsigned*)(lds + (dstoff)), 16, 0, 0)
#define PG8_STAGE_B(bufoff, ptr) do { _Pragma("unroll") for (int _i = 0; _i < 2; ++_i) PG8_GLDS((const char*)(ptr) + voffB[_i], (bufoff) + ldsw + _i * 8192); } while (0)
#define PG8_STAGE_A(bufoff, kb, v0, v1) do { PG8_GLDS(Abase + (size_t)(v0) + (kb), (bufoff) + ldsw); PG8_GLDS(Abase + (size_t)(v1) + (kb), (bufoff) + ldsw + 8192); } while (0)
#define PG8_LDA(dst, b, h) do { _Pragma("unroll") for (int m = 0; m < 4; ++m) _Pragma("unroll") for (int k = 0; k < 2; ++k) dst[m][k] = *(const LAS bf16x8*)(lds + PG8_SA(b, h) + aoff + m * 2048 + k * 1024); } while (0)
#define PG8_LDB(dst, b, h) do { _Pragma("unroll") for (int n = 0; n < 2; ++n) _Pragma("unroll") for (int k = 0; k < 2; ++k) dst[n][k] = *(const LAS bf16x8*)(lds + PG8_SB(b, h) + boff + n * 2048 + k * 1024); } while (0)
#define PG8_MMA(ai, bj, At, Bt) do { __builtin_amdgcn_s_setprio(1); _Pragma("unroll") for (int m = 0; m < 4; ++m) _Pragma("unroll") for (int n = 0; n < 2; ++n) _Pragma("unroll") for (int k = 0; k < 2; ++k) \
        acc[ai][bj][m][n] = __builtin_amdgcn_mfma_f32_16x16x32_bf16(Bt[n][k], At[m][k], acc[ai][bj][m][n], 0, 0, 0); __builtin_amdgcn_s_setprio(0); } while (0)
#define PG8_WAIT_V(n) asm volatile("s_waitcnt vmcnt(" #n ")" ::: "memory")
#define PG8_WAIT_L(n) asm volatile("s_waitcnt lgkmcnt(" #n ")" ::: "memory")
#define PG8_BAR __builtin_amdgcn_s_barrier()
#define PG8_SCHED __builtin_amdgcn_sched_barrier(0)
    Unit cur, nxt; int ui = 0;
    if (!S.next(0, cur)) return;
    Acc acc;
#pragma unroll
    for (int a = 0; a < 2; ++a)
#pragma unroll
        for (int b = 0; b < 2; ++b)
#pragma unroll
            for (int m = 0; m < 4; ++m)
#pragma unroll
                for (int n = 0; n < 2; ++n) acc[a][b][m][n] = (f32x4){0.f, 0.f, 0.f, 0.f};
    bf16x8 At[4][2], B0[2][2], B1[2][2];
    unsigned vA00 = S.arow(cur, Rr[0]) + Cc2[0], vA01 = S.arow(cur, Rr[1]) + Cc2[1], vA10 = S.arow(cur, HALF + Rr[0]) + Cc2[0], vA11 = S.arow(cur, HALF + Rr[1]) + Cc2[1];
    const char* cB = S.bptr(cur);
    PG8_STAGE_B(PG8_SB(0, 0), cB); PG8_STAGE_B(PG8_SB(0, 1), cB + hstepB); PG8_STAGE_A(PG8_SA(0, 0), 0, vA00, vA01); PG8_STAGE_A(PG8_SA(0, 1), 0, vA10, vA11);
    if (wr == 1) PG8_BAR;
    PG8_WAIT_V(2); PG8_BAR;
    PG8_STAGE_B(PG8_SB(1, 0), cB + kstep); PG8_STAGE_A(PG8_SA(1, 0), kstep, vA00, vA01); PG8_STAGE_B(PG8_SB(1, 1), cB + hstepB + kstep);
    PG8_WAIT_V(6); PG8_BAR;
    for (;;) {
        const bool has_next = S.next(ui + 1, nxt);
        const char* nB = has_next ? S.bptr(nxt) : cB;
        for (int t = 0; t < nt; t += 2) {
            const bool last = (t == nt - 2);
            if constexpr (Epi::SEGMENTED) { if (t > 0 && E.boundary(t)) E.rescale(acc, cur, t, wr, wc, fr, fq); }
            const size_t k1 = (size_t)(t + 1) * kstep;
            const size_t k2 = last ? 0 : (size_t)(t + 2) * kstep, k3 = k2 + kstep;
            const char* b2 = last ? nB : cB + (size_t)(t + 2) * kstep; const char* b3 = b2 + kstep;
            unsigned w00 = vA00, w01 = vA01, w10 = vA10, w11 = vA11;
            if (last && has_next) { w00 = S.arow(nxt, Rr[0]) + Cc2[0]; w01 = S.arow(nxt, Rr[1]) + Cc2[1]; w10 = S.arow(nxt, HALF + Rr[0]) + Cc2[0]; w11 = S.arow(nxt, HALF + Rr[1]) + Cc2[1]; }
            PG8_LDB(B0, 0, 0); PG8_LDB(B1, 0, 1); PG8_SCHED; PG8_LDA(At, 0, 0); PG8_STAGE_A(PG8_SA(1, 1), k1, vA10, vA11);
            PG8_WAIT_V(8); PG8_WAIT_L(0); PG8_BAR; PG8_MMA(0, 0, At, B0); PG8_MMA(0, 1, At, B1); PG8_BAR; PG8_SCHED;
            PG8_LDA(At, 0, 1); PG8_STAGE_B(PG8_SB(0, 0), b2); PG8_STAGE_B(PG8_SB(0, 1), b2 + hstepB); PG8_STAGE_A(PG8_SA(0, 0), k2, w00, w01);
            PG8_WAIT_V(8); PG8_WAIT_L(0); PG8_BAR; PG8_MMA(1, 0, At, B0); PG8_MMA(1, 1, At, B1); PG8_BAR; PG8_SCHED;
            PG8_LDB(B0, 1, 0); PG8_LDB(B1, 1, 1); PG8_SCHED; PG8_LDA(At, 1, 0); PG8_STAGE_A(PG8_SA(0, 1), k2, w10, w11);
            PG8_WAIT_V(8); PG8_WAIT_L(0); PG8_BAR; PG8_MMA(0, 0, At, B0); PG8_MMA(0, 1, At, B1); PG8_BAR; PG8_SCHED;
            PG8_LDA(At, 1, 1); PG8_STAGE_B(PG8_SB(1, 0), b3); PG8_STAGE_B(PG8_SB(1, 1), b3 + hstepB); PG8_STAGE_A(PG8_SA(1, 0), k3, w00, w01);
            PG8_WAIT_V(8); PG8_WAIT_L(0); PG8_BAR; PG8_MMA(1, 0, At, B0); PG8_MMA(1, 1, At, B1); PG8_BAR; PG8_SCHED;
            if (last) { vA00 = w00; vA01 = w01; vA10 = w10; vA11 = w11; }
        }
        if (wr == 0) PG8_BAR;
        E(acc, cur, wr, wc, fr, fq);
        if (!has_next) break;
#pragma unroll
        for (int a = 0; a < 2; ++a)
#pragma unroll
            for (int b = 0; b < 2; ++b)
#pragma unroll
                for (int m = 0; m < 4; ++m)
#pragma unroll
                    for (int n = 0; n < 2; ++n) acc[a][b][m][n] = (f32x4){0.f, 0.f, 0.f, 0.f};
        cur = nxt; cB = nB; ++ui;
        if (wr == 1) PG8_BAR;
    }
    PG8_WAIT_V(0);
    PG8_BAR;
#undef PG8_SA
#undef PG8_SB
#undef PG8_GLDS
#undef PG8_STAGE_A
#undef PG8_STAGE_B
#undef PG8_LDA
#undef PG8_LDB
#undef PG8_MMA
#undef PG8_WAIT_V
#undef PG8_WAIT_L
#undef PG8_BAR
#undef PG8_SCHED
}

DI bool static_tile(int L, int nM, int nN, int& pm, int& pn) {
    const int nwg = nM * nN; if (L >= nwg) return false;
    int wgid = L; { const int q = nwg / 8, r = nwg % 8, xcd = wgid % 8, off = wgid / 8; wgid = (xcd < r ? xcd * (q + 1) : r * (q + 1) + (xcd - r) * q) + off; }
    const int nig = 8 * nN, gid = wgid / nig, fm = gid * 8, gsz = (nM - fm) < 8 ? (nM - fm) : 8;
    pm = fm + ((wgid % nig) % gsz); pn = (wgid % nig) / gsz; return true;
}
}
using pg8::Unit; using pg8::Acc;

DI float silu_(float v) { return v * sigmoidf_(v); }
DI float softplus_(float x) { return fmaxf(x, 0.f) + __logf(1.0f + __expf(-fabsf(x))); }

struct SchedIn {
    int G, c, ncol, t0, nsplit, t1, nextra; const char* win; const char* wmem; int reps;
    DI bool next(int i, Unit& u) const {
        const int U = (T / 256) * ncol + nextra; int L = i * G + c; if (L >= U * reps) return false; L %= U; int pm, pn;
        if (pg8::static_tile(L, T / 256, ncol, pm, pn)) { u.kind = 0; u.pm = pm; u.pn = pn < nsplit ? t0 + pn : t1 + (pn - nsplit); u.aux = 0; return true; }
        const int j = L - (T / 256) * ncol; if (j < nextra) { u.kind = 1; u.pm = j >> 3; u.pn = j & 7; u.aux = 0; return true; }
        return false;
    }
    DI unsigned arow(const Unit& u, int r) const { return (u.kind == 0 ? 0u : (unsigned)(WS_MEMN - WS_XN)) + (unsigned)(u.pm * 256 + r) * 2048u; }
    DI const char* bptr(const Unit& u) const { return (u.kind == 0 ? win : wmem) + (size_t)u.pn * (256 * 1024 * 2); }
};

struct EpiIn {
    static constexpr bool SEGMENTED = false;
    bf16_t *act, *ka, *va, *xbc, *gates, *memkv; float* dt; const float *qgain, *kgain, *dtbias;
    template <int OP> DI void ew(const Acc& acc, bf16_t* dst, size_t pitch, int col0, int row0, int wc, int fq) const {
#pragma unroll
        for (int ai = 0; ai < 2; ++ai)
#pragma unroll
            for (int m = 0; m < 4; ++m) { bf16_t* rowp = dst + (size_t)(row0 + ai * 128 + m * 16) * pitch + col0 + wc * 32 + 8 * fq;
#pragma unroll
                for (int bj = 0; bj < 2; ++bj) { f32x4 v0 = acc[ai][bj][m][0], v1 = acc[ai][bj][m][1];
                    if (OP == 1) { for (int e = 0; e < 4; ++e) { v0[e] = silu_(v0[e]); v1[e] = silu_(v1[e]); } }
                    if (OP == 2) { for (int e = 0; e < 4; ++e) { v0[e] = sigmoidf_(fminf(fmaxf(v0[e], -30.f), 30.f)); v1[e] = sigmoidf_(fminf(fmaxf(v1[e], -30.f), 30.f)); } }
                    u32x4 w; w.x = pk2(v0[0], v0[1]); w.y = pk2(v0[2], v0[3]); w.z = pk2(v1[0], v1[1]); w.w = pk2(v1[2], v1[3]);
                    *(u32x4*)(rowp + bj * 128) = w; }
                asm volatile("" ::: "memory"); }
    }
    DI void headnorm(const Acc& acc, bf16_t* dst, size_t pitch, int col0, int row0, int wc, int fq, const float* gain, float mul) const {
#pragma unroll
        for (int ai = 0; ai < 2; ++ai)
#pragma unroll
            for (int m = 0; m < 4; ++m) {
                float ss = 0.f;
#pragma unroll
                for (int bj = 0; bj < 2; ++bj)
#pragma unroll
                    for (int n = 0; n < 2; ++n) { const f32x4 x = acc[ai][bj][m][n]; ss += (x[0] * x[0] + x[1] * x[1]) + (x[2] * x[2] + x[3] * x[3]); }
                ss += __shfl_xor(ss, 16); ss += __shfl_xor(ss, 32);
                const float rs = __builtin_amdgcn_rsqf(ss * (1.0f / 64.0f) + EPS) * mul;
                bf16_t* rowp = dst + (size_t)(row0 + ai * 128 + m * 16) * pitch + col0 + wc * 64 + 8 * fq;
#pragma unroll
                for (int bj = 0; bj < 2; ++bj) { const f32x4 g0 = *(const f32x4*)(gain + 32 * bj + 8 * fq), g1 = *(const f32x4*)(gain + 32 * bj + 8 * fq + 4);
                    const f32x4 v0 = acc[ai][bj][m][0] * rs * g0, v1 = acc[ai][bj][m][1] * rs * g1;
                    u32x4 w; w.x = pk2(v0[0], v0[1]); w.y = pk2(v0[2], v0[3]); w.z = pk2(v1[0], v1[1]); w.w = pk2(v1[2], v1[3]);
                    *(u32x4*)(rowp + bj * 32) = w; }
                asm volatile("" ::: "memory"); }
    }
    DI void operator()(const Acc& acc, const Unit& u, int wr, int wc, int fr, int fq) const {
        const int row0 = u.pm * 256 + wr * 64 + fr;
        if (u.kind == 1) { ew<0>(acc, memkv, 2048, u.pn * 256, row0, wc, fq); return; }
        const int tl = u.pn;
        if (tl < TL_K) headnorm(acc, act, ACT_P, (tl - TL_Q) * 256, row0, wc, fq, qgain, 0.125f * LOG2E);
        else if (tl < TL_V) headnorm(acc, ka, 1024, (tl - TL_K) * 256, row0, wc, fq, kgain, 1.0f);
        else if (tl < TL_Z) ew<0>(acc, va, 1024, (tl - TL_V) * 256, row0, wc, fq);
        else if (tl < TL_XBC) ew<1>(acc, act, ACT_P, 1024 + (tl - TL_Z) * 256, row0, wc, fq);
        else if (tl < TL_DT) ew<0>(acc, xbc, 3072, (tl - TL_XBC) * 256, row0, wc, fq);
        else if (tl == TL_DT) {
            if (wc == 0) {
                f32x4 b0 = *(const f32x4*)(dtbias + 8 * fq), b1 = *(const f32x4*)(dtbias + 8 * fq + 4);
#pragma unroll
                for (int ai = 0; ai < 2; ++ai)
#pragma unroll
                    for (int m = 0; m < 4; ++m) { float* rowp = dt + (size_t)(row0 + ai * 128 + m * 16) * 32 + 8 * fq;
                        f32x4 v0 = acc[ai][0][m][0] + b0, v1 = acc[ai][0][m][1] + b1;
                        for (int e = 0; e < 4; ++e) { v0[e] = softplus_(v0[e]); v1[e] = softplus_(v1[e]); }
                        *(f32x4*)rowp = v0; *(f32x4*)(rowp + 4) = v1; }
            }
        }
        else if (tl < TL_G) ew<0>(acc, act, ACT_P, 3072 + (tl - TL_QX) * 256, row0, wc, fq);
        else ew<2>(acc, gates, 3072, (tl - TL_G) * 256, row0, wc, fq);
    }
};

struct SchedDense {
    int G, c, nM, nN, K; const char* bbase; int reps;
    DI bool next(int i, Unit& u) const { u.kind = 0; u.aux = 0; const int U = nM * nN; int L = i * G + c; if (L >= U * reps) return false; return pg8::static_tile(L % U, nM, nN, u.pm, u.pn); }
    DI unsigned arow(const Unit& u, int r) const { return (unsigned)(u.pm * 256 + r) * (unsigned)(K * 2); }
    DI const char* bptr(const Unit& u) const { return bbase + (size_t)u.pn * 256 * K * 2; }
};

struct EpiMerge {
    static constexpr bool SEGMENTED = true;
    const bf16_t* gates; const float* rstd; bf16_t* merged; int last_seg;
    DI bool boundary(int t) const { return t == 16 || t == 24 || t == 32 || t == 40 || t == 48; }
    DI void load8(const bf16_t* p, float (&g)[8]) const { const u32x4 w = *(const u32x4*)p; g[0] = bf_lo(w.x); g[1] = bf_hi(w.x); g[2] = bf_lo(w.y); g[3] = bf_hi(w.y); g[4] = bf_lo(w.z); g[5] = bf_hi(w.z); g[6] = bf_lo(w.w); g[7] = bf_hi(w.w); }
    DI void rescale(Acc& acc, const Unit& u, int t, int wr, int wc, int fr, int fq) const {
        int row0 = u.pm * 256 + wr * 64 + fr, col0 = u.pn * 256 + wc * 32 + 8 * fq;
        asm volatile("" : "+v"(row0), "+v"(col0));
#pragma unroll
        for (int ai = 0; ai < 2; ++ai)
#pragma unroll
            for (int m = 0; m < 4; ++m) { const int row = row0 + ai * 128 + m * 16; const f32x4 rs = *(const f32x4*)(rstd + (size_t)row * 4);
                if (t == 16 || t == 48) {
                    const bf16_t* gp = gates + (size_t)row * 3072 + col0;
#pragma unroll
                    for (int bj = 0; bj < 2; ++bj) { float ga[8], gb[8]; float f[8];
                        if (t == 16) { load8(gp + bj * 128, ga); load8(gp + 1024 + bj * 128, gb); for (int j = 0; j < 8; ++j) f[j] = ga[j] * fast_rcp(gb[j] * rs[0]); }
                        else { load8(gp + 1024 + bj * 128, ga); load8(gp + 2048 + bj * 128, gb); for (int j = 0; j < 8; ++j) f[j] = ga[j] * rs[3] * fast_rcp(gb[j]); }
                        for (int e = 0; e < 4; ++e) { acc[ai][bj][m][0][e] *= f[e]; acc[ai][bj][m][1][e] *= f[4 + e]; } }
                } else {
                    const float f = (t == 24) ? rs[0] * fast_rcp(rs[1]) : (t == 32) ? rs[1] * fast_rcp(rs[2]) : rs[2] * fast_rcp(rs[3]);
#pragma unroll
                    for (int bj = 0; bj < 2; ++bj) { acc[ai][bj][m][0] *= f; acc[ai][bj][m][1] *= f; }
                }
                asm volatile("" ::: "memory"); }
    }
    DI void operator()(const Acc& acc, const Unit& u, int wr, int wc, int fr, int fq) const {
        const int row0 = u.pm * 256 + wr * 64 + fr, col0 = u.pn * 256 + wc * 32 + 8 * fq;
#pragma unroll
        for (int ai = 0; ai < 2; ++ai)
#pragma unroll
            for (int m = 0; m < 4; ++m) { const int row = row0 + ai * 128 + m * 16; const float r3 = rstd[(size_t)row * 4 + 3];
                const bf16_t* gp = gates + (size_t)row * 3072 + col0 + last_seg * 1024; bf16_t* op = merged + (size_t)row * 1024 + col0;
#pragma unroll
                for (int bj = 0; bj < 2; ++bj) { float g[8]; load8(gp + bj * 128, g); const float s = (last_seg == 1) ? r3 : 1.0f;
                    f32x4 v0 = acc[ai][bj][m][0], v1 = acc[ai][bj][m][1];
                    u32x4 w; w.x = pk2(v0[0] * g[0] * s, v0[1] * g[1] * s); w.y = pk2(v0[2] * g[2] * s, v0[3] * g[3] * s); w.z = pk2(v1[0] * g[4] * s, v1[1] * g[5] * s); w.w = pk2(v1[2] * g[6] * s, v1[3] * g[7] * s);
                    *(u32x4*)(op + bj * 128) = w; }
                asm volatile("" ::: "memory"); }
    }
};

struct EpiOut {
    static constexpr bool SEGMENTED = false;
    const float* x; float* out;
    DI void operator()(const Acc& acc, const Unit& u, int wr, int wc, int fr, int fq) const {
        const int row0 = u.pm * 256 + wr * 64 + fr, col0 = u.pn * 256 + wc * 32 + 8 * fq;
#pragma unroll
        for (int ai = 0; ai < 2; ++ai)
#pragma unroll
            for (int m = 0; m < 4; ++m) { const size_t off = (size_t)(row0 + ai * 128 + m * 16) * 1024 + col0;
#pragma unroll
                for (int bj = 0; bj < 2; ++bj) { const f32x4 x0 = *(const f32x4*)(x + off + bj * 128), x1 = *(const f32x4*)(x + off + bj * 128 + 4);
                    *(f32x4*)(out + off + bj * 128) = x0 + acc[ai][bj][m][0]; *(f32x4*)(out + off + bj * 128 + 4) = x1 + acc[ai][bj][m][1]; } }
    }
};

struct SchedMoE {
    int G, c, NC, tlo, thi; const LAS int* tstart; const LAS int* cnt; const int* tokl; const char* wbase; size_t wexp; int reps;
    DI bool next(int i, Unit& u) const {
        const int n = (thi - tlo) * NC; int L = i * G + c; if (L >= n * reps) return false; L %= n;
        { const int q = n / 8, r = n % 8, xcd = L % 8, off = L / 8; L = (xcd < r ? xcd * (q + 1) : r * (q + 1) + (xcd - r) * q) + off; }
        const int rt = tlo + L / NC; u.pn = L % NC; u.pm = rt; int e = 0;
        for (int j = 1; j < NEXP; ++j) e += (tstart[j] <= rt) ? 1 : 0;
        u.aux = __builtin_amdgcn_readfirstlane(e); u.kind = 0; return true;
    }
    DI unsigned arow(const Unit& u, int r) const {
        if (tokl) { const int e = u.aux, idx = (u.pm - tstart[e]) * 256 + r; const int tok = idx < cnt[e] ? tokl[(size_t)e * T + idx] : 0; return (unsigned)tok * 2048u; }
        return (unsigned)((u.pm - tlo) * 256 + r) * 2048u;
    }
    DI const char* bptr(const Unit& u) const { return wbase + (size_t)u.aux * wexp + (size_t)u.pn * (256 * 1024 * 2); }
};
struct EpiGU {
    static constexpr bool SEGMENTED = false;
    bf16_t* actm; const float *bg, *bu; int tlo;
    DI void operator()(const Acc& acc, const Unit& u, int wr, int wc, int fr, int fq) const {
        const int row0 = (u.pm - tlo) * 256 + wr * 64 + fr, col = u.pn * 128 + wc * 32 + 8 * fq; const size_t eb = (size_t)u.aux * 1024 + col;
        const f32x4 g0 = *(const f32x4*)(bg + eb), g1 = *(const f32x4*)(bg + eb + 4), u0 = *(const f32x4*)(bu + eb), u1 = *(const f32x4*)(bu + eb + 4);
#pragma unroll
        for (int ai = 0; ai < 2; ++ai)
#pragma unroll
            for (int m = 0; m < 4; ++m) { f32x4 a0 = acc[ai][0][m][0] + g0, a1 = acc[ai][0][m][1] + g1, b0 = acc[ai][1][m][0] + u0, b1 = acc[ai][1][m][1] + u1;
                for (int e = 0; e < 4; ++e) { float g = fminf(a0[e], 7.f), uu = fminf(fmaxf(b0[e], -7.f), 7.f); a0[e] = (uu + 1.f) * g * sigmoidf_(1.702f * g);
                                              g = fminf(a1[e], 7.f); uu = fminf(fmaxf(b1[e], -7.f), 7.f); a1[e] = (uu + 1.f) * g * sigmoidf_(1.702f * g); }
                u32x4 w; w.x = pk2(a0[0], a0[1]); w.y = pk2(a0[2], a0[3]); w.z = pk2(a1[0], a1[1]); w.w = pk2(a1[2], a1[3]);
                *(u32x4*)(actm + (size_t)(row0 + ai * 128 + m * 16) * 1024 + col) = w; }
    }
};
struct EpiDown {
    static constexpr bool SEGMENTED = false;
    bf16_t* y; const float* bd; int tlo;
    DI void operator()(const Acc& acc, const Unit& u, int wr, int wc, int fr, int fq) const {
        const int row0 = (u.pm - tlo) * 256 + wr * 64 + fr, col0 = u.pn * 256 + wc * 32 + 8 * fq; const float* bp = bd + (size_t)u.aux * 1024 + col0;
        f32x4 bv[2][2];
#pragma unroll
        for (int bj = 0; bj < 2; ++bj) { bv[bj][0] = *(const f32x4*)(bp + bj * 128); bv[bj][1] = *(const f32x4*)(bp + bj * 128 + 4); }
#pragma unroll
        for (int ai = 0; ai < 2; ++ai)
#pragma unroll
            for (int m = 0; m < 4; ++m) { bf16_t* rowp = y + (size_t)(row0 + ai * 128 + m * 16) * 1024 + col0;
#pragma unroll
                for (int bj = 0; bj < 2; ++bj) { const f32x4 v0 = acc[ai][bj][m][0] + bv[bj][0], v1 = acc[ai][bj][m][1] + bv[bj][1];
                    u32x4 w; w.x = pk2(v0[0], v0[1]); w.y = pk2(v0[2], v0[3]); w.z = pk2(v1[0], v1[1]); w.w = pk2(v1[2], v1[3]);
                    *(u32x4*)(rowp + bj * 128) = w; } }
    }
};
DI void transpose_item64(const float* W, int Ns, int k0, int sc0, int sc1, bf16_t* dst, int dpitch, const float* kscale, LAS float* scr, int lane) {
    const int cl = lane & 15, kl = lane >> 4, sc = (cl < 8) ? sc0 : sc1, col = sc + 4 * (cl & 7);
    f32x4 v[16];
#pragma unroll
    for (int i = 0; i < 16; ++i) { v[i] = (f32x4){0.f, 0.f, 0.f, 0.f}; if (sc >= 0) v[i] = *(const f32x4*)(W + (size_t)(k0 + 4 * i + kl) * Ns + col); }
#pragma unroll
    for (int i = 0; i < 16; ++i) { const int kk = 4 * i + kl; f32x4 x = v[i]; if (kscale) x *= kscale[k0 + kk]; LAS float* p = scr + kk * 65 + 4 * cl; p[0] = x[0]; p[1] = x[1]; p[2] = x[2]; p[3] = x[3]; }
    asm volatile("s_waitcnt lgkmcnt(0)" ::: "memory");
    const int c = lane & 7;
#pragma unroll
    for (int j = 0; j < 8; ++j) { const int n = (lane >> 3) + 8 * j; const LAS float* s = scr + (8 * c) * 65 + n;
        u32x4 o; o.x = pk2(s[0 * 65], s[1 * 65]); o.y = pk2(s[2 * 65], s[3 * 65]); o.z = pk2(s[4 * 65], s[5 * 65]); o.w = pk2(s[6 * 65], s[7 * 65]);
        *(u32x4*)(dst + (size_t)n * dpitch + 8 * c) = o; }
    asm volatile("s_waitcnt lgkmcnt(0)" ::: "memory");
}
DI int win_src_col(int nb) {
    const int tile = nb >> 3, sub = nb & 7;
    if (tile < TL_V) { const int base = tile < TL_K ? 256 * tile : 1024 + 256 * (tile - TL_K); return base + 32 * (2 * (sub & 3) + (sub >> 2)); }
    if (tile < TL_Z) return 2048 + 256 * (tile - TL_V) + 32 * sub;
    if (tile < TL_XBC) return 3072 + 256 * (tile - TL_Z) + 32 * sub;
    if (tile < TL_DT) return 5120 + 256 * (tile - TL_XBC) + 32 * sub;
    if (tile == TL_DT) return sub == 0 ? 8192 : -1;
    if (tile < TL_G) return 8224 + 256 * (tile - TL_QX) + 32 * sub;
    return 9248 + 256 * (tile - TL_G) + 32 * sub;
}
template <int NR> DI void rms_rows_to_bf16(const float* x, bf16_t* o, size_t row_stride, const float* gain, int lane) {
    f32x4 v[NR][4]; float s[NR];
#pragma unroll
    for (int r = 0; r < NR; ++r) { const f32x4* xr = (const f32x4*)(x + (size_t)r * row_stride * 1024) + lane; s[r] = 0.f;
#pragma unroll
        for (int j = 0; j < 4; ++j) { v[r][j] = xr[64 * j]; } }
#pragma unroll
    for (int r = 0; r < NR; ++r) {
#pragma unroll
        for (int j = 0; j < 4; ++j) s[r] += (v[r][j].x * v[r][j].x + v[r][j].y * v[r][j].y) + (v[r][j].z * v[r][j].z + v[r][j].w * v[r][j].w);
        s[r] = __builtin_amdgcn_rsqf(wave_sum(s[r]) * (1.f / 1024.f) + EPS); }
    const f32x4* gr = (const f32x4*)gain + lane;
#pragma unroll
    for (int j = 0; j < 4; ++j) { const f32x4 g = gr[64 * j];
#pragma unroll
        for (int r = 0; r < NR; ++r) { u32x2 w; w.x = pk2(v[r][j].x * s[r] * g.x, v[r][j].y * s[r] * g.y); w.y = pk2(v[r][j].z * s[r] * g.z, v[r][j].w * s[r] * g.w); ((u32x2*)(o + (size_t)r * row_stride * 1024) + lane)[64 * j] = w; } }
}

DI int crow(int r, int hi) { return (r & 3) + 8 * (r >> 2) + 4 * hi; }
DI s16x4 vtr(const LAS unsigned char* p) { return __builtin_bit_cast(s16x4, __builtin_amdgcn_ds_read_tr16_b64_v4i16((LAS v4i16_t*)p)); }
#define MFMA32(a, b, c) __builtin_amdgcn_mfma_f32_32x32x16_bf16((a), (b), (c), 0, 0, 0)
#define MFMA16(a, b, c) __builtin_amdgcn_mfma_f32_16x16x32_bf16((a), (b), (c), 0, 0, 0)
DI void tile_load(u32x4 (&r)[4], const bf16_t* g, size_t pitch, int tid) {
#pragma unroll
    for (int i = 0; i < 4; ++i) { const int q = tid + 512 * i, row = q >> 5, ch = q & 31; r[i] = *(const u32x4*)(g + (size_t)row * pitch + ch * 8); }
}
DI void tile_store_k(LAS unsigned char* dst, const u32x4 (&r)[4], int tid) {
#pragma unroll
    for (int i = 0; i < 4; ++i) { const int q = tid + 512 * i, row = q >> 5, ch = q & 31; *(LAS u32x4*)(dst + row * 512 + ((ch ^ (row & 15)) << 4)) = r[i]; }
}
DI void tile_store_v(LAS unsigned char* dst, const u32x4 (&r)[4], int tid) {
#pragma unroll
    for (int i = 0; i < 4; ++i) { const int q = tid + 512 * i, row = q >> 5, ch = q & 31; *(LAS u32x4*)(dst + row * 512 + ((((ch >> 2) ^ (row & 3)) * 4 + (ch & 3)) << 4)) = r[i]; }
}
constexpr int AT_K = 0, AT_V = 32768, AT_BIAS = 65536, AT_BIAS_STRIDE = 260;

DI float softmax_tile(f32x16& s0, f32x16& s1, float& m, float& l, bf16x8 (&pa)[4]) {
    float mx = fmaxf(s0[0], s1[0]);
#pragma unroll
    for (int r = 1; r < 16; ++r) mx = fmaxf(mx, fmaxf(s0[r], s1[r]));
    mx = fmaxf(mx, __shfl_xor(mx, 32));
    const float mn = fmaxf(m, mx), alpha = fast_exp2(m - mn);
    float sum = 0.f;
#pragma unroll
    for (int r = 0; r < 16; ++r) { s0[r] = fast_exp2(s0[r] - mn); s1[r] = fast_exp2(s1[r] - mn); sum += s0[r] + s1[r]; }
    l = l * alpha + sum; m = mn;
    u32x4 w;
    w.x = pk2(s0[0], s0[1]); w.y = pk2(s0[2], s0[3]); w.z = pk2(s0[4], s0[5]); w.w = pk2(s0[6], s0[7]); pa[0] = __builtin_bit_cast(bf16x8, w);
    w.x = pk2(s0[8], s0[9]); w.y = pk2(s0[10], s0[11]); w.z = pk2(s0[12], s0[13]); w.w = pk2(s0[14], s0[15]); pa[1] = __builtin_bit_cast(bf16x8, w);
    w.x = pk2(s1[0], s1[1]); w.y = pk2(s1[2], s1[3]); w.z = pk2(s1[4], s1[5]); w.w = pk2(s1[6], s1[7]); pa[2] = __builtin_bit_cast(bf16x8, w);
    w.x = pk2(s1[8], s1[9]); w.y = pk2(s1[10], s1[11]); w.z = pk2(s1[12], s1[13]); w.w = pk2(s1[14], s1[15]); pa[3] = __builtin_bit_cast(bf16x8, w);
    return alpha;
}
DI bf16x8 v_frag(const LAS unsigned char* vt, int s, int colbyte0, int lane) {
    const int hi = lane >> 5, q_ = (lane & 15) >> 2, p_ = lane & 3, blk = (lane >> 4) & 1;
    const int cb = colbyte0 + blk * 32 + p_ * 8, u = cb >> 6, within = cb & 63;
    const int R = 16 * s + 4 * hi + q_;
    const s16x4 lo = vtr(vt + R * 512 + ((u ^ q_) << 6) + within);
    const s16x4 h4 = vtr(vt + (R + 8) * 512 + ((u ^ q_) << 6) + within);
    return __builtin_shufflevector(lo, h4, 0, 1, 2, 3, 4, 5, 6, 7);
}

DI void attnA_unit(LAS unsigned char* lds, int b, int c, int hq, bf16_t* act, const bf16_t* ka, const bf16_t* va, bf16_t* outp, size_t opitch) {
    const int tid = threadIdx.x, lane = tid & 63, wid = __builtin_amdgcn_readfirstlane(tid >> 6), hl = wid >> 1, qh = wid & 1, head = 4 * hq + hl, l31 = lane & 31, hi = lane >> 5;
    const size_t trow = (size_t)b * SEQ + 64 * c + 32 * qh + l31;
    bf16_t* qp = act + trow * ACT_P + 64 * head;
    bf16x8 qf[4];
#pragma unroll
    for (int d0 = 0; d0 < 4; ++d0) qf[d0] = *(const bf16x8*)(qp + 16 * d0 + 8 * hi);
    f32x16 o0, o1;
#pragma unroll
    for (int r = 0; r < 16; ++r) { o0[r] = 0.f; o1[r] = 0.f; }
    float m = -1e30f, l = 0.f;
    const int kc0 = c < 8 ? 0 : c - 8;
    const LAS float* bias = (const LAS float*)(lds + AT_BIAS) + head * AT_BIAS_STRIDE;
    const float b256 = bias[256];
    u32x4 rk[4], rv[4];
    const bf16_t* kb = ka + ((size_t)b * SEQ + 64 * kc0) * 1024 + 256 * hq; const bf16_t* vb = va + ((size_t)b * SEQ + 64 * kc0) * 1024 + 256 * hq;
    tile_load(rk, kb, 1024, tid); tile_load(rv, vb, 1024, tid);
    const int qi = 32 * qh + l31;
    for (int kc = kc0; kc <= c; ++kc) {
        __syncthreads();
        tile_store_k(lds + AT_K, rk, tid); tile_store_v(lds + AT_V, rv, tid);
        if (kc < c) { kb += 64 * 1024; vb += 64 * 1024; tile_load(rk, kb, 1024, tid); tile_load(rv, vb, 1024, tid); }
        __syncthreads();
        const int j = c - kc;
        f32x16 s0, s1;
        if (j >= 3) {
#pragma unroll
            for (int r = 0; r < 16; ++r) { s0[r] = b256; s1[r] = b256; }
        } else {
#pragma unroll
            for (int r = 0; r < 16; ++r) { const int rel0 = 64 * j + qi - crow(r, hi); s0[r] = bias[min(rel0, 128) + 128]; s1[r] = bias[min(rel0 - 32, 128) + 128]; }
        }
#pragma unroll
        for (int d0 = 0; d0 < 4; ++d0) {
            const int ch = 8 * hl + 2 * d0 + hi;
            const bf16x8 k0 = *(const LAS bf16x8*)(lds + AT_K + l31 * 512 + ((ch ^ (l31 & 15)) << 4));
            const bf16x8 k1 = *(const LAS bf16x8*)(lds + AT_K + (32 + l31) * 512 + ((ch ^ (l31 & 15)) << 4));
            s0 = MFMA32(k0, qf[d0], s0); s1 = MFMA32(k1, qf[d0], s1);
        }
        bf16x8 pa[4];
        const float alpha = softmax_tile(s0, s1, m, l, pa);
#pragma unroll
        for (int r = 0; r < 16; ++r) { o0[r] *= alpha; o1[r] *= alpha; }
#pragma unroll
        for (int s = 0; s < 4; ++s) {
            const bf16x8 v0 = v_frag(lds + AT_V, s, (64 * hl) * 2, lane), v1 = v_frag(lds + AT_V, s, (64 * hl + 32) * 2, lane);
            o0 = MFMA32(v0, pa[s], o0); o1 = MFMA32(v1, pa[s], o1);
        }
    }
    const float lt = l + __shfl_xor(l, 32), inv = fast_rcp(lt);
#pragma unroll
    for (int rg = 0; rg < 4; ++rg) {
        u32x2 w0, w1; w0.x = pk2(o0[4 * rg] * inv, o0[4 * rg + 1] * inv); w0.y = pk2(o0[4 * rg + 2] * inv, o0[4 * rg + 3] * inv);
        w1.x = pk2(o1[4 * rg] * inv, o1[4 * rg + 1] * inv); w1.y = pk2(o1[4 * rg + 2] * inv, o1[4 * rg + 3] * inv);
        bf16_t* op = outp + trow * opitch + 64 * head; *(u32x2*)(op + 8 * rg + 4 * hi) = w0; *(u32x2*)(op + 32 + 8 * rg + 4 * hi) = w1;
    }
}

DI void attnC_unit(LAS unsigned char* lds, int b, int hx, int rb, bf16_t* act, const bf16_t* kx, const bf16_t* memkv, bf16_t* outp, size_t opitch) {
    const int tid = threadIdx.x, lane = tid & 63, wid = __builtin_amdgcn_readfirstlane(tid >> 6), rg = wid >> 1, dh = wid & 1, l31 = lane & 31, hi = lane >> 5;
    const size_t trow = (size_t)b * SEQ + 128 * rb + 32 * rg + l31;
    bf16_t* qp = act + trow * ACT_P + 3072 + 256 * hx;
    float ssq = 0.f;
#pragma unroll
    for (int d0 = 0; d0 < 16; ++d0) { const bf16x8 q = *(const bf16x8*)(qp + 16 * d0 + 8 * hi);
#pragma unroll
        for (int e = 0; e < 8; ++e) { const float v = bf2f((bf16_t)q[e]); ssq += v * v; } }
    ssq += __shfl_xor(ssq, 32);
    const float rstd = __builtin_amdgcn_rsqf(ssq * (1.f / 256.f) + EPS);
    f32x16 o[4];
#pragma unroll
    for (int i = 0; i < 4; ++i)
#pragma unroll
        for (int r = 0; r < 16; ++r) o[i][r] = 0.f;
    float m = -1e30f, l = 0.f;
    for (int j = 0; j < 4; ++j) {
        u32x4 rk[4], rv[4];
        tile_load(rk, kx + ((size_t)b * MEMLEN + 64 * j) * 1024 + 256 * hx, 1024, tid);
        tile_load(rv, memkv + ((size_t)b * MEMLEN + 64 * j) * 2048 + 1024 + 256 * hx, 2048, tid);
        __syncthreads();
        tile_store_k(lds + AT_K, rk, tid); tile_store_v(lds + AT_V, rv, tid);
        __syncthreads();
        f32x16 s0, s1;
#pragma unroll
        for (int r = 0; r < 16; ++r) { s0[r] = 0.f; s1[r] = 0.f; }
#pragma unroll
        for (int d0 = 0; d0 < 16; ++d0) {
            const int ch = 2 * d0 + hi;
            const bf16x8 qfr = *(const bf16x8*)(qp + 16 * d0 + 8 * hi);
            const bf16x8 k0 = *(const LAS bf16x8*)(lds + AT_K + l31 * 512 + ((ch ^ (l31 & 15)) << 4));
            const bf16x8 k1 = *(const LAS bf16x8*)(lds + AT_K + (32 + l31) * 512 + ((ch ^ (l31 & 15)) << 4));
            s0 = MFMA32(k0, qfr, s0); s1 = MFMA32(k1, qfr, s1);
        }
#pragma unroll
        for (int r = 0; r < 16; ++r) { s0[r] *= rstd; s1[r] *= rstd; }
        bf16x8 pa[4];
        const float alpha = softmax_tile(s0, s1, m, l, pa);
#pragma unroll
        for (int i = 0; i < 4; ++i)
#pragma unroll
            for (int r = 0; r < 16; ++r) o[i][r] *= alpha;
#pragma unroll
        for (int s = 0; s < 4; ++s)
#pragma unroll
            for (int i = 0; i < 4; ++i) { const bf16x8 vf = v_frag(lds + AT_V, s, (128 * dh + 32 * i) * 2, lane); o[i] = MFMA32(vf, pa[s], o[i]); }
    }
    const float lt = l + __shfl_xor(l, 32), inv = fast_rcp(lt);
    __syncthreads();
#pragma unroll
    for (int i = 0; i < 4; ++i)
#pragma unroll
        for (int g4 = 0; g4 < 4; ++g4) { u32x2 w; w.x = pk2(o[i][4 * g4] * inv, o[i][4 * g4 + 1] * inv); w.y = pk2(o[i][4 * g4 + 2] * inv, o[i][4 * g4 + 3] * inv);
            *(u32x2*)(outp + trow * opitch + 256 * hx + 128 * dh + 32 * i + 8 * g4 + 4 * hi) = w; }
}

constexpr int MB_XDT = 0, MB_XDTW = 9216, MB_BM = 18432, MB_CM = 35840, MB_YD = 53248, MB_YO = 70656, MB_ACS = 88064, MB_YSTR = 272;
DI int mb_b256(int row, int col) { return row * 272 + col * 2; }
DI int mb_b128(int row, int col) { return row * 144 + col * 2; }
template <bool W256> DI bf16x8 tr_pair(const LAS unsigned char* base, int row_lo, int row_hi, int col0, int lane) {
    const int i = lane & 15, r = i >> 2, c = col0 + 4 * (i & 3);
    const s16x4 lo = vtr(base + (W256 ? mb_b256(row_lo + r, c) : mb_b128(row_lo + r, c))), h4 = vtr(base + (W256 ? mb_b256(row_hi + r, c) : mb_b128(row_hi + r, c)));
    return __builtin_shufflevector(lo, h4, 0, 1, 2, 3, 4, 5, 6, 7);
}
DI void bcconv_phase(int vcu, int G, const bf16_t* xbc, bf16_t* bc, const float* conv_w, const float* conv_b) {
    for (int task = vcu * 512 + threadIdx.x; task < (T / 16) * 128; task += G * 512) {
        const int cc = task & 127, run = task >> 7, g = cc >> 5, w = cc & 31;
        const int scol = (w < 16 ? 2048 + 128 * g + 8 * w : 2560 + 128 * g + 8 * (w - 16));
        const int t0 = run * 16, pos0 = t0 & (SEQ - 1);
        float cw[4][8], cb[8];
#pragma unroll
        for (int e = 0; e < 8; ++e) { cb[e] = conv_b[scol + e];
#pragma unroll
            for (int i = 0; i < 4; ++i) cw[i][e] = conv_w[i * 3072 + scol + e]; }
        float win[3][8];
#pragma unroll
        for (int k = 0; k < 3; ++k) { u32x4 wv = (u32x4){0u, 0u, 0u, 0u}; if (pos0 + k - 3 >= 0) wv = *(const u32x4*)(xbc + (size_t)(t0 + k - 3) * 3072 + scol);
            win[k][0] = bf_lo(wv.x); win[k][1] = bf_hi(wv.x); win[k][2] = bf_lo(wv.y); win[k][3] = bf_hi(wv.y); win[k][4] = bf_lo(wv.z); win[k][5] = bf_hi(wv.z); win[k][6] = bf_lo(wv.w); win[k][7] = bf_hi(wv.w); }
#pragma unroll 4
        for (int k = 0; k < 16; ++k) {
            const u32x4 wv = *(const u32x4*)(xbc + (size_t)(t0 + k) * 3072 + scol);
            const float cur[8] = {bf_lo(wv.x), bf_hi(wv.x), bf_lo(wv.y), bf_hi(wv.y), bf_lo(wv.z), bf_hi(wv.z), bf_lo(wv.w), bf_hi(wv.w)};
            float o[8];
#pragma unroll
            for (int e = 0; e < 8; ++e) { o[e] = silu_(cb[e] + cw[0][e] * win[0][e] + cw[1][e] * win[1][e] + cw[2][e] * win[2][e] + cw[3][e] * cur[e]); win[0][e] = win[1][e]; win[1][e] = win[2][e]; win[2][e] = cur[e]; }
            u32x4 ov; ov.x = pk2(o[0], o[1]); ov.y = pk2(o[2], o[3]); ov.z = pk2(o[4], o[5]); ov.w = pk2(o[6], o[7]);
            *(u32x4*)(bc + (size_t)(t0 + k) * 1024 + 8 * cc) = ov;
        }
    }
}
DI void mamba_unit(LAS unsigned char* lds, int b, int h, const bf16_t* xbc, const bf16_t* bc, const float* dtp, bf16_t* act, float* ssq_out, bf16_t* outp, size_t opitch,
                   const float* conv_w, const float* conv_b, const float* a_log, const float* d_skip) {
    const int tid = threadIdx.x, lane = tid & 63, wid = __builtin_amdgcn_readfirstlane(tid >> 6), fr = lane & 15, fq = lane >> 4, g = h >> 3;
    const float A_h = -__expf(a_log[h]), D_h = d_skip[h];
    const int l = tid >> 3, pc = tid & 7, xcol = 64 * h + 8 * pc;
    float cw[4][8], cbias[8];
#pragma unroll
    for (int e = 0; e < 8; ++e) { cbias[e] = conv_b[xcol + e];
#pragma unroll
        for (int i = 0; i < 4; ++i) cw[i][e] = conv_w[i * 3072 + xcol + e]; }
    f32x4 Z[8];
#pragma unroll
    for (int i = 0; i < 8; ++i) Z[i] = (f32x4){0.f, 0.f, 0.f, 0.f};
    LAS float* acs = (LAS float*)(lds + MB_ACS);
    const int frow0 = tid >> 4, fch = tid & 15;
    u32x4 xr[4], bcr[4]; float dtv;
    const size_t tb = (size_t)b * SEQ;
#define MB_LOAD(c_) do { const int p0_ = 64 * (c_); \
        _Pragma("unroll") for (int i_ = 0; i_ < 4; ++i_) { const int pos_ = p0_ + l - 3 + i_; xr[i_] = (u32x4){0u, 0u, 0u, 0u}; if (pos_ >= 0) xr[i_] = *(const u32x4*)(xbc + (tb + pos_) * 3072 + xcol); } \
        _Pragma("unroll") for (int i_ = 0; i_ < 4; ++i_) bcr[i_] = *(const u32x4*)(bc + (tb + p0_ + frow0 + 32 * (i_ & 1)) * 1024 + 256 * g + 128 * (i_ >> 1) + 8 * fch); \
        dtv = dtp[(tb + p0_ + lane) * 32 + h]; } while (0)
    MB_LOAD(0);
    for (int c = 0; c < 64; ++c) {
        const size_t t0 = tb + 64 * c;
        float a = dtv * A_h;
#pragma unroll
        for (int o = 1; o < 64; o <<= 1) { const float u = __shfl_up(a, o); if (lane >= o) a += u; }
        const float acs63 = __shfl(a, 63), acs_l = __shfl(a, l), dt_l = __shfl(dtv, l);
        if (wid == 0) acs[lane] = a;
        float xs[8];
        { float r[4][8];
#pragma unroll
          for (int i = 0; i < 4; ++i) { r[i][0] = bf_lo(xr[i].x); r[i][1] = bf_hi(xr[i].x); r[i][2] = bf_lo(xr[i].y); r[i][3] = bf_hi(xr[i].y); r[i][4] = bf_lo(xr[i].z); r[i][5] = bf_hi(xr[i].z); r[i][6] = bf_lo(xr[i].w); r[i][7] = bf_hi(xr[i].w); }
#pragma unroll
          for (int e = 0; e < 8; ++e) xs[e] = silu_(cbias[e] + cw[0][e] * r[0][e] + cw[1][e] * r[1][e] + cw[2][e] * r[2][e] + cw[3][e] * r[3][e]); }
        { const float d = dt_l, dw = d * __expf(acs63 - acs_l);
          u32x4 av, bw; av.x = pk2(xs[0] * d, xs[1] * d); av.y = pk2(xs[2] * d, xs[3] * d); av.z = pk2(xs[4] * d, xs[5] * d); av.w = pk2(xs[6] * d, xs[7] * d);
          bw.x = pk2(xs[0] * dw, xs[1] * dw); bw.y = pk2(xs[2] * dw, xs[3] * dw); bw.z = pk2(xs[4] * dw, xs[5] * dw); bw.w = pk2(xs[6] * dw, xs[7] * dw);
          *(LAS u32x4*)(lds + MB_XDT + mb_b128(l, 8 * pc)) = av; *(LAS u32x4*)(lds + MB_XDTW + mb_b128(l, 8 * pc)) = bw; }
#pragma unroll
        for (int i = 0; i < 4; ++i) *(LAS u32x4*)(lds + (i < 2 ? MB_BM : MB_CM) + mb_b256(frow0 + 32 * (i & 1), 8 * fch)) = bcr[i];
        const u32x4 zw = *(const u32x4*)(act + (t0 + l) * ACT_P + 1024 + 64 * h + 8 * pc);
        if (c < 63) MB_LOAD(c + 1);
        __syncthreads();
        if (wid >= 4) {
            const int d = wid - 4; const float la = acs[16 * d + fr];
            f32x4 X[4];
#pragma unroll
            for (int si = 0; si < 4; ++si) { X[si] = (f32x4){0.f, 0.f, 0.f, 0.f};
                if (si <= d) {
#pragma unroll
                    for (int ks = 0; ks < 4; ++ks) { const bf16x8 av = *(const LAS bf16x8*)(lds + MB_BM + mb_b256(16 * si + fr, 32 * ks + 8 * fq));
                        const bf16x8 bb = *(const LAS bf16x8*)(lds + MB_CM + mb_b256(16 * d + fr, 32 * ks + 8 * fq)); X[si] = MFMA16(av, bb, X[si]); }
                    const f32x4 sa = *(const LAS f32x4*)(acs + 16 * si + 4 * fq);
#pragma unroll
                    for (int r = 0; r < 4; ++r) { const int s_abs = 16 * si + 4 * fq + r, l_abs = 16 * d + fr; X[si][r] = (s_abs <= l_abs) ? X[si][r] * __expf(la - sa[r]) : 0.f; }
                } }
            bf16x8 Xp[2];
#pragma unroll
            for (int sb = 0; sb < 2; ++sb) { u32x4 w; w.x = pk2(X[2 * sb][0], X[2 * sb][1]); w.y = pk2(X[2 * sb][2], X[2 * sb][3]); w.z = pk2(X[2 * sb + 1][0], X[2 * sb + 1][1]); w.w = pk2(X[2 * sb + 1][2], X[2 * sb + 1][3]); Xp[sb] = __builtin_bit_cast(bf16x8, w); }
#pragma unroll
            for (int pt = 0; pt < 4; ++pt) { f32x4 y = (f32x4){0.f, 0.f, 0.f, 0.f};
#pragma unroll
                for (int sb = 0; sb < 2; ++sb) { if (2 * sb <= d) { const bf16x8 av = tr_pair<false>(lds + MB_XDT, 32 * sb + 4 * fq, 32 * sb + 16 + 4 * fq, 16 * pt, lane); y = MFMA16(av, Xp[sb], y); } }
                *(LAS f32x4*)(lds + MB_YD + (16 * d + fr) * MB_YSTR + (16 * pt + 4 * fq) * 4) = y; }
        } else {
            const int pw = wid;
            bf16x8 Zp[4];
#pragma unroll
            for (int nb = 0; nb < 4; ++nb) { u32x4 w; w.x = pk2(Z[2 * nb][0], Z[2 * nb][1]); w.y = pk2(Z[2 * nb][2], Z[2 * nb][3]); w.z = pk2(Z[2 * nb + 1][0], Z[2 * nb + 1][1]); w.w = pk2(Z[2 * nb + 1][2], Z[2 * nb + 1][3]); Zp[nb] = __builtin_bit_cast(bf16x8, w); }
#pragma unroll
            for (int lt = 0; lt < 4; ++lt) { f32x4 y = (f32x4){0.f, 0.f, 0.f, 0.f};
#pragma unroll
                for (int nb = 0; nb < 4; ++nb) { const s16x4 lo = *(const LAS s16x4*)(lds + MB_CM + mb_b256(16 * lt + fr, 32 * nb + 4 * fq)), h4 = *(const LAS s16x4*)(lds + MB_CM + mb_b256(16 * lt + fr, 32 * nb + 16 + 4 * fq));
                    const bf16x8 bfr = __builtin_shufflevector(lo, h4, 0, 1, 2, 3, 4, 5, 6, 7);
                    y = MFMA16(Zp[nb], bfr, y); }
                const float ea = __expf(acs[16 * lt + fr]); y *= ea;
                *(LAS f32x4*)(lds + MB_YO + (16 * lt + fr) * MB_YSTR + (16 * pw + 4 * fq) * 4) = y; }
            const float dec = __expf(acs[63]);
            bf16x8 xw[2];
#pragma unroll
            for (int lb = 0; lb < 2; ++lb) xw[lb] = tr_pair<false>(lds + MB_XDTW, 32 * lb + 8 * fq, 32 * lb + 8 * fq + 4, 16 * pw, lane);
#pragma unroll
            for (int nt = 0; nt < 8; ++nt) { Z[nt] *= dec;
#pragma unroll
                for (int lb = 0; lb < 2; ++lb) { const bf16x8 av = tr_pair<true>(lds + MB_BM, 32 * lb + 8 * fq, 32 * lb + 8 * fq + 4, 16 * nt, lane); Z[nt] = MFMA16(av, xw[lb], Z[nt]); } }
        }
        __syncthreads();
        { const f32x4 a0 = *(const LAS f32x4*)(lds + MB_YD + l * MB_YSTR + pc * 32), a1 = *(const LAS f32x4*)(lds + MB_YD + l * MB_YSTR + pc * 32 + 16);
          const f32x4 b0 = *(const LAS f32x4*)(lds + MB_YO + l * MB_YSTR + pc * 32), b1 = *(const LAS f32x4*)(lds + MB_YO + l * MB_YSTR + pc * 32 + 16);
          float y[8];
          y[0] = (a0[0] + b0[0] + D_h * xs[0]) * bf_lo(zw.x); y[1] = (a0[1] + b0[1] + D_h * xs[1]) * bf_hi(zw.x);
          y[2] = (a0[2] + b0[2] + D_h * xs[2]) * bf_lo(zw.y); y[3] = (a0[3] + b0[3] + D_h * xs[3]) * bf_hi(zw.y);
          y[4] = (a1[0] + b1[0] + D_h * xs[4]) * bf_lo(zw.z); y[5] = (a1[1] + b1[1] + D_h * xs[5]) * bf_hi(zw.z);
          y[6] = (a1[2] + b1[2] + D_h * xs[6]) * bf_lo(zw.w); y[7] = (a1[3] + b1[3] + D_h * xs[7]) * bf_hi(zw.w);
          float ss = 0.f;
#pragma unroll
          for (int e = 0; e < 8; ++e) ss += y[e] * y[e];
          ss += __shfl_xor(ss, 1); ss += __shfl_xor(ss, 2); ss += __shfl_xor(ss, 4);
          if (pc == 0) ssq_out[(t0 + l) * 32 + h] = ss;
          u32x4 w; w.x = pk2(y[0], y[1]); w.y = pk2(y[2], y[3]); w.z = pk2(y[4], y[5]); w.w = pk2(y[6], y[7]); *(u32x4*)(outp + (t0 + l) * opitch + 64 * h + 8 * pc) = w; }
    }
#undef MB_LOAD
    __syncthreads();
}
constexpr int RT_W = 0, RT_CNT = 131072, RT_BASE = 131072 + 128;
constexpr int MO_TS = 131072 + 256, MO_CNT = 131072 + 512;

DI void router_phase(LAS unsigned char* lds, int vcu, int G, const float* x1, const float* norm_ffn, const float* w_router, const float* b_router,
                     bf16_t* h2, int* sel_e, int* sel_r, float* sel_w, int* tokl, unsigned* gcnt) {
    const int tid = threadIdx.x, lane = tid & 63, wid = __builtin_amdgcn_readfirstlane(tid >> 6), l31 = lane & 31, hi = lane >> 5;
    LAS float* Wl = (LAS float*)(lds + RT_W); LAS unsigned* lcnt = (LAS unsigned*)(lds + RT_CNT); LAS unsigned* lbase = (LAS unsigned*)(lds + RT_BASE);
    for (int idx = tid; idx < 1024 * 8; idx += 512) { const f32x4 w = *(const f32x4*)(w_router + 4 * idx); const float gk = norm_ffn[idx >> 3]; LAS float* p = Wl + 4 * idx; p[0] = w[0] * gk; p[1] = w[1] * gk; p[2] = w[2] * gk; p[3] = w[3] * gk; }
    if (tid < 32) lcnt[tid] = 0u;
    __syncthreads();
    if (wid >= 4) {
        for (int m = (vcu * 4 + (wid - 4)) * 4; m < T; m += G * 16) rms_rows_to_bf16<4>(x1 + (size_t)m * 1024, h2 + (size_t)m * 1024, 1, norm_ffn, lane);
    } else
    for (int tile = vcu + G * wid; tile < T / 32; tile += G * 4) {
        const int t0 = tile * 32;
        f32x16 acc;
#pragma unroll
        for (int r = 0; r < 16; ++r) acc[r] = 0.f;
        float ssq = 0.f;
        const float* xr = x1 + (size_t)(t0 + l31) * 1024 + 4 * hi;
#pragma unroll 4
        for (int c = 0; c < 128; ++c) {
            const f32x4 xv = *(const f32x4*)(xr + 8 * c);
            ssq += (xv[0] * xv[0] + xv[1] * xv[1]) + (xv[2] * xv[2] + xv[3] * xv[3]);
#pragma unroll
            for (int u = 0; u < 4; ++u) { const float a = Wl[(8 * c + 4 * hi + u) * 32 + l31]; acc = __builtin_amdgcn_mfma_f32_32x32x2f32(a, xv[u], acc, 0, 0, 0); }
        }
        ssq += __shfl_xor(ssq, 32);
        const float rstd = __builtin_amdgcn_rsqf(ssq * (1.f / 1024.f) + EPS);
        float lg[16];
#pragma unroll
        for (int r = 0; r < 16; ++r) lg[r] = acc[r] * rstd + b_router[crow(r, hi)];
        float sv[4]; int si[4];
#pragma unroll
        for (int k = 0; k < 4; ++k) {
            float bv = lg[0]; int bi = crow(0, hi);
#pragma unroll
            for (int r = 1; r < 16; ++r) { const int id = crow(r, hi); if (lg[r] > bv) { bv = lg[r]; bi = id; } }
            const float pv = __shfl_xor(bv, 32); const int pi = __shfl_xor(bi, 32);
            if (pv > bv || (pv == bv && pi < bi)) { bv = pv; bi = pi; }
            sv[k] = bv; si[k] = bi;
#pragma unroll
            for (int r = 0; r < 16; ++r) if (crow(r, hi) == bi) lg[r] = -INFINITY;
        }
        const float e1 = __expf(sv[1] - sv[0]), e2 = __expf(sv[2] - sv[0]), e3 = __expf(sv[3] - sv[0]), inv = 1.0f / (1.0f + e1 + e2 + e3);
        if (hi == 0) {
            const int t = t0 + l31; const float wv[4] = {inv, e1 * inv, e2 * inv, e3 * inv};
#pragma unroll
            for (int k = 0; k < 4; ++k) { const unsigned lr = atomicAdd((unsigned*)&lcnt[si[k]], 1u); sel_e[t * 4 + k] = si[k]; sel_r[t * 4 + k] = (int)lr; sel_w[t * 4 + k] = wv[k]; }
        }
    }
    __syncthreads();
    if (tid < 32) lbase[tid] = atomicAdd(&gcnt[tid], lcnt[tid]);
    __syncthreads();
    if (wid < 4) for (int tile = vcu + G * wid; tile < T / 32; tile += G * 4) {
        if (hi == 0) { const int t = tile * 32 + l31;
#pragma unroll
            for (int k = 0; k < 4; ++k) { const int e = sel_e[t * 4 + k]; const int r = sel_r[t * 4 + k] + (int)lbase[e]; sel_r[t * 4 + k] = r; tokl[(size_t)e * T + r] = t; } }
    }
}

DI int moe_tables(LAS unsigned char* lds, const unsigned* gcnt) {
    LAS int* ts = (LAS int*)(lds + MO_TS); LAS int* cn = (LAS int*)(lds + MO_CNT);
    __syncthreads();
    if (threadIdx.x < 32) cn[threadIdx.x] = (int)gcnt[threadIdx.x];
    __syncthreads();
    if (threadIdx.x == 0) { int s = 0; for (int e = 0; e < NEXP; ++e) { ts[e] = s; s += (cn[e] + 255) >> 8; } ts[NEXP] = s; }
    __syncthreads();
    return ts[NEXP];
}

DI void combine_phase(LAS unsigned char* lds, int vcu, int G, int tlo, int thi, const bf16_t* y, const int* sel_e, const int* sel_r, const float* sel_w, float* out) {
    const int lane = threadIdx.x & 63, wid = threadIdx.x >> 6; const LAS int* ts = (const LAS int*)(lds + MO_TS);
    for (int tb = (vcu * 8 + wid) * 4; tb < T; tb += G * 32) {
        int rowi[4][4]; float wv[4][4];
#pragma unroll
        for (int q = 0; q < 4; ++q) { const int4 e4 = *(const int4*)(sel_e + (tb + q) * 4), r4 = *(const int4*)(sel_r + (tb + q) * 4); const f32x4 w4 = *(const f32x4*)(sel_w + (tb + q) * 4);
            const int ee[4] = {e4.x, e4.y, e4.z, e4.w}, rr[4] = {r4.x, r4.y, r4.z, r4.w};
#pragma unroll
            for (int k = 0; k < 4; ++k) { const int row = ts[ee[k]] * 256 + rr[k], tile = row >> 8; const bool in = tile >= tlo && tile < thi; rowi[q][k] = in ? row - tlo * 256 : -1; wv[q][k] = w4[k]; } }
#pragma unroll
        for (int q = 0; q < 4; ++q) {
            float* op = out + (size_t)(tb + q) * 1024 + 8 * lane;
            f32x4 a0 = *(const f32x4*)op, a1 = *(const f32x4*)(op + 4), a2 = *(const f32x4*)(op + 512), a3 = *(const f32x4*)(op + 516);
            u32x4 v0[4], v1[4];
#pragma unroll
            for (int k = 0; k < 4; ++k) { v0[k] = (u32x4){0u, 0u, 0u, 0u}; v1[k] = v0[k]; if (rowi[q][k] >= 0) { const bf16_t* yp = y + (size_t)rowi[q][k] * 1024 + 8 * lane; v0[k] = *(const u32x4*)yp; v1[k] = *(const u32x4*)(yp + 512); } }
#pragma unroll
            for (int k = 0; k < 4; ++k) { const float w = wv[q][k];
                a0[0] += w * bf_lo(v0[k].x); a0[1] += w * bf_hi(v0[k].x); a0[2] += w * bf_lo(v0[k].y); a0[3] += w * bf_hi(v0[k].y);
                a1[0] += w * bf_lo(v0[k].z); a1[1] += w * bf_hi(v0[k].z); a1[2] += w * bf_lo(v0[k].w); a1[3] += w * bf_hi(v0[k].w);
                a2[0] += w * bf_lo(v1[k].x); a2[1] += w * bf_hi(v1[k].x); a2[2] += w * bf_lo(v1[k].y); a2[3] += w * bf_hi(v1[k].y);
                a3[0] += w * bf_lo(v1[k].z); a3[1] += w * bf_hi(v1[k].z); a3[2] += w * bf_lo(v1[k].w); a3[3] += w * bf_hi(v1[k].w); }
            *(f32x4*)op = a0; *(f32x4*)(op + 4) = a1; *(f32x4*)(op + 512) = a2; *(f32x4*)(op + 516) = a3;
        }
    }
}
#define XB_TMO      128
#define XB_XCNT(j)  (256  + 64 * (j))
#define XB_XSUB(j)  (1280 + 64 * (j))
#define XB_XGEN(j)  (2304 + 64 * (j))
#define XB_TOP      3328
#define XB_TOPGEN   3392
#define XCD_BAR_WORDS 3456
#define XB_SPIN_CAP (1u << 18)

__device__ __forceinline__ unsigned xb_ld(unsigned* p)              { return __hip_atomic_load(p, __ATOMIC_RELAXED, __HIP_MEMORY_SCOPE_AGENT); }
__device__ __forceinline__ unsigned xb_add(unsigned* p, unsigned v) { return __hip_atomic_fetch_add(p, v, __ATOMIC_RELAXED, __HIP_MEMORY_SCOPE_AGENT); }
__device__ __forceinline__ unsigned xb_xcc_id() { return (unsigned)__builtin_amdgcn_s_getreg((3 << 11) | 20) & 0xFu; }
#define XB_SPIN(cond, bar) do { unsigned _sp = 0; while (cond) { __builtin_amdgcn_s_sleep(1); \
    if ((++_sp & 255u) == 0u) { if (xb_ld(&(bar)[XB_TMO])) break; if (_sp > XB_SPIN_CAP) { atomicAdd(&(bar)[XB_TMO], 1u); break; } } } } while (0)

struct XcdBarrier {
    unsigned* bar; unsigned x;
    volatile LAS unsigned* st;
};

__device__ __forceinline__ XcdBarrier xcd_barrier_post(unsigned* bar, volatile LAS unsigned* st) {
    XcdBarrier b; b.bar = bar; b.x = xb_xcc_id(); b.st = st;
    if (threadIdx.x == 0) (void)xb_add(&bar[XB_XCNT(b.x)], 1u);
    return b;
}
__device__ __forceinline__ void xcd_barrier_complete(unsigned* bar, unsigned x, unsigned& nloc, unsigned& nx) {
    const unsigned G = gridDim.x * gridDim.y * gridDim.z;
    unsigned sum, cnt, mine, sp = 0u;
    for (;;) {
        sum = 0u; cnt = 0u; mine = 0u;
#pragma unroll
        for (unsigned j = 0; j < 16; ++j) { const unsigned c = xb_ld(&bar[XB_XCNT(j)]); sum += c; cnt += (c > 0u) ? 1u : 0u; mine = (j == x) ? c : mine; }
        if (sum == G) break;
        __builtin_amdgcn_s_sleep(1);
        if ((++sp & 255u) == 0u) { if (xb_ld(&bar[XB_TMO])) break; if (sp > XB_SPIN_CAP) { atomicAdd(&bar[XB_TMO], 1u); break; } }
    }
    nloc = mine > 0u ? mine : 1u; nx = cnt > 0u ? cnt : 1u;
}

__device__ __forceinline__ void xcd_barrier(const XcdBarrier& b) {
    asm volatile("s_waitcnt vmcnt(0)" ::: "memory");
    __syncthreads();
    if (threadIdx.x == 0) {
        unsigned* bar = b.bar;
        __builtin_amdgcn_s_waitcnt(0);
        unsigned nloc = b.st[0], nx = b.st[1];
        if (nloc == 0u) { xcd_barrier_complete(bar, b.x, nloc, nx); b.st[0] = nloc; b.st[1] = nx; }
        const unsigned old = xb_add(&bar[XB_XSUB(b.x)], 1u);
        const unsigned gen = old / nloc;
        if (old + 1u == (gen + 1u) * nloc) {
            __builtin_amdgcn_fence(__ATOMIC_RELEASE, "agent");
            asm volatile("s_waitcnt vmcnt(0)" ::: "memory");
            const unsigned og = xb_add(&bar[XB_TOP], 1u);
            const unsigned tg = og / nx;
            if (og + 1u == (tg + 1u) * nx) xb_add(&bar[XB_TOPGEN], 1u);
            else XB_SPIN(xb_ld(&bar[XB_TOPGEN]) == tg, bar);
            __builtin_amdgcn_fence(__ATOMIC_ACQUIRE, "agent");
            xb_add(&bar[XB_XGEN(b.x)], 1u);
            asm volatile("s_waitcnt vmcnt(0)" ::: "memory");
        } else {
            XB_SPIN(xb_ld(&bar[XB_XGEN(b.x)]) == gen, bar);
            __builtin_amdgcn_fence(__ATOMIC_ACQUIRE, "agent");
            asm volatile("s_waitcnt vmcnt(0)" ::: "memory");
        }
    }
    __syncthreads();
}


#ifndef MK_N_LAUNCHES
#define MK_N_LAUNCHES 1
#endif
#ifndef MK_BRANCHES
#define MK_BRANCHES 15
#endif
constexpr int N_PHASES = 15;
#ifndef MK_USE_CG
#define MK_USE_CG 0
#endif
constexpr int LDS_BARST = 147456 - 64;
constexpr int CW_BAR = 4096;
constexpr int LDS_BYTES = 147456;
constexpr int NTHREADS = 512;

struct Args { const float* in[30]; float* out; unsigned char* ws; int ph_lo, ph_hi; };
enum { I_x = 0, I_mem = 1, I_norm_mix = 2, I_w_in = 3, I_a_q_gain = 4, I_a_k_gain = 5, I_a_rel_bias = 6, I_conv_w = 7, I_conv_b = 8, I_dt_bias = 9, I_a_log = 10, I_d_skip = 11, I_ssm_norm = 12, I_norm_mem = 13, I_w_mem_kv = 14, I_x_q_gain = 15, I_x_k_gain = 16, I_w_br_a = 17, I_w_br_b = 18, I_w_br_c = 19, I_w_out = 20, I_norm_ffn = 21, I_w_router = 22, I_b_router = 23, I_w_gate = 24, I_b_gate = 25, I_w_up = 26, I_b_up = 27, I_w_down = 28, I_b_down = 29 };

#define WIN WSP(bf16_t, WS_WIN)
#define WCAT WSP(bf16_t, WS_WCAT)
#define WOUT WSP(bf16_t, WS_WOUT)
#define WMEM WSP(bf16_t, WS_WMEM)
#define DTB WSP(float, WS_DT)
#define SSQ WSP(float, WS_SSQ)
#define RSTD WSP(float, WS_RSTD)
#define KX WSP(bf16_t, WS_KX)
#define MEMKV WSP(bf16_t, WS_MEMKV)
#define XN WSP(bf16_t, WS_XN)
#define MEMN WSP(bf16_t, WS_MEMN)
#define ACT WSP(bf16_t, WS_ACT)
#define KA WSP(bf16_t, WS_KA)
#define VA WSP(bf16_t, WS_VA)
#define XBC WSP(bf16_t, WS_XBC)
#define GATES WSP(bf16_t, WS_GATES)
#define MERGED WSP(bf16_t, WS_MERGED)
#define H2 WSP(bf16_t, MOE_H2)
#define WGU WSP(bf16_t, MOE_WGU)
#define WD WSP(bf16_t, MOE_WD)
#define ACTM WSP(bf16_t, MOE_ACTM)
#define YB WSP(bf16_t, MOE_Y)
#define SELE WSP(int, MOE_SELE)
#define SELR WSP(int, MOE_SELR)
#define SELW WSP(float, MOE_SELW)
#define TOKL WSP(int, MOE_TOKL)
#define GCNT (WSP(unsigned, WS_CTL) + CW_CNT)
#define BCC ((bf16_t*)kq[30])
#define EI_INIT const EpiIn EI{ACT, KA, VA, XBC, GATES, MEMKV, DTB, AP(a_q_gain), AP(a_k_gain), AP(dt_bias)}
typedef const __attribute__((address_space(4))) unsigned long long* KW;
DI KW launder(KW p) { asm volatile("" : "+s"(p)); return p; }
#define AP(name) ((const float*)kq[I_##name])
#define PHASE_ARGS const KW kq = launder(kp); unsigned char* const ws = (unsigned char*)kq[31]; (void)ws
#define WSP(type, off) ((type*)(ws + (off)))
__global__ void __launch_bounds__(NTHREADS, 2) mega_fwd(Args a_unused) {
    extern __shared__ __attribute__((aligned(16))) unsigned char lds_raw[];
    LAS unsigned char* lds = (LAS unsigned char*)lds_raw;
    const KW kp = (KW)__builtin_amdgcn_kernarg_segment_ptr();
    const int tid = threadIdx.x, lane = tid & 63, wid = __builtin_amdgcn_readfirstlane(tid >> 6);
    const int G = gridDim.x, bx = blockIdx.x, vcu = (G % 8 == 0) ? (bx % 8) * (G / 8) + bx / 8 : bx;
    const int lo = (int)(unsigned)kp[32], hi = (int)(kp[32] >> 32);
#ifndef MK_PHASE_MASK
#define MK_PHASE_MASK 0x7fff
#endif
#define IN(k) (((MK_PHASE_MASK >> (k)) & 1) && lo <= (k) && (k) < hi)
#ifndef MK_REP_MASK
#define MK_REP_MASK 0
#endif
#define REPS(k) (((MK_REP_MASK >> (k)) & 1) + 1)
#if MK_USE_CG
#define SEAM(k) do { if (IN(k) && IN((k) + 1)) { cg::this_grid().sync(); } } while (0)
#else
#define SEAM(k) do { if (IN(k) && IN((k) + 1)) { xcd_barrier(bar); } } while (0)
#endif
    const int gw = vcu * 8 + wid, NGW = G * 8;
    for (int u = tid; u < 16; u += NTHREADS) ((LAS unsigned*)(lds + LDS_BARST))[u] = 0u;
    __syncthreads();
    XcdBarrier bar = xcd_barrier_post((unsigned*)(kp[31]) + CW_BAR, (volatile LAS unsigned*)(lds + LDS_BARST));
    LAS float* scr = (LAS float*)(lds + wid * 16896);

    if (IN(0)) { PHASE_ARGS;
        constexpr int I_IN = 16 * 196, I_MEM = 16 * 32, I_A = 16 * 16, I_B = 32 * 16, I_C = 16 * 16, I_O = 16 * 16, NIT = I_IN + I_MEM + I_A + I_B + I_C + I_O;
        for (int it = gw; it < NIT * REPS(0); it += NGW) {
            int r = it % NIT;
            if (r < I_IN) { const int kb = r / 196, nb = r % 196; transpose_item64(AP(w_in), IN_COLS, 64 * kb, win_src_col(2 * nb), win_src_col(2 * nb + 1), WIN + (size_t)(64 * nb) * 1024 + 64 * kb, 1024, nullptr, scr, lane); continue; } r -= I_IN;
            if (r < I_MEM) { const int kb = r / 32, nb = r % 32; transpose_item64(AP(w_mem_kv), 2048, 64 * kb, 64 * nb, 64 * nb + 32, WMEM + (size_t)(64 * nb) * 1024 + 64 * kb, 1024, nullptr, scr, lane); continue; } r -= I_MEM;
            if (r < I_A) { const int kb = r / 16, nb = r % 16; transpose_item64(AP(w_br_a), 1024, 64 * kb, 64 * nb, 64 * nb + 32, WCAT + (size_t)(64 * nb) * 4096 + 64 * kb, 4096, nullptr, scr, lane); continue; } r -= I_A;
            if (r < I_B) { const int kb = r / 16, nb = r % 16; transpose_item64(AP(w_br_b), 1024, 64 * kb, 64 * nb, 64 * nb + 32, WCAT + (size_t)(64 * nb) * 4096 + 1024 + 64 * kb, 4096, AP(ssm_norm), scr, lane); continue; } r -= I_B;
            if (r < I_C) { const int kb = r / 16, nb = r % 16; transpose_item64(AP(w_br_c), 1024, 64 * kb, 64 * nb, 64 * nb + 32, WCAT + (size_t)(64 * nb) * 4096 + 3072 + 64 * kb, 4096, nullptr, scr, lane); continue; } r -= I_C;
            { const int kb = r / 16, nb = r % 16; transpose_item64(AP(w_out), 1024, 64 * kb, 64 * nb, 64 * nb + 32, WOUT + (size_t)(64 * nb) * 1024 + 64 * kb, 1024, nullptr, scr, lane); }
        }
        for (int m0 = gw * 4; m0 < T * REPS(0); m0 += NGW * 4) { const int m = m0 % T; rms_rows_to_bf16<4>(AP(x) + (size_t)m * 1024, XN + (size_t)m * 1024, 1, AP(norm_mix), lane); }
        for (int m = gw; m < NBATCH * MEMLEN; m += NGW) rms_rows_to_bf16<1>(AP(mem) + (size_t)m * 1024, MEMN + (size_t)m * 1024, 1, AP(norm_mem), lane);
    }
    SEAM(0);
    if (IN(1)) { PHASE_ARGS; EI_INIT;
        const SchedIn S{G, bx, 16, TL_Q, 12, TL_QX, 64, (const char*)WIN, (const char*)WMEM, REPS(1)};
        pg8::gemm_phase(lds, (const char*)XN, 1024, 1024, S, EI);
    }
    SEAM(1);
    if (IN(2)) { PHASE_ARGS;
        for (int w = gw; w < NBATCH * MEMLEN * 4; w += NGW) {
            const int row = w >> 2, hx = w & 3; const u32x2 kv = *(const u32x2*)(MEMKV + (size_t)row * 2048 + 256 * hx + 4 * lane);
            const float k0 = bf_lo(kv.x), k1 = bf_hi(kv.x), k2 = bf_lo(kv.y), k3 = bf_hi(kv.y);
            const float rs = __builtin_amdgcn_rsqf(wave_sum(k0 * k0 + k1 * k1 + k2 * k2 + k3 * k3) * (1.f / 256.f) + EPS) * (0.0625f * LOG2E);
            const f32x4 gk = *(const f32x4*)(AP(x_k_gain) + 4 * lane), gq = *(const f32x4*)(AP(x_q_gain) + 4 * lane);
            u32x2 o; o.x = pk2(k0 * rs * gk.x * gq.x, k1 * rs * gk.y * gq.y); o.y = pk2(k2 * rs * gk.z * gq.z, k3 * rs * gk.w * gq.w);
            *(u32x2*)(KX + (size_t)row * 1024 + 256 * hx + 4 * lane) = o;
        }
        if (MK_BRANCHES & 1) {
            LAS float* bl = (LAS float*)(lds + AT_BIAS);
            for (int i = tid; i < 16 * 257; i += NTHREADS) bl[(i / 257) * AT_BIAS_STRIDE + (i % 257)] = AP(a_rel_bias)[i] * LOG2E;
            __syncthreads();
            for (int u = vcu; u < 4 * NBATCH * 64; u += G) { const int c = u & 63, b = (u >> 6) & 7, hq = u >> 9; attnA_unit(lds, b, c, hq, ACT, KA, VA, (MK_REP_MASK >> 2 & 1) ? (bf16_t*)(ws + WS_BUF + 128 * MiB) : ACT, (MK_REP_MASK >> 2 & 1) ? 1024 : ACT_P);
                if (MK_REP_MASK >> 2 & 1) attnA_unit(lds, b, c, hq, ACT, KA, VA, ACT, ACT_P); }
        } else {
            for (int idx = vcu * NTHREADS + tid; idx < T * 128; idx += G * NTHREADS) { const int t = idx >> 7, ch = idx & 127; *(u32x4*)(ACT + (size_t)t * ACT_P + ch * 8) = (u32x4){0u, 0u, 0u, 0u}; }
        }
    }
    SEAM(2);
    if (IN(3)) { PHASE_ARGS; EI_INIT;
        const SchedIn S{G, bx, 21, TL_Z, 21, 0, 0, (const char*)WIN, (const char*)WMEM, REPS(3)};
        pg8::gemm_phase(lds, (const char*)XN, 1024, 1024, S, EI);
    }
    SEAM(3);
    if (IN(4)) { PHASE_ARGS;
        if (MK_BRANCHES & 2) bcconv_phase(vcu, G, XBC, BCC, AP(conv_w), AP(conv_b));
        if (MK_REP_MASK >> 14 & 1) for (int u = vcu; u < NBATCH * 4 * 32; u += G) { const int rb = u & 31, hx = (u >> 5) & 3, b = u >> 7; attnC_unit(lds, b, hx, rb, ACT, KX, MEMKV, (bf16_t*)kq[30] + (size_t)T * 1024, 1024); }
        if (MK_BRANCHES & 4) for (int u = vcu; u < NBATCH * 4 * 32; u += G) { const int rb = u & 31, hx = (u >> 5) & 3, b = u >> 7; attnC_unit(lds, b, hx, rb, ACT, KX, MEMKV, ACT + 3072, ACT_P); }
        if (MK_BRANCHES & 2) {
            xcd_barrier(bar);
            for (int u = vcu; u < NBATCH * 32; u += G) mamba_unit(lds, u >> 5, u & 31, XBC, BCC, DTB, ACT, SSQ, ACT + 1024, ACT_P, AP(conv_w), AP(conv_b), AP(a_log), AP(d_skip));
        }
    }
    SEAM(4);
    if (IN(5)) { PHASE_ARGS; EI_INIT;
        for (int idx = vcu * NTHREADS + tid; idx < T * 4; idx += G * NTHREADS) { const int t = idx >> 2, g = idx & 3; const f32x4 s0 = *(const f32x4*)(SSQ + (size_t)t * 32 + 8 * g), s1 = *(const f32x4*)(SSQ + (size_t)t * 32 + 8 * g + 4);
            RSTD[idx] = __builtin_amdgcn_rsqf(((s0[0] + s0[1]) + (s0[2] + s0[3]) + (s1[0] + s1[1]) + (s1[2] + s1[3])) * (1.f / 512.f) + EPS); }
        const SchedIn S{G, bx, 12, TL_G, 12, 0, 0, (const char*)WIN, (const char*)WMEM, REPS(5)};
        pg8::gemm_phase(lds, (const char*)XN, 1024, 1024, S, EI);
    }
    SEAM(5);
    if (IN(6)) { PHASE_ARGS;
        constexpr int LASTSEG = (MK_BRANCHES & 4) ? 2 : ((MK_BRANCHES & 2) ? 1 : 0);
        constexpr int KM = LASTSEG == 2 ? 4096 : (LASTSEG == 1 ? 3072 : 1024);
        const SchedDense S{G, bx, T / 256, 4, 4096, (const char*)WCAT, REPS(6)};
        const EpiMerge E{GATES, RSTD, MERGED, LASTSEG};
        pg8::gemm_phase(lds, (const char*)ACT, KM, 4096, S, E);
    }
    SEAM(6);
    if (IN(7)) { PHASE_ARGS;
        const SchedDense S{G, bx, T / 256, 4, 1024, (const char*)WOUT, REPS(7)};
        const EpiOut E{AP(x), ((float*)kq[30])};
        pg8::gemm_phase(lds, (const char*)MERGED, 1024, 1024, S, E);
    }
    SEAM(7);
    if (IN(8) && (MK_BRANCHES & 8)) { PHASE_ARGS;
        router_phase(lds, vcu, G, ((float*)kq[30]), AP(norm_ffn), AP(w_router), AP(b_router), H2, SELE, SELR, SELW, TOKL, GCNT);
        __syncthreads();
        for (int it0 = gw; it0 < NEXP * 768 * REPS(8); it0 += NGW) { const int it = it0 % (NEXP * 768);
            const int e = it / 768, r = it % 768, which = r >> 8, kb = (r & 255) >> 4, nb = r & 15;
            const float* src = (which == 0 ? AP(w_gate) : which == 1 ? AP(w_up) : AP(w_down)) + (size_t)e * 1024 * 1024;
            bf16_t* dst = which == 2 ? WD + ((size_t)e * 1024 + 64 * nb) * 1024 + 64 * kb : WGU + ((size_t)e * 2048 + 256 * (nb >> 1) + 128 * which + 64 * (nb & 1)) * 1024 + 64 * kb;
            transpose_item64(src, 1024, 64 * kb, 64 * nb, 64 * nb + 32, dst, 1024, nullptr, scr, lane);
        }
    }
    SEAM(8);
#pragma unroll 1
    for (int g = 0; g < 2; ++g) {
        const int p0 = 9 + 3 * g;
        if ((MK_BRANCHES & 8) && (IN(p0) || IN(p0 + 1) || IN(p0 + 2))) { PHASE_ARGS;
            const int total = moe_tables(lds, GCNT), half = (total + 1) >> 1, tlo = g ? half : 0, thi = g ? total : half;
            const LAS int* ts = (const LAS int*)(lds + MO_TS); const LAS int* cn = (const LAS int*)(lds + MO_CNT);
            if (IN(p0)) { const SchedMoE S{G, bx, 8, tlo, thi, ts, cn, TOKL, (const char*)WGU, (size_t)2048 * 1024 * 2, REPS(9)}; const EpiGU E{ACTM, AP(b_gate), AP(b_up), tlo};
                pg8::gemm_phase(lds, (const char*)H2, 1024, 1024, S, E); }
            SEAM(p0);
            if (IN(p0 + 1)) { const SchedMoE S{G, bx, 4, tlo, thi, ts, cn, nullptr, (const char*)WD, (size_t)1024 * 1024 * 2, REPS(10)}; const EpiDown E{YB, AP(b_down), tlo};
                pg8::gemm_phase(lds, (const char*)ACTM, 1024, 1024, S, E); }
            SEAM(p0 + 1);
            if (IN(p0 + 2)) combine_phase(lds, vcu, G, tlo, thi, YB, SELE, SELR, SELW, ((float*)kq[30]));
            SEAM(p0 + 2);
        } else { SEAM(p0); SEAM(p0 + 1); SEAM(p0 + 2); }
    }
#undef IN
#undef SEAM
}

extern "C" void kernel_launch(void* const* d_in, const int* in_sizes, int n_in, void* d_out, int out_size, void* d_ws, size_t ws_size, hipStream_t stream) {
    static int grid = 0;
    if (grid == 0) {
        if (n_in != 30 || ws_size < WS_MIX_END || ws_size < WS_END) { fprintf(stderr, "kernel_launch: unexpected n_in %d / ws_size %zu\n", n_in, ws_size); grid = -1; return; }
        int dev = 0, cus = 0, per_cu = 0;
        (void)hipGetDevice(&dev); (void)hipDeviceGetAttribute(&cus, hipDeviceAttributeMultiprocessorCount, dev);
        (void)hipFuncSetAttribute((const void*)mega_fwd, hipFuncAttributeMaxDynamicSharedMemorySize, LDS_BYTES);
        (void)hipOccupancyMaxActiveBlocksPerMultiprocessor(&per_cu, (const void*)mega_fwd, NTHREADS, LDS_BYTES);
        if (per_cu < 1) { fprintf(stderr, "kernel_launch: occupancy query reports %d blocks per CU\n", per_cu); grid = -1; return; }
        grid = cus;
    }
    if (grid < 0) return;
    (void)hipMemsetAsync((char*)d_ws + WS_CTL, 0, 65536, stream);
    Args a{};
    for (int i = 0; i < 30; ++i) a.in[i] = (const float*)d_in[i];
    a.out = (float*)d_out; a.ws = (unsigned char*)d_ws;
    if (MK_N_LAUNCHES == 1) {
        a.ph_lo = 0; a.ph_hi = N_PHASES;
        void* args[] = {&a};
        hipError_t e = hipLaunchCooperativeKernel((void*)mega_fwd, dim3(grid), dim3(NTHREADS), args, LDS_BYTES, stream);
        if (e != hipSuccess) fprintf(stderr, "cooperative launch failed: %s (grid %d)\n", hipGetErrorString(e), grid);
    } else {
        for (int ph = 0; ph < N_PHASES; ++ph) { a.ph_lo = ph; a.ph_hi = ph + 1; hipLaunchKernelGGL(mega_fwd, dim3(grid), dim3(NTHREADS), LDS_BYTES, stream, a); }
    }
}
```

```cpp
#include <hip/hip_runtime.h>
#include <hip/hip_cooperative_groups.h>
#include <cstdio>
#include <cstdint>
namespace cg = cooperative_groups;

#define LAS __attribute__((address_space(3)))
#define GAS __attribute__((address_space(1)))
#define DI __device__ __forceinline__
typedef unsigned short bf16_t;
typedef short bf16x8 __attribute__((ext_vector_type(8)));
typedef short s16x4 __attribute__((ext_vector_type(4)));
typedef float f32x2 __attribute__((ext_vector_type(2)));
typedef float f32x4 __attribute__((ext_vector_type(4)));
typedef float f32x16 __attribute__((ext_vector_type(16)));
typedef unsigned u32x2 __attribute__((ext_vector_type(2)));
typedef unsigned u32x4 __attribute__((ext_vector_type(4)));
typedef __bf16 bf16x2_t __attribute__((ext_vector_type(2)));
typedef short v4i16_t __attribute__((ext_vector_type(4)));

DI unsigned pk2(float lo, float hi) { f32x2 v = {lo, hi}; bf16x2_t b = __builtin_convertvector(v, bf16x2_t); return __builtin_bit_cast(unsigned, b); }
DI float bf_lo(unsigned w) { return __uint_as_float(w << 16); }
DI float bf_hi(unsigned w) { return __uint_as_float(w & 0xffff0000u); }
DI float bf2f(bf16_t b) { return __uint_as_float(((unsigned)b) << 16); }
DI float wave_sum(float v) {
#pragma unroll
    for (int o = 1; o < 64; o <<= 1) v += __shfl_xor(v, o);
    return v;
}
DI float fast_exp2(float x) { return __builtin_amdgcn_exp2f(x); }
DI float fast_rcp(float x) { return __builtin_amdgcn_rcpf(x); }
DI float sigmoidf_(float x) { return fast_rcp(1.0f + fast_exp2(-1.4426950408889634f * x)); }

constexpr int NBATCH = 8, SEQ = 4096, T = NBATCH * SEQ, DM = 1024;
constexpr int NWIN_TILES = 49, NWIN = NWIN_TILES * 256;
constexpr int IN_COLS = 12320;
constexpr float EPS = 1e-6f;
constexpr float LOG2E = 1.4426950408889634f;
constexpr int NEXP = 32, TOPK = 4;
constexpr int MEMLEN = 256;
constexpr int ACT_P = 4096;
constexpr int TL_Q = 0, TL_K = 4, TL_V = 8, TL_Z = 12, TL_XBC = 20, TL_DT = 32, TL_QX = 33, TL_G = 37;

constexpr size_t MiB = (size_t)1 << 20;
constexpr size_t WS_CTL = 0, CTL_BYTES = 1 * MiB;
constexpr size_t WS_WIN = 1 * MiB, WS_WCAT = 26 * MiB, WS_WOUT = 34 * MiB, WS_WMEM = 36 * MiB;
constexpr size_t WS_DT = 40 * MiB, WS_SSQ = 44 * MiB, WS_RSTD = 48 * MiB, WS_KX = 49 * MiB, WS_MEMKV = 53 * MiB;
constexpr size_t WS_XN = 61 * MiB, WS_MEMN = 125 * MiB, WS_ACT = 129 * MiB, WS_BUF = 385 * MiB, WS_MIX_END = 577 * MiB;
constexpr size_t WS_KA = WS_BUF, WS_VA = WS_BUF + 64 * MiB, WS_XBC = WS_BUF, WS_GATES = WS_BUF, WS_MERGED = WS_XN;
constexpr int MOE_TILE_CAP = 280;
constexpr size_t MOE_H2 = 1 * MiB, MOE_WGU = 65 * MiB, MOE_WD = 193 * MiB, MOE_ACTM = 257 * MiB, MOE_Y = 397 * MiB;
constexpr size_t MOE_SELE = 537 * MiB, MOE_SELR = 537 * MiB + 512 * 1024, MOE_SELW = 538 * MiB, MOE_TOKL = 539 * MiB, WS_END = 543 * MiB;
constexpr int CW_CNT = 64;

#ifndef MK_KREP
#define MK_KREP 1
#endif
namespace pg8 {
constexpr int BM = 256, BK = 64, HALF = 128, HTB = HALF * BK * 2, STAGE_BYTES = 8 * HTB;
__host__ __device__ __forceinline__ int lds_byte(int r, int c) { const int st = (r >> 4) * 2 + (c >> 5), rr = r & 15, cc = c & 31, ob = rr * 64 + cc * 2; return st * 1024 + (ob ^ (((ob >> 9) & 1) << 5)); }
__host__ __device__ __forceinline__ void stage_rc(int b, int& R, int& C) { const int st = b / 1024, sb = b % 1024, swz = sb ^ (((sb >> 9) & 1) << 5); R = (st >> 1) * 16 + swz / 64; C = (st & 1) * 32 + (swz % 64) / 2; }
__host__ __device__ __forceinline__ int perm32(int rho) { const int n = rho >> 4, i = rho & 15; return 8 * (i >> 2) + 4 * n + (i & 3); }

struct Unit { int kind, pm, pn, aux; };

typedef f32x4 Acc[2][2][4][2];

typedef int v8i_t __attribute__((ext_vector_type(8)));
template <bool FP8, class Epi, class Sched>
DI void gemm_phase(LAS unsigned char* lds, const char* Abase, const int Kb, const int ldbb, const Sched& S, const Epi& E) {
    int tid_ = threadIdx.x; asm volatile("" : "+v"(tid_));
    const int tid = tid_, wid = __builtin_amdgcn_readfirstlane(tid >> 6), lane = tid & 63, wr = wid >> 2, wc = wid & 3, fr = lane & 15, fq = lane >> 4;
    const int nt = Kb / (BK * 2);
    int Rr[2], Cc2[2]; unsigned voffB[2];
#pragma unroll
    for (int i = 0; i < 2; ++i) { int R, C; stage_rc(tid * 16 + i * 8192, R, C); Rr[i] = R; Cc2[i] = C * 2; const int Rb = (R & ~31) + perm32(R & 31); voffB[i] = (unsigned)(Rb * ldbb + C * 2); }
    const unsigned kstep = (unsigned)(BK * 2);
    const size_t hstepB = (size_t)HALF * ldbb;
    const unsigned ldsw = (unsigned)wid * 1024u;
    const int aoff0 = lds_byte(wr * 64 + fr, fq * 8), aoff1 = aoff0 + 1024;
    const int boff0 = lds_byte(wc * 32 + fr, fq * 8), boff1 = boff0 + 1024;
#define PG8_SA(b, h) (((b) * 2 + (h)) * HTB)
#define PG8_SB(b, h) ((4 + (b) * 2 + (h)) * HTB)
#define PG8_GLDS(src, dstoff) __builtin_amdgcn_global_load_lds((const unsigned*)(src), (LAS unsigned*)(lds + (dstoff)), 16, 0, 0)
#define PG8_STAGE_B(bufoff, ptr) do { _Pragma("unroll") for (int _i = 0; _i < 2; ++_i) PG8_GLDS((const char*)(ptr) + voffB[_i], (bufoff) + ldsw + _i * 8192); } while (0)
#define PG8_STAGE_A(bufoff, kb, v0, v1) do { PG8_GLDS(Abase + (size_t)(v0) + (kb), (bufoff) + ldsw); PG8_GLDS(Abase + (size_t)(v1) + (kb), (bufoff) + ldsw + 8192); } while (0)
#define PG8_LDA(dst, b, h) do { _Pragma("unroll") for (int m = 0; m < 4; ++m) { dst[m][0] = *(const LAS u32x4*)(lds + PG8_SA(b, h) + aoff0 + m * 2048); dst[m][1] = *(const LAS u32x4*)(lds + PG8_SA(b, h) + aoff1 + m * 2048); } } while (0)
#define PG8_LDB(dst, b, h) do { _Pragma("unroll") for (int n = 0; n < 2; ++n) { dst[n][0] = *(const LAS u32x4*)(lds + PG8_SB(b, h) + boff0 + n * 2048); dst[n][1] = *(const LAS u32x4*)(lds + PG8_SB(b, h) + boff1 + n * 2048); } } while (0)
#define PG8_CAT(x) __builtin_bit_cast(v8i_t, __builtin_shufflevector((x)[0], (x)[1], 0, 1, 2, 3, 4, 5, 6, 7))
#define PG8_MMA(ai, bj, At, Bt) do { __builtin_amdgcn_s_setprio(1); _Pragma("unroll") for (int m = 0; m < 4; ++m) _Pragma("unroll") for (int n = 0; n < 2; ++n) { \
        if constexpr (FP8) asm volatile("v_mfma_scale_f32_16x16x128_f8f6f4 %0, %1, %2, %0, %3, %4 op_sel_hi:[0,0,0]" : "+v"(acc[ai][bj][m][n]) : "v"(PG8_CAT(Bt[n])), "v"(PG8_CAT(At[m])), "v"(sclB), "v"(sclA)); \
        else { _Pragma("unroll") for (int k = 0; k < 2; ++k) acc[ai][bj][m][n] = __builtin_amdgcn_mfma_f32_16x16x32_bf16(__builtin_bit_cast(bf16x8, Bt[n][k]), __builtin_bit_cast(bf16x8, At[m][k]), acc[ai][bj][m][n], 0, 0, 0); } } \
        __builtin_amdgcn_s_setprio(0); } while (0)
#define PG8_WAIT_V(n) asm volatile("s_waitcnt vmcnt(" #n ")" ::: "memory")
#define PG8_WAIT_L(n) asm volatile("s_waitcnt lgkmcnt(" #n ")" ::: "memory")
#define PG8_BAR __builtin_amdgcn_s_barrier()
#define PG8_SCHED __builtin_amdgcn_sched_barrier(0)
    Unit cur, nxt; int ui = 0;
    if (!S.next(0, cur)) return;
    Acc acc;
#pragma unroll
    for (int a = 0; a < 2; ++a)
#pragma unroll
        for (int b = 0; b < 2; ++b)
#pragma unroll
            for (int m = 0; m < 4; ++m)
#pragma unroll
                for (int n = 0; n < 2; ++n) acc[a][b][m][n] = (f32x4){0.f, 0.f, 0.f, 0.f};
    u32x4 At[4][2], B0[2][2], B1[2][2];
    int sclB = 0x7a7a7a7a, sclA = 0x7f7f7f7f;
    asm volatile("" : "+v"(sclB), "+v"(sclA));
    unsigned vA00 = S.arow(cur, Rr[0]) + Cc2[0], vA01 = S.arow(cur, Rr[1]) + Cc2[1], vA10 = S.arow(cur, HALF + Rr[0]) + Cc2[0], vA11 = S.arow(cur, HALF + Rr[1]) + Cc2[1];
    const char* cB = S.bptr(cur);
    PG8_STAGE_B(PG8_SB(0, 0), cB); PG8_STAGE_B(PG8_SB(0, 1), cB + hstepB); PG8_STAGE_A(PG8_SA(0, 0), 0, vA00, vA01); PG8_STAGE_A(PG8_SA(0, 1), 0, vA10, vA11);
    if (wr == 1) PG8_BAR;
    PG8_WAIT_V(2); PG8_BAR;
    PG8_STAGE_B(PG8_SB(1, 0), cB + kstep); PG8_STAGE_A(PG8_SA(1, 0), kstep, vA00, vA01); PG8_STAGE_B(PG8_SB(1, 1), cB + hstepB + kstep);
    PG8_WAIT_V(6); PG8_BAR;
    for (;;) {
        const bool has_next = S.next(ui + 1, nxt);
        const char* nB = has_next ? S.bptr(nxt) : cB;
        constexpr int KREP = (MK_KREP > 1 && !Epi::SEGMENTED) ? MK_KREP : 1;
        for (int tt = 0; tt < nt * KREP; tt += 2) {
            const int t = KREP > 1 ? tt % nt : tt;
            const bool last = (tt == nt * KREP - 2);
            if constexpr (Epi::SEGMENTED) { if (t > 0 && E.boundary(t)) E.rescale(acc, cur, t, wr, wc, fr, fq); }
            const unsigned k1 = (unsigned)(t + 1) * kstep;
            const unsigned t2 = (KREP > 1) ? (unsigned)((t + 2) % nt) : (unsigned)(t + 2);
            const unsigned k2 = last ? 0u : t2 * kstep, k3 = k2 + kstep;
            const char* b2 = last ? nB : cB + t2 * kstep; const char* b3 = b2 + kstep;
            unsigned w00 = vA00, w01 = vA01, w10 = vA10, w11 = vA11;
            if (last && has_next) { w00 = S.arow(nxt, Rr[0]) + Cc2[0]; w01 = S.arow(nxt, Rr[1]) + Cc2[1]; w10 = S.arow(nxt, HALF + Rr[0]) + Cc2[0]; w11 = S.arow(nxt, HALF + Rr[1]) + Cc2[1]; }
            PG8_LDB(B0, 0, 0); PG8_LDB(B1, 0, 1); PG8_SCHED; PG8_LDA(At, 0, 0); PG8_STAGE_A(PG8_SA(1, 1), k1, vA10, vA11);
            PG8_WAIT_V(8); PG8_WAIT_L(0); PG8_BAR; PG8_MMA(0, 0, At, B0); PG8_MMA(0, 1, At, B1); PG8_BAR; PG8_SCHED;
            PG8_LDA(At, 0, 1); PG8_STAGE_B(PG8_SB(0, 0), b2); PG8_STAGE_B(PG8_SB(0, 1), b2 + hstepB); PG8_STAGE_A(PG8_SA(0, 0), k2, w00, w01);
            PG8_WAIT_V(8); PG8_WAIT_L(0); PG8_BAR; PG8_MMA(1, 0, At, B0); PG8_MMA(1, 1, At, B1); PG8_BAR; PG8_SCHED;
            PG8_LDB(B0, 1, 0); PG8_LDB(B1, 1, 1); PG8_SCHED; PG8_LDA(At, 1, 0); PG8_STAGE_A(PG8_SA(0, 1), k2, w10, w11);
            PG8_WAIT_V(8); PG8_WAIT_L(0); PG8_BAR; PG8_MMA(0, 0, At, B0); PG8_MMA(0, 1, At, B1); PG8_BAR; PG8_SCHED;
            PG8_LDA(At, 1, 1); PG8_STAGE_B(PG8_SB(1, 0), b3); PG8_STAGE_B(PG8_SB(1, 1), b3 + hstepB); PG8_STAGE_A(PG8_SA(1, 0), k3, w00, w01);
            PG8_WAIT_V(8); PG8_WAIT_L(0); PG8_BAR; PG8_MMA(1, 0, At, B0); PG8_MMA(1, 1, At, B1); PG8_BAR; PG8_SCHED;
            if (last) { vA00 = w00; vA01 = w01; vA10 = w10; vA11 = w11; }
        }
        if (wr == 0) PG8_BAR;
        if constexpr (FP8) asm volatile("s_nop 15\n\ts_nop 7" ::: "memory");
        if constexpr (KREP > 1) {
#pragma unroll
            for (int a = 0; a < 2; ++a)
#pragma unroll
                for (int b = 0; b < 2; ++b)
#pragma unroll
                    for (int m = 0; m < 4; ++m)
#pragma unroll
                        for (int n = 0; n < 2; ++n) acc[a][b][m][n] *= (1.0f / KREP); }
        E(acc, cur, wr, wc, fr, fq);
        if (!has_next) break;
#pragma unroll
        for (int a = 0; a < 2; ++a)
#pragma unroll
            for (int b = 0; b < 2; ++b)
#pragma unroll
                for (int m = 0; m < 4; ++m)
#pragma unroll
                    for (int n = 0; n < 2; ++n) acc[a][b][m][n] = (f32x4){0.f, 0.f, 0.f, 0.f};
        cur = nxt; cB = nB; ++ui;
        if (wr == 1) PG8_BAR;
    }
    PG8_WAIT_V(0);
    PG8_BAR;
#undef PG8_SA
#undef PG8_SB
#undef PG8_GLDS
#undef PG8_STAGE_A
#undef PG8_STAGE_B
#undef PG8_LDA
#undef PG8_LDB
#undef PG8_MMA
#undef PG8_CAT
#undef PG8_WAIT_V
#undef PG8_WAIT_L
#undef PG8_BAR
#undef PG8_SCHED
}

DI bool static_tile(int L, int nM, int nN, int& pm, int& pn) {
    const int nwg = nM * nN; if (L >= nwg) return false;
    int wgid = L; { const int q = nwg / 8, r = nwg % 8, xcd = wgid % 8, off = wgid / 8; wgid = (xcd < r ? xcd * (q + 1) : r * (q + 1) + (xcd - r) * q) + off; }
    const int nig = 8 * nN, gid = wgid / nig, fm = gid * 8, gsz = (nM - fm) < 8 ? (nM - fm) : 8;
    pm = fm + ((wgid % nig) % gsz); pn = (wgid % nig) / gsz; return true;
}
}
using pg8::Unit; using pg8::Acc;

DI unsigned pk4_fp8(float a, float b, float c, float d) { int p = 0; p = __builtin_amdgcn_cvt_pk_fp8_f32(a, b, p, false); p = __builtin_amdgcn_cvt_pk_fp8_f32(c, d, p, true); return (unsigned)p; }
DI float silu_(float v) { return v * sigmoidf_(v); }
DI float softplus_(float x) { return fmaxf(x, 0.f) + __logf(1.0f + __expf(-fabsf(x))); }

struct SchedIn {
    int G, c, ncol, t0, nsplit, t1, nextra; const char* win; const char* wmem; int reps;
    DI bool next(int i, Unit& u) const {
        const int U = (T / 256) * ncol + nextra; int L = i * G + c; if (L >= U * reps) return false; L %= U; int pm, pn;
        if (pg8::static_tile(L, T / 256, ncol, pm, pn)) { u.kind = 0; u.pm = pm; u.pn = pn < nsplit ? t0 + pn : t1 + (pn - nsplit); u.aux = 0; return true; }
        const int j = L - (T / 256) * ncol; if (j < nextra) { u.kind = 1; u.pm = j >> 3; u.pn = j & 7; u.aux = 0; return true; }
        return false;
    }
    DI unsigned arow(const Unit& u, int r) const { return (u.kind == 0 ? 0u : (unsigned)(WS_MEMN - WS_XN)) + (unsigned)(u.pm * 256 + r) * 2048u; }
    DI const char* bptr(const Unit& u) const { return (u.kind == 0 ? win : wmem) + (size_t)u.pn * (256 * 1024 * 2); }
};

struct EpiIn {
    static constexpr bool SEGMENTED = false;
    unsigned char* ws; const float *qgain, *kgain, *dtbias;
    template <int OP> DI void ew(const Acc& acc, bf16_t* dst, size_t pitch, int col0, int row0, int wc, int fq) const {
#pragma unroll
        for (int ai = 0; ai < 2; ++ai)
#pragma unroll
            for (int m = 0; m < 4; ++m) { bf16_t* rowp = dst + (size_t)(row0 + ai * 128 + m * 16) * pitch + col0 + wc * 32 + 8 * fq;
#pragma unroll
                for (int bj = 0; bj < 2; ++bj) { f32x4 v0 = acc[ai][bj][m][0], v1 = acc[ai][bj][m][1];
                    if (OP == 1) { for (int e = 0; e < 4; ++e) { v0[e] = silu_(v0[e]); v1[e] = silu_(v1[e]); } }
                    if (OP == 2) { for (int e = 0; e < 4; ++e) { v0[e] = sigmoidf_(fminf(fmaxf(v0[e], -30.f), 30.f)); v1[e] = sigmoidf_(fminf(fmaxf(v1[e], -30.f), 30.f)); } }
                    u32x4 w; w.x = pk2(v0[0], v0[1]); w.y = pk2(v0[2], v0[3]); w.z = pk2(v1[0], v1[1]); w.w = pk2(v1[2], v1[3]);
                    *(u32x4*)(rowp + bj * 128) = w; }
                asm volatile("" ::: "memory"); }
    }
    DI void headnorm(const Acc& acc, bf16_t* dst, size_t pitch, int col0, int row0, int wc, int fq, const float* gain, float mul) const {
#pragma unroll
        for (int ai = 0; ai < 2; ++ai)
#pragma unroll
            for (int m = 0; m < 4; ++m) {
                float ss = 0.f;
#pragma unroll
                for (int bj = 0; bj < 2; ++bj)
#pragma unroll
                    for (int n = 0; n < 2; ++n) { const f32x4 x = acc[ai][bj][m][n]; ss += (x[0] * x[0] + x[1] * x[1]) + (x[2] * x[2] + x[3] * x[3]); }
                ss += __shfl_xor(ss, 16); ss += __shfl_xor(ss, 32);
                const float rs = __builtin_amdgcn_rsqf(ss * (1.0f / 64.0f) + EPS) * mul;
                bf16_t* rowp = dst + (size_t)(row0 + ai * 128 + m * 16) * pitch + col0 + wc * 64 + 8 * fq;
#pragma unroll
                for (int bj = 0; bj < 2; ++bj) { const f32x4 g0 = *(const f32x4*)(gain + 32 * bj + 8 * fq), g1 = *(const f32x4*)(gain + 32 * bj + 8 * fq + 4);
                    const f32x4 v0 = acc[ai][bj][m][0] * rs * g0, v1 = acc[ai][bj][m][1] * rs * g1;
                    u32x4 w; w.x = pk2(v0[0], v0[1]); w.y = pk2(v0[2], v0[3]); w.z = pk2(v1[0], v1[1]); w.w = pk2(v1[2], v1[3]);
                    *(u32x4*)(rowp + bj * 32) = w; }
                asm volatile("" ::: "memory"); }
    }
    DI void operator()(const Acc& acc, const Unit& u, int wr, int wc, int fr, int fq) const {
        const int row0 = u.pm * 256 + wr * 64 + fr;
        bf16_t* const act = (bf16_t*)(ws + WS_ACT); bf16_t* const ka = (bf16_t*)(ws + WS_KA); bf16_t* const va = (bf16_t*)(ws + WS_VA); bf16_t* const xbc = (bf16_t*)(ws + WS_XBC);
        bf16_t* const gates = (bf16_t*)(ws + WS_GATES); bf16_t* const memkv = (bf16_t*)(ws + WS_MEMKV); float* const dt = (float*)(ws + WS_DT);
        if (u.kind == 1) { ew<0>(acc, memkv, 2048, u.pn * 256, row0, wc, fq); return; }
        const int tl = u.pn;
        if (tl < TL_K) headnorm(acc, act, ACT_P, (tl - TL_Q) * 256, row0, wc, fq, qgain, 0.125f * LOG2E);
        else if (tl < TL_V) headnorm(acc, ka, 1024, (tl - TL_K) * 256, row0, wc, fq, kgain, 1.0f);
        else if (tl < TL_Z) ew<0>(acc, va, 1024, (tl - TL_V) * 256, row0, wc, fq);
        else if (tl < TL_XBC) ew<1>(acc, act, ACT_P, 1024 + (tl - TL_Z) * 256, row0, wc, fq);
        else if (tl < TL_DT) ew<0>(acc, xbc, 3072, (tl - TL_XBC) * 256, row0, wc, fq);
        else if (tl == TL_DT) {
            if (wc == 0) {
                f32x4 b0 = *(const f32x4*)(dtbias + 8 * fq), b1 = *(const f32x4*)(dtbias + 8 * fq + 4);
#pragma unroll
                for (int ai = 0; ai < 2; ++ai)
#pragma unroll
                    for (int m = 0; m < 4; ++m) { float* rowp = dt + (size_t)(row0 + ai * 128 + m * 16) * 32 + 8 * fq;
                        f32x4 v0 = acc[ai][0][m][0] + b0, v1 = acc[ai][0][m][1] + b1;
                        for (int e = 0; e < 4; ++e) { v0[e] = softplus_(v0[e]); v1[e] = softplus_(v1[e]); }
                        *(f32x4*)rowp = v0; *(f32x4*)(rowp + 4) = v1; }
            }
        }
        else if (tl < TL_G) ew<0>(acc, act, ACT_P, 3072 + (tl - TL_QX) * 256, row0, wc, fq);
        else ew<2>(acc, gates, 3072, (tl - TL_G) * 256, row0, wc, fq);
    }
};

struct SchedDense {
    int G, c, nM, nN, K; const char* bbase; int reps;
    DI bool next(int i, Unit& u) const { u.kind = 0; u.aux = 0; const int U = nM * nN; int L = i * G + c; if (L >= U * reps) return false; return pg8::static_tile(L % U, nM, nN, u.pm, u.pn); }
    DI unsigned arow(const Unit& u, int r) const { return (unsigned)(u.pm * 256 + r) * (unsigned)(K * 2); }
    DI const char* bptr(const Unit& u) const { return bbase + (size_t)u.pn * 256 * K * 2; }
};

struct EpiMerge {
    static constexpr bool SEGMENTED = true;
    const bf16_t* gates; const float* rstd; bf16_t* merged; int last_seg;
    DI bool boundary(int t) const { return t == 16 || t == 24 || t == 32 || t == 40 || t == 48; }
    DI void load8(const bf16_t* p, float (&g)[8]) const { const u32x4 w = *(const u32x4*)p; g[0] = bf_lo(w.x); g[1] = bf_hi(w.x); g[2] = bf_lo(w.y); g[3] = bf_hi(w.y); g[4] = bf_lo(w.z); g[5] = bf_hi(w.z); g[6] = bf_lo(w.w); g[7] = bf_hi(w.w); }
    DI void rescale(Acc& acc, const Unit& u, int t, int wr, int wc, int fr, int fq) const {
        int row0 = u.pm * 256 + wr * 64 + fr, col0 = u.pn * 256 + wc * 32 + 8 * fq;
        asm volatile("" : "+v"(row0), "+v"(col0));
#pragma unroll
        for (int ai = 0; ai < 2; ++ai)
#pragma unroll
            for (int m = 0; m < 4; ++m) { const int row = row0 + ai * 128 + m * 16; const f32x4 rs = *(const f32x4*)(rstd + (size_t)row * 4);
                if (t == 16 || t == 48) {
                    const bf16_t* gp = gates + (size_t)row * 3072 + col0;
#pragma unroll
                    for (int bj = 0; bj < 2; ++bj) { float ga[8], gb[8]; float f[8];
                        if (t == 16) { load8(gp + bj * 128, ga); load8(gp + 1024 + bj * 128, gb); for (int j = 0; j < 8; ++j) f[j] = ga[j] * fast_rcp(gb[j] * rs[0]); }
                        else { load8(gp + 1024 + bj * 128, ga); load8(gp + 2048 + bj * 128, gb); for (int j = 0; j < 8; ++j) f[j] = ga[j] * rs[3] * fast_rcp(gb[j]); }
                        for (int e = 0; e < 4; ++e) { acc[ai][bj][m][0][e] *= f[e]; acc[ai][bj][m][1][e] *= f[4 + e]; } }
                } else {
                    const float f = (t == 24) ? rs[0] * fast_rcp(rs[1]) : (t == 32) ? rs[1] * fast_rcp(rs[2]) : rs[2] * fast_rcp(rs[3]);
#pragma unroll
                    for (int bj = 0; bj < 2; ++bj) { acc[ai][bj][m][0] *= f; acc[ai][bj][m][1] *= f; }
                }
                asm volatile("" ::: "memory"); }
    }
    DI void operator()(const Acc& acc, const Unit& u, int wr, int wc, int fr, int fq) const {
        const int row0 = u.pm * 256 + wr * 64 + fr, col0 = u.pn * 256 + wc * 32 + 8 * fq;
#pragma unroll
        for (int ai = 0; ai < 2; ++ai)
#pragma unroll
            for (int m = 0; m < 4; ++m) { const int row = row0 + ai * 128 + m * 16; const float r3 = rstd[(size_t)row * 4 + 3];
                const bf16_t* gp = gates + (size_t)row * 3072 + col0 + last_seg * 1024; bf16_t* op = merged + (size_t)row * 1024 + col0;
#pragma unroll
                for (int bj = 0; bj < 2; ++bj) { float g[8]; load8(gp + bj * 128, g); const float s = (last_seg == 1) ? r3 : 1.0f;
                    f32x4 v0 = acc[ai][bj][m][0], v1 = acc[ai][bj][m][1];
                    u32x4 w; w.x = pk2(v0[0] * g[0] * s, v0[1] * g[1] * s); w.y = pk2(v0[2] * g[2] * s, v0[3] * g[3] * s); w.z = pk2(v1[0] * g[4] * s, v1[1] * g[5] * s); w.w = pk2(v1[2] * g[6] * s, v1[3] * g[7] * s);
                    *(u32x4*)(op + bj * 128) = w; }
                asm volatile("" ::: "memory"); }
    }
};

struct EpiOut {
    static constexpr bool SEGMENTED = false;
    const float* x; float* out;
    DI void operator()(const Acc& acc, const Unit& u, int wr, int wc, int fr, int fq) const {
        const int row0 = u.pm * 256 + wr * 64 + fr, col0 = u.pn * 256 + wc * 32 + 8 * fq;
#pragma unroll
        for (int ai = 0; ai < 2; ++ai)
#pragma unroll
            for (int m = 0; m < 4; ++m) { const size_t off = (size_t)(row0 + ai * 128 + m * 16) * 1024 + col0;
#pragma unroll
                for (int bj = 0; bj < 2; ++bj) { const f32x4 x0 = *(const f32x4*)(x + off + bj * 128), x1 = *(const f32x4*)(x + off + bj * 128 + 4);
                    *(f32x4*)(out + off + bj * 128) = x0 + acc[ai][bj][m][0]; *(f32x4*)(out + off + bj * 128 + 4) = x1 + acc[ai][bj][m][1]; } }
    }
};

struct SchedMoE {
    int G, c, NC, tlo, thi; const LAS int* tstart; const LAS int* cnt; const int* tokl; const char* wbase; size_t wexp; int reps; unsigned rowb; unsigned ldbb;
    DI bool next(int i, Unit& u) const {
        const int n = (thi - tlo) * NC; int L = i * G + c; if (L >= n * reps) return false; L %= n;
        { const int q = n / 8, r = n % 8, xcd = L % 8, off = L / 8; L = (xcd < r ? xcd * (q + 1) : r * (q + 1) + (xcd - r) * q) + off; }
        const int rt = tlo + L / NC; u.pn = L % NC; u.pm = rt; int e = 0;
        for (int j = 1; j < NEXP; ++j) e += (tstart[j] <= rt) ? 1 : 0;
        u.aux = __builtin_amdgcn_readfirstlane(e); u.kind = 0; return true;
    }
    DI unsigned arow(const Unit& u, int r) const {
        if (tokl) { const int e = u.aux, idx = (u.pm - tstart[e]) * 256 + r; const int tok = idx < cnt[e] ? tokl[(size_t)e * T + idx] : 0; return (unsigned)tok * rowb; }
        return (unsigned)((u.pm - tlo) * 256 + r) * rowb;
    }
    DI const char* bptr(const Unit& u) const { return wbase + (size_t)u.aux * wexp + (size_t)u.pn * 256 * ldbb; }
};
struct EpiGU {
    static constexpr bool SEGMENTED = false;
    unsigned char* actm; const float *bg, *bu; int tlo;
    DI void operator()(const Acc& acc, const Unit& u, int wr, int wc, int fr, int fq) const {
        const int row0 = (u.pm - tlo) * 256 + wr * 64 + fr, col = u.pn * 128 + wc * 32 + 8 * fq; const size_t eb = (size_t)u.aux * 1024 + col;
        const f32x4 g0 = *(const f32x4*)(bg + eb), g1 = *(const f32x4*)(bg + eb + 4), u0 = *(const f32x4*)(bu + eb), u1 = *(const f32x4*)(bu + eb + 4);
#pragma unroll
        for (int ai = 0; ai < 2; ++ai)
#pragma unroll
            for (int m = 0; m < 4; ++m) { f32x4 a0 = acc[ai][0][m][0] + g0, a1 = acc[ai][0][m][1] + g1, b0 = acc[ai][1][m][0] + u0, b1 = acc[ai][1][m][1] + u1;
                for (int e = 0; e < 4; ++e) { float g = fminf(a0[e], 7.f), uu = fminf(fmaxf(b0[e], -7.f), 7.f); a0[e] = (uu + 1.f) * g * sigmoidf_(1.702f * g);
                                              g = fminf(a1[e], 7.f); uu = fminf(fmaxf(b1[e], -7.f), 7.f); a1[e] = (uu + 1.f) * g * sigmoidf_(1.702f * g); }
                u32x2 w; w.x = pk4_fp8(a0[0], a0[1], a0[2], a0[3]); w.y = pk4_fp8(a1[0], a1[1], a1[2], a1[3]);
                *(u32x2*)(actm + (size_t)(row0 + ai * 128 + m * 16) * 1024 + col) = w; }
    }
};
struct EpiDown {
    static constexpr bool SEGMENTED = false;
    bf16_t* y; const float* bd; int tlo;
    DI void operator()(const Acc& acc, const Unit& u, int wr, int wc, int fr, int fq) const {
        const int row0 = (u.pm - tlo) * 256 + wr * 64 + fr, col0 = u.pn * 256 + wc * 32 + 8 * fq; const float* bp = bd + (size_t)u.aux * 1024 + col0;
        f32x4 bv[2][2];
#pragma unroll
        for (int bj = 0; bj < 2; ++bj) { bv[bj][0] = *(const f32x4*)(bp + bj * 128); bv[bj][1] = *(const f32x4*)(bp + bj * 128 + 4); }
#pragma unroll
        for (int ai = 0; ai < 2; ++ai)
#pragma unroll
            for (int m = 0; m < 4; ++m) { bf16_t* rowp = y + (size_t)(row0 + ai * 128 + m * 16) * 1024 + col0;
#pragma unroll
                for (int bj = 0; bj < 2; ++bj) { const f32x4 v0 = acc[ai][bj][m][0] + bv[bj][0], v1 = acc[ai][bj][m][1] + bv[bj][1];
                    u32x4 w; w.x = pk2(v0[0], v0[1]); w.y = pk2(v0[2], v0[3]); w.z = pk2(v1[0], v1[1]); w.w = pk2(v1[2], v1[3]);
                    *(u32x4*)(rowp + bj * 128) = w; } }
    }
};
DI void transpose_item64(const float* W, int Ns, int k0, int sc0, int sc1, bf16_t* dst, int dpitch, const float* kscale, LAS float* scr, int lane) {
    const int cl = lane & 15, kl = lane >> 4, sc = (cl < 8) ? sc0 : sc1, col = sc + 4 * (cl & 7);
    f32x4 v[16];
#pragma unroll
    for (int i = 0; i < 16; ++i) { v[i] = (f32x4){0.f, 0.f, 0.f, 0.f}; if (sc >= 0) v[i] = *(const f32x4*)(W + (size_t)(k0 + 4 * i + kl) * Ns + col); }
#pragma unroll
    for (int i = 0; i < 16; ++i) { const int kk = 4 * i + kl; f32x4 x = v[i]; if (kscale) x *= kscale[k0 + kk]; LAS float* p = scr + kk * 65 + 4 * cl; p[0] = x[0]; p[1] = x[1]; p[2] = x[2]; p[3] = x[3]; }
    asm volatile("s_waitcnt lgkmcnt(0)" ::: "memory");
    const int c = lane & 7;
#pragma unroll
    for (int j = 0; j < 8; ++j) { const int n = (lane >> 3) + 8 * j; const LAS float* s = scr + (8 * c) * 65 + n;
        u32x4 o; o.x = pk2(s[0 * 65], s[1 * 65]); o.y = pk2(s[2 * 65], s[3 * 65]); o.z = pk2(s[4 * 65], s[5 * 65]); o.w = pk2(s[6 * 65], s[7 * 65]);
        *(u32x4*)(dst + (size_t)n * dpitch + 8 * c) = o; }
    asm volatile("s_waitcnt lgkmcnt(0)" ::: "memory");
}
DI int win_src_col(int nb) {
    const int tile = nb >> 3, sub = nb & 7;
    if (tile < TL_V) { const int base = tile < TL_K ? 256 * tile : 1024 + 256 * (tile - TL_K); return base + 32 * (2 * (sub & 3) + (sub >> 2)); }
    if (tile < TL_Z) return 2048 + 256 * (tile - TL_V) + 32 * sub;
    if (tile < TL_XBC) return 3072 + 256 * (tile - TL_Z) + 32 * sub;
    if (tile < TL_DT) return 5120 + 256 * (tile - TL_XBC) + 32 * sub;
    if (tile == TL_DT) return sub == 0 ? 8192 : -1;
    if (tile < TL_G) return 8224 + 256 * (tile - TL_QX) + 32 * sub;
    return 9248 + 256 * (tile - TL_G) + 32 * sub;
}
template <int NR> DI void rms_rows_to_bf16(const float* x, bf16_t* o, size_t row_stride, const float* gain, int lane) {
    f32x4 v[NR][4]; float s[NR];
#pragma unroll
    for (int r = 0; r < NR; ++r) { const f32x4* xr = (const f32x4*)(x + (size_t)r * row_stride * 1024) + lane; s[r] = 0.f;
#pragma unroll
        for (int j = 0; j < 4; ++j) { v[r][j] = xr[64 * j]; } }
#pragma unroll
    for (int r = 0; r < NR; ++r) {
#pragma unroll
        for (int j = 0; j < 4; ++j) s[r] += (v[r][j].x * v[r][j].x + v[r][j].y * v[r][j].y) + (v[r][j].z * v[r][j].z + v[r][j].w * v[r][j].w);
        s[r] = __builtin_amdgcn_rsqf(wave_sum(s[r]) * (1.f / 1024.f) + EPS); }
    const f32x4* gr = (const f32x4*)gain + lane;
#pragma unroll
    for (int j = 0; j < 4; ++j) { const f32x4 g = gr[64 * j];
#pragma unroll
        for (int r = 0; r < NR; ++r) { u32x2 w; w.x = pk2(v[r][j].x * s[r] * g.x, v[r][j].y * s[r] * g.y); w.y = pk2(v[r][j].z * s[r] * g.z, v[r][j].w * s[r] * g.w); ((u32x2*)(o + (size_t)r * row_stride * 1024) + lane)[64 * j] = w; } }
}


DI void transpose_item64_fp8(const float* W, int Ns, int k0, int sc0, int sc1, unsigned char* dst, int dpitch, float mul, LAS float* scr, int lane) {
    const int cl = lane & 15, kl = lane >> 4, sc = (cl < 8) ? sc0 : sc1, col = sc + 4 * (cl & 7);
    f32x4 v[16];
#pragma unroll
    for (int i = 0; i < 16; ++i) { v[i] = (f32x4){0.f, 0.f, 0.f, 0.f}; if (sc >= 0) v[i] = *(const f32x4*)(W + (size_t)(k0 + 4 * i + kl) * Ns + col); }
#pragma unroll
    for (int i = 0; i < 16; ++i) { const int kk = 4 * i + kl; const f32x4 x = v[i] * mul; LAS float* p = scr + kk * 65 + 4 * cl; p[0] = x[0]; p[1] = x[1]; p[2] = x[2]; p[3] = x[3]; }
    asm volatile("s_waitcnt lgkmcnt(0)" ::: "memory");
    const int c = lane & 3;
#pragma unroll
    for (int j = 0; j < 4; ++j) { const int n = (lane >> 2) + 16 * j; const LAS float* s = scr + (16 * c) * 65 + n;
        u32x4 o; o.x = pk4_fp8(s[0 * 65], s[1 * 65], s[2 * 65], s[3 * 65]); o.y = pk4_fp8(s[4 * 65], s[5 * 65], s[6 * 65], s[7 * 65]);
        o.z = pk4_fp8(s[8 * 65], s[9 * 65], s[10 * 65], s[11 * 65]); o.w = pk4_fp8(s[12 * 65], s[13 * 65], s[14 * 65], s[15 * 65]);
        *(u32x4*)(dst + (size_t)n * dpitch + 16 * c) = o; }
    asm volatile("s_waitcnt lgkmcnt(0)" ::: "memory");
}
template <int NR> DI void rms_rows_to_fp8(const float* x, unsigned char* o, const float* gain, int lane) {
    f32x4 v[NR][4]; float s[NR];
#pragma unroll
    for (int r = 0; r < NR; ++r) { const f32x4* xr = (const f32x4*)(x + (size_t)r * 1024) + lane; s[r] = 0.f;
#pragma unroll
        for (int j = 0; j < 4; ++j) { v[r][j] = xr[64 * j]; } }
#pragma unroll
    for (int r = 0; r < NR; ++r) {
#pragma unroll
        for (int j = 0; j < 4; ++j) s[r] += (v[r][j].x * v[r][j].x + v[r][j].y * v[r][j].y) + (v[r][j].z * v[r][j].z + v[r][j].w * v[r][j].w);
        s[r] = __builtin_amdgcn_rsqf(wave_sum(s[r]) * (1.f / 1024.f) + EPS); }
    const f32x4* gr = (const f32x4*)gain + lane;
#pragma unroll
    for (int j = 0; j < 4; ++j) { const f32x4 g = gr[64 * j];
#pragma unroll
        for (int r = 0; r < NR; ++r) ((unsigned*)(o + (size_t)r * 1024) + lane)[64 * j] = pk4_fp8(v[r][j].x * s[r] * g.x, v[r][j].y * s[r] * g.y, v[r][j].z * s[r] * g.z, v[r][j].w * s[r] * g.w); }
}

DI int crow(int r, int hi) { return (r & 3) + 8 * (r >> 2) + 4 * hi; }
DI s16x4 vtr(const LAS unsigned char* p) { return __builtin_bit_cast(s16x4, __builtin_amdgcn_ds_read_tr16_b64_v4i16((LAS v4i16_t*)p)); }
#define MFMA32(a, b, c) __builtin_amdgcn_mfma_f32_32x32x16_bf16((a), (b), (c), 0, 0, 0)
#define MFMA16(a, b, c) __builtin_amdgcn_mfma_f32_16x16x32_bf16((a), (b), (c), 0, 0, 0)
DI void tile_load(u32x4 (&r)[4], const bf16_t* g, size_t pitch, int tid) {
#pragma unroll
    for (int i = 0; i < 4; ++i) { const int q = tid + 512 * i, row = q >> 5, ch = q & 31; r[i] = *(const u32x4*)(g + (size_t)row * pitch + ch * 8); }
}
DI void tile_store_k(LAS unsigned char* dst, const u32x4 (&r)[4], int tid) {
#pragma unroll
    for (int i = 0; i < 4; ++i) { const int q = tid + 512 * i, row = q >> 5, ch = q & 31; *(LAS u32x4*)(dst + row * 512 + ((ch ^ (row & 15)) << 4)) = r[i]; }
}
DI void tile_store_v(LAS unsigned char* dst, const u32x4 (&r)[4], int tid) {
#pragma unroll
    for (int i = 0; i < 4; ++i) { const int q = tid + 512 * i, row = q >> 5, ch = q & 31; *(LAS u32x4*)(dst + row * 512 + ((((ch >> 2) ^ (row & 3)) * 4 + (ch & 3)) << 4)) = r[i]; }
}
constexpr int AT_K = 0, AT_V = 32768, AT_BIAS = 65536, AT_BIAS_STRIDE = 260;

DI float softmax_tile(f32x16& s0, f32x16& s1, float& m, float& l, bf16x8 (&pa)[4]) {
    float mx = fmaxf(s0[0], s1[0]);
#pragma unroll
    for (int r = 1; r < 16; ++r) mx = fmaxf(mx, fmaxf(s0[r], s1[r]));
    mx = fmaxf(mx, __shfl_xor(mx, 32));
    const float mn = fmaxf(m, mx), alpha = fast_exp2(m - mn);
    float sum = 0.f;
#pragma unroll
    for (int r = 0; r < 16; ++r) { s0[r] = fast_exp2(s0[r] - mn); s1[r] = fast_exp2(s1[r] - mn); sum += s0[r] + s1[r]; }
    l = l * alpha + sum; m = mn;
    u32x4 w;
    w.x = pk2(s0[0], s0[1]); w.y = pk2(s0[2], s0[3]); w.z = pk2(s0[4], s0[5]); w.w = pk2(s0[6], s0[7]); pa[0] = __builtin_bit_cast(bf16x8, w);
    w.x = pk2(s0[8], s0[9]); w.y = pk2(s0[10], s0[11]); w.z = pk2(s0[12], s0[13]); w.w = pk2(s0[14], s0[15]); pa[1] = __builtin_bit_cast(bf16x8, w);
    w.x = pk2(s1[0], s1[1]); w.y = pk2(s1[2], s1[3]); w.z = pk2(s1[4], s1[5]); w.w = pk2(s1[6], s1[7]); pa[2] = __builtin_bit_cast(bf16x8, w);
    w.x = pk2(s1[8], s1[9]); w.y = pk2(s1[10], s1[11]); w.z = pk2(s1[12], s1[13]); w.w = pk2(s1[14], s1[15]); pa[3] = __builtin_bit_cast(bf16x8, w);
    return alpha;
}
DI bf16x8 v_frag(const LAS unsigned char* vt, int s, int colbyte0, int lane) {
    const int hi = lane >> 5, q_ = (lane & 15) >> 2, p_ = lane & 3, blk = (lane >> 4) & 1;
    const int cb = colbyte0 + blk * 32 + p_ * 8, u = cb >> 6, within = cb & 63;
    const int R = 16 * s + 4 * hi + q_;
    const s16x4 lo = vtr(vt + R * 512 + ((u ^ q_) << 6) + within);
    const s16x4 h4 = vtr(vt + (R + 8) * 512 + ((u ^ q_) << 6) + within);
    return __builtin_shufflevector(lo, h4, 0, 1, 2, 3, 4, 5, 6, 7);
}

DI void attnA_unit(LAS unsigned char* lds, int b, int c, int hq, bf16_t* act, const bf16_t* ka, const bf16_t* va, bf16_t* outp, size_t opitch) {
    const int tid = threadIdx.x, lane = tid & 63, wid = __builtin_amdgcn_readfirstlane(tid >> 6), hl = wid >> 1, qh = wid & 1, head = 4 * hq + hl, l31 = lane & 31, hi = lane >> 5;
    const size_t trow = (size_t)b * SEQ + 64 * c + 32 * qh + l31;
    bf16_t* qp = act + trow * ACT_P + 64 * head;
    bf16x8 qf[4];
#pragma unroll
    for (int d0 = 0; d0 < 4; ++d0) qf[d0] = *(const bf16x8*)(qp + 16 * d0 + 8 * hi);
    f32x16 o0, o1;
#pragma unroll
    for (int r = 0; r < 16; ++r) { o0[r] = 0.f; o1[r] = 0.f; }
    float m = -1e30f, l = 0.f;
    const int kc0 = c < 8 ? 0 : c - 8;
    const LAS float* bias = (const LAS float*)(lds + AT_BIAS) + head * AT_BIAS_STRIDE;
    const float b256 = bias[256];
    u32x4 rk[4], rv[4];
    const bf16_t* kb = ka + ((size_t)b * SEQ + 64 * kc0) * 1024 + 256 * hq; const bf16_t* vb = va + ((size_t)b * SEQ + 64 * kc0) * 1024 + 256 * hq;
    tile_load(rk, kb, 1024, tid); tile_load(rv, vb, 1024, tid);
    const int qi = 32 * qh + l31;
    for (int kc = kc0; kc <= c; ++kc) {
        __syncthreads();
        tile_store_k(lds + AT_K, rk, tid); tile_store_v(lds + AT_V, rv, tid);
        if (kc < c) { kb += 64 * 1024; vb += 64 * 1024; tile_load(rk, kb, 1024, tid); tile_load(rv, vb, 1024, tid); }
        __syncthreads();
        const int j = c - kc;
        f32x16 s0, s1;
        if (j >= 3) {
#pragma unroll
            for (int r = 0; r < 16; ++r) { s0[r] = b256; s1[r] = b256; }
        } else {
#pragma unroll
            for (int r = 0; r < 16; ++r) { const int rel0 = 64 * j + qi - crow(r, hi); s0[r] = bias[min(rel0, 128) + 128]; s1[r] = bias[min(rel0 - 32, 128) + 128]; }
        }
#pragma unroll
        for (int d0 = 0; d0 < 4; ++d0) {
            const int ch = 8 * hl + 2 * d0 + hi;
            const bf16x8 k0 = *(const LAS bf16x8*)(lds + AT_K + l31 * 512 + ((ch ^ (l31 & 15)) << 4));
            const bf16x8 k1 = *(const LAS bf16x8*)(lds + AT_K + (32 + l31) * 512 + ((ch ^ (l31 & 15)) << 4));
            s0 = MFMA32(k0, qf[d0], s0); s1 = MFMA32(k1, qf[d0], s1);
        }
        bf16x8 pa[4];
        const float alpha = softmax_tile(s0, s1, m, l, pa);
#pragma unroll
        for (int r = 0; r < 16; ++r) { o0[r] *= alpha; o1[r] *= alpha; }
#pragma unroll
        for (int s = 0; s < 4; ++s) {
            const bf16x8 v0 = v_frag(lds + AT_V, s, (64 * hl) * 2, lane), v1 = v_frag(lds + AT_V, s, (64 * hl + 32) * 2, lane);
            o0 = MFMA32(v0, pa[s], o0); o1 = MFMA32(v1, pa[s], o1);
        }
    }
    const float lt = l + __shfl_xor(l, 32), inv = fast_rcp(lt);
#pragma unroll
    for (int rg = 0; rg < 4; ++rg) {
        u32x2 w0, w1; w0.x = pk2(o0[4 * rg] * inv, o0[4 * rg + 1] * inv); w0.y = pk2(o0[4 * rg + 2] * inv, o0[4 * rg + 3] * inv);
        w1.x = pk2(o1[4 * rg] * inv, o1[4 * rg + 1] * inv); w1.y = pk2(o1[4 * rg + 2] * inv, o1[4 * rg + 3] * inv);
        bf16_t* op = outp + trow * opitch + 64 * head; *(u32x2*)(op + 8 * rg + 4 * hi) = w0; *(u32x2*)(op + 32 + 8 * rg + 4 * hi) = w1;
    }
}

DI void attnC_unit(LAS unsigned char* lds, int b, int hx, int rb, bf16_t* act, const bf16_t* kx, const bf16_t* memkv, bf16_t* outp, size_t opitch) {
    const int tid = threadIdx.x, lane = tid & 63, wid = __builtin_amdgcn_readfirstlane(tid >> 6), rg = wid >> 1, dh = wid & 1, l31 = lane & 31, hi = lane >> 5;
    const size_t trow = (size_t)b * SEQ + 128 * rb + 32 * rg + l31;
    bf16_t* qp = act + trow * ACT_P + 3072 + 256 * hx;
    float ssq = 0.f;
#pragma unroll
    for (int d0 = 0; d0 < 16; ++d0) { const bf16x8 q = *(const bf16x8*)(qp + 16 * d0 + 8 * hi);
#pragma unroll
        for (int e = 0; e < 8; ++e) { const float v = bf2f((bf16_t)q[e]); ssq += v * v; } }
    ssq += __shfl_xor(ssq, 32);
    const float rstd = __builtin_amdgcn_rsqf(ssq * (1.f / 256.f) + EPS);
    f32x16 o[4];
#pragma unroll
    for (int i = 0; i < 4; ++i)
#pragma unroll
        for (int r = 0; r < 16; ++r) o[i][r] = 0.f;
    float m = -1e30f, l = 0.f;
    for (int j = 0; j < 4; ++j) {
        u32x4 rk[4], rv[4];
        tile_load(rk, kx + ((size_t)b * MEMLEN + 64 * j) * 1024 + 256 * hx, 1024, tid);
        tile_load(rv, memkv + ((size_t)b * MEMLEN + 64 * j) * 2048 + 1024 + 256 * hx, 2048, tid);
        __syncthreads();
        tile_store_k(lds + AT_K, rk, tid); tile_store_v(lds + AT_V, rv, tid);
        __syncthreads();
        f32x16 s0, s1;
#pragma unroll
        for (int r = 0; r < 16; ++r) { s0[r] = 0.f; s1[r] = 0.f; }
#pragma unroll
        for (int d0 = 0; d0 < 16; ++d0) {
            const int ch = 2 * d0 + hi;
            const bf16x8 qfr = *(const bf16x8*)(qp + 16 * d0 + 8 * hi);
            const bf16x8 k0 = *(const LAS bf16x8*)(lds + AT_K + l31 * 512 + ((ch ^ (l31 & 15)) << 4));
            const bf16x8 k1 = *(const LAS bf16x8*)(lds + AT_K + (32 + l31) * 512 + ((ch ^ (l31 & 15)) << 4));
            s0 = MFMA32(k0, qfr, s0); s1 = MFMA32(k1, qfr, s1);
        }
#pragma unroll
        for (int r = 0; r < 16; ++r) { s0[r] *= rstd; s1[r] *= rstd; }
        bf16x8 pa[4];
        const float alpha = softmax_tile(s0, s1, m, l, pa);
#pragma unroll
        for (int i = 0; i < 4; ++i)
#pragma unroll
            for (int r = 0; r < 16; ++r) o[i][r] *= alpha;
#pragma unroll
        for (int s = 0; s < 4; ++s)
#pragma unroll
            for (int i = 0; i < 4; ++i) { const bf16x8 vf = v_frag(lds + AT_V, s, (128 * dh + 32 * i) * 2, lane); o[i] = MFMA32(vf, pa[s], o[i]); }
    }
    const float lt = l + __shfl_xor(l, 32), inv = fast_rcp(lt);
    __syncthreads();
#pragma unroll
    for (int i = 0; i < 4; ++i)
#pragma unroll
        for (int g4 = 0; g4 < 4; ++g4) { u32x2 w; w.x = pk2(o[i][4 * g4] * inv, o[i][4 * g4 + 1] * inv); w.y = pk2(o[i][4 * g4 + 2] * inv, o[i][4 * g4 + 3] * inv);
            *(u32x2*)(outp + trow * opitch + 256 * hx + 128 * dh + 32 * i + 8 * g4 + 4 * hi) = w; }
}

constexpr int MB_XDT = 0, MB_XDTW = 9216, MB_BM = 18432, MB_CM = 35840, MB_YD = 53248, MB_YO = 70656, MB_ACS = 88064, MB_YSTR = 272;
DI int mb_b256(int row, int col) { return row * 272 + col * 2; }
DI int mb_b128(int row, int col) { return row * 144 + col * 2; }
template <bool W256> DI bf16x8 tr_pair(const LAS unsigned char* base, int row_lo, int row_hi, int col0, int lane) {
    const int i = lane & 15, r = i >> 2, c = col0 + 4 * (i & 3);
    const s16x4 lo = vtr(base + (W256 ? mb_b256(row_lo + r, c) : mb_b128(row_lo + r, c))), h4 = vtr(base + (W256 ? mb_b256(row_hi + r, c) : mb_b128(row_hi + r, c)));
    return __builtin_shufflevector(lo, h4, 0, 1, 2, 3, 4, 5, 6, 7);
}
DI void bcconv_phase(int vcu, int G, const bf16_t* xbc, bf16_t* bc, const float* conv_w, const float* conv_b) {
    for (int task = vcu * 512 + threadIdx.x; task < (T / 16) * 128; task += G * 512) {
        const int cc = task & 127, run = task >> 7, g = cc >> 5, w = cc & 31;
        const int scol = (w < 16 ? 2048 + 128 * g + 8 * w : 2560 + 128 * g + 8 * (w - 16));
        const int t0 = run * 16, pos0 = t0 & (SEQ - 1);
        float cw[4][8], cb[8];
#pragma unroll
        for (int e = 0; e < 8; ++e) { cb[e] = conv_b[scol + e];
#pragma unroll
            for (int i = 0; i < 4; ++i) cw[i][e] = conv_w[i * 3072 + scol + e]; }
        float win[3][8];
#pragma unroll
        for (int k = 0; k < 3; ++k) { u32x4 wv = (u32x4){0u, 0u, 0u, 0u}; if (pos0 + k - 3 >= 0) wv = *(const u32x4*)(xbc + (size_t)(t0 + k - 3) * 3072 + scol);
            win[k][0] = bf_lo(wv.x); win[k][1] = bf_hi(wv.x); win[k][2] = bf_lo(wv.y); win[k][3] = bf_hi(wv.y); win[k][4] = bf_lo(wv.z); win[k][5] = bf_hi(wv.z); win[k][6] = bf_lo(wv.w); win[k][7] = bf_hi(wv.w); }
#pragma unroll 4
        for (int k = 0; k < 16; ++k) {
            const u32x4 wv = *(const u32x4*)(xbc + (size_t)(t0 + k) * 3072 + scol);
            const float cur[8] = {bf_lo(wv.x), bf_hi(wv.x), bf_lo(wv.y), bf_hi(wv.y), bf_lo(wv.z), bf_hi(wv.z), bf_lo(wv.w), bf_hi(wv.w)};
            float o[8];
#pragma unroll
            for (int e = 0; e < 8; ++e) { o[e] = silu_(cb[e] + cw[0][e] * win[0][e] + cw[1][e] * win[1][e] + cw[2][e] * win[2][e] + cw[3][e] * cur[e]); win[0][e] = win[1][e]; win[1][e] = win[2][e]; win[2][e] = cur[e]; }
            u32x4 ov; ov.x = pk2(o[0], o[1]); ov.y = pk2(o[2], o[3]); ov.z = pk2(o[4], o[5]); ov.w = pk2(o[6], o[7]);
            *(u32x4*)(bc + (size_t)(t0 + k) * 1024 + 8 * cc) = ov;
        }
    }
}
DI void mamba_unit(LAS unsigned char* lds, int b, int h, const bf16_t* xbc, const bf16_t* bc, const float* dtp, bf16_t* act, float* ssq_out, bf16_t* outp, size_t opitch,
                   const float* conv_w, const float* conv_b, const float* a_log, const float* d_skip) {
    const int tid = threadIdx.x, lane = tid & 63, wid = __builtin_amdgcn_readfirstlane(tid >> 6), fr = lane & 15, fq = lane >> 4, g = h >> 3;
    const float A_h = -__expf(a_log[h]), D_h = d_skip[h];
    const int l = tid >> 3, pc = tid & 7, xcol = 64 * h + 8 * pc;
    float cw[4][8], cbias[8];
#pragma unroll
    for (int e = 0; e < 8; ++e) { cbias[e] = conv_b[xcol + e];
#pragma unroll
        for (int i = 0; i < 4; ++i) cw[i][e] = conv_w[i * 3072 + xcol + e]; }
    f32x4 Z[8];
#pragma unroll
    for (int i = 0; i < 8; ++i) Z[i] = (f32x4){0.f, 0.f, 0.f, 0.f};
    LAS float* acs = (LAS float*)(lds + MB_ACS);
    const int frow0 = tid >> 4, fch = tid & 15;
    u32x4 xr[4], bcr[4]; float dtv;
    const size_t tb = (size_t)b * SEQ;
#define MB_LOAD(c_) do { const int p0_ = 64 * (c_); \
        _Pragma("unroll") for (int i_ = 0; i_ < 4; ++i_) { const int pos_ = p0_ + l - 3 + i_; xr[i_] = (u32x4){0u, 0u, 0u, 0u}; if (pos_ >= 0) xr[i_] = *(const u32x4*)(xbc + (tb + pos_) * 3072 + xcol); } \
        _Pragma("unroll") for (int i_ = 0; i_ < 4; ++i_) bcr[i_] = *(const u32x4*)(bc + (tb + p0_ + frow0 + 32 * (i_ & 1)) * 1024 + 256 * g + 128 * (i_ >> 1) + 8 * fch); \
        dtv = dtp[(tb + p0_ + lane) * 32 + h]; } while (0)
    MB_LOAD(0);
    for (int c = 0; c < 64; ++c) {
        const size_t t0 = tb + 64 * c;
        float a = dtv * A_h;
#pragma unroll
        for (int o = 1; o < 64; o <<= 1) { const float u = __shfl_up(a, o); if (lane >= o) a += u; }
        const float acs63 = __shfl(a, 63), acs_l = __shfl(a, l), dt_l = __shfl(dtv, l);
        if (wid == 0) acs[lane] = a;
        float xs[8];
        { float r[4][8];
#pragma unroll
          for (int i = 0; i < 4; ++i) { r[i][0] = bf_lo(xr[i].x); r[i][1] = bf_hi(xr[i].x); r[i][2] = bf_lo(xr[i].y); r[i][3] = bf_hi(xr[i].y); r[i][4] = bf_lo(xr[i].z); r[i][5] = bf_hi(xr[i].z); r[i][6] = bf_lo(xr[i].w); r[i][7] = bf_hi(xr[i].w); }
#pragma unroll
          for (int e = 0; e < 8; ++e) xs[e] = silu_(cbias[e] + cw[0][e] * r[0][e] + cw[1][e] * r[1][e] + cw[2][e] * r[2][e] + cw[3][e] * r[3][e]); }
        { const float d = dt_l, dw = d * __expf(acs63 - acs_l);
          u32x4 av, bw; av.x = pk2(xs[0] * d, xs[1] * d); av.y = pk2(xs[2] * d, xs[3] * d); av.z = pk2(xs[4] * d, xs[5] * d); av.w = pk2(xs[6] * d, xs[7] * d);
          bw.x = pk2(xs[0] * dw, xs[1] * dw); bw.y = pk2(xs[2] * dw, xs[3] * dw); bw.z = pk2(xs[4] * dw, xs[5] * dw); bw.w = pk2(xs[6] * dw, xs[7] * dw);
          *(LAS u32x4*)(lds + MB_XDT + mb_b128(l, 8 * pc)) = av; *(LAS u32x4*)(lds + MB_XDTW + mb_b128(l, 8 * pc)) = bw; }
#pragma unroll
        for (int i = 0; i < 4; ++i) *(LAS u32x4*)(lds + (i < 2 ? MB_BM : MB_CM) + mb_b256(frow0 + 32 * (i & 1), 8 * fch)) = bcr[i];
        const u32x4 zw = *(const u32x4*)(act + (t0 + l) * ACT_P + 1024 + 64 * h + 8 * pc);
        if (c < 63) MB_LOAD(c + 1);
        __syncthreads();
        if (wid >= 4) {
            const int d = wid - 4; const float la = acs[16 * d + fr];
            f32x4 X[4];
#pragma unroll
            for (int si = 0; si < 4; ++si) { X[si] = (f32x4){0.f, 0.f, 0.f, 0.f};
                if (si <= d) {
#pragma unroll
                    for (int ks = 0; ks < 4; ++ks) { const bf16x8 av = *(const LAS bf16x8*)(lds + MB_BM + mb_b256(16 * si + fr, 32 * ks + 8 * fq));
                        const bf16x8 bb = *(const LAS bf16x8*)(lds + MB_CM + mb_b256(16 * d + fr, 32 * ks + 8 * fq)); X[si] = MFMA16(av, bb, X[si]); }
                    const f32x4 sa = *(const LAS f32x4*)(acs + 16 * si + 4 * fq);
#pragma unroll
                    for (int r = 0; r < 4; ++r) { const int s_abs = 16 * si + 4 * fq + r, l_abs = 16 * d + fr; X[si][r] = (s_abs <= l_abs) ? X[si][r] * __expf(la - sa[r]) : 0.f; }
                } }
            bf16x8 Xp[2];
#pragma unroll
            for (int sb = 0; sb < 2; ++sb) { u32x4 w; w.x = pk2(X[2 * sb][0], X[2 * sb][1]); w.y = pk2(X[2 * sb][2], X[2 * sb][3]); w.z = pk2(X[2 * sb + 1][0], X[2 * sb + 1][1]); w.w = pk2(X[2 * sb + 1][2], X[2 * sb + 1][3]); Xp[sb] = __builtin_bit_cast(bf16x8, w); }
#pragma unroll
            for (int pt = 0; pt < 4; ++pt) { f32x4 y = (f32x4){0.f, 0.f, 0.f, 0.f};
#pragma unroll
                for (int sb = 0; sb < 2; ++sb) { if (2 * sb <= d) { const bf16x8 av = tr_pair<false>(lds + MB_XDT, 32 * sb + 4 * fq, 32 * sb + 16 + 4 * fq, 16 * pt, lane); y = MFMA16(av, Xp[sb], y); } }
                *(LAS f32x4*)(lds + MB_YD + (16 * d + fr) * MB_YSTR + (16 * pt + 4 * fq) * 4) = y; }
        } else {
            const int pw = wid;
            bf16x8 Zp[4];
#pragma unroll
            for (int nb = 0; nb < 4; ++nb) { u32x4 w; w.x = pk2(Z[2 * nb][0], Z[2 * nb][1]); w.y = pk2(Z[2 * nb][2], Z[2 * nb][3]); w.z = pk2(Z[2 * nb + 1][0], Z[2 * nb + 1][1]); w.w = pk2(Z[2 * nb + 1][2], Z[2 * nb + 1][3]); Zp[nb] = __builtin_bit_cast(bf16x8, w); }
#pragma unroll
            for (int lt = 0; lt < 4; ++lt) { f32x4 y = (f32x4){0.f, 0.f, 0.f, 0.f};
#pragma unroll
                for (int nb = 0; nb < 4; ++nb) { const s16x4 lo = *(const LAS s16x4*)(lds + MB_CM + mb_b256(16 * lt + fr, 32 * nb + 4 * fq)), h4 = *(const LAS s16x4*)(lds + MB_CM + mb_b256(16 * lt + fr, 32 * nb + 16 + 4 * fq));
                    const bf16x8 bfr = __builtin_shufflevector(lo, h4, 0, 1, 2, 3, 4, 5, 6, 7);
                    y = MFMA16(Zp[nb], bfr, y); }
                const float ea = __expf(acs[16 * lt + fr]); y *= ea;
                *(LAS f32x4*)(lds + MB_YO + (16 * lt + fr) * MB_YSTR + (16 * pw + 4 * fq) * 4) = y; }
            const float dec = __expf(acs[63]);
            bf16x8 xw[2];
#pragma unroll
            for (int lb = 0; lb < 2; ++lb) xw[lb] = tr_pair<false>(lds + MB_XDTW, 32 * lb + 8 * fq, 32 * lb + 8 * fq + 4, 16 * pw, lane);
#pragma unroll
            for (int nt = 0; nt < 8; ++nt) { Z[nt] *= dec;
#pragma unroll
                for (int lb = 0; lb < 2; ++lb) { const bf16x8 av = tr_pair<true>(lds + MB_BM, 32 * lb + 8 * fq, 32 * lb + 8 * fq + 4, 16 * nt, lane); Z[nt] = MFMA16(av, xw[lb], Z[nt]); } }
        }
        __syncthreads();
        { const f32x4 a0 = *(const LAS f32x4*)(lds + MB_YD + l * MB_YSTR + pc * 32), a1 = *(const LAS f32x4*)(lds + MB_YD + l * MB_YSTR + pc * 32 + 16);
          const f32x4 b0 = *(const LAS f32x4*)(lds + MB_YO + l * MB_YSTR + pc * 32), b1 = *(const LAS f32x4*)(lds + MB_YO + l * MB_YSTR + pc * 32 + 16);
          float y[8];
          y[0] = (a0[0] + b0[0] + D_h * xs[0]) * bf_lo(zw.x); y[1] = (a0[1] + b0[1] + D_h * xs[1]) * bf_hi(zw.x);
          y[2] = (a0[2] + b0[2] + D_h * xs[2]) * bf_lo(zw.y); y[3] = (a0[3] + b0[3] + D_h * xs[3]) * bf_hi(zw.y);
          y[4] = (a1[0] + b1[0] + D_h * xs[4]) * bf_lo(zw.z); y[5] = (a1[1] + b1[1] + D_h * xs[5]) * bf_hi(zw.z);
          y[6] = (a1[2] + b1[2] + D_h * xs[6]) * bf_lo(zw.w); y[7] = (a1[3] + b1[3] + D_h * xs[7]) * bf_hi(zw.w);
          float ss = 0.f;
#pragma unroll
          for (int e = 0; e < 8; ++e) ss += y[e] * y[e];
          ss += __shfl_xor(ss, 1); ss += __shfl_xor(ss, 2); ss += __shfl_xor(ss, 4);
          if (pc == 0) ssq_out[(t0 + l) * 32 + h] = ss;
          u32x4 w; w.x = pk2(y[0], y[1]); w.y = pk2(y[2], y[3]); w.z = pk2(y[4], y[5]); w.w = pk2(y[6], y[7]); *(u32x4*)(outp + (t0 + l) * opitch + 64 * h + 8 * pc) = w; }
    }
#undef MB_LOAD
    __syncthreads();
}
constexpr int RT_W = 0, RT_CNT = 131072, RT_BASE = 131072 + 128;
constexpr int MO_TS = 131072 + 256, MO_CNT = 131072 + 512;

DI void router_phase(LAS unsigned char* lds, int vcu, int G, const float* x1, const float* norm_ffn, const float* w_router, const float* b_router,
                     unsigned char* h2, int* sel_e, int* sel_r, float* sel_w, int* tokl, unsigned* gcnt) {
    const int tid = threadIdx.x, lane = tid & 63, wid = __builtin_amdgcn_readfirstlane(tid >> 6), l31 = lane & 31, hi = lane >> 5;
    LAS float* Wl = (LAS float*)(lds + RT_W); LAS unsigned* lcnt = (LAS unsigned*)(lds + RT_CNT); LAS unsigned* lbase = (LAS unsigned*)(lds + RT_BASE);
    for (int idx = tid; idx < 1024 * 8; idx += 512) { const f32x4 w = *(const f32x4*)(w_router + 4 * idx); const float gk = norm_ffn[idx >> 3]; LAS float* p = Wl + 4 * idx; p[0] = w[0] * gk; p[1] = w[1] * gk; p[2] = w[2] * gk; p[3] = w[3] * gk; }
    if (tid < 32) lcnt[tid] = 0u;
    __syncthreads();
    if (wid >= 4) {
        for (int m = (vcu * 4 + (wid - 4)) * 4; m < T; m += G * 16) rms_rows_to_fp8<4>(x1 + (size_t)m * 1024, h2 + (size_t)m * 1024, norm_ffn, lane);
    } else
    for (int tile = vcu + G * wid; tile < T / 32; tile += G * 4) {
        const int t0 = tile * 32;
        f32x16 acc;
#pragma unroll
        for (int r = 0; r < 16; ++r) acc[r] = 0.f;
        float ssq = 0.f;
        const float* xr = x1 + (size_t)(t0 + l31) * 1024 + 4 * hi;
#pragma unroll 4
        for (int c = 0; c < 128; ++c) {
            const f32x4 xv = *(const f32x4*)(xr + 8 * c);
            ssq += (xv[0] * xv[0] + xv[1] * xv[1]) + (xv[2] * xv[2] + xv[3] * xv[3]);
#pragma unroll
            for (int u = 0; u < 4; ++u) { const float a = Wl[(8 * c + 4 * hi + u) * 32 + l31]; acc = __builtin_amdgcn_mfma_f32_32x32x2f32(a, xv[u], acc, 0, 0, 0); }
        }
        ssq += __shfl_xor(ssq, 32);
        const float rstd = __builtin_amdgcn_rsqf(ssq * (1.f / 1024.f) + EPS);
        float lg[16];
#pragma unroll
        for (int r = 0; r < 16; ++r) lg[r] = acc[r] * rstd + b_router[crow(r, hi)];
        float sv[4]; int si[4];
#pragma unroll
        for (int k = 0; k < 4; ++k) {
            float bv = lg[0]; int bi = crow(0, hi);
#pragma unroll
            for (int r = 1; r < 16; ++r) { const int id = crow(r, hi); if (lg[r] > bv) { bv = lg[r]; bi = id; } }
            const float pv = __shfl_xor(bv, 32); const int pi = __shfl_xor(bi, 32);
            if (pv > bv || (pv == bv && pi < bi)) { bv = pv; bi = pi; }
            sv[k] = bv; si[k] = bi;
#pragma unroll
            for (int r = 0; r < 16; ++r) if (crow(r, hi) == bi) lg[r] = -INFINITY;
        }
        const float e1 = __expf(sv[1] - sv[0]), e2 = __expf(sv[2] - sv[0]), e3 = __expf(sv[3] - sv[0]), inv = 1.0f / (1.0f + e1 + e2 + e3);
        if (hi == 0) {
            const int t = t0 + l31; const float wv[4] = {inv, e1 * inv, e2 * inv, e3 * inv};
#pragma unroll
            for (int k = 0; k < 4; ++k) { const unsigned lr = atomicAdd((unsigned*)&lcnt[si[k]], 1u); sel_e[t * 4 + k] = si[k]; sel_r[t * 4 + k] = (int)lr; sel_w[t * 4 + k] = wv[k]; }
        }
    }
    __syncthreads();
    if (tid < 32) lbase[tid] = atomicAdd(&gcnt[tid], lcnt[tid]);
    __syncthreads();
    if (wid < 4) for (int tile = vcu + G * wid; tile < T / 32; tile += G * 4) {
        if (hi == 0) { const int t = tile * 32 + l31;
#pragma unroll
            for (int k = 0; k < 4; ++k) { const int e = sel_e[t * 4 + k]; const int r = sel_r[t * 4 + k] + (int)lbase[e]; sel_r[t * 4 + k] = r; tokl[(size_t)e * T + r] = t; } }
    }
}

DI int moe_tables(LAS unsigned char* lds, const unsigned* gcnt) {
    LAS int* ts = (LAS int*)(lds + MO_TS); LAS int* cn = (LAS int*)(lds + MO_CNT);
    __syncthreads();
    if (threadIdx.x < 32) cn[threadIdx.x] = (int)gcnt[threadIdx.x];
    __syncthreads();
    if (threadIdx.x == 0) { int s = 0; for (int e = 0; e < NEXP; ++e) { ts[e] = s; s += (cn[e] + 255) >> 8; } ts[NEXP] = s; }
    __syncthreads();
    return ts[NEXP];
}

DI void combine_phase(LAS unsigned char* lds, int vcu, int G, int tlo, int thi, const bf16_t* y, const int* sel_e, const int* sel_r, const float* sel_w, float* out) {
    const int lane = threadIdx.x & 63, wid = threadIdx.x >> 6; const LAS int* ts = (const LAS int*)(lds + MO_TS);
    for (int tb = (vcu * 8 + wid) * 4; tb < T; tb += G * 32) {
        int rowi[4][4]; float wv[4][4];
#pragma unroll
        for (int q = 0; q < 4; ++q) { const int4 e4 = *(const int4*)(sel_e + (tb + q) * 4), r4 = *(const int4*)(sel_r + (tb + q) * 4); const f32x4 w4 = *(const f32x4*)(sel_w + (tb + q) * 4);
            const int ee[4] = {e4.x, e4.y, e4.z, e4.w}, rr[4] = {r4.x, r4.y, r4.z, r4.w};
#pragma unroll
            for (int k = 0; k < 4; ++k) { const int row = ts[ee[k]] * 256 + rr[k], tile = row >> 8; const bool in = tile >= tlo && tile < thi; rowi[q][k] = in ? row - tlo * 256 : -1; wv[q][k] = w4[k]; } }
#pragma unroll
        for (int q = 0; q < 4; ++q) {
            float* op = out + (size_t)(tb + q) * 1024 + 8 * lane;
            f32x4 a0 = *(const f32x4*)op, a1 = *(const f32x4*)(op + 4), a2 = *(const f32x4*)(op + 512), a3 = *(const f32x4*)(op + 516);
            u32x4 v0[4], v1[4];
#pragma unroll
            for (int k = 0; k < 4; ++k) { v0[k] = (u32x4){0u, 0u, 0u, 0u}; v1[k] = v0[k]; if (rowi[q][k] >= 0) { const bf16_t* yp = y + (size_t)rowi[q][k] * 1024 + 8 * lane; v0[k] = *(const u32x4*)yp; v1[k] = *(const u32x4*)(yp + 512); } }
#pragma unroll
            for (int k = 0; k < 4; ++k) { const float w = wv[q][k];
                a0[0] += w * bf_lo(v0[k].x); a0[1] += w * bf_hi(v0[k].x); a0[2] += w * bf_lo(v0[k].y); a0[3] += w * bf_hi(v0[k].y);
                a1[0] += w * bf_lo(v0[k].z); a1[1] += w * bf_hi(v0[k].z); a1[2] += w * bf_lo(v0[k].w); a1[3] += w * bf_hi(v0[k].w);
                a2[0] += w * bf_lo(v1[k].x); a2[1] += w * bf_hi(v1[k].x); a2[2] += w * bf_lo(v1[k].y); a2[3] += w * bf_hi(v1[k].y);
                a3[0] += w * bf_lo(v1[k].z); a3[1] += w * bf_hi(v1[k].z); a3[2] += w * bf_lo(v1[k].w); a3[3] += w * bf_hi(v1[k].w); }
            *(f32x4*)op = a0; *(f32x4*)(op + 4) = a1; *(f32x4*)(op + 512) = a2; *(f32x4*)(op + 516) = a3;
        }
    }
}
#define XB_TMO      128
#define XB_XCNT(j)  (256  + 64 * (j))
#define XB_XSUB(j)  (1280 + 64 * (j))
#define XB_XGEN(j)  (2304 + 64 * (j))
#define XB_TOP      3328
#define XB_TOPGEN   3392
#define XCD_BAR_WORDS 3456
#define XB_SPIN_CAP (1u << 18)

__device__ __forceinline__ unsigned xb_ld(unsigned* p)              { return __hip_atomic_load(p, __ATOMIC_RELAXED, __HIP_MEMORY_SCOPE_AGENT); }
__device__ __forceinline__ unsigned xb_add(unsigned* p, unsigned v) { return __hip_atomic_fetch_add(p, v, __ATOMIC_RELAXED, __HIP_MEMORY_SCOPE_AGENT); }
__device__ __forceinline__ unsigned xb_xcc_id() { return (unsigned)__builtin_amdgcn_s_getreg((3 << 11) | 20) & 0xFu; }
#define XB_SPIN(cond, bar) do { unsigned _sp = 0; while (cond) { __builtin_amdgcn_s_sleep(1); \
    if ((++_sp & 255u) == 0u) { if (xb_ld(&(bar)[XB_TMO])) break; if (_sp > XB_SPIN_CAP) { atomicAdd(&(bar)[XB_TMO], 1u); break; } } } } while (0)

struct XcdBarrier {
    unsigned* bar; unsigned x;
    volatile LAS unsigned* st;
};

__device__ __forceinline__ XcdBarrier xcd_barrier_post(unsigned* bar, volatile LAS unsigned* st) {
    XcdBarrier b; b.bar = bar; b.x = xb_xcc_id(); b.st = st;
    if (threadIdx.x == 0) (void)xb_add(&bar[XB_XCNT(b.x)], 1u);
    return b;
}
__device__ __forceinline__ void xcd_barrier_complete(unsigned* bar, unsigned x, unsigned& nloc, unsigned& nx) {
    const unsigned G = gridDim.x * gridDim.y * gridDim.z;
    unsigned sum, cnt, mine, sp = 0u;
    for (;;) {
        sum = 0u; cnt = 0u; mine = 0u;
#pragma unroll
        for (unsigned j = 0; j < 16; ++j) { const unsigned c = xb_ld(&bar[XB_XCNT(j)]); sum += c; cnt += (c > 0u) ? 1u : 0u; mine = (j == x) ? c : mine; }
        if (sum == G) break;
        __builtin_amdgcn_s_sleep(1);
        if ((++sp & 255u) == 0u) { if (xb_ld(&bar[XB_TMO])) break; if (sp > XB_SPIN_CAP) { atomicAdd(&bar[XB_TMO], 1u); break; } }
    }
    nloc = mine > 0u ? mine : 1u; nx = cnt > 0u ? cnt : 1u;
}

__device__ __forceinline__ void xcd_barrier(const XcdBarrier& b) {
    asm volatile("s_waitcnt vmcnt(0)" ::: "memory");
    __syncthreads();
    if (threadIdx.x == 0) {
        unsigned* bar = b.bar;
        __builtin_amdgcn_s_waitcnt(0);
        unsigned nloc = b.st[0], nx = b.st[1];
        if (nloc == 0u) { xcd_barrier_complete(bar, b.x, nloc, nx); b.st[0] = nloc; b.st[1] = nx; }
        const unsigned old = xb_add(&bar[XB_XSUB(b.x)], 1u);
        const unsigned gen = old / nloc;
        if (old + 1u == (gen + 1u) * nloc) {
            __builtin_amdgcn_fence(__ATOMIC_RELEASE, "agent");
            asm volatile("s_waitcnt vmcnt(0)" ::: "memory");
            const unsigned og = xb_add(&bar[XB_TOP], 1u);
            const unsigned tg = og / nx;
            if (og + 1u == (tg + 1u) * nx) xb_add(&bar[XB_TOPGEN], 1u);
            else XB_SPIN(xb_ld(&bar[XB_TOPGEN]) == tg, bar);
            __builtin_amdgcn_fence(__ATOMIC_ACQUIRE, "agent");
            xb_add(&bar[XB_XGEN(b.x)], 1u);
            asm volatile("s_waitcnt vmcnt(0)" ::: "memory");
        } else {
            XB_SPIN(xb_ld(&bar[XB_XGEN(b.x)]) == gen, bar);
            __builtin_amdgcn_fence(__ATOMIC_ACQUIRE, "agent");
            asm volatile("s_waitcnt vmcnt(0)" ::: "memory");
        }
    }
    __syncthreads();
}


#ifndef MK_N_LAUNCHES
#define MK_N_LAUNCHES 1
#endif
#ifndef MK_BRANCHES
#define MK_BRANCHES 15
#endif
constexpr int N_PHASES = 15;
#ifndef MK_USE_CG
#define MK_USE_CG 0
#endif
constexpr int LDS_BARST = 147456 - 64;
constexpr int CW_BAR = 4096;
constexpr int LDS_BYTES = 147456;
constexpr int NTHREADS = 512;

struct Args { const float* in[30]; float* out; unsigned char* ws; int ph_lo, ph_hi; };
enum { I_x = 0, I_mem = 1, I_norm_mix = 2, I_w_in = 3, I_a_q_gain = 4, I_a_k_gain = 5, I_a_rel_bias = 6, I_conv_w = 7, I_conv_b = 8, I_dt_bias = 9, I_a_log = 10, I_d_skip = 11, I_ssm_norm = 12, I_norm_mem = 13, I_w_mem_kv = 14, I_x_q_gain = 15, I_x_k_gain = 16, I_w_br_a = 17, I_w_br_b = 18, I_w_br_c = 19, I_w_out = 20, I_norm_ffn = 21, I_w_router = 22, I_b_router = 23, I_w_gate = 24, I_b_gate = 25, I_w_up = 26, I_b_up = 27, I_w_down = 28, I_b_down = 29 };

#define WIN WSP(bf16_t, WS_WIN)
#define WCAT WSP(bf16_t, WS_WCAT)
#define WOUT WSP(bf16_t, WS_WOUT)
#define WMEM WSP(bf16_t, WS_WMEM)
#define DTB WSP(float, WS_DT)
#define SSQ WSP(float, WS_SSQ)
#define RSTD WSP(float, WS_RSTD)
#define KX WSP(bf16_t, WS_KX)
#define MEMKV WSP(bf16_t, WS_MEMKV)
#define XN WSP(bf16_t, WS_XN)
#define MEMN WSP(bf16_t, WS_MEMN)
#define ACT WSP(bf16_t, WS_ACT)
#define KA WSP(bf16_t, WS_KA)
#define VA WSP(bf16_t, WS_VA)
#define XBC WSP(bf16_t, WS_XBC)
#define GATES WSP(bf16_t, WS_GATES)
#define MERGED WSP(bf16_t, WS_MERGED)
#define H2 WSP(unsigned char, MOE_H2)
#define WGU WSP(unsigned char, MOE_WGU)
#define WD WSP(unsigned char, MOE_WD)
#define ACTM WSP(unsigned char, MOE_ACTM)
#define YB WSP(bf16_t, MOE_Y)
#define SELE WSP(int, MOE_SELE)
#define SELR WSP(int, MOE_SELR)
#define SELW WSP(float, MOE_SELW)
#define TOKL WSP(int, MOE_TOKL)
#define GCNT (WSP(unsigned, WS_CTL) + CW_CNT)
#define BCC ((bf16_t*)kq[30])
#define EI_INIT const EpiIn EI{ws, AP(a_q_gain), AP(a_k_gain), AP(dt_bias)}
typedef const __attribute__((address_space(4))) unsigned long long* KW;
DI KW launder(KW p) { asm volatile("" : "+s"(p)); return p; }
#define AP(name) ((const float*)kq[I_##name])
#define PHASE_ARGS const KW kq = launder(kp); unsigned char* const ws = (unsigned char*)kq[31]; (void)ws
#define WSP(type, off) ((type*)(ws + (off)))
__global__ void __launch_bounds__(NTHREADS, 2) mega_fwd(Args a_unused) {
    extern __shared__ __attribute__((aligned(16))) unsigned char lds_raw[];
    LAS unsigned char* lds = (LAS unsigned char*)lds_raw;
    const KW kp = (KW)__builtin_amdgcn_kernarg_segment_ptr();
    const int tid = threadIdx.x, lane = tid & 63, wid = __builtin_amdgcn_readfirstlane(tid >> 6);
    const int G = gridDim.x, bx = blockIdx.x, vcu = (G % 8 == 0) ? (bx % 8) * (G / 8) + bx / 8 : bx;
    const int lo = (int)(unsigned)kp[32], hi = (int)(kp[32] >> 32);
#ifndef MK_PHASE_MASK
#define MK_PHASE_MASK 0x7fff
#endif
#define IN(k) (((MK_PHASE_MASK >> (k)) & 1) && lo <= (k) && (k) < hi)
#ifndef MK_REP_MASK
#define MK_REP_MASK 0
#endif
#define REPS(k) (((MK_REP_MASK >> (k)) & 1) + 1)
#if MK_USE_CG
#define SEAM(k) do { if (IN(k) && IN((k) + 1)) { cg::this_grid().sync(); } } while (0)
#else
#define SEAM(k) do { if (IN(k) && IN((k) + 1)) { xcd_barrier(bar); } } while (0)
#endif
    const int gw = vcu * 8 + wid, NGW = G * 8;
    for (int u = tid; u < 16; u += NTHREADS) ((LAS unsigned*)(lds + LDS_BARST))[u] = 0u;
    __syncthreads();
    XcdBarrier bar = xcd_barrier_post((unsigned*)(kp[31]) + CW_BAR, (volatile LAS unsigned*)(lds + LDS_BARST));
    LAS float* scr = (LAS float*)(lds + wid * 16896);

    if (IN(0)) { PHASE_ARGS;
        constexpr int I_IN = 16 * 196, I_MEM = 16 * 32, I_A = 16 * 16, I_B = 32 * 16, I_C = 16 * 16, I_O = 16 * 16, NIT = I_IN + I_MEM + I_A + I_B + I_C + I_O;
        for (int it = gw; it < NIT * REPS(0); it += NGW) {
            int r = it % NIT;
            if (r < I_IN) { const int kb = r / 196, nb = r % 196; transpose_item64(AP(w_in), IN_COLS, 64 * kb, win_src_col(2 * nb), win_src_col(2 * nb + 1), WIN + (size_t)(64 * nb) * 1024 + 64 * kb, 1024, nullptr, scr, lane); continue; } r -= I_IN;
            if (r < I_MEM) { const int kb = r / 32, nb = r % 32; transpose_item64(AP(w_mem_kv), 2048, 64 * kb, 64 * nb, 64 * nb + 32, WMEM + (size_t)(64 * nb) * 1024 + 64 * kb, 1024, nullptr, scr, lane); continue; } r -= I_MEM;
            if (r < I_A) { const int kb = r / 16, nb = r % 16; transpose_item64(AP(w_br_a), 1024, 64 * kb, 64 * nb, 64 * nb + 32, WCAT + (size_t)(64 * nb) * 4096 + 64 * kb, 4096, nullptr, scr, lane); continue; } r -= I_A;
            if (r < I_B) { const int kb = r / 16, nb = r % 16; transpose_item64(AP(w_br_b), 1024, 64 * kb, 64 * nb, 64 * nb + 32, WCAT + (size_t)(64 * nb) * 4096 + 1024 + 64 * kb, 4096, AP(ssm_norm), scr, lane); continue; } r -= I_B;
            if (r < I_C) { const int kb = r / 16, nb = r % 16; transpose_item64(AP(w_br_c), 1024, 64 * kb, 64 * nb, 64 * nb + 32, WCAT + (size_t)(64 * nb) * 4096 + 3072 + 64 * kb, 4096, nullptr, scr, lane); continue; } r -= I_C;
            { const int kb = r / 16, nb = r % 16; transpose_item64(AP(w_out), 1024, 64 * kb, 64 * nb, 64 * nb + 32, WOUT + (size_t)(64 * nb) * 1024 + 64 * kb, 1024, nullptr, scr, lane); }
        }
        for (int m0 = gw * 4; m0 < T * REPS(0); m0 += NGW * 4) { const int m = m0 % T; rms_rows_to_bf16<4>(AP(x) + (size_t)m * 1024, XN + (size_t)m * 1024, 1, AP(norm_mix), lane); }
        for (int m = gw; m < NBATCH * MEMLEN; m += NGW) rms_rows_to_bf16<1>(AP(mem) + (size_t)m * 1024, MEMN + (size_t)m * 1024, 1, AP(norm_mem), lane);
    }
    SEAM(0);
    if (IN(1)) { PHASE_ARGS; EI_INIT;
        const SchedIn S{G, bx, 16, TL_Q, 12, TL_QX, 0, (const char*)WIN, (const char*)WMEM, REPS(1)};
        pg8::gemm_phase<false>(lds, (const char*)XN, 2048, 2048, S, EI);
    }
    SEAM(1);
    if (IN(2)) { PHASE_ARGS;
        if (MK_BRANCHES & 1) {
            LAS float* bl = (LAS float*)(lds + AT_BIAS);
            for (int i = tid; i < 16 * 257; i += NTHREADS) bl[(i / 257) * AT_BIAS_STRIDE + (i % 257)] = AP(a_rel_bias)[i] * LOG2E;
            __syncthreads();
            for (int u = vcu; u < 4 * NBATCH * 64; u += G) { const int c = u & 63, b = (u >> 6) & 7, hq = u >> 9; attnA_unit(lds, b, c, hq, ACT, KA, VA, (MK_REP_MASK >> 2 & 1) ? (bf16_t*)(ws + WS_BUF + 128 * MiB) : ACT, (MK_REP_MASK >> 2 & 1) ? 1024 : ACT_P);
                if (MK_REP_MASK >> 2 & 1) attnA_unit(lds, b, c, hq, ACT, KA, VA, ACT, ACT_P); }
        } else {
            for (int idx = vcu * NTHREADS + tid; idx < T * 128; idx += G * NTHREADS) { const int t = idx >> 7, ch = idx & 127; *(u32x4*)(ACT + (size_t)t * ACT_P + ch * 8) = (u32x4){0u, 0u, 0u, 0u}; }
        }
    }
    SEAM(2);
    if (IN(3)) { PHASE_ARGS; EI_INIT;
        const SchedIn S{G, bx, 21, TL_Z, 21, 0, 64, (const char*)WIN, (const char*)WMEM, REPS(3)};
        pg8::gemm_phase<false>(lds, (const char*)XN, 2048, 2048, S, EI);
    }
    SEAM(3);
    if (IN(4)) { PHASE_ARGS;
        if (MK_BRANCHES & 2) bcconv_phase(vcu, G, XBC, BCC, AP(conv_w), AP(conv_b));
        for (int w = gw; w < NBATCH * MEMLEN * 4; w += NGW) {
            const int row = w >> 2, hx = w & 3; const u32x2 kv = *(const u32x2*)(MEMKV + (size_t)row * 2048 + 256 * hx + 4 * lane);
            const float k0 = bf_lo(kv.x), k1 = bf_hi(kv.x), k2 = bf_lo(kv.y), k3 = bf_hi(kv.y);
            const float rs = __builtin_amdgcn_rsqf(wave_sum(k0 * k0 + k1 * k1 + k2 * k2 + k3 * k3) * (1.f / 256.f) + EPS) * (0.0625f * LOG2E);
            const f32x4 gk = *(const f32x4*)(AP(x_k_gain) + 4 * lane), gq = *(const f32x4*)(AP(x_q_gain) + 4 * lane);
            u32x2 o; o.x = pk2(k0 * rs * gk.x * gq.x, k1 * rs * gk.y * gq.y); o.y = pk2(k2 * rs * gk.z * gq.z, k3 * rs * gk.w * gq.w);
            *(u32x2*)(KX + (size_t)row * 1024 + 256 * hx + 4 * lane) = o;
        }
        xcd_barrier(bar);
        if (MK_REP_MASK >> 14 & 1) for (int u = vcu; u < NBATCH * 4 * 32; u += G) { const int rb = u & 31, hx = (u >> 5) & 3, b = u >> 7; attnC_unit(lds, b, hx, rb, ACT, KX, MEMKV, (bf16_t*)kq[30] + (size_t)T * 1024, 1024); }
        if (MK_BRANCHES & 4) for (int u = vcu; u < NBATCH * 4 * 32; u += G) { const int rb = u & 31, hx = (u >> 5) & 3, b = u >> 7; attnC_unit(lds, b, hx, rb, ACT, KX, MEMKV, ACT + 3072, ACT_P); }
        if (MK_BRANCHES & 2) for (int u = vcu; u < NBATCH * 32; u += G) mamba_unit(lds, u >> 5, u & 31, XBC, BCC, DTB, ACT, SSQ, ACT + 1024, ACT_P, AP(conv_w), AP(conv_b), AP(a_log), AP(d_skip));
    }
    SEAM(4);
    if (IN(5)) { PHASE_ARGS; EI_INIT;
        for (int idx = vcu * NTHREADS + tid; idx < T * 4; idx += G * NTHREADS) { const int t = idx >> 2, g = idx & 3; const f32x4 s0 = *(const f32x4*)(SSQ + (size_t)t * 32 + 8 * g), s1 = *(const f32x4*)(SSQ + (size_t)t * 32 + 8 * g + 4);
            RSTD[idx] = __builtin_amdgcn_rsqf(((s0[0] + s0[1]) + (s0[2] + s0[3]) + (s1[0] + s1[1]) + (s1[2] + s1[3])) * (1.f / 512.f) + EPS); }
        const SchedIn S{G, bx, 12, TL_G, 12, 0, 0, (const char*)WIN, (const char*)WMEM, REPS(5)};
        pg8::gemm_phase<false>(lds, (const char*)XN, 2048, 2048, S, EI);
    }
    SEAM(5);
    if (IN(6)) { PHASE_ARGS;
        constexpr int LASTSEG = (MK_BRANCHES & 4) ? 2 : ((MK_BRANCHES & 2) ? 1 : 0);
        constexpr int KM = LASTSEG == 2 ? 4096 : (LASTSEG == 1 ? 3072 : 1024);
        const SchedDense S{G, bx, T / 256, 4, 4096, (const char*)WCAT, REPS(6)};
        const EpiMerge E{GATES, RSTD, MERGED, LASTSEG};
        pg8::gemm_phase<false>(lds, (const char*)ACT, KM * 2, 8192, S, E);
    }
    SEAM(6);
    if (IN(7)) { PHASE_ARGS;
        const SchedDense S{G, bx, T / 256, 4, 1024, (const char*)WOUT, REPS(7)};
        const EpiOut E{AP(x), ((float*)kq[30])};
        pg8::gemm_phase<false>(lds, (const char*)MERGED, 2048, 2048, S, E);
    }
    SEAM(7);
    if (IN(8) && (MK_BRANCHES & 8)) { PHASE_ARGS;
        router_phase(lds, vcu, G, ((float*)kq[30]), AP(norm_ffn), AP(w_router), AP(b_router), H2, SELE, SELR, SELW, TOKL, GCNT);
        __syncthreads();
        for (int it0 = gw; it0 < NEXP * 768 * REPS(8); it0 += NGW) { const int it = it0 % (NEXP * 768);
            const int e = it / 768, r = it % 768, which = r >> 8, kb = (r & 255) >> 4, nb = r & 15;
            const float* src = (which == 0 ? AP(w_gate) : which == 1 ? AP(w_up) : AP(w_down)) + (size_t)e * 1024 * 1024;
            if (which == 2) transpose_item64_fp8(src, 1024, 64 * kb, 64 * nb, 64 * nb + 32, WD + ((size_t)e * 1024 + 64 * nb) * 1024 + 64 * kb, 1024, 32.0f, scr, lane);
            else transpose_item64_fp8(src, 1024, 64 * kb, 64 * nb, 64 * nb + 32, WGU + ((size_t)e * 2048 + 256 * (nb >> 1) + 128 * which + 64 * (nb & 1)) * 1024 + 64 * kb, 1024, 32.0f, scr, lane);
        }
    }
    SEAM(8);
#pragma unroll 1
    for (int g = 0; g < 2; ++g) {
        const int p0 = 9 + 3 * g;
        if ((MK_BRANCHES & 8) && (IN(p0) || IN(p0 + 1) || IN(p0 + 2))) { PHASE_ARGS;
            const int total = moe_tables(lds, GCNT), half = total < 256 ? total : 256, tlo = g ? half : 0, thi = g ? total : half;
            const LAS int* ts = (const LAS int*)(lds + MO_TS); const LAS int* cn = (const LAS int*)(lds + MO_CNT);
            if (IN(p0)) { const SchedMoE S{G, bx, 8, tlo, thi, ts, cn, TOKL, (const char*)WGU, (size_t)2048 * 1024, REPS(9), 1024u, 1024u}; const EpiGU E{ACTM, AP(b_gate), AP(b_up), tlo};
                pg8::gemm_phase<true>(lds, (const char*)H2, 1024, 1024, S, E); }
            SEAM(p0);
            if (IN(p0 + 1)) { const SchedMoE S{G, bx, 4, tlo, thi, ts, cn, nullptr, (const char*)WD, (size_t)1024 * 1024, REPS(10), 1024u, 1024u}; const EpiDown E{YB, AP(b_down), tlo};
                pg8::gemm_phase<true>(lds, (const char*)ACTM, 1024, 1024, S, E); }
            SEAM(p0 + 1);
            if (IN(p0 + 2)) combine_phase(lds, vcu, G, tlo, thi, YB, SELE, SELR, SELW, ((float*)kq[30]));
            SEAM(p0 + 2);
        } else { SEAM(p0); SEAM(p0 + 1); SEAM(p0 + 2); }
    }
#undef IN
#undef SEAM
}

extern "C" void kernel_launch(void* const* d_in, const int* in_sizes, int n_in, void* d_out, int out_size, void* d_ws, size_t ws_size, hipStream_t stream) {
    static int grid = 0;
    if (grid == 0) {
        if (n_in != 30 || ws_size < WS_MIX_END || ws_size < WS_END) { fprintf(stderr, "kernel_launch: unexpected n_in %d / ws_size %zu\n", n_in, ws_size); grid = -1; return; }
        int dev = 0, cus = 0, per_cu = 0;
        (void)hipGetDevice(&dev); (void)hipDeviceGetAttribute(&cus, hipDeviceAttributeMultiprocessorCount, dev);
        (void)hipFuncSetAttribute((const void*)mega_fwd, hipFuncAttributeMaxDynamicSharedMemorySize, LDS_BYTES);
        (void)hipOccupancyMaxActiveBlocksPerMultiprocessor(&per_cu, (const void*)mega_fwd, NTHREADS, LDS_BYTES);
        if (per_cu < 1) { fprintf(stderr, "kernel_launch: occupancy query reports %d blocks per CU\n", per_cu); grid = -1; return; }
        grid = cus;
    }
    if (grid < 0) return;
    (void)hipMemsetAsync((char*)d_ws + WS_CTL, 0, 65536, stream);
    Args a{};
    for (int i = 0; i < 30; ++i) a.in[i] = (const float*)d_in[i];
    a.out = (float*)d_out; a.ws = (unsigned char*)d_ws;
    if (MK_N_LAUNCHES == 1) {
        a.ph_lo = 0; a.ph_hi = N_PHASES;
        void* args[] = {&a};
        hipError_t e = hipLaunchCooperativeKernel((void*)mega_fwd, dim3(grid), dim3(NTHREADS), args, LDS_BYTES, stream);
        if (e != hipSuccess) fprintf(stderr, "cooperative launch failed: %s (grid %d)\n", hipGetErrorString(e), grid);
    } else {
        for (int ph = 0; ph < N_PHASES; ++ph) { a.ph_lo = ph; a.ph_hi = ph + 1; hipLaunchKernelGGL(mega_fwd, dim3(grid), dim3(NTHREADS), LDS_BYTES, stream, a); }
    }
}
```

```cpp
#include <hip/hip_runtime.h>
#include <hip/hip_cooperative_groups.h>
#include <cstdio>
#include <cstdint>
namespace cg = cooperative_groups;

#define LAS __attribute__((address_space(3)))
#define GAS __attribute__((address_space(1)))
#define DI __device__ __forceinline__
typedef unsigned short bf16_t;
typedef short bf16x8 __attribute__((ext_vector_type(8)));
typedef short s16x4 __attribute__((ext_vector_type(4)));
typedef float f32x2 __attribute__((ext_vector_type(2)));
typedef float f32x4 __attribute__((ext_vector_type(4)));
typedef float f32x16 __attribute__((ext_vector_type(16)));
typedef unsigned u32x2 __attribute__((ext_vector_type(2)));
typedef unsigned u32x4 __attribute__((ext_vector_type(4)));
typedef __bf16 bf16x2_t __attribute__((ext_vector_type(2)));
typedef short v4i16_t __attribute__((ext_vector_type(4)));

DI unsigned pk2(float lo, float hi) { f32x2 v = {lo, hi}; bf16x2_t b = __builtin_convertvector(v, bf16x2_t); return __builtin_bit_cast(unsigned, b); }
DI float bf_lo(unsigned w) { return __uint_as_float(w << 16); }
DI float bf_hi(unsigned w) { return __uint_as_float(w & 0xffff0000u); }
DI float bf2f(bf16_t b) { return __uint_as_float(((unsigned)b) << 16); }
DI float wave_sum(float v) {
#pragma unroll
    for (int o = 1; o < 64; o <<= 1) v += __shfl_xor(v, o);
    return v;
}
DI float fast_exp2(float x) { return __builtin_amdgcn_exp2f(x); }
DI float fast_rcp(float x) { return __builtin_amdgcn_rcpf(x); }
DI float sigmoidf_(float x) { return fast_rcp(1.0f + fast_exp2(-1.4426950408889634f * x)); }

constexpr int NBATCH = 8, SEQ = 4096, T = NBATCH * SEQ, DM = 1024;
constexpr int NWIN_TILES = 49, NWIN = NWIN_TILES * 256;
constexpr int IN_COLS = 12320;
constexpr float EPS = 1e-6f;
constexpr float LOG2E = 1.4426950408889634f;
constexpr int NEXP = 32, TOPK = 4;
constexpr int MEMLEN = 256;
constexpr int ACT_P = 4096;
constexpr int TL_Q = 0, TL_K = 4, TL_V = 8, TL_Z = 12, TL_XBC = 20, TL_DT = 32, TL_QX = 33, TL_G = 37;

constexpr size_t MiB = (size_t)1 << 20;
constexpr size_t WS_CTL = 0, CTL_BYTES = 1 * MiB;
constexpr size_t WS_WIN = 1 * MiB, WS_WCAT = 26 * MiB, WS_WOUT = 34 * MiB, WS_WMEM = 36 * MiB;
constexpr size_t WS_DT = 40 * MiB, WS_SSQ = 44 * MiB, WS_RSTD = 48 * MiB, WS_KX = 49 * MiB, WS_MEMKV = 53 * MiB;
constexpr size_t WS_XN = 61 * MiB, WS_MEMN = 125 * MiB, WS_ACT = 129 * MiB, WS_BUF = 385 * MiB, WS_MIX_END = 577 * MiB;
constexpr size_t WS_KA = WS_BUF, WS_VA = WS_BUF + 64 * MiB, WS_XBC = WS_BUF, WS_GATES = WS_BUF, WS_MERGED = WS_XN;
constexpr int MOE_TILE_CAP = 280;
constexpr size_t MOE_H2 = 1 * MiB, MOE_WGU = 33 * MiB, MOE_WD = 97 * MiB, MOE_ACTM = 129 * MiB, MOE_Y = 265 * MiB;
constexpr size_t MOE_SELE = 537 * MiB, MOE_SELR = 537 * MiB + 512 * 1024, MOE_SELW = 538 * MiB, MOE_TOKL = 539 * MiB, WS_END = 543 * MiB;
constexpr int CW_CNT = 64;

#ifndef MK_KREP
#define MK_KREP 1
#endif
#ifndef MK_NT_STORES
#define MK_NT_STORES 0
#endif
namespace pg8 {
constexpr int BM = 256, BK = 64, HALF = 128, HTB = HALF * BK * 2, STAGE_BYTES = 8 * HTB;
__host__ __device__ __forceinline__ int lds_byte(int r, int c) { const int st = (r >> 4) * 2 + (c >> 5), rr = r & 15, cc = c & 31, ob = rr * 64 + cc * 2; return st * 1024 + (ob ^ (((ob >> 9) & 1) << 5)); }
__host__ __device__ __forceinline__ void stage_rc(int b, int& R, int& C) { const int st = b / 1024, sb = b % 1024, swz = sb ^ (((sb >> 9) & 1) << 5); R = (st >> 1) * 16 + swz / 64; C = (st & 1) * 32 + (swz % 64) / 2; }
__host__ __device__ __forceinline__ int perm32(int rho) { const int n = rho >> 4, i = rho & 15; return 8 * (i >> 2) + 4 * n + (i & 3); }

struct Unit { int kind, pm, pn, aux; };

typedef f32x4 Acc[2][2][4][2];

typedef int v8i_t __attribute__((ext_vector_type(8)));
template <bool FP8, class Epi, class Sched>
DI void gemm_phase(LAS unsigned char* lds, const char* Abase, const int Kb, const int ldbb, const Sched& S, const Epi& E) {
    int tid_ = threadIdx.x; asm volatile("" : "+v"(tid_));
    const int tid = tid_, wid = __builtin_amdgcn_readfirstlane(tid >> 6), lane = tid & 63, wr = wid >> 2, wc = wid & 3, fr = lane & 15, fq = lane >> 4;
    const int nt = Kb / (BK * 2);
    int Rr[2], Cc2[2]; unsigned voffB[2];
#pragma unroll
    for (int i = 0; i < 2; ++i) { int R, C; stage_rc(tid * 16 + i * 8192, R, C); Rr[i] = R; Cc2[i] = C * 2; const int Rb = (R & ~31) + perm32(R & 31); voffB[i] = (unsigned)(Rb * ldbb + C * 2); }
    const unsigned kstep = (unsigned)(BK * 2);
    const size_t hstepB = (size_t)HALF * ldbb;
    const unsigned ldsw = (unsigned)wid * 1024u;
    const int aoff0 = lds_byte(wr * 64 + fr, fq * 8), aoff1 = aoff0 + 1024;
    const int boff0 = lds_byte(wc * 32 + fr, fq * 8), boff1 = boff0 + 1024;
#define PG8_SA(b, h) (((b) * 2 + (h)) * HTB)
#define PG8_SB(b, h) ((4 + (b) * 2 + (h)) * HTB)
#define PG8_GLDS(src, dstoff) __builtin_amdgcn_global_load_lds((const unsigned*)(src), (LAS unsigned*)(lds + (dstoff)), 16, 0, 0)
#define PG8_STAGE_B(bufoff, ptr) do { _Pragma("unroll") for (int _i = 0; _i < 2; ++_i) PG8_GLDS((const char*)(ptr) + voffB[_i], (bufoff) + ldsw + _i * 8192); } while (0)
#define PG8_STAGE_A(bufoff, kb, v0, v1) do { PG8_GLDS(Abase + (size_t)(v0) + (kb), (bufoff) + ldsw); PG8_GLDS(Abase + (size_t)(v1) + (kb), (bufoff) + ldsw + 8192); } while (0)
#define PG8_LDA(dst, b, h) do { _Pragma("unroll") for (int m = 0; m < 4; ++m) { dst[m][0] = *(const LAS u32x4*)(lds + PG8_SA(b, h) + aoff0 + m * 2048); dst[m][1] = *(const LAS u32x4*)(lds + PG8_SA(b, h) + aoff1 + m * 2048); } } while (0)
#define PG8_LDB(dst, b, h) do { _Pragma("unroll") for (int n = 0; n < 2; ++n) { dst[n][0] = *(const LAS u32x4*)(lds + PG8_SB(b, h) + boff0 + n * 2048); dst[n][1] = *(const LAS u32x4*)(lds + PG8_SB(b, h) + boff1 + n * 2048); } } while (0)
#define PG8_CAT(x) __builtin_bit_cast(v8i_t, __builtin_shufflevector((x)[0], (x)[1], 0, 1, 2, 3, 4, 5, 6, 7))
#define PG8_MMA(ai, bj, At, Bt) do { __builtin_amdgcn_s_setprio(1); _Pragma("unroll") for (int m = 0; m < 4; ++m) _Pragma("unroll") for (int n = 0; n < 2; ++n) { \
        if constexpr (FP8) asm volatile("v_mfma_scale_f32_16x16x128_f8f6f4 %0, %1, %2, %0, %3, %4 op_sel_hi:[0,0,0]" : "+v"(acc[ai][bj][m][n]) : "v"(PG8_CAT(Bt[n])), "v"(PG8_CAT(At[m])), "v"(sclB), "v"(sclA)); \
        else { _Pragma("unroll") for (int k = 0; k < 2; ++k) acc[ai][bj][m][n] = __builtin_amdgcn_mfma_f32_16x16x32_bf16(__builtin_bit_cast(bf16x8, Bt[n][k]), __builtin_bit_cast(bf16x8, At[m][k]), acc[ai][bj][m][n], 0, 0, 0); } } \
        __builtin_amdgcn_s_setprio(0); } while (0)
#define PG8_WAIT_V(n) asm volatile("s_waitcnt vmcnt(" #n ")" ::: "memory")
#define PG8_WAIT_L(n) asm volatile("s_waitcnt lgkmcnt(" #n ")" ::: "memory")
#define PG8_BAR __builtin_amdgcn_s_barrier()
#define PG8_SCHED __builtin_amdgcn_sched_barrier(0)
    Unit cur, nxt; int ui = 0;
    if (!S.next(0, cur)) return;
    Acc acc;
#pragma unroll
    for (int a = 0; a < 2; ++a)
#pragma unroll
        for (int b = 0; b < 2; ++b)
#pragma unroll
            for (int m = 0; m < 4; ++m)
#pragma unroll
                for (int n = 0; n < 2; ++n) acc[a][b][m][n] = (f32x4){0.f, 0.f, 0.f, 0.f};
    u32x4 At[4][2], B0[2][2], B1[2][2];
    int sclB = 0x7a7a7a7a, sclA = 0x7f7f7f7f;
    asm volatile("" : "+v"(sclB), "+v"(sclA));
    unsigned vA00 = S.arow(cur, Rr[0]) + Cc2[0], vA01 = S.arow(cur, Rr[1]) + Cc2[1], vA10 = S.arow(cur, HALF + Rr[0]) + Cc2[0], vA11 = S.arow(cur, HALF + Rr[1]) + Cc2[1];
    const char* cB = S.bptr(cur);
    PG8_STAGE_B(PG8_SB(0, 0), cB); PG8_STAGE_B(PG8_SB(0, 1), cB + hstepB); PG8_STAGE_A(PG8_SA(0, 0), 0, vA00, vA01); PG8_STAGE_A(PG8_SA(0, 1), 0, vA10, vA11);
    if (wr == 1) PG8_BAR;
    PG8_WAIT_V(2); PG8_BAR;
    PG8_STAGE_B(PG8_SB(1, 0), cB + kstep); PG8_STAGE_A(PG8_SA(1, 0), kstep, vA00, vA01); PG8_STAGE_B(PG8_SB(1, 1), cB + hstepB + kstep);
    PG8_WAIT_V(6); PG8_BAR;
    for (;;) {
        const bool has_next = S.next(ui + 1, nxt);
        const char* nB = has_next ? S.bptr(nxt) : cB;
        constexpr int KREP = (MK_KREP > 1 && !Epi::SEGMENTED) ? MK_KREP : 1;
        for (int tt = 0; tt < nt * KREP; tt += 2) {
            const int t = KREP > 1 ? tt % nt : tt;
            const bool last = (tt == nt * KREP - 2);
            if constexpr (Epi::SEGMENTED) { if (t > 0 && E.boundary(t)) E.rescale(acc, cur, t, wr, wc, fr, fq); }
            const unsigned k1 = (unsigned)(t + 1) * kstep;
            const unsigned t2 = (KREP > 1) ? (unsigned)((t + 2) % nt) : (unsigned)(t + 2);
            const unsigned k2 = last ? 0u : t2 * kstep, k3 = k2 + kstep;
            const char* b2 = last ? nB : cB + t2 * kstep; const char* b3 = b2 + kstep;
            unsigned w00 = vA00, w01 = vA01, w10 = vA10, w11 = vA11;
            if (last && has_next) { w00 = S.arow(nxt, Rr[0]) + Cc2[0]; w01 = S.arow(nxt, Rr[1]) + Cc2[1]; w10 = S.arow(nxt, HALF + Rr[0]) + Cc2[0]; w11 = S.arow(nxt, HALF + Rr[1]) + Cc2[1]; }
            PG8_LDB(B0, 0, 0); PG8_LDB(B1, 0, 1); PG8_SCHED; PG8_LDA(At, 0, 0); PG8_STAGE_A(PG8_SA(1, 1), k1, vA10, vA11);
            PG8_WAIT_V(8); PG8_WAIT_L(0); PG8_BAR; PG8_MMA(0, 0, At, B0); PG8_MMA(0, 1, At, B1); PG8_BAR; PG8_SCHED;
            PG8_LDA(At, 0, 1); PG8_STAGE_B(PG8_SB(0, 0), b2); PG8_STAGE_B(PG8_SB(0, 1), b2 + hstepB); PG8_STAGE_A(PG8_SA(0, 0), k2, w00, w01);
            PG8_WAIT_V(8); PG8_WAIT_L(0); PG8_BAR; PG8_MMA(1, 0, At, B0); PG8_MMA(1, 1, At, B1); PG8_BAR; PG8_SCHED;
            PG8_LDB(B0, 1, 0); PG8_LDB(B1, 1, 1); PG8_SCHED; PG8_LDA(At, 1, 0); PG8_STAGE_A(PG8_SA(0, 1), k2, w10, w11);
            PG8_WAIT_V(8); PG8_WAIT_L(0); PG8_BAR; PG8_MMA(0, 0, At, B0); PG8_MMA(0, 1, At, B1); PG8_BAR; PG8_SCHED;
            PG8_LDA(At, 1, 1); PG8_STAGE_B(PG8_SB(1, 0), b3); PG8_STAGE_B(PG8_SB(1, 1), b3 + hstepB); PG8_STAGE_A(PG8_SA(1, 0), k3, w00, w01);
            PG8_WAIT_V(8); PG8_WAIT_L(0); PG8_BAR; PG8_MMA(1, 0, At, B0); PG8_MMA(1, 1, At, B1); PG8_BAR; PG8_SCHED;
            if (last) { vA00 = w00; vA01 = w01; vA10 = w10; vA11 = w11; }
        }
        if (wr == 0) PG8_BAR;
        if constexpr (FP8) asm volatile("s_nop 15\n\ts_nop 7" ::: "memory");
        if constexpr (KREP > 1) {
#pragma unroll
            for (int a = 0; a < 2; ++a)
#pragma unroll
                for (int b = 0; b < 2; ++b)
#pragma unroll
                    for (int m = 0; m < 4; ++m)
#pragma unroll
                        for (int n = 0; n < 2; ++n) acc[a][b][m][n] *= (1.0f / KREP); }
        E(acc, cur, wr, wc, fr, fq);
        if (!has_next) break;
#pragma unroll
        for (int a = 0; a < 2; ++a)
#pragma unroll
            for (int b = 0; b < 2; ++b)
#pragma unroll
                for (int m = 0; m < 4; ++m)
#pragma unroll
                    for (int n = 0; n < 2; ++n) acc[a][b][m][n] = (f32x4){0.f, 0.f, 0.f, 0.f};
        cur = nxt; cB = nB; ++ui;
        if (wr == 1) PG8_BAR;
    }
    PG8_WAIT_V(0);
    PG8_BAR;
#undef PG8_SA
#undef PG8_SB
#undef PG8_GLDS
#undef PG8_STAGE_A
#undef PG8_STAGE_B
#undef PG8_LDA
#undef PG8_LDB
#undef PG8_MMA
#undef PG8_CAT
#undef PG8_WAIT_V
#undef PG8_WAIT_L
#undef PG8_BAR
#undef PG8_SCHED
}

DI bool static_tile(int L, int nM, int nN, int& pm, int& pn) {
    const int nwg = nM * nN; if (L >= nwg) return false;
    int wgid = L; { const int q = nwg / 8, r = nwg % 8, xcd = wgid % 8, off = wgid / 8; wgid = (xcd < r ? xcd * (q + 1) : r * (q + 1) + (xcd - r) * q) + off; }
    const int nig = 8 * nN, gid = wgid / nig, fm = gid * 8, gsz = (nM - fm) < 8 ? (nM - fm) : 8;
    pm = fm + ((wgid % nig) % gsz); pn = (wgid % nig) / gsz; return true;
}
}
using pg8::Unit; using pg8::Acc;

DI unsigned pk4_fp8(float a, float b, float c, float d) { int p = 0; p = __builtin_amdgcn_cvt_pk_fp8_f32(a, b, p, false); p = __builtin_amdgcn_cvt_pk_fp8_f32(c, d, p, true); return (unsigned)p; }
DI float silu_(float v) { return v * sigmoidf_(v); }
DI float softplus_(float x) { return fmaxf(x, 0.f) + __logf(1.0f + __expf(-fabsf(x))); }

struct SchedIn {
    int G, c, ncol, t0, nsplit, t1, nextra; const char* win; const char* wmem; int reps;
    DI bool next(int i, Unit& u) const {
        const int U = (T / 256) * ncol + nextra; int L = i * G + c; if (L >= U * reps) return false; L %= U; int pm, pn;
        if (pg8::static_tile(L, T / 256, ncol, pm, pn)) { u.kind = 0; u.pm = pm; u.pn = pn < nsplit ? t0 + pn : t1 + (pn - nsplit); u.aux = 0; return true; }
        const int j = L - (T / 256) * ncol; if (j < nextra) { u.kind = 1; u.pm = j >> 3; u.pn = j & 7; u.aux = 0; return true; }
        return false;
    }
    DI unsigned arow(const Unit& u, int r) const { return (u.kind == 0 ? 0u : (unsigned)(WS_MEMN - WS_XN)) + (unsigned)(u.pm * 256 + r) * 2048u; }
    DI const char* bptr(const Unit& u) const { return (u.kind == 0 ? win : wmem) + (size_t)u.pn * (256 * 1024 * 2); }
};

struct EpiIn {
    static constexpr bool SEGMENTED = false;
    unsigned char* ws; const float *qgain, *kgain, *dtbias;
    template <int OP> DI void ew(const Acc& acc, bf16_t* dst, size_t pitch, int col0, int row0, int wc, int fq) const {
#pragma unroll
        for (int ai = 0; ai < 2; ++ai)
#pragma unroll
            for (int m = 0; m < 4; ++m) { bf16_t* rowp = dst + (size_t)(row0 + ai * 128 + m * 16) * pitch + col0 + wc * 32 + 8 * fq;
#pragma unroll
                for (int bj = 0; bj < 2; ++bj) { f32x4 v0 = acc[ai][bj][m][0], v1 = acc[ai][bj][m][1];
                    if (OP == 1) { for (int e = 0; e < 4; ++e) { v0[e] = silu_(v0[e]); v1[e] = silu_(v1[e]); } }
                    if (OP == 2) { for (int e = 0; e < 4; ++e) { v0[e] = sigmoidf_(fminf(fmaxf(v0[e], -30.f), 30.f)); v1[e] = sigmoidf_(fminf(fmaxf(v1[e], -30.f), 30.f)); } }
                    u32x4 w; w.x = pk2(v0[0], v0[1]); w.y = pk2(v0[2], v0[3]); w.z = pk2(v1[0], v1[1]); w.w = pk2(v1[2], v1[3]);
                    *(u32x4*)(rowp + bj * 128) = w; }
                asm volatile("" ::: "memory"); }
    }
    DI void headnorm(const Acc& acc, bf16_t* dst, size_t pitch, int col0, int row0, int wc, int fq, const float* gain, float mul) const {
#pragma unroll
        for (int ai = 0; ai < 2; ++ai)
#pragma unroll
            for (int m = 0; m < 4; ++m) {
                float ss = 0.f;
#pragma unroll
                for (int bj = 0; bj < 2; ++bj)
#pragma unroll
                    for (int n = 0; n < 2; ++n) { const f32x4 x = acc[ai][bj][m][n]; ss += (x[0] * x[0] + x[1] * x[1]) + (x[2] * x[2] + x[3] * x[3]); }
                ss += __shfl_xor(ss, 16); ss += __shfl_xor(ss, 32);
                const float rs = __builtin_amdgcn_rsqf(ss * (1.0f / 64.0f) + EPS) * mul;
                bf16_t* rowp = dst + (size_t)(row0 + ai * 128 + m * 16) * pitch + col0 + wc * 64 + 8 * fq;
#pragma unroll
                for (int bj = 0; bj < 2; ++bj) { const f32x4 g0 = *(const f32x4*)(gain + 32 * bj + 8 * fq), g1 = *(const f32x4*)(gain + 32 * bj + 8 * fq + 4);
                    const f32x4 v0 = acc[ai][bj][m][0] * rs * g0, v1 = acc[ai][bj][m][1] * rs * g1;
                    u32x4 w; w.x = pk2(v0[0], v0[1]); w.y = pk2(v0[2], v0[3]); w.z = pk2(v1[0], v1[1]); w.w = pk2(v1[2], v1[3]);
                    *(u32x4*)(rowp + bj * 32) = w; }
                asm volatile("" ::: "memory"); }
    }
    DI void operator()(const Acc& acc, const Unit& u, int wr, int wc, int fr, int fq) const {
        const int row0 = u.pm * 256 + wr * 64 + fr;
        bf16_t* const act = (bf16_t*)(ws + WS_ACT); bf16_t* const ka = (bf16_t*)(ws + WS_KA); bf16_t* const va = (bf16_t*)(ws + WS_VA); bf16_t* const xbc = (bf16_t*)(ws + WS_XBC);
        bf16_t* const gates = (bf16_t*)(ws + WS_GATES); bf16_t* const memkv = (bf16_t*)(ws + WS_MEMKV); float* const dt = (float*)(ws + WS_DT);
        if (u.kind == 1) { ew<0>(acc, memkv, 2048, u.pn * 256, row0, wc, fq); return; }
        const int tl = u.pn;
        if (tl < TL_K) headnorm(acc, act, ACT_P, (tl - TL_Q) * 256, row0, wc, fq, qgain, 0.125f * LOG2E);
        else if (tl < TL_V) headnorm(acc, ka, 1024, (tl - TL_K) * 256, row0, wc, fq, kgain, 1.0f);
        else if (tl < TL_Z) ew<0>(acc, va, 1024, (tl - TL_V) * 256, row0, wc, fq);
        else if (tl < TL_XBC) ew<1>(acc, act, ACT_P, 1024 + (tl - TL_Z) * 256, row0, wc, fq);
        else if (tl < TL_DT) ew<0>(acc, xbc, 3072, (tl - TL_XBC) * 256, row0, wc, fq);
        else if (tl == TL_DT) {
            if (wc == 0) {
                f32x4 b0 = *(const f32x4*)(dtbias + 8 * fq), b1 = *(const f32x4*)(dtbias + 8 * fq + 4);
#pragma unroll
                for (int ai = 0; ai < 2; ++ai)
#pragma unroll
                    for (int m = 0; m < 4; ++m) { float* rowp = dt + (size_t)(row0 + ai * 128 + m * 16) * 32 + 8 * fq;
                        f32x4 v0 = acc[ai][0][m][0] + b0, v1 = acc[ai][0][m][1] + b1;
                        for (int e = 0; e < 4; ++e) { v0[e] = softplus_(v0[e]); v1[e] = softplus_(v1[e]); }
                        *(f32x4*)rowp = v0; *(f32x4*)(rowp + 4) = v1; }
            }
        }
        else if (tl < TL_G) ew<0>(acc, act, ACT_P, 3072 + (tl - TL_QX) * 256, row0, wc, fq);
        else ew<2>(acc, gates, 3072, (tl - TL_G) * 256, row0, wc, fq);
    }
};

struct SchedDense {
    int G, c, nM, nN, K; const char* bbase; int reps;
    DI bool next(int i, Unit& u) const { u.kind = 0; u.aux = 0; const int U = nM * nN; int L = i * G + c; if (L >= U * reps) return false; return pg8::static_tile(L % U, nM, nN, u.pm, u.pn); }
    DI unsigned arow(const Unit& u, int r) const { return (unsigned)(u.pm * 256 + r) * (unsigned)(K * 2); }
    DI const char* bptr(const Unit& u) const { return bbase + (size_t)u.pn * 256 * K * 2; }
};

struct EpiMerge {
    static constexpr bool SEGMENTED = true;
    const bf16_t* gates; const float* rstd; bf16_t* merged; int last_seg;
    DI bool boundary(int t) const { return t == 16 || t == 24 || t == 32 || t == 40 || t == 48; }
    DI void load8(const bf16_t* p, float (&g)[8]) const { const u32x4 w = *(const u32x4*)p; g[0] = bf_lo(w.x); g[1] = bf_hi(w.x); g[2] = bf_lo(w.y); g[3] = bf_hi(w.y); g[4] = bf_lo(w.z); g[5] = bf_hi(w.z); g[6] = bf_lo(w.w); g[7] = bf_hi(w.w); }
    DI void rescale(Acc& acc, const Unit& u, int t, int wr, int wc, int fr, int fq) const {
        int row0 = u.pm * 256 + wr * 64 + fr, col0 = u.pn * 256 + wc * 32 + 8 * fq;
        asm volatile("" : "+v"(row0), "+v"(col0));
        const int go = (t == 16) ? 0 : 1024, ri = (t == 16) ? 0 : 3, g = (t == 24) ? 0 : (t == 32) ? 1 : 2;
        asm volatile("s_nop 15" ::: "memory");
#pragma unroll
        for (int ai = 0; ai < 2; ++ai)
#pragma unroll
          for (int mp = 0; mp < 2; ++mp) {
            float f[2][2][8];
            if (t == 16 || t == 48) {
                u32x4 ga[2][2], gb[2][2]; float rsv[2];
#pragma unroll
                for (int mm = 0; mm < 2; ++mm) { const int row = row0 + ai * 128 + (2 * mp + mm) * 16; const bf16_t* gp = gates + (size_t)row * 3072 + col0 + go; rsv[mm] = rstd[(size_t)row * 4 + ri];
#pragma unroll
                    for (int bj = 0; bj < 2; ++bj) { ga[mm][bj] = *(const u32x4*)(gp + bj * 128); gb[mm][bj] = *(const u32x4*)(gp + 1024 + bj * 128); } }
#pragma unroll
                for (int mm = 0; mm < 2; ++mm)
#pragma unroll
                    for (int bj = 0; bj < 2; ++bj) { float a[8], b[8]; unpack8(ga[mm][bj], a); unpack8(gb[mm][bj], b);
#pragma unroll
                        for (int j = 0; j < 8; ++j) f[mm][bj][j] = (t == 16) ? a[j] * fast_rcp(b[j] * rsv[mm]) : a[j] * rsv[mm] * fast_rcp(b[j]); }
            } else {
#pragma unroll
                for (int mm = 0; mm < 2; ++mm) { const float* rp = rstd + (size_t)(row0 + ai * 128 + (2 * mp + mm) * 16) * 4 + g; const float fr_ = rp[0] * fast_rcp(rp[1]);
#pragma unroll
                    for (int bj = 0; bj < 2; ++bj)
#pragma unroll
                        for (int j = 0; j < 8; ++j) f[mm][bj][j] = fr_; }
            }
#pragma unroll
            for (int mm = 0; mm < 2; ++mm)
#pragma unroll
                for (int bj = 0; bj < 2; ++bj)
#pragma unroll
                    for (int e = 0; e < 4; ++e) { const int m = 2 * mp + mm;
                        asm volatile("v_mul_f32 %0, %0, %1" : "+v"(acc[ai][bj][m][0][e]) : "v"(f[mm][bj][e]));
                        asm volatile("v_mul_f32 %0, %0, %1" : "+v"(acc[ai][bj][m][1][e]) : "v"(f[mm][bj][4 + e])); }
            asm volatile("" ::: "memory");
          }
    }
    DI void unpack8(const u32x4 w, float (&g)[8]) const { g[0] = bf_lo(w.x); g[1] = bf_hi(w.x); g[2] = bf_lo(w.y); g[3] = bf_hi(w.y); g[4] = bf_lo(w.z); g[5] = bf_hi(w.z); g[6] = bf_lo(w.w); g[7] = bf_hi(w.w); }
    DI void operator()(const Acc& acc, const Unit& u, int wr, int wc, int fr, int fq) const {
        int row0 = u.pm * 256 + wr * 64 + fr, col0 = u.pn * 256 + wc * 32 + 8 * fq;
        asm volatile("" : "+v"(row0), "+v"(col0));
#pragma unroll
        for (int ai = 0; ai < 2; ++ai)
#pragma unroll
          for (int mp = 0; mp < 2; ++mp) {
            u32x4 gg[2][2]; float r3[2];
#pragma unroll
            for (int mm = 0; mm < 2; ++mm) { const int row = row0 + ai * 128 + (2 * mp + mm) * 16; r3[mm] = rstd[(size_t)row * 4 + 3]; const bf16_t* gp = gates + (size_t)row * 3072 + col0 + last_seg * 1024;
#pragma unroll
                for (int bj = 0; bj < 2; ++bj) gg[mm][bj] = *(const u32x4*)(gp + bj * 128); }
#pragma unroll
            for (int mm = 0; mm < 2; ++mm) { const int m = 2 * mp + mm; const int row = row0 + ai * 128 + m * 16; bf16_t* op = merged + (size_t)row * 1024 + col0;
#pragma unroll
                for (int bj = 0; bj < 2; ++bj) { float g[8]; unpack8(gg[mm][bj], g); const float s = (last_seg == 1) ? r3[mm] : 1.0f;
                    f32x4 v0 = acc[ai][bj][m][0], v1 = acc[ai][bj][m][1];
                    u32x4 w; w.x = pk2(v0[0] * g[0] * s, v0[1] * g[1] * s); w.y = pk2(v0[2] * g[2] * s, v0[3] * g[3] * s); w.z = pk2(v1[0] * g[4] * s, v1[1] * g[5] * s); w.w = pk2(v1[2] * g[6] * s, v1[3] * g[7] * s);
                    *(u32x4*)(op + bj * 128) = w; } }
            asm volatile("" ::: "memory");
          }
    }
};

struct EpiOut {
    static constexpr bool SEGMENTED = false;
    const float* x; float* out;
    DI void operator()(const Acc& acc, const Unit& u, int wr, int wc, int fr, int fq) const {
        const int row0 = u.pm * 256 + wr * 64 + fr, col0 = u.pn * 256 + wc * 32 + 8 * fq;
#pragma unroll
        for (int ai = 0; ai < 2; ++ai)
#pragma unroll
            for (int m = 0; m < 4; ++m) { const size_t off = (size_t)(row0 + ai * 128 + m * 16) * 1024 + col0;
#pragma unroll
                for (int bj = 0; bj < 2; ++bj) { const f32x4 x0 = *(const f32x4*)(x + off + bj * 128), x1 = *(const f32x4*)(x + off + bj * 128 + 4);
                    *(f32x4*)(out + off + bj * 128) = x0 + acc[ai][bj][m][0]; *(f32x4*)(out + off + bj * 128 + 4) = x1 + acc[ai][bj][m][1]; } }
    }
};

struct SchedMoE {
    int G, c, NC, tlo, thi; const LAS int* tstart; const LAS int* cnt; const int* tokl; const char* wbase; size_t wexp; int reps; unsigned rowb; unsigned ldbb;
    DI bool next(int i, Unit& u) const {
        const int n = (thi - tlo) * NC; int L = i * G + c; if (L >= n * reps) return false; L %= n;
        { const int q = n / 8, r = n % 8, xcd = L % 8, off = L / 8; L = (xcd < r ? xcd * (q + 1) : r * (q + 1) + (xcd - r) * q) + off; }
        const int rt = tlo + L / NC; u.pn = L % NC; u.pm = rt; int e = 0;
        for (int j = 1; j < NEXP; ++j) e += (tstart[j] <= rt) ? 1 : 0;
        u.aux = __builtin_amdgcn_readfirstlane(e); u.kind = 0; return true;
    }
    DI unsigned arow(const Unit& u, int r) const {
        if (tokl) { const int e = u.aux, idx = (u.pm - tstart[e]) * 256 + r; const int tok = idx < cnt[e] ? tokl[(size_t)e * T + idx] : 0; return (unsigned)tok * rowb; }
        return (unsigned)((u.pm - tlo) * 256 + r) * rowb;
    }
    DI const char* bptr(const Unit& u) const { return wbase + (size_t)u.aux * wexp + (size_t)u.pn * 256 * ldbb; }
};
struct EpiGU {
    static constexpr bool SEGMENTED = false;
    unsigned char* actm; const float *bg, *bu; int tlo;
    DI void operator()(const Acc& acc, const Unit& u, int wr, int wc, int fr, int fq) const {
        const int row0 = (u.pm - tlo) * 256 + wr * 64 + fr, col = u.pn * 128 + wc * 32 + 8 * fq; const size_t eb = (size_t)u.aux * 1024 + col;
        const f32x4 g0 = *(const f32x4*)(bg + eb), g1 = *(const f32x4*)(bg + eb + 4), u0 = *(const f32x4*)(bu + eb), u1 = *(const f32x4*)(bu + eb + 4);
#pragma unroll
        for (int ai = 0; ai < 2; ++ai)
#pragma unroll
            for (int m = 0; m < 4; ++m) { f32x4 a0 = acc[ai][0][m][0] + g0, a1 = acc[ai][0][m][1] + g1, b0 = acc[ai][1][m][0] + u0, b1 = acc[ai][1][m][1] + u1;
                for (int e = 0; e < 4; ++e) { float g = fminf(a0[e], 7.f), uu = fminf(fmaxf(b0[e], -7.f), 7.f); a0[e] = (uu + 1.f) * g * sigmoidf_(1.702f * g);
                                              g = fminf(a1[e], 7.f); uu = fminf(fmaxf(b1[e], -7.f), 7.f); a1[e] = (uu + 1.f) * g * sigmoidf_(1.702f * g); }
                u32x2 w; w.x = pk4_fp8(a0[0], a0[1], a0[2], a0[3]); w.y = pk4_fp8(a1[0], a1[1], a1[2], a1[3]);
                *(u32x2*)(actm + (size_t)(row0 + ai * 128 + m * 16) * 1024 + col) = w; }
    }
};
struct EpiDown {
    static constexpr bool SEGMENTED = false;
    bf16_t* y; const float* bd; int tlo;
    DI void operator()(const Acc& acc, const Unit& u, int wr, int wc, int fr, int fq) const {
        const int row0 = (u.pm - tlo) * 256 + wr * 64 + fr, col0 = u.pn * 256 + wc * 32 + 8 * fq; const float* bp = bd + (size_t)u.aux * 1024 + col0;
        f32x4 bv[2][2];
#pragma unroll
        for (int bj = 0; bj < 2; ++bj) { bv[bj][0] = *(const f32x4*)(bp + bj * 128); bv[bj][1] = *(const f32x4*)(bp + bj * 128 + 4); }
#pragma unroll
        for (int ai = 0; ai < 2; ++ai)
#pragma unroll
            for (int m = 0; m < 4; ++m) { bf16_t* rowp = y + (size_t)(row0 + ai * 128 + m * 16) * 1024 + col0;
#pragma unroll
                for (int bj = 0; bj < 2; ++bj) { const f32x4 v0 = acc[ai][bj][m][0] + bv[bj][0], v1 = acc[ai][bj][m][1] + bv[bj][1];
                    u32x4 w; w.x = pk2(v0[0], v0[1]); w.y = pk2(v0[2], v0[3]); w.z = pk2(v1[0], v1[1]); w.w = pk2(v1[2], v1[3]);
                    *(u32x4*)(rowp + bj * 128) = w; } }
    }
};
DI void transpose_item64(const float* W, int Ns, int k0, int sc0, int sc1, bf16_t* dst, int dpitch, const float* kscale, LAS float* scr, int lane) {
    const int cl = lane & 15, kl = lane >> 4, sc = (cl < 8) ? sc0 : sc1, col = sc + 4 * (cl & 7);
    f32x4 v[16];
#pragma unroll
    for (int i = 0; i < 16; ++i) { v[i] = (f32x4){0.f, 0.f, 0.f, 0.f}; if (sc >= 0) v[i] = *(const f32x4*)(W + (size_t)(k0 + 4 * i + kl) * Ns + col); }
#pragma unroll
    for (int i = 0; i < 16; ++i) { const int kk = 4 * i + kl; f32x4 x = v[i]; if (kscale) x *= kscale[k0 + kk]; LAS float* p = scr + kk * 65 + 4 * cl; p[0] = x[0]; p[1] = x[1]; p[2] = x[2]; p[3] = x[3]; }
    asm volatile("s_waitcnt lgkmcnt(0)" ::: "memory");
    const int c = lane & 7;
#pragma unroll
    for (int j = 0; j < 8; ++j) { const int n = (lane >> 3) + 8 * j; const LAS float* s = scr + (8 * c) * 65 + n;
        u32x4 o; o.x = pk2(s[0 * 65], s[1 * 65]); o.y = pk2(s[2 * 65], s[3 * 65]); o.z = pk2(s[4 * 65], s[5 * 65]); o.w = pk2(s[6 * 65], s[7 * 65]);
        *(u32x4*)(dst + (size_t)n * dpitch + 8 * c) = o; }
    asm volatile("s_waitcnt lgkmcnt(0)" ::: "memory");
}
DI int win_src_col(int nb) {
    const int tile = nb >> 3, sub = nb & 7;
    if (tile < TL_V) { const int base = tile < TL_K ? 256 * tile : 1024 + 256 * (tile - TL_K); return base + 32 * (2 * (sub & 3) + (sub >> 2)); }
    if (tile < TL_Z) return 2048 + 256 * (tile - TL_V) + 32 * sub;
    if (tile < TL_XBC) return 3072 + 256 * (tile - TL_Z) + 32 * sub;
    if (tile < TL_DT) return 5120 + 256 * (tile - TL_XBC) + 32 * sub;
    if (tile == TL_DT) return sub == 0 ? 8192 : -1;
    if (tile < TL_G) return 8224 + 256 * (tile - TL_QX) + 32 * sub;
    return 9248 + 256 * (tile - TL_G) + 32 * sub;
}
template <int NR> DI void rms_rows_to_bf16(const float* x, bf16_t* o, size_t row_stride, const float* gain, int lane) {
    f32x4 v[NR][4]; float s[NR];
#pragma unroll
    for (int r = 0; r < NR; ++r) { const f32x4* xr = (const f32x4*)(x + (size_t)r * row_stride * 1024) + lane; s[r] = 0.f;
#pragma unroll
        for (int j = 0; j < 4; ++j) { v[r][j] = xr[64 * j]; } }
#pragma unroll
    for (int r = 0; r < NR; ++r) {
#pragma unroll
        for (int j = 0; j < 4; ++j) s[r] += (v[r][j].x * v[r][j].x + v[r][j].y * v[r][j].y) + (v[r][j].z * v[r][j].z + v[r][j].w * v[r][j].w);
        s[r] = __builtin_amdgcn_rsqf(wave_sum(s[r]) * (1.f / 1024.f) + EPS); }
    const f32x4* gr = (const f32x4*)gain + lane;
#pragma unroll
    for (int j = 0; j < 4; ++j) { const f32x4 g = gr[64 * j];
#pragma unroll
        for (int r = 0; r < NR; ++r) { u32x2 w; w.x = pk2(v[r][j].x * s[r] * g.x, v[r][j].y * s[r] * g.y); w.y = pk2(v[r][j].z * s[r] * g.z, v[r][j].w * s[r] * g.w); ((u32x2*)(o + (size_t)r * row_stride * 1024) + lane)[64 * j] = w; } }
}


DI void transpose_item64_fp8(const float* W, int Ns, int k0, int sc0, int sc1, unsigned char* dst, int dpitch, float mul, LAS float* scr, int lane) {
    const int cl = lane & 15, kl = lane >> 4, sc = (cl < 8) ? sc0 : sc1, col = sc + 4 * (cl & 7);
    f32x4 v[16];
#pragma unroll
    for (int i = 0; i < 16; ++i) { v[i] = (f32x4){0.f, 0.f, 0.f, 0.f}; if (sc >= 0) v[i] = *(const f32x4*)(W + (size_t)(k0 + 4 * i + kl) * Ns + col); }
#pragma unroll
    for (int i = 0; i < 16; ++i) { const int kk = 4 * i + kl; const f32x4 x = v[i] * mul; LAS float* p = scr + kk * 65 + 4 * cl; p[0] = x[0]; p[1] = x[1]; p[2] = x[2]; p[3] = x[3]; }
    asm volatile("s_waitcnt lgkmcnt(0)" ::: "memory");
    const int c = lane & 3;
#pragma unroll
    for (int j = 0; j < 4; ++j) { const int n = (lane >> 2) + 16 * j; const LAS float* s = scr + (16 * c) * 65 + n;
        u32x4 o; o.x = pk4_fp8(s[0 * 65], s[1 * 65], s[2 * 65], s[3 * 65]); o.y = pk4_fp8(s[4 * 65], s[5 * 65], s[6 * 65], s[7 * 65]);
        o.z = pk4_fp8(s[8 * 65], s[9 * 65], s[10 * 65], s[11 * 65]); o.w = pk4_fp8(s[12 * 65], s[13 * 65], s[14 * 65], s[15 * 65]);
        *(u32x4*)(dst + (size_t)n * dpitch + 16 * c) = o; }
    asm volatile("s_waitcnt lgkmcnt(0)" ::: "memory");
}
template <int NR> DI void rms_rows_to_fp8(const float* x, unsigned char* o, const float* gain, int lane) {
    f32x4 v[NR][4]; float s[NR];
#pragma unroll
    for (int r = 0; r < NR; ++r) { const f32x4* xr = (const f32x4*)(x + (size_t)r * 1024) + lane; s[r] = 0.f;
#pragma unroll
        for (int j = 0; j < 4; ++j) { v[r][j] = xr[64 * j]; } }
#pragma unroll
    for (int r = 0; r < NR; ++r) {
#pragma unroll
        for (int j = 0; j < 4; ++j) s[r] += (v[r][j].x * v[r][j].x + v[r][j].y * v[r][j].y) + (v[r][j].z * v[r][j].z + v[r][j].w * v[r][j].w);
        s[r] = __builtin_amdgcn_rsqf(wave_sum(s[r]) * (1.f / 1024.f) + EPS); }
    const f32x4* gr = (const f32x4*)gain + lane;
#pragma unroll
    for (int j = 0; j < 4; ++j) { const f32x4 g = gr[64 * j];
#pragma unroll
        for (int r = 0; r < NR; ++r) ((unsigned*)(o + (size_t)r * 1024) + lane)[64 * j] = pk4_fp8(v[r][j].x * s[r] * g.x, v[r][j].y * s[r] * g.y, v[r][j].z * s[r] * g.z, v[r][j].w * s[r] * g.w); }
}

DI int crow(int r, int hi) { return (r & 3) + 8 * (r >> 2) + 4 * hi; }
DI s16x4 vtr(const LAS unsigned char* p) { return __builtin_bit_cast(s16x4, __builtin_amdgcn_ds_read_tr16_b64_v4i16((LAS v4i16_t*)p)); }
#define MFMA32(a, b, c) __builtin_amdgcn_mfma_f32_32x32x16_bf16((a), (b), (c), 0, 0, 0)
#define MFMA16(a, b, c) __builtin_amdgcn_mfma_f32_16x16x32_bf16((a), (b), (c), 0, 0, 0)
DI void tile_load(u32x4 (&r)[4], const bf16_t* g, size_t pitch, int tid) {
#pragma unroll
    for (int i = 0; i < 4; ++i) { const int q = tid + 512 * i, row = q >> 5, ch = q & 31; r[i] = *(const u32x4*)(g + (size_t)row * pitch + ch * 8); }
}
DI void tile_store_k(LAS unsigned char* dst, const u32x4 (&r)[4], int tid) {
#pragma unroll
    for (int i = 0; i < 4; ++i) { const int q = tid + 512 * i, row = q >> 5, ch = q & 31; *(LAS u32x4*)(dst + row * 512 + ((ch ^ (row & 15)) << 4)) = r[i]; }
}
DI void tile_store_v(LAS unsigned char* dst, const u32x4 (&r)[4], int tid) {
#pragma unroll
    for (int i = 0; i < 4; ++i) { const int q = tid + 512 * i, row = q >> 5, ch = q & 31; *(LAS u32x4*)(dst + row * 512 + ((((ch >> 2) ^ (row & 3)) * 4 + (ch & 3)) << 4)) = r[i]; }
}
constexpr int AT_K = 0, AT_V = 32768, AT_BIAS = 65536, AT_BIAS_STRIDE = 260;

DI float softmax_tile(f32x16& s0, f32x16& s1, float& m, float& l, bf16x8 (&pa)[4]) {
    float mx = fmaxf(s0[0], s1[0]);
#pragma unroll
    for (int r = 1; r < 16; ++r) mx = fmaxf(mx, fmaxf(s0[r], s1[r]));
    mx = fmaxf(mx, __shfl_xor(mx, 32));
    const float mn = fmaxf(m, mx), alpha = fast_exp2(m - mn);
    float sum = 0.f;
#pragma unroll
    for (int r = 0; r < 16; ++r) { s0[r] = fast_exp2(s0[r] - mn); s1[r] = fast_exp2(s1[r] - mn); sum += s0[r] + s1[r]; }
    l = l * alpha + sum; m = mn;
    u32x4 w;
    w.x = pk2(s0[0], s0[1]); w.y = pk2(s0[2], s0[3]); w.z = pk2(s0[4], s0[5]); w.w = pk2(s0[6], s0[7]); pa[0] = __builtin_bit_cast(bf16x8, w);
    w.x = pk2(s0[8], s0[9]); w.y = pk2(s0[10], s0[11]); w.z = pk2(s0[12], s0[13]); w.w = pk2(s0[14], s0[15]); pa[1] = __builtin_bit_cast(bf16x8, w);
    w.x = pk2(s1[0], s1[1]); w.y = pk2(s1[2], s1[3]); w.z = pk2(s1[4], s1[5]); w.w = pk2(s1[6], s1[7]); pa[2] = __builtin_bit_cast(bf16x8, w);
    w.x = pk2(s1[8], s1[9]); w.y = pk2(s1[10], s1[11]); w.z = pk2(s1[12], s1[13]); w.w = pk2(s1[14], s1[15]); pa[3] = __builtin_bit_cast(bf16x8, w);
    return alpha;
}
DI bf16x8 v_frag(const LAS unsigned char* vt, int s, int colbyte0, int lane) {
    const int hi = lane >> 5, q_ = (lane & 15) >> 2, p_ = lane & 3, blk = (lane >> 4) & 1;
    const int cb = colbyte0 + blk * 32 + p_ * 8, u = cb >> 6, within = cb & 63;
    const int R = 16 * s + 4 * hi + q_;
    const s16x4 lo = vtr(vt + R * 512 + ((u ^ q_) << 6) + within);
    const s16x4 h4 = vtr(vt + (R + 8) * 512 + ((u ^ q_) << 6) + within);
    return __builtin_shufflevector(lo, h4, 0, 1, 2, 3, 4, 5, 6, 7);
}

DI void attnA_unit(LAS unsigned char* lds, int b, int c, int hq, bf16_t* act, const bf16_t* ka, const bf16_t* va, bf16_t* outp, size_t opitch) {
    const int tid = threadIdx.x, lane = tid & 63, wid = __builtin_amdgcn_readfirstlane(tid >> 6), hl = wid >> 1, qh = wid & 1, head = 4 * hq + hl, l31 = lane & 31, hi = lane >> 5;
    const size_t trow = (size_t)b * SEQ + 64 * c + 32 * qh + l31;
    bf16_t* qp = act + trow * ACT_P + 64 * head;
    bf16x8 qf[4];
#pragma unroll
    for (int d0 = 0; d0 < 4; ++d0) qf[d0] = *(const bf16x8*)(qp + 16 * d0 + 8 * hi);
    f32x16 o0, o1;
#pragma unroll
    for (int r = 0; r < 16; ++r) { o0[r] = 0.f; o1[r] = 0.f; }
    float m = -1e30f, l = 0.f;
    const int kc0 = c < 8 ? 0 : c - 8;
    const LAS float* bias = (const LAS float*)(lds + AT_BIAS) + head * AT_BIAS_STRIDE;
    const float b256 = bias[256];
    u32x4 rk[4], rv[4];
    const bf16_t* kb = ka + ((size_t)b * SEQ + 64 * kc0) * 1024 + 256 * hq; const bf16_t* vb = va + ((size_t)b * SEQ + 64 * kc0) * 1024 + 256 * hq;
    tile_load(rk, kb, 1024, tid); tile_load(rv, vb, 1024, tid);
    const int qi = 32 * qh + l31;
    for (int kc = kc0; kc <= c; ++kc) {
        __syncthreads();
        tile_store_k(lds + AT_K, rk, tid); tile_store_v(lds + AT_V, rv, tid);
        if (kc < c) { kb += 64 * 1024; vb += 64 * 1024; tile_load(rk, kb, 1024, tid); tile_load(rv, vb, 1024, tid); }
        __syncthreads();
        const int j = c - kc;
        f32x16 s0, s1;
        if (j >= 3) {
#pragma unroll
            for (int r = 0; r < 16; ++r) { s0[r] = b256; s1[r] = b256; }
        } else {
#pragma unroll
            for (int r = 0; r < 16; ++r) { const int rel0 = 64 * j + qi - crow(r, hi); s0[r] = bias[min(rel0, 128) + 128]; s1[r] = bias[min(rel0 - 32, 128) + 128]; }
        }
#pragma unroll
        for (int d0 = 0; d0 < 4; ++d0) {
            const int ch = 8 * hl + 2 * d0 + hi;
            const bf16x8 k0 = *(const LAS bf16x8*)(lds + AT_K + l31 * 512 + ((ch ^ (l31 & 15)) << 4));
            const bf16x8 k1 = *(const LAS bf16x8*)(lds + AT_K + (32 + l31) * 512 + ((ch ^ (l31 & 15)) << 4));
            s0 = MFMA32(k0, qf[d0], s0); s1 = MFMA32(k1, qf[d0], s1);
        }
        bf16x8 pa[4];
        const float alpha = softmax_tile(s0, s1, m, l, pa);
#pragma unroll
        for (int r = 0; r < 16; ++r) { o0[r] *= alpha; o1[r] *= alpha; }
#pragma unroll
        for (int s = 0; s < 4; ++s) {
            const bf16x8 v0 = v_frag(lds + AT_V, s, (64 * hl) * 2, lane), v1 = v_frag(lds + AT_V, s, (64 * hl + 32) * 2, lane);
            o0 = MFMA32(v0, pa[s], o0); o1 = MFMA32(v1, pa[s], o1);
        }
    }
    const float lt = l + __shfl_xor(l, 32), inv = fast_rcp(lt);
#pragma unroll
    for (int rg = 0; rg < 4; ++rg) {
        u32x2 w0, w1; w0.x = pk2(o0[4 * rg] * inv, o0[4 * rg + 1] * inv); w0.y = pk2(o0[4 * rg + 2] * inv, o0[4 * rg + 3] * inv);
        w1.x = pk2(o1[4 * rg] * inv, o1[4 * rg + 1] * inv); w1.y = pk2(o1[4 * rg + 2] * inv, o1[4 * rg + 3] * inv);
        bf16_t* op = outp + trow * opitch + 64 * head; *(u32x2*)(op + 8 * rg + 4 * hi) = w0; *(u32x2*)(op + 32 + 8 * rg + 4 * hi) = w1;
    }
}

DI void attnC_unit(LAS unsigned char* lds, int b, int hx, int rb, bf16_t* act, const bf16_t* kx, const bf16_t* memkv, bf16_t* outp, size_t opitch) {
    const int tid = threadIdx.x, lane = tid & 63, wid = __builtin_amdgcn_readfirstlane(tid >> 6), rg = wid >> 1, dh = wid & 1, l31 = lane & 31, hi = lane >> 5;
    const size_t trow = (size_t)b * SEQ + 128 * rb + 32 * rg + l31;
    bf16_t* qp = act + trow * ACT_P + 3072 + 256 * hx;
    float ssq = 0.f;
#pragma unroll
    for (int d0 = 0; d0 < 16; ++d0) { const bf16x8 q = *(const bf16x8*)(qp + 16 * d0 + 8 * hi);
#pragma unroll
        for (int e = 0; e < 8; ++e) { const float v = bf2f((bf16_t)q[e]); ssq += v * v; } }
    ssq += __shfl_xor(ssq, 32);
    const float rstd = __builtin_amdgcn_rsqf(ssq * (1.f / 256.f) + EPS);
    f32x16 o[4];
#pragma unroll
    for (int i = 0; i < 4; ++i)
#pragma unroll
        for (int r = 0; r < 16; ++r) o[i][r] = 0.f;
    float m = -1e30f, l = 0.f;
    for (int j = 0; j < 4; ++j) {
        u32x4 rk[4], rv[4];
        tile_load(rk, kx + ((size_t)b * MEMLEN + 64 * j) * 1024 + 256 * hx, 1024, tid);
        tile_load(rv, memkv + ((size_t)b * MEMLEN + 64 * j) * 2048 + 1024 + 256 * hx, 2048, tid);
        __syncthreads();
        tile_store_k(lds + AT_K, rk, tid); tile_store_v(lds + AT_V, rv, tid);
        __syncthreads();
        f32x16 s0, s1;
#pragma unroll
        for (int r = 0; r < 16; ++r) { s0[r] = 0.f; s1[r] = 0.f; }
#pragma unroll
        for (int d0 = 0; d0 < 16; ++d0) {
            const int ch = 2 * d0 + hi;
            const bf16x8 qfr = *(const bf16x8*)(qp + 16 * d0 + 8 * hi);
            const bf16x8 k0 = *(const LAS bf16x8*)(lds + AT_K + l31 * 512 + ((ch ^ (l31 & 15)) << 4));
            const bf16x8 k1 = *(const LAS bf16x8*)(lds + AT_K + (32 + l31) * 512 + ((ch ^ (l31 & 15)) << 4));
            s0 = MFMA32(k0, qfr, s0); s1 = MFMA32(k1, qfr, s1);
        }
#pragma unroll
        for (int r = 0; r < 16; ++r) { s0[r] *= rstd; s1[r] *= rstd; }
        bf16x8 pa[4];
        const float alpha = softmax_tile(s0, s1, m, l, pa);
#pragma unroll
        for (int i = 0; i < 4; ++i)
#pragma unroll
            for (int r = 0; r < 16; ++r) o[i][r] *= alpha;
#pragma unroll
        for (int s = 0; s < 4; ++s)
#pragma unroll
            for (int i = 0; i < 4; ++i) { const bf16x8 vf = v_frag(lds + AT_V, s, (128 * dh + 32 * i) * 2, lane); o[i] = MFMA32(vf, pa[s], o[i]); }
    }
    const float lt = l + __shfl_xor(l, 32), inv = fast_rcp(lt);
    __syncthreads();
#pragma unroll
    for (int i = 0; i < 4; ++i)
#pragma unroll
        for (int g4 = 0; g4 < 4; ++g4) { u32x2 w; w.x = pk2(o[i][4 * g4] * inv, o[i][4 * g4 + 1] * inv); w.y = pk2(o[i][4 * g4 + 2] * inv, o[i][4 * g4 + 3] * inv);
            *(u32x2*)(outp + trow * opitch + 256 * hx + 128 * dh + 32 * i + 8 * g4 + 4 * hi) = w; }
}

constexpr int MB_XDT = 0, MB_XDTW = 9216, MB_BM = 18432, MB_CM = 35840, MB_YD = 53248, MB_YO = 70656, MB_ACS = 88064, MB_YSTR = 272;
DI int mb_b256(int row, int col) { return row * 272 + col * 2; }
DI int mb_b128(int row, int col) { return row * 144 + col * 2; }
template <bool W256> DI bf16x8 tr_pair(const LAS unsigned char* base, int row_lo, int row_hi, int col0, int lane) {
    const int i = lane & 15, r = i >> 2, c = col0 + 4 * (i & 3);
    const s16x4 lo = vtr(base + (W256 ? mb_b256(row_lo + r, c) : mb_b128(row_lo + r, c))), h4 = vtr(base + (W256 ? mb_b256(row_hi + r, c) : mb_b128(row_hi + r, c)));
    return __builtin_shufflevector(lo, h4, 0, 1, 2, 3, 4, 5, 6, 7);
}
DI void bcconv_phase(int vcu, int G, const bf16_t* xbc, bf16_t* bc, const float* conv_w, const float* conv_b, const float* dtp, float* acsp, const float* a_log) {
    {
        const int lane = threadIdx.x & 63, wv = threadIdx.x >> 6;
        for (int ck = vcu * 8 + wv; ck < T / 64; ck += G * 8) {
            const float* dr = dtp + ((size_t)ck * 64 + lane) * 32; float* orow = acsp + ((size_t)ck * 64 + lane) * 32;
#pragma unroll
            for (int q = 0; q < 8; ++q) { f32x4 v = *(const f32x4*)(dr + 4 * q); const f32x4 al = *(const f32x4*)(a_log + 4 * q);
#pragma unroll
                for (int e = 0; e < 4; ++e) { float a = -v[e] * __expf(al[e]);
#pragma unroll
                    for (int o = 1; o < 64; o <<= 1) { const float u = __shfl_up(a, o); if (lane >= o) a += u; }
                    v[e] = a; }
                *(f32x4*)(orow + 4 * q) = v; }
        }
    }
    for (int task = vcu * 512 + threadIdx.x; task < (T / 16) * 128; task += G * 512) {
        const int cc = task & 127, run = task >> 7, g = cc >> 5, w = cc & 31;
        const int scol = (w < 16 ? 2048 + 128 * g + 8 * w : 2560 + 128 * g + 8 * (w - 16));
        const int t0 = run * 16, pos0 = t0 & (SEQ - 1);
        float cw[4][8], cb[8];
#pragma unroll
        for (int e = 0; e < 8; ++e) { cb[e] = conv_b[scol + e];
#pragma unroll
            for (int i = 0; i < 4; ++i) cw[i][e] = conv_w[i * 3072 + scol + e]; }
        float win[3][8];
#pragma unroll
        for (int k = 0; k < 3; ++k) { u32x4 wv = (u32x4){0u, 0u, 0u, 0u}; if (pos0 + k - 3 >= 0) wv = *(const u32x4*)(xbc + (size_t)(t0 + k - 3) * 3072 + scol);
            win[k][0] = bf_lo(wv.x); win[k][1] = bf_hi(wv.x); win[k][2] = bf_lo(wv.y); win[k][3] = bf_hi(wv.y); win[k][4] = bf_lo(wv.z); win[k][5] = bf_hi(wv.z); win[k][6] = bf_lo(wv.w); win[k][7] = bf_hi(wv.w); }
#pragma unroll 4
        for (int k = 0; k < 16; ++k) {
            const u32x4 wv = *(const u32x4*)(xbc + (size_t)(t0 + k) * 3072 + scol);
            const float cur[8] = {bf_lo(wv.x), bf_hi(wv.x), bf_lo(wv.y), bf_hi(wv.y), bf_lo(wv.z), bf_hi(wv.z), bf_lo(wv.w), bf_hi(wv.w)};
            float o[8];
#pragma unroll
            for (int e = 0; e < 8; ++e) { o[e] = silu_(cb[e] + cw[0][e] * win[0][e] + cw[1][e] * win[1][e] + cw[2][e] * win[2][e] + cw[3][e] * cur[e]); win[0][e] = win[1][e]; win[1][e] = win[2][e]; win[2][e] = cur[e]; }
            u32x4 ov; ov.x = pk2(o[0], o[1]); ov.y = pk2(o[2], o[3]); ov.z = pk2(o[4], o[5]); ov.w = pk2(o[6], o[7]);
            *(u32x4*)(bc + (size_t)(t0 + k) * 1024 + 8 * cc) = ov;
        }
    }
}
DI void mamba_unit(LAS unsigned char* lds, int b, int h, const bf16_t* xbc, const bf16_t* bc, const float* dtp, const float* acsp, bf16_t* act, float* ssq_out, bf16_t* outp, size_t opitch,
                   const float* conv_w, const float* conv_b, const float* a_log, const float* d_skip) {
    const int tid = threadIdx.x, lane = tid & 63, wid = __builtin_amdgcn_readfirstlane(tid >> 6), fr = lane & 15, fq = lane >> 4, g = h >> 3;
    const float A_h = -__expf(a_log[h]), D_h = d_skip[h];
    const int l = tid >> 3, pc = tid & 7, xcol = 64 * h + 8 * pc;
    float cw[4][8], cbias[8];
#pragma unroll
    for (int e = 0; e < 8; ++e) { cbias[e] = conv_b[xcol + e];
#pragma unroll
        for (int i = 0; i < 4; ++i) cw[i][e] = conv_w[i * 3072 + xcol + e]; }
    f32x4 Z[8];
#pragma unroll
    for (int i = 0; i < 8; ++i) Z[i] = (f32x4){0.f, 0.f, 0.f, 0.f};
    LAS float* acs = (LAS float*)(lds + MB_ACS);
    const int frow0 = tid >> 4, fch = tid & 15;
    u32x4 xr[4], bcr[4]; float dt_l, acs_l, acs63;
    const size_t tb = (size_t)b * SEQ;
#define MB_LOAD(c_) do { const int p0_ = 64 * (c_); \
        _Pragma("unroll") for (int i_ = 0; i_ < 4; ++i_) { const int pos_ = p0_ + l - 3 + i_; xr[i_] = (u32x4){0u, 0u, 0u, 0u}; if (pos_ >= 0) xr[i_] = *(const u32x4*)(xbc + (tb + pos_) * 3072 + xcol); } \
        _Pragma("unroll") for (int i_ = 0; i_ < 4; ++i_) bcr[i_] = *(const u32x4*)(bc + (tb + p0_ + frow0 + 32 * (i_ & 1)) * 1024 + 256 * g + 128 * (i_ >> 1) + 8 * fch); \
        dt_l = dtp[(tb + p0_ + l) * 32 + h]; acs_l = acsp[(tb + p0_ + l) * 32 + h]; acs63 = acsp[(tb + p0_ + 63) * 32 + h]; } while (0)
    MB_LOAD(0);
    for (int c = 0; c < 64; ++c) {
        const size_t t0 = tb + 64 * c;
        if (pc == 0) acs[l] = acs_l;
        float xs[8];
        { float r[4][8];
#pragma unroll
          for (int i = 0; i < 4; ++i) { r[i][0] = bf_lo(xr[i].x); r[i][1] = bf_hi(xr[i].x); r[i][2] = bf_lo(xr[i].y); r[i][3] = bf_hi(xr[i].y); r[i][4] = bf_lo(xr[i].z); r[i][5] = bf_hi(xr[i].z); r[i][6] = bf_lo(xr[i].w); r[i][7] = bf_hi(xr[i].w); }
#pragma unroll
          for (int e = 0; e < 8; ++e) xs[e] = silu_(cbias[e] + cw[0][e] * r[0][e] + cw[1][e] * r[1][e] + cw[2][e] * r[2][e] + cw[3][e] * r[3][e]); }
        { const float d = dt_l, dw = d * __expf(acs63 - acs_l);
          u32x4 av, bw; av.x = pk2(xs[0] * d, xs[1] * d); av.y = pk2(xs[2] * d, xs[3] * d); av.z = pk2(xs[4] * d, xs[5] * d); av.w = pk2(xs[6] * d, xs[7] * d);
          bw.x = pk2(xs[0] * dw, xs[1] * dw); bw.y = pk2(xs[2] * dw, xs[3] * dw); bw.z = pk2(xs[4] * dw, xs[5] * dw); bw.w = pk2(xs[6] * dw, xs[7] * dw);
          *(LAS u32x4*)(lds + MB_XDT + mb_b128(l, 8 * pc)) = av; *(LAS u32x4*)(lds + MB_XDTW + mb_b128(l, 8 * pc)) = bw; }
#pragma unroll
        for (int i = 0; i < 4; ++i) *(LAS u32x4*)(lds + (i < 2 ? MB_BM : MB_CM) + mb_b256(frow0 + 32 * (i & 1), 8 * fch)) = bcr[i];
        const u32x4 zw = *(const u32x4*)(act + (t0 + l) * ACT_P + 1024 + 64 * h + 8 * pc);
        { const int cn = c < 63 ? c + 1 : 63; MB_LOAD(cn); }
        __syncthreads();
        if (wid >= 4) {
            const int d = wid - 4; const float la = acs[16 * d + fr];
            f32x4 X[4];
            bf16x8 cf[4];
#pragma unroll
            for (int ks = 0; ks < 4; ++ks) cf[ks] = *(const LAS bf16x8*)(lds + MB_CM + mb_b256(16 * d + fr, 32 * ks + 8 * fq));
#pragma unroll
            for (int si = 0; si < 4; ++si) { X[si] = (f32x4){0.f, 0.f, 0.f, 0.f};
                if (si <= d) {
                    bf16x8 af[4];
#pragma unroll
                    for (int ks = 0; ks < 4; ++ks) af[ks] = *(const LAS bf16x8*)(lds + MB_BM + mb_b256(16 * si + fr, 32 * ks + 8 * fq));
#pragma unroll
                    for (int ks = 0; ks < 4; ++ks) X[si] = MFMA16(af[ks], cf[ks], X[si]);
                    const f32x4 sa = *(const LAS f32x4*)(acs + 16 * si + 4 * fq);
#pragma unroll
                    for (int r = 0; r < 4; ++r) { const int s_abs = 16 * si + 4 * fq + r, l_abs = 16 * d + fr; X[si][r] = (s_abs <= l_abs) ? X[si][r] * __expf(la - sa[r]) : 0.f; }
                } }
            bf16x8 Xp[2];
#pragma unroll
            for (int sb = 0; sb < 2; ++sb) { u32x4 w; w.x = pk2(X[2 * sb][0], X[2 * sb][1]); w.y = pk2(X[2 * sb][2], X[2 * sb][3]); w.z = pk2(X[2 * sb + 1][0], X[2 * sb + 1][1]); w.w = pk2(X[2 * sb + 1][2], X[2 * sb + 1][3]); Xp[sb] = __builtin_bit_cast(bf16x8, w); }
            bf16x8 xa[4][2];
#pragma unroll
            for (int pt = 0; pt < 4; ++pt)
#pragma unroll
                for (int sb = 0; sb < 2; ++sb) if (2 * sb <= d) xa[pt][sb] = tr_pair<false>(lds + MB_XDT, 32 * sb + 4 * fq, 32 * sb + 16 + 4 * fq, 16 * pt, lane);
#pragma unroll
            for (int pt = 0; pt < 4; ++pt) { f32x4 y = (f32x4){0.f, 0.f, 0.f, 0.f};
#pragma unroll
                for (int sb = 0; sb < 2; ++sb) { if (2 * sb <= d) y = MFMA16(xa[pt][sb], Xp[sb], y); }
                *(LAS f32x4*)(lds + MB_YD + (16 * d + fr) * MB_YSTR + (16 * pt + 4 * fq) * 4) = y; }
        } else {
            const int pw = wid;
            bf16x8 Zp[4];
#pragma unroll
            for (int nb = 0; nb < 4; ++nb) { u32x4 w; w.x = pk2(Z[2 * nb][0], Z[2 * nb][1]); w.y = pk2(Z[2 * nb][2], Z[2 * nb][3]); w.z = pk2(Z[2 * nb + 1][0], Z[2 * nb + 1][1]); w.w = pk2(Z[2 * nb + 1][2], Z[2 * nb + 1][3]); Zp[nb] = __builtin_bit_cast(bf16x8, w); }
#pragma unroll
            for (int lt = 0; lt < 4; ++lt) { f32x4 y = (f32x4){0.f, 0.f, 0.f, 0.f};
                bf16x8 bfr[4];
#pragma unroll
                for (int nb = 0; nb < 4; ++nb) { const s16x4 lo = *(const LAS s16x4*)(lds + MB_CM + mb_b256(16 * lt + fr, 32 * nb + 4 * fq)), h4 = *(const LAS s16x4*)(lds + MB_CM + mb_b256(16 * lt + fr, 32 * nb + 16 + 4 * fq));
                    bfr[nb] = __builtin_shufflevector(lo, h4, 0, 1, 2, 3, 4, 5, 6, 7); }
#pragma unroll
                for (int nb = 0; nb < 4; ++nb) y = MFMA16(Zp[nb], bfr[nb], y);
                const float ea = __expf(acs[16 * lt + fr]); y *= ea;
                *(LAS f32x4*)(lds + MB_YO + (16 * lt + fr) * MB_YSTR + (16 * pw + 4 * fq) * 4) = y; }
            const float dec = __expf(acs[63]);
            bf16x8 xw[2];
#pragma unroll
            for (int lb = 0; lb < 2; ++lb) xw[lb] = tr_pair<false>(lds + MB_XDTW, 32 * lb + 8 * fq, 32 * lb + 8 * fq + 4, 16 * pw, lane);
#pragma unroll
            for (int np = 0; np < 4; ++np) { bf16x8 av[2][2];
#pragma unroll
                for (int q = 0; q < 2; ++q)
#pragma unroll
                    for (int lb = 0; lb < 2; ++lb) av[q][lb] = tr_pair<true>(lds + MB_BM, 32 * lb + 8 * fq, 32 * lb + 8 * fq + 4, 16 * (2 * np + q), lane);
#pragma unroll
                for (int q = 0; q < 2; ++q) { Z[2 * np + q] *= dec;
#pragma unroll
                    for (int lb = 0; lb < 2; ++lb) Z[2 * np + q] = MFMA16(av[q][lb], xw[lb], Z[2 * np + q]); } }
        }
        __syncthreads();
        { const f32x4 a0 = *(const LAS f32x4*)(lds + MB_YD + l * MB_YSTR + pc * 32), a1 = *(const LAS f32x4*)(lds + MB_YD + l * MB_YSTR + pc * 32 + 16);
          const f32x4 b0 = *(const LAS f32x4*)(lds + MB_YO + l * MB_YSTR + pc * 32), b1 = *(const LAS f32x4*)(lds + MB_YO + l * MB_YSTR + pc * 32 + 16);
          float y[8];
          y[0] = (a0[0] + b0[0] + D_h * xs[0]) * bf_lo(zw.x); y[1] = (a0[1] + b0[1] + D_h * xs[1]) * bf_hi(zw.x);
          y[2] = (a0[2] + b0[2] + D_h * xs[2]) * bf_lo(zw.y); y[3] = (a0[3] + b0[3] + D_h * xs[3]) * bf_hi(zw.y);
          y[4] = (a1[0] + b1[0] + D_h * xs[4]) * bf_lo(zw.z); y[5] = (a1[1] + b1[1] + D_h * xs[5]) * bf_hi(zw.z);
          y[6] = (a1[2] + b1[2] + D_h * xs[6]) * bf_lo(zw.w); y[7] = (a1[3] + b1[3] + D_h * xs[7]) * bf_hi(zw.w);
          float ss = 0.f;
#pragma unroll
          for (int e = 0; e < 8; ++e) ss += y[e] * y[e];
          ss += __shfl_xor(ss, 1); ss += __shfl_xor(ss, 2); ss += __shfl_xor(ss, 4);
          if (pc == 0) ssq_out[(t0 + l) * 32 + h] = ss;
          u32x4 w; w.x = pk2(y[0], y[1]); w.y = pk2(y[2], y[3]); w.z = pk2(y[4], y[5]); w.w = pk2(y[6], y[7]); *(u32x4*)(outp + (t0 + l) * opitch + 64 * h + 8 * pc) = w; }
    }
#undef MB_LOAD
    __syncthreads();
}
constexpr int RT_W = 0, RT_CNT = 131072, RT_BASE = 131072 + 128;
constexpr int MO_TS = 131072 + 256, MO_CNT = 131072 + 512;

DI void router_phase(LAS unsigned char* lds, int vcu, int G, const float* x1, const float* norm_ffn, const float* w_router, const float* b_router,
                     unsigned char* h2, int* sel_e, int* sel_r, float* sel_w, int* tokl, unsigned* gcnt) {
    const int tid = threadIdx.x, lane = tid & 63, wid = __builtin_amdgcn_readfirstlane(tid >> 6), l31 = lane & 31, hi = lane >> 5;
    LAS float* Wl = (LAS float*)(lds + RT_W); LAS unsigned* lcnt = (LAS unsigned*)(lds + RT_CNT); LAS unsigned* lbase = (LAS unsigned*)(lds + RT_BASE);
    for (int idx = tid; idx < 1024 * 8; idx += 512) { const f32x4 w = *(const f32x4*)(w_router + 4 * idx); const float gk = norm_ffn[idx >> 3]; LAS float* p = Wl + 4 * idx; p[0] = w[0] * gk; p[1] = w[1] * gk; p[2] = w[2] * gk; p[3] = w[3] * gk; }
    if (tid < 32) lcnt[tid] = 0u;
    __syncthreads();
    if (wid >= 4) {
        for (int m = (vcu * 4 + (wid - 4)) * 4; m < T; m += G * 16) rms_rows_to_fp8<4>(x1 + (size_t)m * 1024, h2 + (size_t)m * 1024, norm_ffn, lane);
    } else
    for (int tile = vcu + G * wid; tile < T / 32; tile += G * 4) {
        const int t0 = tile * 32;
        f32x16 acc;
#pragma unroll
        for (int r = 0; r < 16; ++r) acc[r] = 0.f;
        float ssq = 0.f;
        const float* xr = x1 + (size_t)(t0 + l31) * 1024 + 4 * hi;
#pragma unroll 4
        for (int c = 0; c < 128; ++c) {
            const f32x4 xv = *(const f32x4*)(xr + 8 * c);
            ssq += (xv[0] * xv[0] + xv[1] * xv[1]) + (xv[2] * xv[2] + xv[3] * xv[3]);
#pragma unroll
            for (int u = 0; u < 4; ++u) { const float a = Wl[(8 * c + 4 * hi + u) * 32 + l31]; acc = __builtin_amdgcn_mfma_f32_32x32x2f32(a, xv[u], acc, 0, 0, 0); }
        }
        ssq += __shfl_xor(ssq, 32);
        const float rstd = __builtin_amdgcn_rsqf(ssq * (1.f / 1024.f) + EPS);
        float lg[16];
#pragma unroll
        for (int r = 0; r < 16; ++r) lg[r] = acc[r] * rstd + b_router[crow(r, hi)];
        float sv[4]; int si[4];
#pragma unroll
        for (int k = 0; k < 4; ++k) {
            float bv = lg[0]; int bi = crow(0, hi);
#pragma unroll
            for (int r = 1; r < 16; ++r) { const int id = crow(r, hi); if (lg[r] > bv) { bv = lg[r]; bi = id; } }
            const float pv = __shfl_xor(bv, 32); const int pi = __shfl_xor(bi, 32);
            if (pv > bv || (pv == bv && pi < bi)) { bv = pv; bi = pi; }
            sv[k] = bv; si[k] = bi;
#pragma unroll
            for (int r = 0; r < 16; ++r) if (crow(r, hi) == bi) lg[r] = -INFINITY;
        }
        const float e1 = __expf(sv[1] - sv[0]), e2 = __expf(sv[2] - sv[0]), e3 = __expf(sv[3] - sv[0]), inv = 1.0f / (1.0f + e1 + e2 + e3);
        if (hi == 0) {
            const int t = t0 + l31; const float wv[4] = {inv, e1 * inv, e2 * inv, e3 * inv};
#pragma unroll
            for (int k = 0; k < 4; ++k) { const unsigned lr = atomicAdd((unsigned*)&lcnt[si[k]], 1u); sel_e[t * 4 + k] = si[k]; sel_r[t * 4 + k] = (int)lr; sel_w[t * 4 + k] = wv[k]; }
        }
    }
    __syncthreads();
    if (tid < 32) lbase[tid] = atomicAdd(&gcnt[tid], lcnt[tid]);
    __syncthreads();
    if (wid < 4) for (int tile = vcu + G * wid; tile < T / 32; tile += G * 4) {
        if (hi == 0) { const int t = tile * 32 + l31;
#pragma unroll
            for (int k = 0; k < 4; ++k) { const int e = sel_e[t * 4 + k]; const int r = sel_r[t * 4 + k] + (int)lbase[e]; sel_r[t * 4 + k] = r; tokl[(size_t)e * T + r] = t; } }
    }
}

DI int moe_tables(LAS unsigned char* lds, const unsigned* gcnt) {
    LAS int* ts = (LAS int*)(lds + MO_TS); LAS int* cn = (LAS int*)(lds + MO_CNT);
    __syncthreads();
    if (threadIdx.x < 32) cn[threadIdx.x] = (int)gcnt[threadIdx.x];
    __syncthreads();
    if (threadIdx.x == 0) { int s = 0; for (int e = 0; e < NEXP; ++e) { ts[e] = s; s += (cn[e] + 255) >> 8; } ts[NEXP] = s; }
    __syncthreads();
    return ts[NEXP];
}

DI void combine_phase(LAS unsigned char* lds, int vcu, int G, int tlo, int thi, const bf16_t* y, const int* sel_e, const int* sel_r, const float* sel_w, float* out, float wscale) {
    const int lane = threadIdx.x & 63, wid = threadIdx.x >> 6; const LAS int* ts = (const LAS int*)(lds + MO_TS);
    for (int tb = (vcu * 8 + wid) * 4; tb < T; tb += G * 32) {
        int rowi[4][4]; float wv[4][4];
#pragma unroll
        for (int q = 0; q < 4; ++q) { const int4 e4 = *(const int4*)(sel_e + (tb + q) * 4), r4 = *(const int4*)(sel_r + (tb + q) * 4); const f32x4 w4 = *(const f32x4*)(sel_w + (tb + q) * 4);
            const int ee[4] = {e4.x, e4.y, e4.z, e4.w}, rr[4] = {r4.x, r4.y, r4.z, r4.w};
#pragma unroll
            for (int k = 0; k < 4; ++k) { const int row = ts[ee[k]] * 256 + rr[k], tile = row >> 8; const bool in = tile >= tlo && tile < thi; rowi[q][k] = in ? row - tlo * 256 : -1; wv[q][k] = w4[k] * wscale; } }
#pragma unroll
        for (int q = 0; q < 4; ++q) {
            float* op = out + (size_t)(tb + q) * 1024 + 8 * lane;
            f32x4 a0 = *(const f32x4*)op, a1 = *(const f32x4*)(op + 4), a2 = *(const f32x4*)(op + 512), a3 = *(const f32x4*)(op + 516);
            u32x4 v0[4], v1[4];
#pragma unroll
            for (int k = 0; k < 4; ++k) { v0[k] = (u32x4){0u, 0u, 0u, 0u}; v1[k] = v0[k]; if (rowi[q][k] >= 0) { const bf16_t* yp = y + (size_t)rowi[q][k] * 1024 + 8 * lane; v0[k] = *(const u32x4*)yp; v1[k] = *(const u32x4*)(yp + 512); } }
#pragma unroll
            for (int k = 0; k < 4; ++k) { const float w = wv[q][k];
                a0[0] += w * bf_lo(v0[k].x); a0[1] += w * bf_hi(v0[k].x); a0[2] += w * bf_lo(v0[k].y); a0[3] += w * bf_hi(v0[k].y);
                a1[0] += w * bf_lo(v0[k].z); a1[1] += w * bf_hi(v0[k].z); a1[2] += w * bf_lo(v0[k].w); a1[3] += w * bf_hi(v0[k].w);
                a2[0] += w * bf_lo(v1[k].x); a2[1] += w * bf_hi(v1[k].x); a2[2] += w * bf_lo(v1[k].y); a2[3] += w * bf_hi(v1[k].y);
                a3[0] += w * bf_lo(v1[k].z); a3[1] += w * bf_hi(v1[k].z); a3[2] += w * bf_lo(v1[k].w); a3[3] += w * bf_hi(v1[k].w); }
            *(f32x4*)op = a0; *(f32x4*)(op + 4) = a1; *(f32x4*)(op + 512) = a2; *(f32x4*)(op + 516) = a3;
        }
    }
}
#define XB_TMO      128
#define XB_XCNT(j)  (256  + 64 * (j))
#define XB_XSUB(j)  (1280 + 64 * (j))
#define XB_XGEN(j)  (2304 + 64 * (j))
#define XB_TOP      3328
#define XB_TOPGEN   3392
#define XCD_BAR_WORDS 3456
#define XB_SPIN_CAP (1u << 18)

__device__ __forceinline__ unsigned xb_ld(unsigned* p)              { return __hip_atomic_load(p, __ATOMIC_RELAXED, __HIP_MEMORY_SCOPE_AGENT); }
__device__ __forceinline__ unsigned xb_add(unsigned* p, unsigned v) { return __hip_atomic_fetch_add(p, v, __ATOMIC_RELAXED, __HIP_MEMORY_SCOPE_AGENT); }
__device__ __forceinline__ unsigned xb_xcc_id() { return (unsigned)__builtin_amdgcn_s_getreg((3 << 11) | 20) & 0xFu; }
#define XB_SPIN(cond, bar) do { unsigned _sp = 0; while (cond) { __builtin_amdgcn_s_sleep(1); \
    if ((++_sp & 255u) == 0u) { if (xb_ld(&(bar)[XB_TMO])) break; if (_sp > XB_SPIN_CAP) { atomicAdd(&(bar)[XB_TMO], 1u); break; } } } } while (0)

struct XcdBarrier {
    unsigned* bar; unsigned x;
    volatile LAS unsigned* st;
};

__device__ __forceinline__ XcdBarrier xcd_barrier_post(unsigned* bar, volatile LAS unsigned* st) {
    XcdBarrier b; b.bar = bar; b.x = xb_xcc_id(); b.st = st;
    if (threadIdx.x == 0) (void)xb_add(&bar[XB_XCNT(b.x)], 1u);
    return b;
}
__device__ __forceinline__ void xcd_barrier_complete(unsigned* bar, unsigned x, unsigned& nloc, unsigned& nx) {
    const unsigned G = gridDim.x * gridDim.y * gridDim.z;
    unsigned sum, cnt, mine, sp = 0u;
    for (;;) {
        sum = 0u; cnt = 0u; mine = 0u;
#pragma unroll
        for (unsigned j = 0; j < 16; ++j) { const unsigned c = xb_ld(&bar[XB_XCNT(j)]); sum += c; cnt += (c > 0u) ? 1u : 0u; mine = (j == x) ? c : mine; }
        if (sum == G) break;
        __builtin_amdgcn_s_sleep(1);
        if ((++sp & 255u) == 0u) { if (xb_ld(&bar[XB_TMO])) break; if (sp > XB_SPIN_CAP) { atomicAdd(&bar[XB_TMO], 1u); break; } }
    }
    nloc = mine > 0u ? mine : 1u; nx = cnt > 0u ? cnt : 1u;
}

__device__ __forceinline__ void xcd_barrier(const XcdBarrier& b) {
    asm volatile("s_waitcnt vmcnt(0)" ::: "memory");
    __syncthreads();
    if (threadIdx.x == 0) {
        unsigned* bar = b.bar;
        __builtin_amdgcn_s_waitcnt(0);
        unsigned nloc = b.st[0], nx = b.st[1];
        if (nloc == 0u) { xcd_barrier_complete(bar, b.x, nloc, nx); b.st[0] = nloc; b.st[1] = nx; }
        const unsigned old = xb_add(&bar[XB_XSUB(b.x)], 1u);
        const unsigned gen = old / nloc;
        if (old + 1u == (gen + 1u) * nloc) {
            __builtin_amdgcn_fence(__ATOMIC_RELEASE, "agent");
            asm volatile("s_waitcnt vmcnt(0)" ::: "memory");
            const unsigned og = xb_add(&bar[XB_TOP], 1u);
            const unsigned tg = og / nx;
            if (og + 1u == (tg + 1u) * nx) xb_add(&bar[XB_TOPGEN], 1u);
            else XB_SPIN(xb_ld(&bar[XB_TOPGEN]) == tg, bar);
            __builtin_amdgcn_fence(__ATOMIC_ACQUIRE, "agent");
            xb_add(&bar[XB_XGEN(b.x)], 1u);
            asm volatile("s_waitcnt vmcnt(0)" ::: "memory");
        } else {
            XB_SPIN(xb_ld(&bar[XB_XGEN(b.x)]) == gen, bar);
            __builtin_amdgcn_fence(__ATOMIC_ACQUIRE, "agent");
            asm volatile("s_waitcnt vmcnt(0)" ::: "memory");
        }
    }
    __syncthreads();
}


#ifndef MK_N_LAUNCHES
#define MK_N_LAUNCHES 1
#endif
#ifndef MK_BRANCHES
#define MK_BRANCHES 15
#endif
constexpr int N_PHASES = 12;
#ifndef MK_USE_CG
#define MK_USE_CG 0
#endif
constexpr int LDS_BARST = 147456 - 64;
constexpr int CW_BAR = 4096;
constexpr int LDS_BYTES = 147456;
constexpr int NTHREADS = 512;

struct Args { const float* in[30]; float* out; unsigned char* ws; int ph_lo, ph_hi; };
enum { I_x = 0, I_mem = 1, I_norm_mix = 2, I_w_in = 3, I_a_q_gain = 4, I_a_k_gain = 5, I_a_rel_bias = 6, I_conv_w = 7, I_conv_b = 8, I_dt_bias = 9, I_a_log = 10, I_d_skip = 11, I_ssm_norm = 12, I_norm_mem = 13, I_w_mem_kv = 14, I_x_q_gain = 15, I_x_k_gain = 16, I_w_br_a = 17, I_w_br_b = 18, I_w_br_c = 19, I_w_out = 20, I_norm_ffn = 21, I_w_router = 22, I_b_router = 23, I_w_gate = 24, I_b_gate = 25, I_w_up = 26, I_b_up = 27, I_w_down = 28, I_b_down = 29 };

#define WIN WSP(bf16_t, WS_WIN)
#define WCAT WSP(bf16_t, WS_WCAT)
#define WOUT WSP(bf16_t, WS_WOUT)
#define WMEM WSP(bf16_t, WS_WMEM)
#define DTB WSP(float, WS_DT)
#define SSQ WSP(float, WS_SSQ)
#define RSTD WSP(float, WS_RSTD)
#define KX WSP(bf16_t, WS_KX)
#define MEMKV WSP(bf16_t, WS_MEMKV)
#define XN WSP(bf16_t, WS_XN)
#define MEMN WSP(bf16_t, WS_MEMN)
#define ACT WSP(bf16_t, WS_ACT)
#define KA WSP(bf16_t, WS_KA)
#define VA WSP(bf16_t, WS_VA)
#define XBC WSP(bf16_t, WS_XBC)
#define GATES WSP(bf16_t, WS_GATES)
#define MERGED WSP(bf16_t, WS_MERGED)
#define H2 WSP(unsigned char, MOE_H2)
#define WGU WSP(unsigned char, MOE_WGU)
#define WD WSP(unsigned char, MOE_WD)
#define ACTM WSP(unsigned char, MOE_ACTM)
#define YB WSP(bf16_t, MOE_Y)
#define SELE WSP(int, MOE_SELE)
#define SELR WSP(int, MOE_SELR)
#define SELW WSP(float, MOE_SELW)
#define TOKL WSP(int, MOE_TOKL)
#define GCNT (WSP(unsigned, WS_CTL) + CW_CNT)
#define ACSB ((float*)(GAS float*)kq[30] + (size_t)T * 512)
#define BCC ((bf16_t*)(GAS bf16_t*)kq[30])
#define EI_INIT const EpiIn EI{ws, AP(a_q_gain), AP(a_k_gain), AP(dt_bias)}
typedef const __attribute__((address_space(4))) unsigned long long* KW;
DI KW launder(KW p) { asm volatile("" : "+s"(p)); return p; }
#define AP(name) ((const float*)(const GAS float*)kq[I_##name])
#define PHASE_ARGS const KW kq = launder(kp); unsigned char* const ws = (unsigned char*)(GAS unsigned char*)kq[31]; (void)ws
#define WSP(type, off) ((type*)(ws + (off)))
__global__ void __launch_bounds__(NTHREADS, 2) mega_fwd(Args a_unused) {
    extern __shared__ __attribute__((aligned(16))) unsigned char lds_raw[];
    LAS unsigned char* lds = (LAS unsigned char*)lds_raw;
    const KW kp = (KW)__builtin_amdgcn_kernarg_segment_ptr();
    const int tid = threadIdx.x, lane = tid & 63, wid = __builtin_amdgcn_readfirstlane(tid >> 6);
    const int G = gridDim.x, bx = blockIdx.x, vcu = (G % 8 == 0) ? (bx % 8) * (G / 8) + bx / 8 : bx;
    const int lo = (int)(unsigned)kp[32], hi = (int)(kp[32] >> 32);
#ifndef MK_PHASE_MASK
#define MK_PHASE_MASK 0x7fff
#endif
#define IN(k) (((MK_PHASE_MASK >> (k)) & 1) && lo <= (k) && (k) < hi)
#ifndef MK_REP_MASK
#define MK_REP_MASK 0
#endif
#define REPS(k) (((MK_REP_MASK >> (k)) & 1) + 1)
#if MK_USE_CG
#define SEAM(k) do { if (IN(k) && IN((k) + 1)) { cg::this_grid().sync(); } } while (0)
#else
#define SEAM(k) do { if (IN(k) && IN((k) + 1)) { xcd_barrier(bar); } } while (0)
#endif
    const int gw = vcu * 8 + wid, NGW = G * 8;
    for (int u = tid; u < 16; u += NTHREADS) ((LAS unsigned*)(lds + LDS_BARST))[u] = 0u;
    __syncthreads();
    XcdBarrier bar = xcd_barrier_post((unsigned*)(GAS unsigned*)(kp[31]) + CW_BAR, (volatile LAS unsigned*)(lds + LDS_BARST));
    LAS float* scr = (LAS float*)(lds + wid * 16896);

    if (IN(0)) { PHASE_ARGS;
        constexpr int I_IN = 16 * 196, I_MEM = 16 * 32, I_A = 16 * 16, I_B = 32 * 16, I_C = 16 * 16, I_O = 16 * 16, NIT = I_IN + I_MEM + I_A + I_B + I_C + I_O;
        for (int it = gw; it < NIT * REPS(0); it += NGW) {
            int r = it % NIT;
            if (r < I_IN) { const int kb = r / 196, nb = r % 196; transpose_item64(AP(w_in), IN_COLS, 64 * kb, win_src_col(2 * nb), win_src_col(2 * nb + 1), WIN + (size_t)(64 * nb) * 1024 + 64 * kb, 1024, nullptr, scr, lane); continue; } r -= I_IN;
            if (r < I_MEM) { const int kb = r / 32, nb = r % 32; transpose_item64(AP(w_mem_kv), 2048, 64 * kb, 64 * nb, 64 * nb + 32, WMEM + (size_t)(64 * nb) * 1024 + 64 * kb, 1024, nullptr, scr, lane); continue; } r -= I_MEM;
            if (r < I_A) { const int kb = r / 16, nb = r % 16; transpose_item64(AP(w_br_a), 1024, 64 * kb, 64 * nb, 64 * nb + 32, WCAT + (size_t)(64 * nb) * 4096 + 64 * kb, 4096, nullptr, scr, lane); continue; } r -= I_A;
            if (r < I_B) { const int kb = r / 16, nb = r % 16; transpose_item64(AP(w_br_b), 1024, 64 * kb, 64 * nb, 64 * nb + 32, WCAT + (size_t)(64 * nb) * 4096 + 1024 + 64 * kb, 4096, AP(ssm_norm), scr, lane); continue; } r -= I_B;
            if (r < I_C) { const int kb = r / 16, nb = r % 16; transpose_item64(AP(w_br_c), 1024, 64 * kb, 64 * nb, 64 * nb + 32, WCAT + (size_t)(64 * nb) * 4096 + 3072 + 64 * kb, 4096, nullptr, scr, lane); continue; } r -= I_C;
            { const int kb = r / 16, nb = r % 16; transpose_item64(AP(w_out), 1024, 64 * kb, 64 * nb, 64 * nb + 32, WOUT + (size_t)(64 * nb) * 1024 + 64 * kb, 1024, nullptr, scr, lane); }
        }
        for (int m0 = gw * 4; m0 < T * REPS(0); m0 += NGW * 4) { const int m = m0 % T; rms_rows_to_bf16<4>(AP(x) + (size_t)m * 1024, XN + (size_t)m * 1024, 1, AP(norm_mix), lane); }
        for (int m = gw; m < NBATCH * MEMLEN; m += NGW) rms_rows_to_bf16<1>(AP(mem) + (size_t)m * 1024, MEMN + (size_t)m * 1024, 1, AP(norm_mem), lane);
    }
    SEAM(0);
    if (IN(1)) { PHASE_ARGS; EI_INIT;
        const SchedIn S{G, bx, 16, TL_Q, 12, TL_QX, 0, (const char*)WIN, (const char*)WMEM, REPS(1)};
        pg8::gemm_phase<false>(lds, (const char*)XN, 2048, 2048, S, EI);
    }
    SEAM(1);
    if (IN(2)) { PHASE_ARGS;
        if (MK_BRANCHES & 1) {
            LAS float* bl = (LAS float*)(lds + AT_BIAS);
            for (int i = tid; i < 16 * 257; i += NTHREADS) bl[(i / 257) * AT_BIAS_STRIDE + (i % 257)] = AP(a_rel_bias)[i] * LOG2E;
            __syncthreads();
            for (int u = vcu; u < 4 * NBATCH * 64; u += G) { const int c = u & 63, b = (u >> 6) & 7, hq = u >> 9; attnA_unit(lds, b, c, hq, ACT, KA, VA, (MK_REP_MASK >> 2 & 1) ? (bf16_t*)(ws + WS_BUF + 128 * MiB) : ACT, (MK_REP_MASK >> 2 & 1) ? 1024 : ACT_P);
                if (MK_REP_MASK >> 2 & 1) attnA_unit(lds, b, c, hq, ACT, KA, VA, ACT, ACT_P); }
        } else {
            for (int idx = vcu * NTHREADS + tid; idx < T * 128; idx += G * NTHREADS) { const int t = idx >> 7, ch = idx & 127; *(u32x4*)(ACT + (size_t)t * ACT_P + ch * 8) = (u32x4){0u, 0u, 0u, 0u}; }
        }
    }
    SEAM(2);
    if (IN(3)) { PHASE_ARGS; EI_INIT;
        const SchedIn S{G, bx, 21, TL_Z, 21, 0, 64, (const char*)WIN, (const char*)WMEM, REPS(3)};
        pg8::gemm_phase<false>(lds, (const char*)XN, 2048, 2048, S, EI);
    }
    SEAM(3);
    if (IN(4)) { PHASE_ARGS;
        if (MK_BRANCHES & 2) bcconv_phase(vcu, G, XBC, BCC, AP(conv_w), AP(conv_b), DTB, ACSB, AP(a_log));
        for (int w = gw; w < NBATCH * MEMLEN * 4; w += NGW) {
            const int row = w >> 2, hx = w & 3; const u32x2 kv = *(const u32x2*)(MEMKV + (size_t)row * 2048 + 256 * hx + 4 * lane);
            const float k0 = bf_lo(kv.x), k1 = bf_hi(kv.x), k2 = bf_lo(kv.y), k3 = bf_hi(kv.y);
            const float rs = __builtin_amdgcn_rsqf(wave_sum(k0 * k0 + k1 * k1 + k2 * k2 + k3 * k3) * (1.f / 256.f) + EPS) * (0.0625f * LOG2E);
            const f32x4 gk = *(const f32x4*)(AP(x_k_gain) + 4 * lane), gq = *(const f32x4*)(AP(x_q_gain) + 4 * lane);
            u32x2 o; o.x = pk2(k0 * rs * gk.x * gq.x, k1 * rs * gk.y * gq.y); o.y = pk2(k2 * rs * gk.z * gq.z, k3 * rs * gk.w * gq.w);
            *(u32x2*)(KX + (size_t)row * 1024 + 256 * hx + 4 * lane) = o;
        }
        xcd_barrier(bar);
        if (MK_REP_MASK >> 14 & 1) for (int u = vcu; u < NBATCH * 4 * 32; u += G) { const int rb = u & 31, hx = (u >> 5) & 3, b = u >> 7; attnC_unit(lds, b, hx, rb, ACT, KX, MEMKV, (bf16_t*)(GAS bf16_t*)kq[30] + (size_t)T * 1024, 1024); }
        if (MK_BRANCHES & 4) for (int u = vcu; u < NBATCH * 4 * 32; u += G) { const int rb = u & 31, hx = (u >> 5) & 3, b = u >> 7; attnC_unit(lds, b, hx, rb, ACT, KX, MEMKV, ACT + 3072, ACT_P); }
        if (MK_BRANCHES & 2) { int nrep = 1 + (MK_REP_MASK >> 4 & 1); asm volatile("" : "+s"(nrep));
#pragma unroll 1
            for (int rep = 0; rep < nrep; ++rep) { const bool real = rep == nrep - 1;
                for (int u = vcu; u < NBATCH * 32; u += G) mamba_unit(lds, u >> 5, u & 31, XBC, BCC, DTB, ACSB, ACT, SSQ, real ? ACT + 1024 : (bf16_t*)RSTD, real ? (size_t)ACT_P : (size_t)0, AP(conv_w), AP(conv_b), AP(a_log), AP(d_skip)); } }
    }
    SEAM(4);
    if (IN(5)) { PHASE_ARGS; EI_INIT;
        for (int idx = vcu * NTHREADS + tid; idx < T * 4; idx += G * NTHREADS) { const int t = idx >> 2, g = idx & 3; const f32x4 s0 = *(const f32x4*)(SSQ + (size_t)t * 32 + 8 * g), s1 = *(const f32x4*)(SSQ + (size_t)t * 32 + 8 * g + 4);
            RSTD[idx] = __builtin_amdgcn_rsqf(((s0[0] + s0[1]) + (s0[2] + s0[3]) + (s1[0] + s1[1]) + (s1[2] + s1[3])) * (1.f / 512.f) + EPS); }
        const SchedIn S{G, bx, 12, TL_G, 12, 0, 0, (const char*)WIN, (const char*)WMEM, REPS(5)};
        pg8::gemm_phase<false>(lds, (const char*)XN, 2048, 2048, S, EI);
    }
    SEAM(5);
    if (IN(6)) { PHASE_ARGS;
        constexpr int LASTSEG = (MK_BRANCHES & 4) ? 2 : ((MK_BRANCHES & 2) ? 1 : 0);
        constexpr int KM = LASTSEG == 2 ? 4096 : (LASTSEG == 1 ? 3072 : 1024);
        const SchedDense S{G, bx, T / 256, 4, 4096, (const char*)WCAT, REPS(6)};
        const EpiMerge E{GATES, RSTD, MERGED, LASTSEG};
        pg8::gemm_phase<false>(lds, (const char*)ACT, KM * 2, 8192, S, E);
    }
    SEAM(6);
    if (IN(7)) { PHASE_ARGS;
        const SchedDense S{G, bx, T / 256, 4, 1024, (const char*)WOUT, REPS(7)};
        const EpiOut E{AP(x), ((float*)(GAS float*)kq[30])};
        pg8::gemm_phase<false>(lds, (const char*)MERGED, 2048, 2048, S, E);
    }
    SEAM(7);
    if (IN(8) && (MK_BRANCHES & 8)) { PHASE_ARGS;
        { int nrep = 1 + (MK_REP_MASK >> 11 & 1); asm volatile("" : "+s"(nrep));
#pragma unroll 1
          for (int rep = 0; rep < nrep; ++rep) { const bool real = rep == nrep - 1; const size_t dm = real ? 0 : (MOE_ACTM - MOE_SELE);
            router_phase(lds, vcu, G, ((float*)(GAS float*)kq[30]), AP(norm_ffn), AP(w_router), AP(b_router), H2, (int*)((char*)SELE + dm), (int*)((char*)SELR + dm), (float*)((char*)SELW + dm), (int*)((char*)TOKL + dm), GCNT + (real ? 0 : 64));
            __syncthreads(); } }
        for (int it0 = gw; it0 < NEXP * 768 * REPS(8); it0 += NGW) { const int it = it0 % (NEXP * 768);
            const int e = it / 768, r = it % 768, which = r >> 8, kb = (r & 255) >> 4, nb = r & 15;
            const float* src = (which == 0 ? AP(w_gate) : which == 1 ? AP(w_up) : AP(w_down)) + (size_t)e * 1024 * 1024;
            if (which == 2) transpose_item64_fp8(src, 1024, 64 * kb, 64 * nb, 64 * nb + 32, WD + ((size_t)e * 1024 + 64 * nb) * 1024 + 64 * kb, 1024, 32.0f, scr, lane);
            else transpose_item64_fp8(src, 1024, 64 * kb, 64 * nb, 64 * nb + 32, WGU + ((size_t)e * 2048 + 256 * (nb >> 1) + 128 * which + 64 * (nb & 1)) * 1024 + 64 * kb, 1024, 32.0f, scr, lane);
        }
    }
    SEAM(8);
    {
        if ((MK_BRANCHES & 8) && (IN(9) || IN(10) || IN(11))) { PHASE_ARGS;
            const int total = moe_tables(lds, GCNT), tlo = 0, thi = total;
            const LAS int* ts = (const LAS int*)(lds + MO_TS); const LAS int* cn = (const LAS int*)(lds + MO_CNT);
            if (IN(9)) { const SchedMoE S{G, bx, 8, tlo, thi, ts, cn, TOKL, (const char*)WGU, (size_t)2048 * 1024, REPS(9), 1024u, 1024u}; const EpiGU E{ACTM, AP(b_gate), AP(b_up), tlo};
                pg8::gemm_phase<true>(lds, (const char*)H2, 1024, 1024, S, E); }
            SEAM(9);
            if (IN(10)) { const SchedMoE S{G, bx, 4, tlo, thi, ts, cn, nullptr, (const char*)WD, (size_t)1024 * 1024, REPS(10), 1024u, 1024u}; const EpiDown E{YB, AP(b_down), tlo};
                pg8::gemm_phase<true>(lds, (const char*)ACTM, 1024, 1024, S, E); }
            SEAM(10);
            if (IN(11)) { int nrep = 1 + (MK_REP_MASK >> 12 & 1); asm volatile("" : "+s"(nrep));
#pragma unroll 1
                for (int rep = 0; rep < nrep; ++rep) combine_phase(lds, vcu, G, tlo, thi, YB, SELE, SELR, SELW, ((float*)(GAS float*)kq[30]), 1.0f / (float)nrep); }
        } else { SEAM(9); SEAM(10); }
    }
#undef IN
#undef SEAM
}

extern "C" void kernel_launch(void* const* d_in, const int* in_sizes, int n_in, void* d_out, int out_size, void* d_ws, size_t ws_size, hipStream_t stream) {
    static int grid = 0;
    if (grid == 0) {
        if (n_in != 30 || ws_size < WS_MIX_END || ws_size < WS_END) { fprintf(stderr, "kernel_launch: unexpected n_in %d / ws_size %zu\n", n_in, ws_size); grid = -1; return; }
        int dev = 0, cus = 0, per_cu = 0;
        (void)hipGetDevice(&dev); (void)hipDeviceGetAttribute(&cus, hipDeviceAttributeMultiprocessorCount, dev);
        (void)hipFuncSetAttribute((const void*)mega_fwd, hipFuncAttributeMaxDynamicSharedMemorySize, LDS_BYTES);
        (void)hipOccupancyMaxActiveBlocksPerMultiprocessor(&per_cu, (const void*)mega_fwd, NTHREADS, LDS_BYTES);
        if (per_cu < 1) { fprintf(stderr, "kernel_launch: occupancy query reports %d blocks per CU\n", per_cu); grid = -1; return; }
        grid = cus;
    }
    if (grid < 0) return;
    (void)hipMemsetAsync((char*)d_ws + WS_CTL, 0, 65536, stream);
    Args a{};
    for (int i = 0; i < 30; ++i) a.in[i] = (const float*)d_in[i];
    a.out = (float*)d_out; a.ws = (unsigned char*)d_ws;
    if (MK_N_LAUNCHES == 1) {
        a.ph_lo = 0; a.ph_hi = N_PHASES;
        void* args[] = {&a};
        hipError_t e = hipLaunchCooperativeKernel((void*)mega_fwd, dim3(grid), dim3(NTHREADS), args, LDS_BYTES, stream);
        if (e != hipSuccess) fprintf(stderr, "cooperative launch failed: %s (grid %d)\n", hipGetErrorString(e), grid);
    } else {
        for (int ph = 0; ph < N_PHASES; ++ph) { a.ph_lo = ph; a.ph_hi = ph + 1; hipLaunchKernelGGL(mega_fwd, dim3(grid), dim3(NTHREADS), LDS_BYTES, stream, a); }
    }
}
```

```cpp
#include <hip/hip_runtime.h>
#include <hip/hip_cooperative_groups.h>
#include <cstdio>
#include <cstdint>
namespace cg = cooperative_groups;

#define LAS __attribute__((address_space(3)))
#define GAS __attribute__((address_space(1)))
#define DI __device__ __forceinline__
typedef unsigned short bf16_t;
typedef short bf16x8 __attribute__((ext_vector_type(8)));
typedef short s16x4 __attribute__((ext_vector_type(4)));
typedef float f32x2 __attribute__((ext_vector_type(2)));
typedef float f32x4 __attribute__((ext_vector_type(4)));
typedef float f32x16 __attribute__((ext_vector_type(16)));
typedef unsigned u32x2 __attribute__((ext_vector_type(2)));
typedef unsigned u32x4 __attribute__((ext_vector_type(4)));
typedef __bf16 bf16x2_t __attribute__((ext_vector_type(2)));
typedef short v4i16_t __attribute__((ext_vector_type(4)));

DI unsigned pk2(float lo, float hi) { f32x2 v = {lo, hi}; bf16x2_t b = __builtin_convertvector(v, bf16x2_t); return __builtin_bit_cast(unsigned, b); }
DI float bf_lo(unsigned w) { return __uint_as_float(w << 16); }
DI float bf_hi(unsigned w) { return __uint_as_float(w & 0xffff0000u); }
DI float bf2f(bf16_t b) { return __uint_as_float(((unsigned)b) << 16); }
DI float wave_sum(float v) {
#pragma unroll
    for (int o = 1; o < 64; o <<= 1) v += __shfl_xor(v, o);
    return v;
}
DI float fast_exp2(float x) { return __builtin_amdgcn_exp2f(x); }
DI float fast_rcp(float x) { return __builtin_amdgcn_rcpf(x); }
DI float sigmoidf_(float x) { return fast_rcp(1.0f + fast_exp2(-1.4426950408889634f * x)); }

constexpr int NBATCH = 8, SEQ = 4096, T = NBATCH * SEQ, DM = 1024;
constexpr int NWIN_TILES = 49, NWIN = NWIN_TILES * 256;
constexpr int IN_COLS = 12320;
constexpr float EPS = 1e-6f;
constexpr float LOG2E = 1.4426950408889634f;
constexpr int NEXP = 32, TOPK = 4;
constexpr int MEMLEN = 256;
constexpr int ACT_P = 4096;
constexpr int TL_Q = 0, TL_K = 4, TL_V = 8, TL_Z = 12, TL_XBC = 20, TL_DT = 32, TL_QX = 33, TL_G = 37;

constexpr size_t MiB = (size_t)1 << 20;
constexpr size_t WS_CTL = 0, CTL_BYTES = 1 * MiB;
constexpr size_t WS_WIN = 1 * MiB, WS_WCAT = 26 * MiB, WS_WOUT = 34 * MiB, WS_WMEM = 36 * MiB;
constexpr size_t WS_DT = 40 * MiB, WS_SSQ = 44 * MiB, WS_RSTD = 48 * MiB, WS_KX = 49 * MiB, WS_MEMKV = 53 * MiB;
constexpr size_t WS_XN = 61 * MiB, WS_MEMN = 125 * MiB, WS_ACT = 129 * MiB, WS_BUF = 385 * MiB, WS_MIX_END = 577 * MiB;
constexpr size_t WS_KA = WS_BUF, WS_VA = WS_BUF + 64 * MiB, WS_XBC = WS_BUF, WS_GATES = WS_BUF, WS_MERGED = WS_XN;
constexpr int MOE_TILE_CAP = 280;
constexpr size_t MOE_H2 = 1 * MiB, MOE_WGU = 33 * MiB, MOE_WD = 97 * MiB, MOE_ACTM = 129 * MiB, MOE_Y = 265 * MiB;
constexpr size_t MOE_SELE = 537 * MiB, MOE_SELR = 537 * MiB + 512 * 1024, MOE_SELW = 538 * MiB, MOE_TOKL = 539 * MiB, WS_END = 543 * MiB;
constexpr int CW_CNT = 64;

#ifndef MK_KREP
#define MK_KREP 1
#endif
#ifndef MK_NT_STORES
#define MK_NT_STORES 0
#endif
namespace pg8 {
constexpr int BM = 256, BK = 64, HALF = 128, HTB = HALF * BK * 2, STAGE_BYTES = 8 * HTB;
__host__ __device__ __forceinline__ int lds_byte(int r, int c) { const int st = (r >> 4) * 2 + (c >> 5), rr = r & 15, cc = c & 31, ob = rr * 64 + cc * 2; return st * 1024 + (ob ^ (((ob >> 9) & 1) << 5)); }
__host__ __device__ __forceinline__ void stage_rc(int b, int& R, int& C) { const int st = b / 1024, sb = b % 1024, swz = sb ^ (((sb >> 9) & 1) << 5); R = (st >> 1) * 16 + swz / 64; C = (st & 1) * 32 + (swz % 64) / 2; }
__host__ __device__ __forceinline__ int perm32(int rho) { const int n = rho >> 4, i = rho & 15; return 8 * (i >> 2) + 4 * n + (i & 3); }

struct Unit { int kind, pm, pn, aux; };

typedef f32x4 Acc[2][2][4][2];

typedef int v8i_t __attribute__((ext_vector_type(8)));
template <bool FP8, class Epi, class Sched>
DI void gemm_phase(LAS unsigned char* lds, const char* Abase, const int Kb, const int ldbb, const Sched& S, const Epi& E) {
    int tid_ = threadIdx.x; asm volatile("" : "+v"(tid_));
    const int tid = tid_, wid = __builtin_amdgcn_readfirstlane(tid >> 6), lane = tid & 63, wr = wid >> 2, wc = wid & 3, fr = lane & 15, fq = lane >> 4;
    const int nt = Kb / (BK * 2);
    int Rr[2], Cc2[2]; unsigned voffB[2];
#pragma unroll
    for (int i = 0; i < 2; ++i) { int R, C; stage_rc(tid * 16 + i * 8192, R, C); Rr[i] = R; Cc2[i] = C * 2; const int Rb = (R & ~31) + perm32(R & 31); voffB[i] = (unsigned)(Rb * ldbb + C * 2); }
    const unsigned kstep = (unsigned)(BK * 2);
    const size_t hstepB = (size_t)HALF * ldbb;
    const unsigned ldsw = (unsigned)wid * 1024u;
    const int aoff0 = lds_byte(wr * 64 + fr, fq * 8), aoff1 = aoff0 + 1024;
    const int boff0 = lds_byte(wc * 32 + fr, fq * 8), boff1 = boff0 + 1024;
#define PG8_SA(b, h) (((b) * 2 + (h)) * HTB)
#define PG8_SB(b, h) ((4 + (b) * 2 + (h)) * HTB)
#define PG8_GLDS(src, dstoff) __builtin_amdgcn_global_load_lds((const unsigned*)(src), (LAS unsigned*)(lds + (dstoff)), 16, 0, 0)
#define PG8_STAGE_B(bufoff, ptr) do { _Pragma("unroll") for (int _i = 0; _i < 2; ++_i) PG8_GLDS((const char*)(ptr) + voffB[_i], (bufoff) + ldsw + _i * 8192); } while (0)
#define PG8_STAGE_A(bufoff, kb, v0, v1) do { PG8_GLDS(Abase + (size_t)(v0) + (kb), (bufoff) + ldsw); PG8_GLDS(Abase + (size_t)(v1) + (kb), (bufoff) + ldsw + 8192); } while (0)
#define PG8_LDA(dst, b, h) do { _Pragma("unroll") for (int m = 0; m < 4; ++m) { dst[m][0] = *(const LAS u32x4*)(lds + PG8_SA(b, h) + aoff0 + m * 2048); dst[m][1] = *(const LAS u32x4*)(lds + PG8_SA(b, h) + aoff1 + m * 2048); } } while (0)
#define PG8_LDB(dst, b, h) do { _Pragma("unroll") for (int n = 0; n < 2; ++n) { dst[n][0] = *(const LAS u32x4*)(lds + PG8_SB(b, h) + boff0 + n * 2048); dst[n][1] = *(const LAS u32x4*)(lds + PG8_SB(b, h) + boff1 + n * 2048); } } while (0)
#define PG8_CAT(x) __builtin_bit_cast(v8i_t, __builtin_shufflevector((x)[0], (x)[1], 0, 1, 2, 3, 4, 5, 6, 7))
#define PG8_MMA(ai, bj, At, Bt) do { __builtin_amdgcn_s_setprio(1); _Pragma("unroll") for (int m = 0; m < 4; ++m) _Pragma("unroll") for (int n = 0; n < 2; ++n) { \
        if constexpr (FP8) asm volatile("v_mfma_scale_f32_16x16x128_f8f6f4 %0, %1, %2, %0, %3, %4 op_sel_hi:[0,0,0]" : "+v"(acc[ai][bj][m][n]) : "v"(PG8_CAT(Bt[n])), "v"(PG8_CAT(At[m])), "v"(sclB), "v"(sclA)); \
        else { _Pragma("unroll") for (int k = 0; k < 2; ++k) acc[ai][bj][m][n] = __builtin_amdgcn_mfma_f32_16x16x32_bf16(__builtin_bit_cast(bf16x8, Bt[n][k]), __builtin_bit_cast(bf16x8, At[m][k]), acc[ai][bj][m][n], 0, 0, 0); } } \
        __builtin_amdgcn_s_setprio(0); } while (0)
#define PG8_WAIT_V(n) asm volatile("s_waitcnt vmcnt(" #n ")" ::: "memory")
#define PG8_WAIT_L(n) asm volatile("s_waitcnt lgkmcnt(" #n ")" ::: "memory")
#define PG8_BAR __builtin_amdgcn_s_barrier()
#define PG8_SCHED __builtin_amdgcn_sched_barrier(0)
    Unit cur, nxt; int ui = 0;
    if (!S.next(0, cur)) return;
    Acc acc;
#pragma unroll
    for (int a = 0; a < 2; ++a)
#pragma unroll
        for (int b = 0; b < 2; ++b)
#pragma unroll
            for (int m = 0; m < 4; ++m)
#pragma unroll
                for (int n = 0; n < 2; ++n) acc[a][b][m][n] = (f32x4){0.f, 0.f, 0.f, 0.f};
    u32x4 At[4][2], B0[2][2], B1[2][2];
    int sclB = 0x7a7a7a7a, sclA = 0x7f7f7f7f;
    asm volatile("" : "+v"(sclB), "+v"(sclA));
    unsigned vA00 = S.arow(cur, Rr[0]) + Cc2[0], vA01 = S.arow(cur, Rr[1]) + Cc2[1], vA10 = S.arow(cur, HALF + Rr[0]) + Cc2[0], vA11 = S.arow(cur, HALF + Rr[1]) + Cc2[1];
    const char* cB = S.bptr(cur);
    PG8_STAGE_B(PG8_SB(0, 0), cB); PG8_STAGE_B(PG8_SB(0, 1), cB + hstepB); PG8_STAGE_A(PG8_SA(0, 0), 0, vA00, vA01); PG8_STAGE_A(PG8_SA(0, 1), 0, vA10, vA11);
    if (wr == 1) PG8_BAR;
    PG8_WAIT_V(2); PG8_BAR;
    PG8_STAGE_B(PG8_SB(1, 0), cB + kstep); PG8_STAGE_A(PG8_SA(1, 0), kstep, vA00, vA01); PG8_STAGE_B(PG8_SB(1, 1), cB + hstepB + kstep);
    PG8_WAIT_V(6); PG8_BAR;
    for (;;) {
        const bool has_next = S.next(ui + 1, nxt);
        const char* nB = has_next ? S.bptr(nxt) : cB;
        constexpr int KREP = (MK_KREP > 1 && !Epi::SEGMENTED) ? MK_KREP : 1;
        for (int tt = 0; tt < nt * KREP; tt += 2) {
            const int t = KREP > 1 ? tt % nt : tt;
            const bool last = (tt == nt * KREP - 2);
            if constexpr (Epi::SEGMENTED) { if (t > 0 && E.boundary(t)) E.rescale(acc, cur, t, wr, wc, fr, fq); }
            const unsigned k1 = (unsigned)(t + 1) * kstep;
            const unsigned t2 = (KREP > 1) ? (unsigned)((t + 2) % nt) : (unsigned)(t + 2);
            const unsigned k2 = last ? 0u : t2 * kstep, k3 = k2 + kstep;
            const char* b2 = last ? nB : cB + t2 * kstep; const char* b3 = b2 + kstep;
            unsigned w00 = vA00, w01 = vA01, w10 = vA10, w11 = vA11;
            if (last && has_next) { w00 = S.arow(nxt, Rr[0]) + Cc2[0]; w01 = S.arow(nxt, Rr[1]) + Cc2[1]; w10 = S.arow(nxt, HALF + Rr[0]) + Cc2[0]; w11 = S.arow(nxt, HALF + Rr[1]) + Cc2[1]; }
            PG8_LDB(B0, 0, 0); PG8_LDB(B1, 0, 1); PG8_SCHED; PG8_LDA(At, 0, 0); PG8_STAGE_A(PG8_SA(1, 1), k1, vA10, vA11);
            PG8_WAIT_V(8); PG8_WAIT_L(0); PG8_BAR; PG8_MMA(0, 0, At, B0); PG8_MMA(0, 1, At, B1); PG8_BAR; PG8_SCHED;
            PG8_LDA(At, 0, 1); PG8_STAGE_B(PG8_SB(0, 0), b2); PG8_STAGE_B(PG8_SB(0, 1), b2 + hstepB); PG8_STAGE_A(PG8_SA(0, 0), k2, w00, w01);
            PG8_WAIT_V(8); PG8_WAIT_L(0); PG8_BAR; PG8_MMA(1, 0, At, B0); PG8_MMA(1, 1, At, B1); PG8_BAR; PG8_SCHED;
            PG8_LDB(B0, 1, 0); PG8_LDB(B1, 1, 1); PG8_SCHED; PG8_LDA(At, 1, 0); PG8_STAGE_A(PG8_SA(0, 1), k2, w10, w11);
            PG8_WAIT_V(8); PG8_WAIT_L(0); PG8_BAR; PG8_MMA(0, 0, At, B0); PG8_MMA(0, 1, At, B1); PG8_BAR; PG8_SCHED;
            PG8_LDA(At, 1, 1); PG8_STAGE_B(PG8_SB(1, 0), b3); PG8_STAGE_B(PG8_SB(1, 1), b3 + hstepB); PG8_STAGE_A(PG8_SA(1, 0), k3, w00, w01);
            PG8_WAIT_V(8); PG8_WAIT_L(0); PG8_BAR; PG8_MMA(1, 0, At, B0); PG8_MMA(1, 1, At, B1); PG8_BAR; PG8_SCHED;
            if (last) { vA00 = w00; vA01 = w01; vA10 = w10; vA11 = w11; }
        }
        if (wr == 0) PG8_BAR;
        if constexpr (FP8) asm volatile("s_nop 15\n\ts_nop 7" ::: "memory");
        if constexpr (KREP > 1) {
#pragma unroll
            for (int a = 0; a < 2; ++a)
#pragma unroll
                for (int b = 0; b < 2; ++b)
#pragma unroll
                    for (int m = 0; m < 4; ++m)
#pragma unroll
                        for (int n = 0; n < 2; ++n) acc[a][b][m][n] *= (1.0f / KREP); }
        E(acc, cur, wr, wc, fr, fq);
        if (!has_next) break;
#pragma unroll
        for (int a = 0; a < 2; ++a)
#pragma unroll
            for (int b = 0; b < 2; ++b)
#pragma unroll
                for (int m = 0; m < 4; ++m)
#pragma unroll
                    for (int n = 0; n < 2; ++n) acc[a][b][m][n] = (f32x4){0.f, 0.f, 0.f, 0.f};
        cur = nxt; cB = nB; ++ui;
        if (wr == 1) PG8_BAR;
    }
    PG8_WAIT_V(0);
    PG8_BAR;
#undef PG8_SA
#undef PG8_SB
#undef PG8_GLDS
#undef PG8_STAGE_A
#undef PG8_STAGE_B
#undef PG8_LDA
#undef PG8_LDB
#undef PG8_MMA
#undef PG8_CAT
#undef PG8_WAIT_V
#undef PG8_WAIT_L
#undef PG8_BAR
#undef PG8_SCHED
}

DI bool static_tile(int L, int nM, int nN, int& pm, int& pn) {
    const int nwg = nM * nN; if (L >= nwg) return false;
    int wgid = L; { const int q = nwg / 8, r = nwg % 8, xcd = wgid % 8, off = wgid / 8; wgid = (xcd < r ? xcd * (q + 1) : r * (q + 1) + (xcd - r) * q) + off; }
    const int nig = 8 * nN, gid = wgid / nig, fm = gid * 8, gsz = (nM - fm) < 8 ? (nM - fm) : 8;
    pm = fm + ((wgid % nig) % gsz); pn = (wgid % nig) / gsz; return true;
}
}
using pg8::Unit; using pg8::Acc;

DI unsigned pk4_fp8(float a, float b, float c, float d) { int p = 0; p = __builtin_amdgcn_cvt_pk_fp8_f32(a, b, p, false); p = __builtin_amdgcn_cvt_pk_fp8_f32(c, d, p, true); return (unsigned)p; }
DI float silu_(float v) { return v * sigmoidf_(v); }
DI float softplus_(float x) { return fmaxf(x, 0.f) + __logf(1.0f + __expf(-fabsf(x))); }

struct SchedIn {
    int G, c, ncol, t0, nsplit, t1, nextra; const char* win; const char* wmem; int reps;
    DI bool next(int i, Unit& u) const {
        const int U = (T / 256) * ncol + nextra; int L = i * G + c; if (L >= U * reps) return false; L %= U; int pm, pn;
        if (pg8::static_tile(L, T / 256, ncol, pm, pn)) { u.kind = 0; u.pm = pm; u.pn = pn < nsplit ? t0 + pn : t1 + (pn - nsplit); u.aux = 0; return true; }
        const int j = L - (T / 256) * ncol; if (j < nextra) { u.kind = 1; u.pm = j >> 3; u.pn = j & 7; u.aux = 0; return true; }
        return false;
    }
    DI unsigned arow(const Unit& u, int r) const { return (u.kind == 0 ? 0u : (unsigned)(WS_MEMN - WS_XN)) + (unsigned)(u.pm * 256 + r) * 2048u; }
    DI const char* bptr(const Unit& u) const { return (u.kind == 0 ? win : wmem) + (size_t)u.pn * (256 * 1024 * 2); }
};

struct EpiIn {
    static constexpr bool SEGMENTED = false;
    unsigned char* ws; const float *qgain, *kgain, *dtbias;
    template <int OP> DI void ew(const Acc& acc, bf16_t* dst, size_t pitch, int col0, int row0, int wc, int fq) const {
#pragma unroll
        for (int ai = 0; ai < 2; ++ai)
#pragma unroll
            for (int m = 0; m < 4; ++m) { bf16_t* rowp = dst + (size_t)(row0 + ai * 128 + m * 16) * pitch + col0 + wc * 32 + 8 * fq;
#pragma unroll
                for (int bj = 0; bj < 2; ++bj) { f32x4 v0 = acc[ai][bj][m][0], v1 = acc[ai][bj][m][1];
                    if (OP == 1) { for (int e = 0; e < 4; ++e) { v0[e] = silu_(v0[e]); v1[e] = silu_(v1[e]); } }
                    if (OP == 2) { for (int e = 0; e < 4; ++e) { v0[e] = sigmoidf_(fminf(fmaxf(v0[e], -30.f), 30.f)); v1[e] = sigmoidf_(fminf(fmaxf(v1[e], -30.f), 30.f)); } }
                    u32x4 w; w.x = pk2(v0[0], v0[1]); w.y = pk2(v0[2], v0[3]); w.z = pk2(v1[0], v1[1]); w.w = pk2(v1[2], v1[3]);
                    *(u32x4*)(rowp + bj * 128) = w; }
                asm volatile("" ::: "memory"); }
    }
    DI void headnorm(const Acc& acc, bf16_t* dst, size_t pitch, int col0, int row0, int wc, int fq, const float* gain, float mul) const {
#pragma unroll
        for (int ai = 0; ai < 2; ++ai)
#pragma unroll
            for (int m = 0; m < 4; ++m) {
                float ss = 0.f;
#pragma unroll
                for (int bj = 0; bj < 2; ++bj)
#pragma unroll
                    for (int n = 0; n < 2; ++n) { const f32x4 x = acc[ai][bj][m][n]; ss += (x[0] * x[0] + x[1] * x[1]) + (x[2] * x[2] + x[3] * x[3]); }
                ss += __shfl_xor(ss, 16); ss += __shfl_xor(ss, 32);
                const float rs = __builtin_amdgcn_rsqf(ss * (1.0f / 64.0f) + EPS) * mul;
                bf16_t* rowp = dst + (size_t)(row0 + ai * 128 + m * 16) * pitch + col0 + wc * 64 + 8 * fq;
#pragma unroll
                for (int bj = 0; bj < 2; ++bj) { const f32x4 g0 = *(const f32x4*)(gain + 32 * bj + 8 * fq), g1 = *(const f32x4*)(gain + 32 * bj + 8 * fq + 4);
                    const f32x4 v0 = acc[ai][bj][m][0] * rs * g0, v1 = acc[ai][bj][m][1] * rs * g1;
                    u32x4 w; w.x = pk2(v0[0], v0[1]); w.y = pk2(v0[2], v0[3]); w.z = pk2(v1[0], v1[1]); w.w = pk2(v1[2], v1[3]);
                    *(u32x4*)(rowp + bj * 32) = w; }
                asm volatile("" ::: "memory"); }
    }
    DI void operator()(const Acc& acc, const Unit& u, int wr, int wc, int fr, int fq) const {
        const int row0 = u.pm * 256 + wr * 64 + fr;
        bf16_t* const act = (bf16_t*)(ws + WS_ACT); bf16_t* const ka = (bf16_t*)(ws + WS_KA); bf16_t* const va = (bf16_t*)(ws + WS_VA); bf16_t* const xbc = (bf16_t*)(ws + WS_XBC);
        bf16_t* const gates = (bf16_t*)(ws + WS_GATES); bf16_t* const memkv = (bf16_t*)(ws + WS_MEMKV); float* const dt = (float*)(ws + WS_DT);
        if (u.kind == 1) { ew<0>(acc, memkv, 2048, u.pn * 256, row0, wc, fq); return; }
        const int tl = u.pn;
        if (tl < TL_K) headnorm(acc, act, ACT_P, (tl - TL_Q) * 256, row0, wc, fq, qgain, 0.125f * LOG2E);
        else if (tl < TL_V) headnorm(acc, ka, 1024, (tl - TL_K) * 256, row0, wc, fq, kgain, 1.0f);
        else if (tl < TL_Z) ew<0>(acc, va, 1024, (tl - TL_V) * 256, row0, wc, fq);
        else if (tl < TL_XBC) ew<1>(acc, act, ACT_P, 1024 + (tl - TL_Z) * 256, row0, wc, fq);
        else if (tl < TL_DT) ew<0>(acc, xbc, 3072, (tl - TL_XBC) * 256, row0, wc, fq);
        else if (tl == TL_DT) {
            if (wc == 0) {
                f32x4 b0 = *(const f32x4*)(dtbias + 8 * fq), b1 = *(const f32x4*)(dtbias + 8 * fq + 4);
#pragma unroll
                for (int ai = 0; ai < 2; ++ai)
#pragma unroll
                    for (int m = 0; m < 4; ++m) { float* rowp = dt + (size_t)(row0 + ai * 128 + m * 16) * 32 + 8 * fq;
                        f32x4 v0 = acc[ai][0][m][0] + b0, v1 = acc[ai][0][m][1] + b1;
                        for (int e = 0; e < 4; ++e) { v0[e] = softplus_(v0[e]); v1[e] = softplus_(v1[e]); }
                        *(f32x4*)rowp = v0; *(f32x4*)(rowp + 4) = v1; }
            }
        }
        else if (tl < TL_G) ew<0>(acc, act, ACT_P, 3072 + (tl - TL_QX) * 256, row0, wc, fq);
        else ew<2>(acc, gates, 3072, (tl - TL_G) * 256, row0, wc, fq);
    }
};

struct SchedDense {
    int G, c, nM, nN, K; const char* bbase; int reps;
    DI bool next(int i, Unit& u) const { u.kind = 0; u.aux = 0; const int U = nM * nN; int L = i * G + c; if (L >= U * reps) return false; return pg8::static_tile(L % U, nM, nN, u.pm, u.pn); }
    DI unsigned arow(const Unit& u, int r) const { return (unsigned)(u.pm * 256 + r) * (unsigned)(K * 2); }
    DI const char* bptr(const Unit& u) const { return bbase + (size_t)u.pn * 256 * K * 2; }
};

struct EpiMerge {
    static constexpr bool SEGMENTED = true;
    const bf16_t* gates; const float* rstd; bf16_t* merged; int last_seg;
    DI bool boundary(int t) const { return t == 16 || t == 24 || t == 32 || t == 40 || t == 48; }
    DI void load8(const bf16_t* p, float (&g)[8]) const { const u32x4 w = *(const u32x4*)p; g[0] = bf_lo(w.x); g[1] = bf_hi(w.x); g[2] = bf_lo(w.y); g[3] = bf_hi(w.y); g[4] = bf_lo(w.z); g[5] = bf_hi(w.z); g[6] = bf_lo(w.w); g[7] = bf_hi(w.w); }
    DI void rescale(Acc& acc, const Unit& u, int t, int wr, int wc, int fr, int fq) const {
        int row0 = u.pm * 256 + wr * 64 + fr, col0 = u.pn * 256 + wc * 32 + 8 * fq;
        asm volatile("" : "+v"(row0), "+v"(col0));
        const int go = (t == 16) ? 0 : 1024, ri = (t == 16) ? 0 : 3, g = (t == 24) ? 0 : (t == 32) ? 1 : 2;
        asm volatile("s_nop 15" ::: "memory");
#pragma unroll
        for (int ai = 0; ai < 2; ++ai)
#pragma unroll
          for (int mp = 0; mp < 2; ++mp) {
            float f[2][2][8];
            if (t == 16 || t == 48) {
                u32x4 ga[2][2], gb[2][2]; float rsv[2];
#pragma unroll
                for (int mm = 0; mm < 2; ++mm) { const int row = row0 + ai * 128 + (2 * mp + mm) * 16; const bf16_t* gp = gates + (size_t)row * 3072 + col0 + go; rsv[mm] = rstd[(size_t)row * 4 + ri];
#pragma unroll
                    for (int bj = 0; bj < 2; ++bj) { ga[mm][bj] = *(const u32x4*)(gp + bj * 128); gb[mm][bj] = *(const u32x4*)(gp + 1024 + bj * 128); } }
#pragma unroll
                for (int mm = 0; mm < 2; ++mm)
#pragma unroll
                    for (int bj = 0; bj < 2; ++bj) { float a[8], b[8]; unpack8(ga[mm][bj], a); unpack8(gb[mm][bj], b);
#pragma unroll
                        for (int j = 0; j < 8; ++j) f[mm][bj][j] = (t == 16) ? a[j] * fast_rcp(b[j] * rsv[mm]) : a[j] * rsv[mm] * fast_rcp(b[j]); }
            } else {
#pragma unroll
                for (int mm = 0; mm < 2; ++mm) { const float* rp = rstd + (size_t)(row0 + ai * 128 + (2 * mp + mm) * 16) * 4 + g; const float fr_ = rp[0] * fast_rcp(rp[1]);
#pragma unroll
                    for (int bj = 0; bj < 2; ++bj)
#pragma unroll
                        for (int j = 0; j < 8; ++j) f[mm][bj][j] = fr_; }
            }
#pragma unroll
            for (int mm = 0; mm < 2; ++mm)
#pragma unroll
                for (int bj = 0; bj < 2; ++bj)
#pragma unroll
                    for (int e = 0; e < 4; ++e) { const int m = 2 * mp + mm;
                        asm volatile("v_mul_f32 %0, %0, %1" : "+v"(acc[ai][bj][m][0][e]) : "v"(f[mm][bj][e]));
                        asm volatile("v_mul_f32 %0, %0, %1" : "+v"(acc[ai][bj][m][1][e]) : "v"(f[mm][bj][4 + e])); }
            asm volatile("" ::: "memory");
          }
    }
    DI void unpack8(const u32x4 w, float (&g)[8]) const { g[0] = bf_lo(w.x); g[1] = bf_hi(w.x); g[2] = bf_lo(w.y); g[3] = bf_hi(w.y); g[4] = bf_lo(w.z); g[5] = bf_hi(w.z); g[6] = bf_lo(w.w); g[7] = bf_hi(w.w); }
    DI void operator()(const Acc& acc, const Unit& u, int wr, int wc, int fr, int fq) const {
        int row0 = u.pm * 256 + wr * 64 + fr, col0 = u.pn * 256 + wc * 32 + 8 * fq;
        asm volatile("" : "+v"(row0), "+v"(col0));
#pragma unroll
        for (int ai = 0; ai < 2; ++ai)
#pragma unroll
          for (int mp = 0; mp < 2; ++mp) {
            u32x4 gg[2][2]; float r3[2];
#pragma unroll
            for (int mm = 0; mm < 2; ++mm) { const int row = row0 + ai * 128 + (2 * mp + mm) * 16; r3[mm] = rstd[(size_t)row * 4 + 3]; const bf16_t* gp = gates + (size_t)row * 3072 + col0 + last_seg * 1024;
#pragma unroll
                for (int bj = 0; bj < 2; ++bj) gg[mm][bj] = *(const u32x4*)(gp + bj * 128); }
#pragma unroll
            for (int mm = 0; mm < 2; ++mm) { const int m = 2 * mp + mm; const int row = row0 + ai * 128 + m * 16; bf16_t* op = merged + (size_t)row * 1024 + col0;
#pragma unroll
                for (int bj = 0; bj < 2; ++bj) { float g[8]; unpack8(gg[mm][bj], g); const float s = (last_seg == 1) ? r3[mm] : 1.0f;
                    f32x4 v0 = acc[ai][bj][m][0], v1 = acc[ai][bj][m][1];
                    u32x4 w; w.x = pk2(v0[0] * g[0] * s, v0[1] * g[1] * s); w.y = pk2(v0[2] * g[2] * s, v0[3] * g[3] * s); w.z = pk2(v1[0] * g[4] * s, v1[1] * g[5] * s); w.w = pk2(v1[2] * g[6] * s, v1[3] * g[7] * s);
                    *(u32x4*)(op + bj * 128) = w; } }
            asm volatile("" ::: "memory");
          }
    }
};

struct EpiOut {
    static constexpr bool SEGMENTED = false;
    const float* x; float* out;
    DI void operator()(const Acc& acc, const Unit& u, int wr, int wc, int fr, int fq) const {
        const int row0 = u.pm * 256 + wr * 64 + fr, col0 = u.pn * 256 + wc * 32 + 8 * fq;
#pragma unroll
        for (int ai = 0; ai < 2; ++ai)
#pragma unroll
            for (int m = 0; m < 4; ++m) { const size_t off = (size_t)(row0 + ai * 128 + m * 16) * 1024 + col0;
#pragma unroll
                for (int bj = 0; bj < 2; ++bj) { const f32x4 x0 = *(const f32x4*)(x + off + bj * 128), x1 = *(const f32x4*)(x + off + bj * 128 + 4);
                    *(f32x4*)(out + off + bj * 128) = x0 + acc[ai][bj][m][0]; *(f32x4*)(out + off + bj * 128 + 4) = x1 + acc[ai][bj][m][1]; } }
    }
};

struct SchedMoE {
    int G, c, NC, tlo, thi; const LAS int* tstart; const LAS int* cnt; const int* tokl; const char* wbase; size_t wexp; int reps; unsigned rowb; unsigned ldbb;
    DI bool next(int i, Unit& u) const {
        const int n = (thi - tlo) * NC; int L = i * G + c; if (L >= n * reps) return false; L %= n;
        { const int q = n / 8, r = n % 8, xcd = L % 8, off = L / 8; L = (xcd < r ? xcd * (q + 1) : r * (q + 1) + (xcd - r) * q) + off; }
        const int rt = tlo + L / NC; u.pn = L % NC; u.pm = rt; int e = 0;
        for (int j = 1; j < NEXP; ++j) e += (tstart[j] <= rt) ? 1 : 0;
        u.aux = __builtin_amdgcn_readfirstlane(e); u.kind = 0; return true;
    }
    DI unsigned arow(const Unit& u, int r) const {
        if (tokl) { const int e = u.aux, idx = (u.pm - tstart[e]) * 256 + r; const int tok = idx < cnt[e] ? tokl[(size_t)e * T + idx] : 0; return (unsigned)tok * rowb; }
        return (unsigned)((u.pm - tlo) * 256 + r) * rowb;
    }
    DI const char* bptr(const Unit& u) const { return wbase + (size_t)u.aux * wexp + (size_t)u.pn * 256 * ldbb; }
};
struct EpiGU {
    static constexpr bool SEGMENTED = false;
    unsigned char* actm; const float *bg, *bu; int tlo;
    DI void operator()(const Acc& acc, const Unit& u, int wr, int wc, int fr, int fq) const {
        const int row0 = (u.pm - tlo) * 256 + wr * 64 + fr, col = u.pn * 128 + wc * 32 + 8 * fq; const size_t eb = (size_t)u.aux * 1024 + col;
        const f32x4 g0 = *(const f32x4*)(bg + eb), g1 = *(const f32x4*)(bg + eb + 4), u0 = *(const f32x4*)(bu + eb), u1 = *(const f32x4*)(bu + eb + 4);
#pragma unroll
        for (int ai = 0; ai < 2; ++ai)
#pragma unroll
            for (int m = 0; m < 4; ++m) { f32x4 a0 = acc[ai][0][m][0] + g0, a1 = acc[ai][0][m][1] + g1, b0 = acc[ai][1][m][0] + u0, b1 = acc[ai][1][m][1] + u1;
                for (int e = 0; e < 4; ++e) { float g = fminf(a0[e], 7.f), uu = fminf(fmaxf(b0[e], -7.f), 7.f); a0[e] = (uu + 1.f) * g * sigmoidf_(1.702f * g);
                                              g = fminf(a1[e], 7.f); uu = fminf(fmaxf(b1[e], -7.f), 7.f); a1[e] = (uu + 1.f) * g * sigmoidf_(1.702f * g); }
                u32x2 w; w.x = pk4_fp8(a0[0], a0[1], a0[2], a0[3]); w.y = pk4_fp8(a1[0], a1[1], a1[2], a1[3]);
                *(u32x2*)(actm + (size_t)(row0 + ai * 128 + m * 16) * 1024 + col) = w; }
    }
};
struct EpiDown {
    static constexpr bool SEGMENTED = false;
    bf16_t* y; const float* bd; int tlo;
    DI void operator()(const Acc& acc, const Unit& u, int wr, int wc, int fr, int fq) const {
        const int row0 = (u.pm - tlo) * 256 + wr * 64 + fr, col0 = u.pn * 256 + wc * 32 + 8 * fq; const float* bp = bd + (size_t)u.aux * 1024 + col0;
        f32x4 bv[2][2];
#pragma unroll
        for (int bj = 0; bj < 2; ++bj) { bv[bj][0] = *(const f32x4*)(bp + bj * 128); bv[bj][1] = *(const f32x4*)(bp + bj * 128 + 4); }
#pragma unroll
        for (int ai = 0; ai < 2; ++ai)
#pragma unroll
            for (int m = 0; m < 4; ++m) { bf16_t* rowp = y + (size_t)(row0 + ai * 128 + m * 16) * 1024 + col0;
#pragma unroll
                for (int bj = 0; bj < 2; ++bj) { const f32x4 v0 = acc[ai][bj][m][0] + bv[bj][0], v1 = acc[ai][bj][m][1] + bv[bj][1];
                    u32x4 w; w.x = pk2(v0[0], v0[1]); w.y = pk2(v0[2], v0[3]); w.z = pk2(v1[0], v1[1]); w.w = pk2(v1[2], v1[3]);
                    *(u32x4*)(rowp + bj * 128) = w; } }
    }
};
struct TrItem { const float* W; int Ns, k0, sc0, sc1; void* dst; int dpitch; const float* kscale; float mul; int fp8; };
DI void tr_load(const TrItem& it, f32x4 (&v)[16], int lane) {
    const int cl = lane & 15, kl = lane >> 4, sc = (cl < 8) ? it.sc0 : it.sc1, col = sc + 4 * (cl & 7);
#pragma unroll
    for (int i = 0; i < 16; ++i) { v[i] = (f32x4){0.f, 0.f, 0.f, 0.f}; if (sc >= 0) v[i] = *(const f32x4*)(it.W + (size_t)(it.k0 + 4 * i + kl) * it.Ns + col); }
}
DI void tr_store(const TrItem& it, const f32x4 (&v)[16], LAS float* scr, int lane) {
    const int cl = lane & 15, kl = lane >> 4;
#pragma unroll
    for (int i = 0; i < 16; ++i) { const int kk = 4 * i + kl; f32x4 x = v[i] * it.mul; if (it.kscale) x *= it.kscale[it.k0 + kk]; LAS float* p = scr + kk * 65 + 4 * cl; p[0] = x[0]; p[1] = x[1]; p[2] = x[2]; p[3] = x[3]; }
    asm volatile("s_waitcnt lgkmcnt(0)" ::: "memory");
    if (it.fp8) { const int c = lane & 3; unsigned char* dst = (unsigned char*)it.dst;
#pragma unroll
        for (int j = 0; j < 4; ++j) { const int n = (lane >> 2) + 16 * j; const LAS float* s = scr + (16 * c) * 65 + n;
            u32x4 o; o.x = pk4_fp8(s[0 * 65], s[1 * 65], s[2 * 65], s[3 * 65]); o.y = pk4_fp8(s[4 * 65], s[5 * 65], s[6 * 65], s[7 * 65]);
            o.z = pk4_fp8(s[8 * 65], s[9 * 65], s[10 * 65], s[11 * 65]); o.w = pk4_fp8(s[12 * 65], s[13 * 65], s[14 * 65], s[15 * 65]);
            *(u32x4*)(dst + (size_t)n * it.dpitch + 16 * c) = o; }
    } else { const int c = lane & 7; bf16_t* dst = (bf16_t*)it.dst;
#pragma unroll
        for (int j = 0; j < 8; ++j) { const int n = (lane >> 3) + 8 * j; const LAS float* s = scr + (8 * c) * 65 + n;
            u32x4 o; o.x = pk2(s[0 * 65], s[1 * 65]); o.y = pk2(s[2 * 65], s[3 * 65]); o.z = pk2(s[4 * 65], s[5 * 65]); o.w = pk2(s[6 * 65], s[7 * 65]);
            *(u32x4*)(dst + (size_t)n * it.dpitch + 8 * c) = o; }
    }
    asm volatile("s_waitcnt lgkmcnt(0)" ::: "memory");
}
DI int win_src_col(int nb) {
    const int tile = nb >> 3, sub = nb & 7;
    if (tile < TL_V) { const int base = tile < TL_K ? 256 * tile : 1024 + 256 * (tile - TL_K); return base + 32 * (2 * (sub & 3) + (sub >> 2)); }
    if (tile < TL_Z) return 2048 + 256 * (tile - TL_V) + 32 * sub;
    if (tile < TL_XBC) return 3072 + 256 * (tile - TL_Z) + 32 * sub;
    if (tile < TL_DT) return 5120 + 256 * (tile - TL_XBC) + 32 * sub;
    if (tile == TL_DT) return sub == 0 ? 8192 : -1;
    if (tile < TL_G) return 8224 + 256 * (tile - TL_QX) + 32 * sub;
    return 9248 + 256 * (tile - TL_G) + 32 * sub;
}
template <int NR> DI void rms_rows_to_bf16(const float* x, bf16_t* o, size_t row_stride, const float* gain, int lane) {
    f32x4 v[NR][4]; float s[NR];
#pragma unroll
    for (int r = 0; r < NR; ++r) { const f32x4* xr = (const f32x4*)(x + (size_t)r * row_stride * 1024) + lane; s[r] = 0.f;
#pragma unroll
        for (int j = 0; j < 4; ++j) { v[r][j] = xr[64 * j]; } }
#pragma unroll
    for (int r = 0; r < NR; ++r) {
#pragma unroll
        for (int j = 0; j < 4; ++j) s[r] += (v[r][j].x * v[r][j].x + v[r][j].y * v[r][j].y) + (v[r][j].z * v[r][j].z + v[r][j].w * v[r][j].w);
        s[r] = __builtin_amdgcn_rsqf(wave_sum(s[r]) * (1.f / 1024.f) + EPS); }
    const f32x4* gr = (const f32x4*)gain + lane;
#pragma unroll
    for (int j = 0; j < 4; ++j) { const f32x4 g = gr[64 * j];
#pragma unroll
        for (int r = 0; r < NR; ++r) { u32x2 w; w.x = pk2(v[r][j].x * s[r] * g.x, v[r][j].y * s[r] * g.y); w.y = pk2(v[r][j].z * s[r] * g.z, v[r][j].w * s[r] * g.w); ((u32x2*)(o + (size_t)r * row_stride * 1024) + lane)[64 * j] = w; } }
}


template <int NR> DI void rms_rows_to_fp8(const float* x, unsigned char* o, const float* gain, int lane) {
    f32x4 v[NR][4]; float s[NR];
#pragma unroll
    for (int r = 0; r < NR; ++r) { const f32x4* xr = (const f32x4*)(x + (size_t)r * 1024) + lane; s[r] = 0.f;
#pragma unroll
        for (int j = 0; j < 4; ++j) { v[r][j] = xr[64 * j]; } }
#pragma unroll
    for (int r = 0; r < NR; ++r) {
#pragma unroll
        for (int j = 0; j < 4; ++j) s[r] += (v[r][j].x * v[r][j].x + v[r][j].y * v[r][j].y) + (v[r][j].z * v[r][j].z + v[r][j].w * v[r][j].w);
        s[r] = __builtin_amdgcn_rsqf(wave_sum(s[r]) * (1.f / 1024.f) + EPS); }
    const f32x4* gr = (const f32x4*)gain + lane;
#pragma unroll
    for (int j = 0; j < 4; ++j) { const f32x4 g = gr[64 * j];
#pragma unroll
        for (int r = 0; r < NR; ++r) ((unsigned*)(o + (size_t)r * 1024) + lane)[64 * j] = pk4_fp8(v[r][j].x * s[r] * g.x, v[r][j].y * s[r] * g.y, v[r][j].z * s[r] * g.z, v[r][j].w * s[r] * g.w); }
}

DI int crow(int r, int hi) { return (r & 3) + 8 * (r >> 2) + 4 * hi; }
DI s16x4 vtr(const LAS unsigned char* p) { return __builtin_bit_cast(s16x4, __builtin_amdgcn_ds_read_tr16_b64_v4i16((LAS v4i16_t*)p)); }
#define MFMA32(a, b, c) __builtin_amdgcn_mfma_f32_32x32x16_bf16((a), (b), (c), 0, 0, 0)
#define MFMA16(a, b, c) __builtin_amdgcn_mfma_f32_16x16x32_bf16((a), (b), (c), 0, 0, 0)
DI void tile_load(u32x4 (&r)[4], const bf16_t* g, size_t pitch, int tid) {
#pragma unroll
    for (int i = 0; i < 4; ++i) { const int q = tid + 512 * i, row = q >> 5, ch = q & 31; r[i] = *(const u32x4*)(g + (size_t)row * pitch + ch * 8); }
}
DI void tile_store_k(LAS unsigned char* dst, const u32x4 (&r)[4], int tid) {
#pragma unroll
    for (int i = 0; i < 4; ++i) { const int q = tid + 512 * i, row = q >> 5, ch = q & 31; *(LAS u32x4*)(dst + row * 512 + ((ch ^ (row & 15)) << 4)) = r[i]; }
}
DI void tile_store_v(LAS unsigned char* dst, const u32x4 (&r)[4], int tid) {
#pragma unroll
    for (int i = 0; i < 4; ++i) { const int q = tid + 512 * i, row = q >> 5, ch = q & 31; *(LAS u32x4*)(dst + row * 512 + ((((ch >> 2) ^ (row & 3)) * 4 + (ch & 3)) << 4)) = r[i]; }
}
constexpr int AT_K = 0, AT_V = 32768, AT_BIAS = 65536, AT_BIAS_STRIDE = 260;

constexpr float SM_THR = 8.0f;
DI bool softmax_tile(f32x16& s0, f32x16& s1, float& m, float& l, bf16x8 (&pa)[4], float& alpha) {
    float mx = fmaxf(s0[0], s1[0]);
#pragma unroll
    for (int r = 1; r < 16; ++r) mx = fmaxf(mx, fmaxf(s0[r], s1[r]));
    mx = fmaxf(mx, __shfl_xor(mx, 32));
    bool moved = false; alpha = 1.0f;
    if (__builtin_expect(__any(mx > SM_THR), 0)) {
        const float dl = fmaxf(mx, 0.f); m += dl; alpha = fast_exp2(-dl); l *= alpha; moved = true;
#pragma unroll
        for (int r = 0; r < 16; ++r) { s0[r] -= dl; s1[r] -= dl; }
    }
    float sum = 0.f;
#pragma unroll
    for (int r = 0; r < 16; ++r) { s0[r] = fast_exp2(s0[r]); s1[r] = fast_exp2(s1[r]); sum += s0[r] + s1[r]; }
    l += sum;
    u32x4 w;
    w.x = pk2(s0[0], s0[1]); w.y = pk2(s0[2], s0[3]); w.z = pk2(s0[4], s0[5]); w.w = pk2(s0[6], s0[7]); pa[0] = __builtin_bit_cast(bf16x8, w);
    w.x = pk2(s0[8], s0[9]); w.y = pk2(s0[10], s0[11]); w.z = pk2(s0[12], s0[13]); w.w = pk2(s0[14], s0[15]); pa[1] = __builtin_bit_cast(bf16x8, w);
    w.x = pk2(s1[0], s1[1]); w.y = pk2(s1[2], s1[3]); w.z = pk2(s1[4], s1[5]); w.w = pk2(s1[6], s1[7]); pa[2] = __builtin_bit_cast(bf16x8, w);
    w.x = pk2(s1[8], s1[9]); w.y = pk2(s1[10], s1[11]); w.z = pk2(s1[12], s1[13]); w.w = pk2(s1[14], s1[15]); pa[3] = __builtin_bit_cast(bf16x8, w);
    return moved;
}
DI bf16x8 v_frag(const LAS unsigned char* vt, int s, int colbyte0, int lane) {
    const int hi = lane >> 5, q_ = (lane & 15) >> 2, p_ = lane & 3, blk = (lane >> 4) & 1;
    const int cb = colbyte0 + blk * 32 + p_ * 8, u = cb >> 6, within = cb & 63;
    const int R = 16 * s + 4 * hi + q_;
    const s16x4 lo = vtr(vt + R * 512 + ((u ^ q_) << 6) + within);
    const s16x4 h4 = vtr(vt + (R + 8) * 512 + ((u ^ q_) << 6) + within);
    return __builtin_shufflevector(lo, h4, 0, 1, 2, 3, 4, 5, 6, 7);
}

DI void attnA_unit(LAS unsigned char* lds, int b, int c, int hq, bf16_t* act, const bf16_t* ka, const bf16_t* va, bf16_t* outp, size_t opitch) {
    const int tid = threadIdx.x, lane = tid & 63, wid = __builtin_amdgcn_readfirstlane(tid >> 6), hl = wid >> 1, qh = wid & 1, head = 4 * hq + hl, l31 = lane & 31, hi = lane >> 5;
    const size_t trow = (size_t)b * SEQ + 64 * c + 32 * qh + l31;
    bf16_t* qp = act + trow * ACT_P + 64 * head;
    bf16x8 qf[4];
#pragma unroll
    for (int d0 = 0; d0 < 4; ++d0) qf[d0] = *(const bf16x8*)(qp + 16 * d0 + 8 * hi);
    f32x16 o0, o1;
#pragma unroll
    for (int r = 0; r < 16; ++r) { o0[r] = 0.f; o1[r] = 0.f; }
    float m = 0.f, l = 0.f;
    const int kc0 = c < 8 ? 0 : c - 8;
    const LAS float* bias = (const LAS float*)(lds + AT_BIAS) + head * AT_BIAS_STRIDE;
    const float b256 = bias[256];
    u32x4 rk[4], rv[4];
    const bf16_t* kb = ka + ((size_t)b * SEQ + 64 * kc0) * 1024 + 256 * hq; const bf16_t* vb = va + ((size_t)b * SEQ + 64 * kc0) * 1024 + 256 * hq;
    tile_load(rk, kb, 1024, tid); tile_load(rv, vb, 1024, tid);
    const int qi = 32 * qh + l31;
    for (int kc = kc0; kc <= c; ++kc) {
        __syncthreads();
        tile_store_k(lds + AT_K, rk, tid); tile_store_v(lds + AT_V, rv, tid);
        if (kc < c) { kb += 64 * 1024; vb += 64 * 1024; tile_load(rk, kb, 1024, tid); tile_load(rv, vb, 1024, tid); }
        __syncthreads();
        const int j = c - kc;
        f32x16 s0, s1;
        if (j >= 3) { const float c0 = b256 - m;
#pragma unroll
            for (int r = 0; r < 16; ++r) { s0[r] = c0; s1[r] = c0; }
        } else {
#pragma unroll
            for (int r = 0; r < 16; ++r) { const int rel0 = 64 * j + qi - crow(r, hi); s0[r] = bias[min(rel0, 128) + 128] - m; s1[r] = bias[min(rel0 - 32, 128) + 128] - m; }
        }
#pragma unroll
        for (int d0 = 0; d0 < 4; ++d0) {
            const int ch = 8 * hl + 2 * d0 + hi;
            const bf16x8 k0 = *(const LAS bf16x8*)(lds + AT_K + l31 * 512 + ((ch ^ (l31 & 15)) << 4));
            const bf16x8 k1 = *(const LAS bf16x8*)(lds + AT_K + (32 + l31) * 512 + ((ch ^ (l31 & 15)) << 4));
            s0 = MFMA32(k0, qf[d0], s0); s1 = MFMA32(k1, qf[d0], s1);
        }
        bf16x8 pa[4]; float alpha;
        if (softmax_tile(s0, s1, m, l, pa, alpha)) {
#pragma unroll
            for (int r = 0; r < 16; ++r) { o0[r] *= alpha; o1[r] *= alpha; } }
#pragma unroll
        for (int s = 0; s < 4; ++s) {
            const bf16x8 v0 = v_frag(lds + AT_V, s, (64 * hl) * 2, lane), v1 = v_frag(lds + AT_V, s, (64 * hl + 32) * 2, lane);
            o0 = MFMA32(v0, pa[s], o0); o1 = MFMA32(v1, pa[s], o1);
        }
    }
    const float lt = l + __shfl_xor(l, 32), inv = fast_rcp(lt);
#pragma unroll
    for (int rg = 0; rg < 4; ++rg) {
        u32x2 w0, w1; w0.x = pk2(o0[4 * rg] * inv, o0[4 * rg + 1] * inv); w0.y = pk2(o0[4 * rg + 2] * inv, o0[4 * rg + 3] * inv);
        w1.x = pk2(o1[4 * rg] * inv, o1[4 * rg + 1] * inv); w1.y = pk2(o1[4 * rg + 2] * inv, o1[4 * rg + 3] * inv);
        bf16_t* op = outp + trow * opitch + 64 * head; *(u32x2*)(op + 8 * rg + 4 * hi) = w0; *(u32x2*)(op + 32 + 8 * rg + 4 * hi) = w1;
    }
}

constexpr int AT_Q = 65536;
DI void attnC_phase(LAS unsigned char* lds, int vcu, int G, bf16_t* act, const bf16_t* kx, const bf16_t* memkv, bf16_t* outp, size_t opitch) {
    const int tid = threadIdx.x, lane = tid & 63, wid = __builtin_amdgcn_readfirstlane(tid >> 6), rg = wid >> 1, dh = wid & 1, l31 = lane & 31, hi = lane >> 5;
    constexpr int NU = NBATCH * 4 * 32;
    const int upw = (NU + G - 1) / G, u0 = vcu * upw, u1 = (u0 + upw < NU) ? u0 + upw : NU;
    if (u0 >= NU) return;
    const int nsteps = (u1 - u0) * 4;
    u32x4 rk[4], rv[4];
    { const int b = u0 >> 7, hx = (u0 >> 5) & 3;
      tile_load(rk, kx + ((size_t)b * MEMLEN) * 1024 + 256 * hx, 1024, tid); tile_load(rv, memkv + ((size_t)b * MEMLEN) * 2048 + 1024 + 256 * hx, 2048, tid); }
    f32x16 o[4]; float m = 0.f, l = 0.f, rstd = 1.f;
    for (int n = 0; n < nsteps; ++n) {
        const int u = u0 + (n >> 2), j = n & 3, rb = u & 31, hx = (u >> 5) & 3, b = u >> 7;
        const size_t trow = (size_t)b * SEQ + 128 * rb + 32 * rg + l31;
        u32x4 rq[8];
        if (j == 0) {
#pragma unroll
            for (int i = 0; i < 8; ++i) { const int q = tid + 512 * i, row = q >> 5, ch = q & 31; rq[i] = *(const u32x4*)(act + ((size_t)b * SEQ + 128 * rb + row) * ACT_P + 3072 + 256 * hx + ch * 8); }
#pragma unroll
            for (int i = 0; i < 4; ++i)
#pragma unroll
                for (int r = 0; r < 16; ++r) o[i][r] = 0.f;
            m = 0.f; l = 0.f;
        }
        __syncthreads();
        tile_store_k(lds + AT_K, rk, tid); tile_store_v(lds + AT_V, rv, tid);
        if (j == 0) {
#pragma unroll
            for (int i = 0; i < 8; ++i) { const int q = tid + 512 * i, row = q >> 5, ch = q & 31; *(LAS u32x4*)(lds + AT_Q + row * 512 + ((ch ^ (row & 15)) << 4)) = rq[i]; }
        }
        if (n + 1 < nsteps) { const int un = u0 + ((n + 1) >> 2), jn = (n + 1) & 3, hxn = (un >> 5) & 3, bn = un >> 7;
            tile_load(rk, kx + ((size_t)bn * MEMLEN + 64 * jn) * 1024 + 256 * hxn, 1024, tid); tile_load(rv, memkv + ((size_t)bn * MEMLEN + 64 * jn) * 2048 + 1024 + 256 * hxn, 2048, tid); }
        __syncthreads();
        f32x16 s0, s1;
#pragma unroll
        for (int r = 0; r < 16; ++r) { s0[r] = 0.f; s1[r] = 0.f; }
        float ssq = 0.f;
#pragma unroll
        for (int d0 = 0; d0 < 16; ++d0) {
            const int ch = 2 * d0 + hi;
            const bf16x8 qfr = *(const LAS bf16x8*)(lds + AT_Q + (32 * rg + l31) * 512 + ((ch ^ (l31 & 15)) << 4));
            const bf16x8 k0 = *(const LAS bf16x8*)(lds + AT_K + l31 * 512 + ((ch ^ (l31 & 15)) << 4));
            const bf16x8 k1 = *(const LAS bf16x8*)(lds + AT_K + (32 + l31) * 512 + ((ch ^ (l31 & 15)) << 4));
            if (j == 0) {
#pragma unroll
                for (int e = 0; e < 8; ++e) { const float v = bf2f((bf16_t)qfr[e]); ssq += v * v; } }
            s0 = MFMA32(k0, qfr, s0); s1 = MFMA32(k1, qfr, s1);
        }
        if (j == 0) { ssq += __shfl_xor(ssq, 32); rstd = __builtin_amdgcn_rsqf(ssq * (1.f / 256.f) + EPS); }
#pragma unroll
        for (int r = 0; r < 16; ++r) { s0[r] = s0[r] * rstd - m; s1[r] = s1[r] * rstd - m; }
        bf16x8 pa[4]; float alpha;
        if (softmax_tile(s0, s1, m, l, pa, alpha)) {
#pragma unroll
            for (int i = 0; i < 4; ++i)
#pragma unroll
                for (int r = 0; r < 16; ++r) o[i][r] *= alpha; }
#pragma unroll
        for (int s = 0; s < 4; ++s)
#pragma unroll
            for (int i = 0; i < 4; ++i) { const bf16x8 vf = v_frag(lds + AT_V, s, (128 * dh + 32 * i) * 2, lane); o[i] = MFMA32(vf, pa[s], o[i]); }
        if (j == 3) {
            const float lt = l + __shfl_xor(l, 32), inv = fast_rcp(lt);
            bf16_t* op = outp + trow * opitch + 256 * hx + 128 * dh;
#pragma unroll
            for (int i = 0; i < 4; ++i)
#pragma unroll
                for (int g4 = 0; g4 < 4; ++g4) { u32x2 w; w.x = pk2(o[i][4 * g4] * inv, o[i][4 * g4 + 1] * inv); w.y = pk2(o[i][4 * g4 + 2] * inv, o[i][4 * g4 + 3] * inv);
                    *(u32x2*)(op + 32 * i + 8 * g4 + 4 * hi) = w; }
        }
    }
    __syncthreads();
}

constexpr int MB_XDT = 0, MB_XDTW = 9216, MB_BM = 18432, MB_CM = 35840, MB_YD = 53248, MB_YO = 70656, MB_ACS = 88064, MB_YSTR = 272;
DI int mb_b256(int row, int col) { return row * 272 + col * 2; }
DI int mb_b128(int row, int col) { return row * 144 + col * 2; }
template <bool W256> DI bf16x8 tr_pair(const LAS unsigned char* base, int row_lo, int row_hi, int col0, int lane) {
    const int i = lane & 15, r = i >> 2, c = col0 + 4 * (i & 3);
    const s16x4 lo = vtr(base + (W256 ? mb_b256(row_lo + r, c) : mb_b128(row_lo + r, c))), h4 = vtr(base + (W256 ? mb_b256(row_hi + r, c) : mb_b128(row_hi + r, c)));
    return __builtin_shufflevector(lo, h4, 0, 1, 2, 3, 4, 5, 6, 7);
}
DI void bcconv_phase(int vcu, int G, const bf16_t* xbc, bf16_t* bc, const float* conv_w, const float* conv_b, const float* dtp, float* acsp, const float* a_log) {
    {
        const int lane = threadIdx.x & 63, wv = threadIdx.x >> 6;
        for (int ck = vcu * 8 + wv; ck < T / 64; ck += G * 8) {
            const float* dr = dtp + ((size_t)ck * 64 + lane) * 32; float* orow = acsp + ((size_t)ck * 64 + lane) * 32;
#pragma unroll
            for (int q = 0; q < 8; ++q) { f32x4 v = *(const f32x4*)(dr + 4 * q); const f32x4 al = *(const f32x4*)(a_log + 4 * q);
#pragma unroll
                for (int e = 0; e < 4; ++e) { float a = -v[e] * __expf(al[e]);
#pragma unroll
                    for (int o = 1; o < 64; o <<= 1) { const float u = __shfl_up(a, o); if (lane >= o) a += u; }
                    v[e] = a; }
                *(f32x4*)(orow + 4 * q) = v; }
        }
    }
    for (int task = vcu * 512 + threadIdx.x; task < (T / 16) * 128; task += G * 512) {
        const int cc = task & 127, run = task >> 7, g = cc >> 5, w = cc & 31;
        const int scol = (w < 16 ? 2048 + 128 * g + 8 * w : 2560 + 128 * g + 8 * (w - 16));
        const int t0 = run * 16, pos0 = t0 & (SEQ - 1);
        float cw[4][8], cb[8];
#pragma unroll
        for (int e = 0; e < 8; ++e) { cb[e] = conv_b[scol + e];
#pragma unroll
            for (int i = 0; i < 4; ++i) cw[i][e] = conv_w[i * 3072 + scol + e]; }
        float win[3][8];
#pragma unroll
        for (int k = 0; k < 3; ++k) { u32x4 wv = (u32x4){0u, 0u, 0u, 0u}; if (pos0 + k - 3 >= 0) wv = *(const u32x4*)(xbc + (size_t)(t0 + k - 3) * 3072 + scol);
            win[k][0] = bf_lo(wv.x); win[k][1] = bf_hi(wv.x); win[k][2] = bf_lo(wv.y); win[k][3] = bf_hi(wv.y); win[k][4] = bf_lo(wv.z); win[k][5] = bf_hi(wv.z); win[k][6] = bf_lo(wv.w); win[k][7] = bf_hi(wv.w); }
#pragma unroll 4
        for (int k = 0; k < 16; ++k) {
            const u32x4 wv = *(const u32x4*)(xbc + (size_t)(t0 + k) * 3072 + scol);
            const float cur[8] = {bf_lo(wv.x), bf_hi(wv.x), bf_lo(wv.y), bf_hi(wv.y), bf_lo(wv.z), bf_hi(wv.z), bf_lo(wv.w), bf_hi(wv.w)};
            float o[8];
#pragma unroll
            for (int e = 0; e < 8; ++e) { o[e] = silu_(cb[e] + cw[0][e] * win[0][e] + cw[1][e] * win[1][e] + cw[2][e] * win[2][e] + cw[3][e] * cur[e]); win[0][e] = win[1][e]; win[1][e] = win[2][e]; win[2][e] = cur[e]; }
            u32x4 ov; ov.x = pk2(o[0], o[1]); ov.y = pk2(o[2], o[3]); ov.z = pk2(o[4], o[5]); ov.w = pk2(o[6], o[7]);
            *(u32x4*)(bc + (size_t)(t0 + k) * 1024 + 8 * cc) = ov;
        }
    }
}
DI void mamba_unit(LAS unsigned char* lds, int b, int h, const bf16_t* xbc, const bf16_t* bc, const float* dtp, const float* acsp, bf16_t* act, float* ssq_out, bf16_t* outp, size_t opitch,
                   const float* conv_w, const float* conv_b, const float* a_log, const float* d_skip) {
    const int tid = threadIdx.x, lane = tid & 63, wid = __builtin_amdgcn_readfirstlane(tid >> 6), fr = lane & 15, fq = lane >> 4, g = h >> 3;
    const float A_h = -__expf(a_log[h]), D_h = d_skip[h];
    const int l = tid >> 3, pc = tid & 7, xcol = 64 * h + 8 * pc;
    float cw[4][8], cbias[8];
#pragma unroll
    for (int e = 0; e < 8; ++e) { cbias[e] = conv_b[xcol + e];
#pragma unroll
        for (int i = 0; i < 4; ++i) cw[i][e] = conv_w[i * 3072 + xcol + e]; }
    f32x4 Z[8];
#pragma unroll
    for (int i = 0; i < 8; ++i) Z[i] = (f32x4){0.f, 0.f, 0.f, 0.f};
    LAS float* acs = (LAS float*)(lds + MB_ACS);
    const int frow0 = tid >> 4, fch = tid & 15;
    u32x4 xr[4], bcr[4]; float dt_l, acs_l, acs63;
    const size_t tb = (size_t)b * SEQ;
#define MB_LOAD(c_) do { const int p0_ = 64 * (c_); \
        _Pragma("unroll") for (int i_ = 0; i_ < 4; ++i_) { const int pos_ = p0_ + l - 3 + i_; xr[i_] = (u32x4){0u, 0u, 0u, 0u}; if (pos_ >= 0) xr[i_] = *(const u32x4*)(xbc + (tb + pos_) * 3072 + xcol); } \
        _Pragma("unroll") for (int i_ = 0; i_ < 4; ++i_) bcr[i_] = *(const u32x4*)(bc + (tb + p0_ + frow0 + 32 * (i_ & 1)) * 1024 + 256 * g + 128 * (i_ >> 1) + 8 * fch); \
        dt_l = dtp[(tb + p0_ + l) * 32 + h]; acs_l = acsp[(tb + p0_ + l) * 32 + h]; acs63 = acsp[(tb + p0_ + 63) * 32 + h]; } while (0)
    MB_LOAD(0);
    for (int c = 0; c < 64; ++c) {
        const size_t t0 = tb + 64 * c;
        if (pc == 0) acs[l] = acs_l;
        float xs[8];
        { float r[4][8];
#pragma unroll
          for (int i = 0; i < 4; ++i) { r[i][0] = bf_lo(xr[i].x); r[i][1] = bf_hi(xr[i].x); r[i][2] = bf_lo(xr[i].y); r[i][3] = bf_hi(xr[i].y); r[i][4] = bf_lo(xr[i].z); r[i][5] = bf_hi(xr[i].z); r[i][6] = bf_lo(xr[i].w); r[i][7] = bf_hi(xr[i].w); }
#pragma unroll
          for (int e = 0; e < 8; ++e) xs[e] = silu_(cbias[e] + cw[0][e] * r[0][e] + cw[1][e] * r[1][e] + cw[2][e] * r[2][e] + cw[3][e] * r[3][e]); }
        { const float d = dt_l, dw = d * __expf(acs63 - acs_l);
          u32x4 av, bw; av.x = pk2(xs[0] * d, xs[1] * d); av.y = pk2(xs[2] * d, xs[3] * d); av.z = pk2(xs[4] * d, xs[5] * d); av.w = pk2(xs[6] * d, xs[7] * d);
          bw.x = pk2(xs[0] * dw, xs[1] * dw); bw.y = pk2(xs[2] * dw, xs[3] * dw); bw.z = pk2(xs[4] * dw, xs[5] * dw); bw.w = pk2(xs[6] * dw, xs[7] * dw);
          *(LAS u32x4*)(lds + MB_XDT + mb_b128(l, 8 * pc)) = av; *(LAS u32x4*)(lds + MB_XDTW + mb_b128(l, 8 * pc)) = bw; }
#pragma unroll
        for (int i = 0; i < 4; ++i) *(LAS u32x4*)(lds + (i < 2 ? MB_BM : MB_CM) + mb_b256(frow0 + 32 * (i & 1), 8 * fch)) = bcr[i];
        const u32x4 zw = *(const u32x4*)(act + (t0 + l) * ACT_P + 1024 + 64 * h + 8 * pc);
        { const int cn = c < 63 ? c + 1 : 63; MB_LOAD(cn); }
        __syncthreads();
        if (wid >= 4) {
            const int d = wid - 4; const float la = acs[16 * d + fr];
            f32x4 X[4];
            bf16x8 cf[4];
#pragma unroll
            for (int ks = 0; ks < 4; ++ks) cf[ks] = *(const LAS bf16x8*)(lds + MB_CM + mb_b256(16 * d + fr, 32 * ks + 8 * fq));
#pragma unroll
            for (int si = 0; si < 4; ++si) { X[si] = (f32x4){0.f, 0.f, 0.f, 0.f};
                if (si <= d) {
                    bf16x8 af[4];
#pragma unroll
                    for (int ks = 0; ks < 4; ++ks) af[ks] = *(const LAS bf16x8*)(lds + MB_BM + mb_b256(16 * si + fr, 32 * ks + 8 * fq));
#pragma unroll
                    for (int ks = 0; ks < 4; ++ks) X[si] = MFMA16(af[ks], cf[ks], X[si]);
                    const f32x4 sa = *(const LAS f32x4*)(acs + 16 * si + 4 * fq);
#pragma unroll
                    for (int r = 0; r < 4; ++r) { const int s_abs = 16 * si + 4 * fq + r, l_abs = 16 * d + fr; X[si][r] = (s_abs <= l_abs) ? X[si][r] * __expf(la - sa[r]) : 0.f; }
                } }
            bf16x8 Xp[2];
#pragma unroll
            for (int sb = 0; sb < 2; ++sb) { u32x4 w; w.x = pk2(X[2 * sb][0], X[2 * sb][1]); w.y = pk2(X[2 * sb][2], X[2 * sb][3]); w.z = pk2(X[2 * sb + 1][0], X[2 * sb + 1][1]); w.w = pk2(X[2 * sb + 1][2], X[2 * sb + 1][3]); Xp[sb] = __builtin_bit_cast(bf16x8, w); }
            bf16x8 xa[4][2];
#pragma unroll
            for (int pt = 0; pt < 4; ++pt)
#pragma unroll
                for (int sb = 0; sb < 2; ++sb) if (2 * sb <= d) xa[pt][sb] = tr_pair<false>(lds + MB_XDT, 32 * sb + 4 * fq, 32 * sb + 16 + 4 * fq, 16 * pt, lane);
#pragma unroll
            for (int pt = 0; pt < 4; ++pt) { f32x4 y = (f32x4){0.f, 0.f, 0.f, 0.f};
#pragma unroll
                for (int sb = 0; sb < 2; ++sb) { if (2 * sb <= d) y = MFMA16(xa[pt][sb], Xp[sb], y); }
                *(LAS f32x4*)(lds + MB_YD + (16 * d + fr) * MB_YSTR + (16 * pt + 4 * fq) * 4) = y; }
        } else {
            const int pw = wid;
            bf16x8 Zp[4];
#pragma unroll
            for (int nb = 0; nb < 4; ++nb) { u32x4 w; w.x = pk2(Z[2 * nb][0], Z[2 * nb][1]); w.y = pk2(Z[2 * nb][2], Z[2 * nb][3]); w.z = pk2(Z[2 * nb + 1][0], Z[2 * nb + 1][1]); w.w = pk2(Z[2 * nb + 1][2], Z[2 * nb + 1][3]); Zp[nb] = __builtin_bit_cast(bf16x8, w); }
#pragma unroll
            for (int lt = 0; lt < 4; ++lt) { f32x4 y = (f32x4){0.f, 0.f, 0.f, 0.f};
                bf16x8 bfr[4];
#pragma unroll
                for (int nb = 0; nb < 4; ++nb) { const s16x4 lo = *(const LAS s16x4*)(lds + MB_CM + mb_b256(16 * lt + fr, 32 * nb + 4 * fq)), h4 = *(const LAS s16x4*)(lds + MB_CM + mb_b256(16 * lt + fr, 32 * nb + 16 + 4 * fq));
                    bfr[nb] = __builtin_shufflevector(lo, h4, 0, 1, 2, 3, 4, 5, 6, 7); }
#pragma unroll
                for (int nb = 0; nb < 4; ++nb) y = MFMA16(Zp[nb], bfr[nb], y);
                const float ea = __expf(acs[16 * lt + fr]); y *= ea;
                *(LAS f32x4*)(lds + MB_YO + (16 * lt + fr) * MB_YSTR + (16 * pw + 4 * fq) * 4) = y; }
            const float dec = __expf(acs[63]);
            bf16x8 xw[2];
#pragma unroll
            for (int lb = 0; lb < 2; ++lb) xw[lb] = tr_pair<false>(lds + MB_XDTW, 32 * lb + 8 * fq, 32 * lb + 8 * fq + 4, 16 * pw, lane);
#pragma unroll
            for (int np = 0; np < 4; ++np) { bf16x8 av[2][2];
#pragma unroll
                for (int q = 0; q < 2; ++q)
#pragma unroll
                    for (int lb = 0; lb < 2; ++lb) av[q][lb] = tr_pair<true>(lds + MB_BM, 32 * lb + 8 * fq, 32 * lb + 8 * fq + 4, 16 * (2 * np + q), lane);
#pragma unroll
                for (int q = 0; q < 2; ++q) { Z[2 * np + q] *= dec;
#pragma unroll
                    for (int lb = 0; lb < 2; ++lb) Z[2 * np + q] = MFMA16(av[q][lb], xw[lb], Z[2 * np + q]); } }
        }
        __syncthreads();
        { const f32x4 a0 = *(const LAS f32x4*)(lds + MB_YD + l * MB_YSTR + pc * 32), a1 = *(const LAS f32x4*)(lds + MB_YD + l * MB_YSTR + pc * 32 + 16);
          const f32x4 b0 = *(const LAS f32x4*)(lds + MB_YO + l * MB_YSTR + pc * 32), b1 = *(const LAS f32x4*)(lds + MB_YO + l * MB_YSTR + pc * 32 + 16);
          float y[8];
          y[0] = (a0[0] + b0[0] + D_h * xs[0]) * bf_lo(zw.x); y[1] = (a0[1] + b0[1] + D_h * xs[1]) * bf_hi(zw.x);
          y[2] = (a0[2] + b0[2] + D_h * xs[2]) * bf_lo(zw.y); y[3] = (a0[3] + b0[3] + D_h * xs[3]) * bf_hi(zw.y);
          y[4] = (a1[0] + b1[0] + D_h * xs[4]) * bf_lo(zw.z); y[5] = (a1[1] + b1[1] + D_h * xs[5]) * bf_hi(zw.z);
          y[6] = (a1[2] + b1[2] + D_h * xs[6]) * bf_lo(zw.w); y[7] = (a1[3] + b1[3] + D_h * xs[7]) * bf_hi(zw.w);
          float ss = 0.f;
#pragma unroll
          for (int e = 0; e < 8; ++e) ss += y[e] * y[e];
          ss += __shfl_xor(ss, 1); ss += __shfl_xor(ss, 2); ss += __shfl_xor(ss, 4);
          if (pc == 0) ssq_out[(t0 + l) * 32 + h] = ss;
          u32x4 w; w.x = pk2(y[0], y[1]); w.y = pk2(y[2], y[3]); w.z = pk2(y[4], y[5]); w.w = pk2(y[6], y[7]); *(u32x4*)(outp + (t0 + l) * opitch + 64 * h + 8 * pc) = w; }
    }
#undef MB_LOAD
    __syncthreads();
}
constexpr int RT_W = 0, RT_CNT = 131072, RT_BASE = 131072 + 128;
constexpr int MO_TS = 131072 + 256, MO_CNT = 131072 + 512;

DI void router_phase(LAS unsigned char* lds, int vcu, int G, const float* x1, const float* norm_ffn, const float* w_router, const float* b_router,
                     unsigned char* h2, int* sel_e, int* sel_r, float* sel_w, int* tokl, unsigned* gcnt) {
    const int tid = threadIdx.x, lane = tid & 63, wid = __builtin_amdgcn_readfirstlane(tid >> 6), l31 = lane & 31, hi = lane >> 5;
    LAS float* Wl = (LAS float*)(lds + RT_W); LAS unsigned* lcnt = (LAS unsigned*)(lds + RT_CNT); LAS unsigned* lbase = (LAS unsigned*)(lds + RT_BASE);
    for (int idx = tid; idx < 1024 * 8; idx += 512) { const f32x4 w = *(const f32x4*)(w_router + 4 * idx); const float gk = norm_ffn[idx >> 3]; LAS float* p = Wl + 4 * idx; p[0] = w[0] * gk; p[1] = w[1] * gk; p[2] = w[2] * gk; p[3] = w[3] * gk; }
    if (tid < 32) lcnt[tid] = 0u;
    __syncthreads();
    if (wid >= 4) {
        for (int m = (vcu * 4 + (wid - 4)) * 4; m < T; m += G * 16) rms_rows_to_fp8<4>(x1 + (size_t)m * 1024, h2 + (size_t)m * 1024, norm_ffn, lane);
    } else
    for (int tile = vcu + G * wid; tile < T / 32; tile += G * 4) {
        const int t0 = tile * 32;
        f32x16 acc;
#pragma unroll
        for (int r = 0; r < 16; ++r) acc[r] = 0.f;
        float ssq = 0.f;
        const float* xr = x1 + (size_t)(t0 + l31) * 1024 + 4 * hi;
#pragma unroll 4
        for (int c = 0; c < 128; ++c) {
            const f32x4 xv = *(const f32x4*)(xr + 8 * c);
            ssq += (xv[0] * xv[0] + xv[1] * xv[1]) + (xv[2] * xv[2] + xv[3] * xv[3]);
#pragma unroll
            for (int u = 0; u < 4; ++u) { const float a = Wl[(8 * c + 4 * hi + u) * 32 + l31]; acc = __builtin_amdgcn_mfma_f32_32x32x2f32(a, xv[u], acc, 0, 0, 0); }
        }
        ssq += __shfl_xor(ssq, 32);
        const float rstd = __builtin_amdgcn_rsqf(ssq * (1.f / 1024.f) + EPS);
        float lg[16];
#pragma unroll
        for (int r = 0; r < 16; ++r) lg[r] = acc[r] * rstd + b_router[crow(r, hi)];
        float sv[4]; int si[4];
#pragma unroll
        for (int k = 0; k < 4; ++k) {
            float bv = lg[0]; int bi = crow(0, hi);
#pragma unroll
            for (int r = 1; r < 16; ++r) { const int id = crow(r, hi); if (lg[r] > bv) { bv = lg[r]; bi = id; } }
            const float pv = __shfl_xor(bv, 32); const int pi = __shfl_xor(bi, 32);
            if (pv > bv || (pv == bv && pi < bi)) { bv = pv; bi = pi; }
            sv[k] = bv; si[k] = bi;
#pragma unroll
            for (int r = 0; r < 16; ++r) if (crow(r, hi) == bi) lg[r] = -INFINITY;
        }
        const float e1 = __expf(sv[1] - sv[0]), e2 = __expf(sv[2] - sv[0]), e3 = __expf(sv[3] - sv[0]), inv = 1.0f / (1.0f + e1 + e2 + e3);
        if (hi == 0) {
            const int t = t0 + l31; const float wv[4] = {inv, e1 * inv, e2 * inv, e3 * inv};
#pragma unroll
            for (int k = 0; k < 4; ++k) { const unsigned lr = atomicAdd((unsigned*)&lcnt[si[k]], 1u); sel_e[t * 4 + k] = si[k]; sel_r[t * 4 + k] = (int)lr; sel_w[t * 4 + k] = wv[k]; }
        }
    }
    __syncthreads();
    if (tid < 32) lbase[tid] = atomicAdd(&gcnt[tid], lcnt[tid]);
    __syncthreads();
    if (wid < 4) for (int tile = vcu + G * wid; tile < T / 32; tile += G * 4) {
        if (hi == 0) { const int t = tile * 32 + l31;
#pragma unroll
            for (int k = 0; k < 4; ++k) { const int e = sel_e[t * 4 + k]; const int r = sel_r[t * 4 + k] + (int)lbase[e]; sel_r[t * 4 + k] = r; tokl[(size_t)e * T + r] = t; } }
    }
}

DI int moe_tables(LAS unsigned char* lds, const unsigned* gcnt) {
    LAS int* ts = (LAS int*)(lds + MO_TS); LAS int* cn = (LAS int*)(lds + MO_CNT);
    __syncthreads();
    if (threadIdx.x < 32) cn[threadIdx.x] = (int)gcnt[threadIdx.x];
    __syncthreads();
    if (threadIdx.x == 0) { int s = 0; for (int e = 0; e < NEXP; ++e) { ts[e] = s; s += (cn[e] + 255) >> 8; } ts[NEXP] = s; }
    __syncthreads();
    return ts[NEXP];
}

DI void combine_phase(LAS unsigned char* lds, int vcu, int G, int tlo, int thi, const bf16_t* y, const int* sel_e, const int* sel_r, const float* sel_w, float* out, float wscale) {
    const int lane = threadIdx.x & 63, wid = threadIdx.x >> 6; const LAS int* ts = (const LAS int*)(lds + MO_TS);
    for (int tb = (vcu * 8 + wid) * 4; tb < T; tb += G * 32) {
        int rowi[4][4]; float wv[4][4];
#pragma unroll
        for (int q = 0; q < 4; ++q) { const int4 e4 = *(const int4*)(sel_e + (tb + q) * 4), r4 = *(const int4*)(sel_r + (tb + q) * 4); const f32x4 w4 = *(const f32x4*)(sel_w + (tb + q) * 4);
            const int ee[4] = {e4.x, e4.y, e4.z, e4.w}, rr[4] = {r4.x, r4.y, r4.z, r4.w};
#pragma unroll
            for (int k = 0; k < 4; ++k) { const int row = ts[ee[k]] * 256 + rr[k], tile = row >> 8; const bool in = tile >= tlo && tile < thi; rowi[q][k] = in ? row - tlo * 256 : -1; wv[q][k] = w4[k] * wscale; } }
#pragma unroll
        for (int q = 0; q < 4; ++q) {
            float* op = out + (size_t)(tb + q) * 1024 + 8 * lane;
            f32x4 a0 = *(const f32x4*)op, a1 = *(const f32x4*)(op + 4), a2 = *(const f32x4*)(op + 512), a3 = *(const f32x4*)(op + 516);
            u32x4 v0[4], v1[4];
#pragma unroll
            for (int k = 0; k < 4; ++k) { v0[k] = (u32x4){0u, 0u, 0u, 0u}; v1[k] = v0[k]; if (rowi[q][k] >= 0) { const bf16_t* yp = y + (size_t)rowi[q][k] * 1024 + 8 * lane; v0[k] = *(const u32x4*)yp; v1[k] = *(const u32x4*)(yp + 512); } }
#pragma unroll
            for (int k = 0; k < 4; ++k) { const float w = wv[q][k];
                a0[0] += w * bf_lo(v0[k].x); a0[1] += w * bf_hi(v0[k].x); a0[2] += w * bf_lo(v0[k].y); a0[3] += w * bf_hi(v0[k].y);
                a1[0] += w * bf_lo(v0[k].z); a1[1] += w * bf_hi(v0[k].z); a1[2] += w * bf_lo(v0[k].w); a1[3] += w * bf_hi(v0[k].w);
                a2[0] += w * bf_lo(v1[k].x); a2[1] += w * bf_hi(v1[k].x); a2[2] += w * bf_lo(v1[k].y); a2[3] += w * bf_hi(v1[k].y);
                a3[0] += w * bf_lo(v1[k].z); a3[1] += w * bf_hi(v1[k].z); a3[2] += w * bf_lo(v1[k].w); a3[3] += w * bf_hi(v1[k].w); }
            *(f32x4*)op = a0; *(f32x4*)(op + 4) = a1; *(f32x4*)(op + 512) = a2; *(f32x4*)(op + 516) = a3;
        }
    }
}
#define XB_TMO      128
#define XB_XCNT(j)  (256  + 64 * (j))
#define XB_XSUB(j)  (1280 + 64 * (j))
#define XB_XGEN(j)  (2304 + 64 * (j))
#define XB_TOP      3328
#define XB_TOPGEN   3392
#define XCD_BAR_WORDS 3456
#define XB_SPIN_CAP (1u << 18)

__device__ __forceinline__ unsigned xb_ld(unsigned* p)              { return __hip_atomic_load(p, __ATOMIC_RELAXED, __HIP_MEMORY_SCOPE_AGENT); }
__device__ __forceinline__ unsigned xb_add(unsigned* p, unsigned v) { return __hip_atomic_fetch_add(p, v, __ATOMIC_RELAXED, __HIP_MEMORY_SCOPE_AGENT); }
__device__ __forceinline__ unsigned xb_xcc_id() { return (unsigned)__builtin_amdgcn_s_getreg((3 << 11) | 20) & 0xFu; }
#define XB_SPIN(cond, bar) do { unsigned _sp = 0; while (cond) { __builtin_amdgcn_s_sleep(1); \
    if ((++_sp & 255u) == 0u) { if (xb_ld(&(bar)[XB_TMO])) break; if (_sp > XB_SPIN_CAP) { atomicAdd(&(bar)[XB_TMO], 1u); break; } } } } while (0)

struct XcdBarrier {
    unsigned* bar; unsigned x;
    volatile LAS unsigned* st;
};

__device__ __forceinline__ XcdBarrier xcd_barrier_post(unsigned* bar, volatile LAS unsigned* st) {
    XcdBarrier b; b.bar = bar; b.x = xb_xcc_id(); b.st = st;
    if (threadIdx.x == 0) (void)xb_add(&bar[XB_XCNT(b.x)], 1u);
    return b;
}
__device__ __forceinline__ void xcd_barrier_complete(unsigned* bar, unsigned x, unsigned& nloc, unsigned& nx) {
    const unsigned G = gridDim.x * gridDim.y * gridDim.z;
    unsigned sum, cnt, mine, sp = 0u;
    for (;;) {
        sum = 0u; cnt = 0u; mine = 0u;
#pragma unroll
        for (unsigned j = 0; j < 16; ++j) { const unsigned c = xb_ld(&bar[XB_XCNT(j)]); sum += c; cnt += (c > 0u) ? 1u : 0u; mine = (j == x) ? c : mine; }
        if (sum == G) break;
        __builtin_amdgcn_s_sleep(1);
        if ((++sp & 255u) == 0u) { if (xb_ld(&bar[XB_TMO])) break; if (sp > XB_SPIN_CAP) { atomicAdd(&bar[XB_TMO], 1u); break; } }
    }
    nloc = mine > 0u ? mine : 1u; nx = cnt > 0u ? cnt : 1u;
}

__device__ __forceinline__ void xcd_barrier(const XcdBarrier& b) {
    asm volatile("s_waitcnt vmcnt(0)" ::: "memory");
    __syncthreads();
    if (threadIdx.x == 0) {
        unsigned* bar = b.bar;
        __builtin_amdgcn_s_waitcnt(0);
        unsigned nloc = b.st[0], nx = b.st[1];
        if (nloc == 0u) { xcd_barrier_complete(bar, b.x, nloc, nx); b.st[0] = nloc; b.st[1] = nx; }
        const unsigned old = xb_add(&bar[XB_XSUB(b.x)], 1u);
        const unsigned gen = old / nloc;
        if (old + 1u == (gen + 1u) * nloc) {
            __builtin_amdgcn_fence(__ATOMIC_RELEASE, "agent");
            asm volatile("s_waitcnt vmcnt(0)" ::: "memory");
            const unsigned og = xb_add(&bar[XB_TOP], 1u);
            const unsigned tg = og / nx;
            if (og + 1u == (tg + 1u) * nx) xb_add(&bar[XB_TOPGEN], 1u);
            else XB_SPIN(xb_ld(&bar[XB_TOPGEN]) == tg, bar);
            __builtin_amdgcn_fence(__ATOMIC_ACQUIRE, "agent");
            xb_add(&bar[XB_XGEN(b.x)], 1u);
            asm volatile("s_waitcnt vmcnt(0)" ::: "memory");
        } else {
            XB_SPIN(xb_ld(&bar[XB_XGEN(b.x)]) == gen, bar);
            __builtin_amdgcn_fence(__ATOMIC_ACQUIRE, "agent");
            asm volatile("s_waitcnt vmcnt(0)" ::: "memory");
        }
    }
    __syncthreads();
}


#ifndef MK_N_LAUNCHES
#define MK_N_LAUNCHES 1
#endif
#ifndef MK_BRANCHES
#define MK_BRANCHES 15
#endif
constexpr int N_PHASES = 12;
#ifndef MK_USE_CG
#define MK_USE_CG 0
#endif
constexpr int LDS_BARST = 147456 - 64;
constexpr int CW_BAR = 4096;
constexpr int LDS_BYTES = 147456;
constexpr int NTHREADS = 512;

struct Args { const float* in[30]; float* out; unsigned char* ws; int ph_lo, ph_hi; };
enum { I_x = 0, I_mem = 1, I_norm_mix = 2, I_w_in = 3, I_a_q_gain = 4, I_a_k_gain = 5, I_a_rel_bias = 6, I_conv_w = 7, I_conv_b = 8, I_dt_bias = 9, I_a_log = 10, I_d_skip = 11, I_ssm_norm = 12, I_norm_mem = 13, I_w_mem_kv = 14, I_x_q_gain = 15, I_x_k_gain = 16, I_w_br_a = 17, I_w_br_b = 18, I_w_br_c = 19, I_w_out = 20, I_norm_ffn = 21, I_w_router = 22, I_b_router = 23, I_w_gate = 24, I_b_gate = 25, I_w_up = 26, I_b_up = 27, I_w_down = 28, I_b_down = 29 };

#define WIN WSP(bf16_t, WS_WIN)
#define WCAT WSP(bf16_t, WS_WCAT)
#define WOUT WSP(bf16_t, WS_WOUT)
#define WMEM WSP(bf16_t, WS_WMEM)
#define DTB WSP(float, WS_DT)
#define SSQ WSP(float, WS_SSQ)
#define RSTD WSP(float, WS_RSTD)
#define KX WSP(bf16_t, WS_KX)
#define MEMKV WSP(bf16_t, WS_MEMKV)
#define XN WSP(bf16_t, WS_XN)
#define MEMN WSP(bf16_t, WS_MEMN)
#define ACT WSP(bf16_t, WS_ACT)
#define KA WSP(bf16_t, WS_KA)
#define VA WSP(bf16_t, WS_VA)
#define XBC WSP(bf16_t, WS_XBC)
#define GATES WSP(bf16_t, WS_GATES)
#define MERGED WSP(bf16_t, WS_MERGED)
#define H2 WSP(unsigned char, MOE_H2)
#define WGU WSP(unsigned char, MOE_WGU)
#define WD WSP(unsigned char, MOE_WD)
#define ACTM WSP(unsigned char, MOE_ACTM)
#define YB WSP(bf16_t, MOE_Y)
#define SELE WSP(int, MOE_SELE)
#define SELR WSP(int, MOE_SELR)
#define SELW WSP(float, MOE_SELW)
#define TOKL WSP(int, MOE_TOKL)
#define GCNT (WSP(unsigned, WS_CTL) + CW_CNT)
#define ACSB ((float*)(GAS float*)kq[30] + (size_t)T * 512)
#define BCC ((bf16_t*)(GAS bf16_t*)kq[30])
#define EI_INIT const EpiIn EI{ws, AP(a_q_gain), AP(a_k_gain), AP(dt_bias)}
typedef const __attribute__((address_space(4))) unsigned long long* KW;
DI KW launder(KW p) { asm volatile("" : "+s"(p)); return p; }
#define AP(name) ((const float*)(const GAS float*)kq[I_##name])
#define PHASE_ARGS const KW kq = launder(kp); unsigned char* const ws = (unsigned char*)(GAS unsigned char*)kq[31]; (void)ws
#define WSP(type, off) ((type*)(ws + (off)))
__global__ void __launch_bounds__(NTHREADS, 2) mega_fwd(Args a_unused) {
    extern __shared__ __attribute__((aligned(16))) unsigned char lds_raw[];
    LAS unsigned char* lds = (LAS unsigned char*)lds_raw;
    const KW kp = (KW)__builtin_amdgcn_kernarg_segment_ptr();
    const int tid = threadIdx.x, lane = tid & 63, wid = __builtin_amdgcn_readfirstlane(tid >> 6);
    const int G = gridDim.x, bx = blockIdx.x, vcu = (G % 8 == 0) ? (bx % 8) * (G / 8) + bx / 8 : bx;
    const int lo = (int)(unsigned)kp[32], hi = (int)(kp[32] >> 32);
#ifndef MK_PHASE_MASK
#define MK_PHASE_MASK 0x7fff
#endif
#define IN(k) (((MK_PHASE_MASK >> (k)) & 1) && lo <= (k) && (k) < hi)
#ifndef MK_REP_MASK
#define MK_REP_MASK 0
#endif
#define REPS(k) (((MK_REP_MASK >> (k)) & 1) + 1)
#if MK_USE_CG
#define SEAM(k) do { if (IN(k) && IN((k) + 1)) { cg::this_grid().sync(); } } while (0)
#else
#define SEAM(k) do { if (IN(k) && IN((k) + 1)) { xcd_barrier(bar); } } while (0)
#endif
    const int gw = vcu * 8 + wid, NGW = G * 8;
    for (int u = tid; u < 16; u += NTHREADS) ((LAS unsigned*)(lds + LDS_BARST))[u] = 0u;
    __syncthreads();
    XcdBarrier bar = xcd_barrier_post((unsigned*)(GAS unsigned*)(kp[31]) + CW_BAR, (volatile LAS unsigned*)(lds + LDS_BARST));
    LAS float* scr = (LAS float*)(lds + wid * 16896);

    if (IN(0)) { PHASE_ARGS;
        constexpr int I_IN = 16 * 196, I_MEM = 16 * 32, I_A = 16 * 16, I_B = 32 * 16, I_C = 16 * 16, I_O = 16 * 16, NIT = I_IN + I_MEM + I_A + I_B + I_C + I_O;
        auto mk = [&](int it0) -> TrItem { int r = it0 % NIT; TrItem t; t.kscale = nullptr; t.mul = 1.0f; t.fp8 = 0;
            if (r < I_IN) { const int kb = r / 196, nb = r % 196; t.W = AP(w_in); t.Ns = IN_COLS; t.k0 = 64 * kb; t.sc0 = win_src_col(2 * nb); t.sc1 = win_src_col(2 * nb + 1); t.dst = WIN + (size_t)(64 * nb) * 1024 + 64 * kb; t.dpitch = 1024; return t; } r -= I_IN;
            if (r < I_MEM) { const int kb = r / 32, nb = r % 32; t.W = AP(w_mem_kv); t.Ns = 2048; t.k0 = 64 * kb; t.sc0 = 64 * nb; t.sc1 = 64 * nb + 32; t.dst = WMEM + (size_t)(64 * nb) * 1024 + 64 * kb; t.dpitch = 1024; return t; } r -= I_MEM;
            if (r < I_A) { const int kb = r / 16, nb = r % 16; t.W = AP(w_br_a); t.Ns = 1024; t.k0 = 64 * kb; t.sc0 = 64 * nb; t.sc1 = 64 * nb + 32; t.dst = WCAT + (size_t)(64 * nb) * 4096 + 64 * kb; t.dpitch = 4096; return t; } r -= I_A;
            if (r < I_B) { const int kb = r / 16, nb = r % 16; t.W = AP(w_br_b); t.Ns = 1024; t.k0 = 64 * kb; t.sc0 = 64 * nb; t.sc1 = 64 * nb + 32; t.dst = WCAT + (size_t)(64 * nb) * 4096 + 1024 + 64 * kb; t.dpitch = 4096; t.kscale = AP(ssm_norm); return t; } r -= I_B;
            if (r < I_C) { const int kb = r / 16, nb = r % 16; t.W = AP(w_br_c); t.Ns = 1024; t.k0 = 64 * kb; t.sc0 = 64 * nb; t.sc1 = 64 * nb + 32; t.dst = WCAT + (size_t)(64 * nb) * 4096 + 3072 + 64 * kb; t.dpitch = 4096; return t; } r -= I_C;
            { const int kb = r / 16, nb = r % 16; t.W = AP(w_out); t.Ns = 1024; t.k0 = 64 * kb; t.sc0 = 64 * nb; t.sc1 = 64 * nb + 32; t.dst = WOUT + (size_t)(64 * nb) * 1024 + 64 * kb; t.dpitch = 1024; return t; } };
        { const int nitems = NIT * REPS(0); f32x4 va[16], vb[16]; TrItem ia, ib; int it = gw;
          if (it < nitems) { ia = mk(it); tr_load(ia, va, lane); }
          while (it < nitems) {
              const int i2 = it + NGW; if (i2 < nitems) { ib = mk(i2); tr_load(ib, vb, lane); }
              tr_store(ia, va, scr, lane);
              if (i2 >= nitems) break;
              const int i3 = i2 + NGW; if (i3 < nitems) { ia = mk(i3); tr_load(ia, va, lane); }
              tr_store(ib, vb, scr, lane);
              it = i3; } }
        for (int m0 = gw * 4; m0 < T * REPS(0); m0 += NGW * 4) { const int m = m0 % T; rms_rows_to_bf16<4>(AP(x) + (size_t)m * 1024, XN + (size_t)m * 1024, 1, AP(norm_mix), lane); }
        for (int m = gw; m < NBATCH * MEMLEN; m += NGW) rms_rows_to_bf16<1>(AP(mem) + (size_t)m * 1024, MEMN + (size_t)m * 1024, 1, AP(norm_mem), lane);
    }
    SEAM(0);
    if (IN(1)) { PHASE_ARGS; EI_INIT;
        const SchedIn S{G, bx, 16, TL_Q, 12, TL_QX, 0, (const char*)WIN, (const char*)WMEM, REPS(1)};
        pg8::gemm_phase<false>(lds, (const char*)XN, 2048, 2048, S, EI);
    }
    SEAM(1);
    if (IN(2)) { PHASE_ARGS;
        if (MK_BRANCHES & 1) {
            LAS float* bl = (LAS float*)(lds + AT_BIAS);
            for (int i = tid; i < 16 * 257; i += NTHREADS) bl[(i / 257) * AT_BIAS_STRIDE + (i % 257)] = AP(a_rel_bias)[i] * LOG2E;
            __syncthreads();
            for (int u = vcu; u < 4 * NBATCH * 64; u += G) { const int c = u & 63, b = (u >> 6) & 7, hq = u >> 9; attnA_unit(lds, b, c, hq, ACT, KA, VA, (MK_REP_MASK >> 2 & 1) ? (bf16_t*)(ws + WS_BUF + 128 * MiB) : ACT, (MK_REP_MASK >> 2 & 1) ? 1024 : ACT_P);
                if (MK_REP_MASK >> 2 & 1) attnA_unit(lds, b, c, hq, ACT, KA, VA, ACT, ACT_P); }
        } else {
            for (int idx = vcu * NTHREADS + tid; idx < T * 128; idx += G * NTHREADS) { const int t = idx >> 7, ch = idx & 127; *(u32x4*)(ACT + (size_t)t * ACT_P + ch * 8) = (u32x4){0u, 0u, 0u, 0u}; }
        }
    }
    SEAM(2);
    if (IN(3)) { PHASE_ARGS; EI_INIT;
        const SchedIn S{G, bx, 21, TL_Z, 21, 0, 64, (const char*)WIN, (const char*)WMEM, REPS(3)};
        pg8::gemm_phase<false>(lds, (const char*)XN, 2048, 2048, S, EI);
    }
    SEAM(3);
    if (IN(4)) { PHASE_ARGS;
        if (MK_BRANCHES & 2) bcconv_phase(vcu, G, XBC, BCC, AP(conv_w), AP(conv_b), DTB, ACSB, AP(a_log));
        for (int w = gw; w < NBATCH * MEMLEN * 4; w += NGW) {
            const int row = w >> 2, hx = w & 3; const u32x2 kv = *(const u32x2*)(MEMKV + (size_t)row * 2048 + 256 * hx + 4 * lane);
            const float k0 = bf_lo(kv.x), k1 = bf_hi(kv.x), k2 = bf_lo(kv.y), k3 = bf_hi(kv.y);
            const float rs = __builtin_amdgcn_rsqf(wave_sum(k0 * k0 + k1 * k1 + k2 * k2 + k3 * k3) * (1.f / 256.f) + EPS) * (0.0625f * LOG2E);
            const f32x4 gk = *(const f32x4*)(AP(x_k_gain) + 4 * lane), gq = *(const f32x4*)(AP(x_q_gain) + 4 * lane);
            u32x2 o; o.x = pk2(k0 * rs * gk.x * gq.x, k1 * rs * gk.y * gq.y); o.y = pk2(k2 * rs * gk.z * gq.z, k3 * rs * gk.w * gq.w);
            *(u32x2*)(KX + (size_t)row * 1024 + 256 * hx + 4 * lane) = o;
        }
        xcd_barrier(bar);
        if (MK_BRANCHES & 4) attnC_phase(lds, vcu, G, ACT, KX, MEMKV, ACT + 3072, ACT_P);
        if (MK_BRANCHES & 2) { int nrep = 1 + (MK_REP_MASK >> 4 & 1); asm volatile("" : "+s"(nrep));
#pragma unroll 1
            for (int rep = 0; rep < nrep; ++rep) { const bool real = rep == nrep - 1;
                for (int u = vcu; u < NBATCH * 32; u += G) mamba_unit(lds, u >> 5, u & 31, XBC, BCC, DTB, ACSB, ACT, SSQ, real ? ACT + 1024 : (bf16_t*)RSTD, real ? (size_t)ACT_P : (size_t)0, AP(conv_w), AP(conv_b), AP(a_log), AP(d_skip)); } }
    }
    SEAM(4);
    if (IN(5)) { PHASE_ARGS; EI_INIT;
        for (int idx = vcu * NTHREADS + tid; idx < T * 4; idx += G * NTHREADS) { const int t = idx >> 2, g = idx & 3; const f32x4 s0 = *(const f32x4*)(SSQ + (size_t)t * 32 + 8 * g), s1 = *(const f32x4*)(SSQ + (size_t)t * 32 + 8 * g + 4);
            RSTD[idx] = __builtin_amdgcn_rsqf(((s0[0] + s0[1]) + (s0[2] + s0[3]) + (s1[0] + s1[1]) + (s1[2] + s1[3])) * (1.f / 512.f) + EPS); }
        const SchedIn S{G, bx, 12, TL_G, 12, 0, 0, (const char*)WIN, (const char*)WMEM, REPS(5)};
        pg8::gemm_phase<false>(lds, (const char*)XN, 2048, 2048, S, EI);
    }
    SEAM(5);
    if (IN(6)) { PHASE_ARGS;
        constexpr int LASTSEG = (MK_BRANCHES & 4) ? 2 : ((MK_BRANCHES & 2) ? 1 : 0);
        constexpr int KM = LASTSEG == 2 ? 4096 : (LASTSEG == 1 ? 3072 : 1024);
        const SchedDense S{G, bx, T / 256, 4, 4096, (const char*)WCAT, REPS(6)};
        const EpiMerge E{GATES, RSTD, MERGED, LASTSEG};
        pg8::gemm_phase<false>(lds, (const char*)ACT, KM * 2, 8192, S, E);
    }
    SEAM(6);
    if (IN(7)) { PHASE_ARGS;
        const SchedDense S{G, bx, T / 256, 4, 1024, (const char*)WOUT, REPS(7)};
        const EpiOut E{AP(x), ((float*)(GAS float*)kq[30])};
        pg8::gemm_phase<false>(lds, (const char*)MERGED, 2048, 2048, S, E);
    }
    SEAM(7);
    if (IN(8) && (MK_BRANCHES & 8)) { PHASE_ARGS;
        { int nrep = 1 + (MK_REP_MASK >> 11 & 1); asm volatile("" : "+s"(nrep));
#pragma unroll 1
          for (int rep = 0; rep < nrep; ++rep) { const bool real = rep == nrep - 1; const size_t dm = real ? 0 : (MOE_ACTM - MOE_SELE);
            router_phase(lds, vcu, G, ((float*)(GAS float*)kq[30]), AP(norm_ffn), AP(w_router), AP(b_router), H2, (int*)((char*)SELE + dm), (int*)((char*)SELR + dm), (float*)((char*)SELW + dm), (int*)((char*)TOKL + dm), GCNT + (real ? 0 : 64));
            __syncthreads(); } }
        auto mk = [&](int it0) -> TrItem { const int it = it0 % (NEXP * 768); const int e = it / 768, r = it % 768, which = r >> 8, kb = (r & 255) >> 4, nb = r & 15; TrItem t;
            t.W = (which == 0 ? AP(w_gate) : which == 1 ? AP(w_up) : AP(w_down)) + (size_t)e * 1024 * 1024; t.Ns = 1024; t.k0 = 64 * kb; t.sc0 = 64 * nb; t.sc1 = 64 * nb + 32; t.dpitch = 1024; t.kscale = nullptr; t.mul = 32.0f; t.fp8 = 1;
            t.dst = which == 2 ? (void*)(WD + ((size_t)e * 1024 + 64 * nb) * 1024 + 64 * kb) : (void*)(WGU + ((size_t)e * 2048 + 256 * (nb >> 1) + 128 * which + 64 * (nb & 1)) * 1024 + 64 * kb); return t; };
        { const int nitems = NEXP * 768 * REPS(8); f32x4 va[16], vb[16]; TrItem ia, ib; int it = gw;
          if (it < nitems) { ia = mk(it); tr_load(ia, va, lane); }
          while (it < nitems) {
              const int i2 = it + NGW; if (i2 < nitems) { ib = mk(i2); tr_load(ib, vb, lane); }
              tr_store(ia, va, scr, lane);
              if (i2 >= nitems) break;
              const int i3 = i2 + NGW; if (i3 < nitems) { ia = mk(i3); tr_load(ia, va, lane); }
              tr_store(ib, vb, scr, lane);
              it = i3; } }
    }
    SEAM(8);
    {
        if ((MK_BRANCHES & 8) && (IN(9) || IN(10) || IN(11))) { PHASE_ARGS;
            const int total = moe_tables(lds, GCNT), tlo = 0, thi = total;
            const LAS int* ts = (const LAS int*)(lds + MO_TS); const LAS int* cn = (const LAS int*)(lds + MO_CNT);
            if (IN(9)) { const SchedMoE S{G, bx, 8, tlo, thi, ts, cn, TOKL, (const char*)WGU, (size_t)2048 * 1024, REPS(9), 1024u, 1024u}; const EpiGU E{ACTM, AP(b_gate), AP(b_up), tlo};
                pg8::gemm_phase<true>(lds, (const char*)H2, 1024, 1024, S, E); }
            SEAM(9);
            if (IN(10)) { const SchedMoE S{G, bx, 4, tlo, thi, ts, cn, nullptr, (const char*)WD, (size_t)1024 * 1024, REPS(10), 1024u, 1024u}; const EpiDown E{YB, AP(b_down), tlo};
                pg8::gemm_phase<true>(lds, (const char*)ACTM, 1024, 1024, S, E); }
            SEAM(10);
            if (IN(11)) { int nrep = 1 + (MK_REP_MASK >> 12 & 1); asm volatile("" : "+s"(nrep));
#pragma unroll 1
                for (int rep = 0; rep < nrep; ++rep) combine_phase(lds, vcu, G, tlo, thi, YB, SELE, SELR, SELW, ((float*)(GAS float*)kq[30]), 1.0f / (float)nrep); }
        } else { SEAM(9); SEAM(10); }
    }
#undef IN
#undef SEAM
}

extern "C" void kernel_launch(void* const* d_in, const int* in_sizes, int n_in, void* d_out, int out_size, void* d_ws, size_t ws_size, hipStream_t stream) {
    static int grid = 0;
    if (grid == 0) {
        if (n_in != 30 || ws_size < WS_MIX_END || ws_size < WS_END) { fprintf(stderr, "kernel_launch: unexpected n_in %d / ws_size %zu\n", n_in, ws_size); grid = -1; return; }
        int dev = 0, cus = 0, per_cu = 0;
        (void)hipGetDevice(&dev); (void)hipDeviceGetAttribute(&cus, hipDeviceAttributeMultiprocessorCount, dev);
        (void)hipFuncSetAttribute((const void*)mega_fwd, hipFuncAttributeMaxDynamicSharedMemorySize, LDS_BYTES);
        (void)hipOccupancyMaxActiveBlocksPerMultiprocessor(&per_cu, (const void*)mega_fwd, NTHREADS, LDS_BYTES);
        if (per_cu < 1) { fprintf(stderr, "kernel_launch: occupancy query reports %d blocks per CU\n", per_cu); grid = -1; return; }
        grid = cus;
    }
    if (grid < 0) return;
    (void)hipMemsetAsync((char*)d_ws + WS_CTL, 0, 65536, stream);
    Args a{};
    for (int i = 0; i < 30; ++i) a.in[i] = (const float*)d_in[i];
    a.out = (float*)d_out; a.ws = (unsigned char*)d_ws;
    if (MK_N_LAUNCHES == 1) {
        a.ph_lo = 0; a.ph_hi = N_PHASES;
        void* args[] = {&a};
        hipError_t e = hipLaunchCooperativeKernel((void*)mega_fwd, dim3(grid), dim3(NTHREADS), args, LDS_BYTES, stream);
        if (e != hipSuccess) fprintf(stderr, "cooperative launch failed: %s (grid %d)\n", hipGetErrorString(e), grid);
    } else {
        for (int ph = 0; ph < N_PHASES; ++ph) { a.ph_lo = ph; a.ph_hi = ph + 1; hipLaunchKernelGGL(mega_fwd, dim3(grid), dim3(NTHREADS), LDS_BYTES, stream, a); }
    }
}
```

```cpp
#include <hip/hip_runtime.h>
#include <hip/hip_cooperative_groups.h>
#include <cstdio>
#include <cstdint>
namespace cg = cooperative_groups;

#define LAS __attribute__((address_space(3)))
#define GAS __attribute__((address_space(1)))
#define DI __device__ __forceinline__
typedef unsigned short bf16_t;
typedef short bf16x8 __attribute__((ext_vector_type(8)));
typedef short s16x4 __attribute__((ext_vector_type(4)));
typedef float f32x2 __attribute__((ext_vector_type(2)));
typedef float f32x4 __attribute__((ext_vector_type(4)));
typedef float f32x16 __attribute__((ext_vector_type(16)));
typedef unsigned u32x2 __attribute__((ext_vector_type(2)));
typedef unsigned u32x4 __attribute__((ext_vector_type(4)));
typedef __bf16 bf16x2_t __attribute__((ext_vector_type(2)));
typedef short v4i16_t __attribute__((ext_vector_type(4)));

DI unsigned pk2(float lo, float hi) { f32x2 v = {lo, hi}; bf16x2_t b = __builtin_convertvector(v, bf16x2_t); return __builtin_bit_cast(unsigned, b); }
DI float bf_lo(unsigned w) { return __uint_as_float(w << 16); }
DI float bf_hi(unsigned w) { return __uint_as_float(w & 0xffff0000u); }
DI float bf2f(bf16_t b) { return __uint_as_float(((unsigned)b) << 16); }
DI float wave_sum(float v) {
#pragma unroll
    for (int o = 1; o < 64; o <<= 1) v += __shfl_xor(v, o);
    return v;
}
DI float fast_exp2(float x) { return __builtin_amdgcn_exp2f(x); }
DI float fast_rcp(float x) { return __builtin_amdgcn_rcpf(x); }
DI float sigmoidf_(float x) { return fast_rcp(1.0f + fast_exp2(-1.4426950408889634f * x)); }

constexpr int NBATCH = 8, SEQ = 4096, T = NBATCH * SEQ, DM = 1024;
constexpr int NWIN_TILES = 49, NWIN = NWIN_TILES * 256;
constexpr int IN_COLS = 12320;
constexpr float EPS = 1e-6f;
constexpr float LOG2E = 1.4426950408889634f;
constexpr int NEXP = 32, TOPK = 4;
constexpr int MEMLEN = 256;
constexpr int ACT_P = 4096;
constexpr int TL_Q = 0, TL_K = 4, TL_V = 8, TL_Z = 12, TL_XBC = 20, TL_DT = 32, TL_QX = 33, TL_G = 37;

constexpr size_t MiB = (size_t)1 << 20;
constexpr size_t WS_CTL = 0, CTL_BYTES = 1 * MiB;
constexpr size_t WS_WIN = 1 * MiB, WS_WCAT = 26 * MiB, WS_WOUT = 34 * MiB, WS_WMEM = 36 * MiB;
constexpr size_t WS_DT = 40 * MiB, WS_SSQ = 44 * MiB, WS_RSTD = 48 * MiB, WS_KX = 49 * MiB, WS_MEMKV = 53 * MiB;
constexpr size_t WS_XN = 61 * MiB, WS_MEMN = 125 * MiB, WS_ACT = 129 * MiB, WS_BUF = 385 * MiB, WS_MIX_END = 577 * MiB;
constexpr size_t WS_KA = WS_BUF, WS_VA = WS_BUF + 64 * MiB, WS_XBC = WS_BUF, WS_GATES = WS_BUF, WS_MERGED = WS_XN;
constexpr int MOE_TILE_CAP = 280;
constexpr size_t MOE_H2 = 1 * MiB, MOE_WGU = 33 * MiB, MOE_WD = 97 * MiB, MOE_ACTM = 129 * MiB, MOE_Y = 265 * MiB;
constexpr size_t MOE_SELE = 537 * MiB, MOE_SELR = 537 * MiB + 512 * 1024, MOE_SELW = 538 * MiB, MOE_TOKL = 539 * MiB, WS_END = 543 * MiB;
constexpr int CW_CNT = 64;

#ifndef MK_KREP
#define MK_KREP 1
#endif
#ifndef MK_NT_STORES
#define MK_NT_STORES 0
#endif
namespace pg8 {
constexpr int BM = 256, BK = 64, HALF = 128, HTB = HALF * BK * 2, STAGE_BYTES = 8 * HTB;
__host__ __device__ __forceinline__ int lds_byte(int r, int c) { const int st = (r >> 4) * 2 + (c >> 5), rr = r & 15, cc = c & 31, ob = rr * 64 + cc * 2; return st * 1024 + (ob ^ (((ob >> 9) & 1) << 5)); }
__host__ __device__ __forceinline__ void stage_rc(int b, int& R, int& C) { const int st = b / 1024, sb = b % 1024, swz = sb ^ (((sb >> 9) & 1) << 5); R = (st >> 1) * 16 + swz / 64; C = (st & 1) * 32 + (swz % 64) / 2; }
__host__ __device__ __forceinline__ int perm32(int rho) { const int n = rho >> 4, i = rho & 15; return 8 * (i >> 2) + 4 * n + (i & 3); }

struct Unit { int kind, pm, pn, aux; };

typedef f32x4 Acc[2][2][4][2];

typedef int v8i_t __attribute__((ext_vector_type(8)));
template <bool FP8, class Epi, class Sched>
DI void gemm_phase(LAS unsigned char* lds, const char* Abase, const int Kb, const int ldbb, const Sched& S, const Epi& E) {
    int tid_ = threadIdx.x; asm volatile("" : "+v"(tid_));
    const int tid = tid_, wid = __builtin_amdgcn_readfirstlane(tid >> 6), lane = tid & 63, wr = wid >> 2, wc = wid & 3, fr = lane & 15, fq = lane >> 4;
    const int nt = Kb / (BK * 2);
    int Rr[2], Cc2[2]; unsigned voffB[2];
#pragma unroll
    for (int i = 0; i < 2; ++i) { int R, C; stage_rc(tid * 16 + i * 8192, R, C); Rr[i] = R; Cc2[i] = C * 2; const int Rb = (R & ~31) + perm32(R & 31); voffB[i] = (unsigned)(Rb * ldbb + C * 2); }
    const unsigned kstep = (unsigned)(BK * 2);
    const size_t hstepB = (size_t)HALF * ldbb;
    const unsigned ldsw = (unsigned)wid * 1024u;
    const int aoff0 = lds_byte(wr * 64 + fr, fq * 8), aoff1 = aoff0 + 1024;
    const int boff0 = lds_byte(wc * 32 + fr, fq * 8), boff1 = boff0 + 1024;
#define PG8_SA(b, h) (((b) * 2 + (h)) * HTB)
#define PG8_SB(b, h) ((4 + (b) * 2 + (h)) * HTB)
#define PG8_GLDS(src, dstoff) __builtin_amdgcn_global_load_lds((const unsigned*)(src), (LAS unsigned*)(lds + (dstoff)), 16, 0, 0)
#define PG8_STAGE_B(bufoff, ptr) do { _Pragma("unroll") for (int _i = 0; _i < 2; ++_i) PG8_GLDS((const char*)(ptr) + voffB[_i], (bufoff) + ldsw + _i * 8192); } while (0)
#define PG8_STAGE_A(bufoff, kb, v0, v1) do { PG8_GLDS(Abase + (size_t)(v0) + (kb), (bufoff) + ldsw); PG8_GLDS(Abase + (size_t)(v1) + (kb), (bufoff) + ldsw + 8192); } while (0)
#define PG8_LDA(dst, b, h) do { _Pragma("unroll") for (int m = 0; m < 4; ++m) { dst[m][0] = *(const LAS u32x4*)(lds + PG8_SA(b, h) + aoff0 + m * 2048); dst[m][1] = *(const LAS u32x4*)(lds + PG8_SA(b, h) + aoff1 + m * 2048); } } while (0)
#define PG8_LDB(dst, b, h) do { _Pragma("unroll") for (int n = 0; n < 2; ++n) { dst[n][0] = *(const LAS u32x4*)(lds + PG8_SB(b, h) + boff0 + n * 2048); dst[n][1] = *(const LAS u32x4*)(lds + PG8_SB(b, h) + boff1 + n * 2048); } } while (0)
#define PG8_CAT(x) __builtin_bit_cast(v8i_t, __builtin_shufflevector((x)[0], (x)[1], 0, 1, 2, 3, 4, 5, 6, 7))
#define PG8_MMA(ai, bj, At, Bt) do { __builtin_amdgcn_s_setprio(1); _Pragma("unroll") for (int m = 0; m < 4; ++m) _Pragma("unroll") for (int n = 0; n < 2; ++n) { \
        if constexpr (FP8) asm volatile("v_mfma_scale_f32_16x16x128_f8f6f4 %0, %1, %2, %0, %3, %4 op_sel_hi:[0,0,0]" : "+v"(acc[ai][bj][m][n]) : "v"(PG8_CAT(Bt[n])), "v"(PG8_CAT(At[m])), "v"(sclB), "v"(sclA)); \
        else { _Pragma("unroll") for (int k = 0; k < 2; ++k) acc[ai][bj][m][n] = __builtin_amdgcn_mfma_f32_16x16x32_bf16(__builtin_bit_cast(bf16x8, Bt[n][k]), __builtin_bit_cast(bf16x8, At[m][k]), acc[ai][bj][m][n], 0, 0, 0); } } \
        __builtin_amdgcn_s_setprio(0); } while (0)
#define PG8_WAIT_V(n) asm volatile("s_waitcnt vmcnt(" #n ")" ::: "memory")
#define PG8_WAIT_L(n) asm volatile("s_waitcnt lgkmcnt(" #n ")" ::: "memory")
#define PG8_BAR __builtin_amdgcn_s_barrier()
#define PG8_SCHED __builtin_amdgcn_sched_barrier(0)
    Unit cur, nxt; int ui = 0;
    if (!S.next(0, cur)) return;
    Acc acc;
#pragma unroll
    for (int a = 0; a < 2; ++a)
#pragma unroll
        for (int b = 0; b < 2; ++b)
#pragma unroll
            for (int m = 0; m < 4; ++m)
#pragma unroll
                for (int n = 0; n < 2; ++n) acc[a][b][m][n] = (f32x4){0.f, 0.f, 0.f, 0.f};
    u32x4 At[4][2], B0[2][2], B1[2][2];
    int sclB = 0x7a7a7a7a, sclA = 0x7f7f7f7f;
    asm volatile("" : "+v"(sclB), "+v"(sclA));
    unsigned vA00 = S.arow(cur, Rr[0]) + Cc2[0], vA01 = S.arow(cur, Rr[1]) + Cc2[1], vA10 = S.arow(cur, HALF + Rr[0]) + Cc2[0], vA11 = S.arow(cur, HALF + Rr[1]) + Cc2[1];
    const char* cB = S.bptr(cur);
    PG8_STAGE_B(PG8_SB(0, 0), cB); PG8_STAGE_B(PG8_SB(0, 1), cB + hstepB); PG8_STAGE_A(PG8_SA(0, 0), 0, vA00, vA01); PG8_STAGE_A(PG8_SA(0, 1), 0, vA10, vA11);
    if (wr == 1) PG8_BAR;
    PG8_WAIT_V(2); PG8_BAR;
    PG8_STAGE_B(PG8_SB(1, 0), cB + kstep); PG8_STAGE_A(PG8_SA(1, 0), kstep, vA00, vA01); PG8_STAGE_B(PG8_SB(1, 1), cB + hstepB + kstep);
    PG8_WAIT_V(6); PG8_BAR;
    for (;;) {
        const bool has_next = S.next(ui + 1, nxt);
        const char* nB = has_next ? S.bptr(nxt) : cB;
        constexpr int KREP = (MK_KREP > 1 && !Epi::SEGMENTED) ? MK_KREP : 1;
        for (int tt = 0; tt < nt * KREP; tt += 2) {
            const int t = KREP > 1 ? tt % nt : tt;
            const bool last = (tt == nt * KREP - 2);
            if constexpr (Epi::SEGMENTED) { if (t > 0 && E.boundary(t)) E.rescale(acc, cur, t, wr, wc, fr, fq); }
            const unsigned k1 = (unsigned)(t + 1) * kstep;
            const unsigned t2 = (KREP > 1) ? (unsigned)((t + 2) % nt) : (unsigned)(t + 2);
            const unsigned k2 = last ? 0u : t2 * kstep, k3 = k2 + kstep;
            const char* b2 = last ? nB : cB + t2 * kstep; const char* b3 = b2 + kstep;
            unsigned w00 = vA00, w01 = vA01, w10 = vA10, w11 = vA11;
            if (last && has_next) { w00 = S.arow(nxt, Rr[0]) + Cc2[0]; w01 = S.arow(nxt, Rr[1]) + Cc2[1]; w10 = S.arow(nxt, HALF + Rr[0]) + Cc2[0]; w11 = S.arow(nxt, HALF + Rr[1]) + Cc2[1]; }
            PG8_LDB(B0, 0, 0); PG8_LDB(B1, 0, 1); PG8_SCHED; PG8_LDA(At, 0, 0); PG8_STAGE_A(PG8_SA(1, 1), k1, vA10, vA11);
            PG8_WAIT_V(8); PG8_WAIT_L(0); PG8_BAR; PG8_MMA(0, 0, At, B0); PG8_MMA(0, 1, At, B1); PG8_BAR; PG8_SCHED;
            PG8_LDA(At, 0, 1); PG8_STAGE_B(PG8_SB(0, 0), b2); PG8_STAGE_B(PG8_SB(0, 1), b2 + hstepB); PG8_STAGE_A(PG8_SA(0, 0), k2, w00, w01);
            PG8_WAIT_V(8); PG8_WAIT_L(0); PG8_BAR; PG8_MMA(1, 0, At, B0); PG8_MMA(1, 1, At, B1); PG8_BAR; PG8_SCHED;
            PG8_LDB(B0, 1, 0); PG8_LDB(B1, 1, 1); PG8_SCHED; PG8_LDA(At, 1, 0); PG8_STAGE_A(PG8_SA(0, 1), k2, w10, w11);
            PG8_WAIT_V(8); PG8_WAIT_L(0); PG8_BAR; PG8_MMA(0, 0, At, B0); PG8_MMA(0, 1, At, B1); PG8_BAR; PG8_SCHED;
            PG8_LDA(At, 1, 1); PG8_STAGE_B(PG8_SB(1, 0), b3); PG8_STAGE_B(PG8_SB(1, 1), b3 + hstepB); PG8_STAGE_A(PG8_SA(1, 0), k3, w00, w01);
            PG8_WAIT_V(8); PG8_WAIT_L(0); PG8_BAR; PG8_MMA(1, 0, At, B0); PG8_MMA(1, 1, At, B1); PG8_BAR; PG8_SCHED;
            if (last) { vA00 = w00; vA01 = w01; vA10 = w10; vA11 = w11; }
        }
        if (wr == 0) PG8_BAR;
        if constexpr (FP8) asm volatile("s_nop 15\n\ts_nop 7" ::: "memory");
        if constexpr (KREP > 1) {
#pragma unroll
            for (int a = 0; a < 2; ++a)
#pragma unroll
                for (int b = 0; b < 2; ++b)
#pragma unroll
                    for (int m = 0; m < 4; ++m)
#pragma unroll
                        for (int n = 0; n < 2; ++n) acc[a][b][m][n] *= (1.0f / KREP); }
        E(acc, cur, wr, wc, fr, fq);
        if (!has_next) break;
#pragma unroll
        for (int a = 0; a < 2; ++a)
#pragma unroll
            for (int b = 0; b < 2; ++b)
#pragma unroll
                for (int m = 0; m < 4; ++m)
#pragma unroll
                    for (int n = 0; n < 2; ++n) acc[a][b][m][n] = (f32x4){0.f, 0.f, 0.f, 0.f};
        cur = nxt; cB = nB; ++ui;
        if (wr == 1) PG8_BAR;
    }
    PG8_WAIT_V(0);
    PG8_BAR;
#undef PG8_SA
#undef PG8_SB
#undef PG8_GLDS
#undef PG8_STAGE_A
#undef PG8_STAGE_B
#undef PG8_LDA
#undef PG8_LDB
#undef PG8_MMA
#undef PG8_CAT
#undef PG8_WAIT_V
#undef PG8_WAIT_L
#undef PG8_BAR
#undef PG8_SCHED
}

DI bool static_tile(int L, int nM, int nN, int& pm, int& pn) {
    const int nwg = nM * nN; if (L >= nwg) return false;
    int wgid = L; { const int q = nwg / 8, r = nwg % 8, xcd = wgid % 8, off = wgid / 8; wgid = (xcd < r ? xcd * (q + 1) : r * (q + 1) + (xcd - r) * q) + off; }
    const int nig = 8 * nN, gid = wgid / nig, fm = gid * 8, gsz = (nM - fm) < 8 ? (nM - fm) : 8;
    pm = fm + ((wgid % nig) % gsz); pn = (wgid % nig) / gsz; return true;
}
}
using pg8::Unit; using pg8::Acc;

DI unsigned pk4_fp8(float a, float b, float c, float d) { int p = 0; p = __builtin_amdgcn_cvt_pk_fp8_f32(a, b, p, false); p = __builtin_amdgcn_cvt_pk_fp8_f32(c, d, p, true); return (unsigned)p; }
DI float silu_(float v) { return v * sigmoidf_(v); }
DI float softplus_(float x) { return fmaxf(x, 0.f) + __logf(1.0f + __expf(-fabsf(x))); }

struct SchedIn {
    int G, c, ncol, t0, nsplit, t1, nextra; const char* win; const char* wmem; int reps;
    DI bool next(int i, Unit& u) const {
        const int U = (T / 256) * ncol + nextra; int L = i * G + c; if (L >= U * reps) return false; L %= U; int pm, pn;
        if (pg8::static_tile(L, T / 256, ncol, pm, pn)) { u.kind = 0; u.pm = pm; u.pn = pn < nsplit ? t0 + pn : t1 + (pn - nsplit); u.aux = 0; return true; }
        const int j = L - (T / 256) * ncol; if (j < nextra) { u.kind = 1; u.pm = j >> 3; u.pn = j & 7; u.aux = 0; return true; }
        return false;
    }
    DI unsigned arow(const Unit& u, int r) const { return (u.kind == 0 ? 0u : (unsigned)(WS_MEMN - WS_XN)) + (unsigned)(u.pm * 256 + r) * 2048u; }
    DI const char* bptr(const Unit& u) const { return (u.kind == 0 ? win : wmem) + (size_t)u.pn * (256 * 1024 * 2); }
};

struct EpiIn {
    static constexpr bool SEGMENTED = false;
    unsigned char* ws; const float *qgain, *kgain, *dtbias;
    template <int OP> DI void ew(const Acc& acc, bf16_t* dst, size_t pitch, int col0, int row0, int wc, int fq) const {
#pragma unroll
        for (int ai = 0; ai < 2; ++ai)
#pragma unroll
            for (int m = 0; m < 4; ++m) { bf16_t* rowp = dst + (size_t)(row0 + ai * 128 + m * 16) * pitch + col0 + wc * 32 + 8 * fq;
#pragma unroll
                for (int bj = 0; bj < 2; ++bj) { f32x4 v0 = acc[ai][bj][m][0], v1 = acc[ai][bj][m][1];
                    if (OP == 1) { for (int e = 0; e < 4; ++e) { v0[e] = silu_(v0[e]); v1[e] = silu_(v1[e]); } }
                    if (OP == 2) { for (int e = 0; e < 4; ++e) { v0[e] = sigmoidf_(fminf(fmaxf(v0[e], -30.f), 30.f)); v1[e] = sigmoidf_(fminf(fmaxf(v1[e], -30.f), 30.f)); } }
                    u32x4 w; w.x = pk2(v0[0], v0[1]); w.y = pk2(v0[2], v0[3]); w.z = pk2(v1[0], v1[1]); w.w = pk2(v1[2], v1[3]);
                    *(u32x4*)(rowp + bj * 128) = w; }
                asm volatile("" ::: "memory"); }
    }
    DI void headnorm(const Acc& acc, bf16_t* dst, size_t pitch, int col0, int row0, int wc, int fq, const float* gain, float mul) const {
#pragma unroll
        for (int ai = 0; ai < 2; ++ai)
#pragma unroll
            for (int m = 0; m < 4; ++m) {
                float ss = 0.f;
#pragma unroll
                for (int bj = 0; bj < 2; ++bj)
#pragma unroll
                    for (int n = 0; n < 2; ++n) { const f32x4 x = acc[ai][bj][m][n]; ss += (x[0] * x[0] + x[1] * x[1]) + (x[2] * x[2] + x[3] * x[3]); }
                ss += __shfl_xor(ss, 16); ss += __shfl_xor(ss, 32);
                const float rs = __builtin_amdgcn_rsqf(ss * (1.0f / 64.0f) + EPS) * mul;
                bf16_t* rowp = dst + (size_t)(row0 + ai * 128 + m * 16) * pitch + col0 + wc * 64 + 8 * fq;
#pragma unroll
                for (int bj = 0; bj < 2; ++bj) { const f32x4 g0 = *(const f32x4*)(gain + 32 * bj + 8 * fq), g1 = *(const f32x4*)(gain + 32 * bj + 8 * fq + 4);
                    const f32x4 v0 = acc[ai][bj][m][0] * rs * g0, v1 = acc[ai][bj][m][1] * rs * g1;
                    u32x4 w; w.x = pk2(v0[0], v0[1]); w.y = pk2(v0[2], v0[3]); w.z = pk2(v1[0], v1[1]); w.w = pk2(v1[2], v1[3]);
                    *(u32x4*)(rowp + bj * 32) = w; }
                asm volatile("" ::: "memory"); }
    }
    DI void operator()(const Acc& acc, const Unit& u, int wr, int wc, int fr, int fq) const {
        const int row0 = u.pm * 256 + wr * 64 + fr;
        bf16_t* const act = (bf16_t*)(ws + WS_ACT); bf16_t* const ka = (bf16_t*)(ws + WS_KA); bf16_t* const va = (bf16_t*)(ws + WS_VA); bf16_t* const xbc = (bf16_t*)(ws + WS_XBC);
        bf16_t* const gates = (bf16_t*)(ws + WS_GATES); bf16_t* const memkv = (bf16_t*)(ws + WS_MEMKV); float* const dt = (float*)(ws + WS_DT);
        if (u.kind == 1) { ew<0>(acc, memkv, 2048, u.pn * 256, row0, wc, fq); return; }
        const int tl = u.pn;
        if (tl < TL_K) headnorm(acc, act, ACT_P, (tl - TL_Q) * 256, row0, wc, fq, qgain, 0.125f * LOG2E);
        else if (tl < TL_V) headnorm(acc, ka, 1024, (tl - TL_K) * 256, row0, wc, fq, kgain, 1.0f);
        else if (tl < TL_Z) ew<0>(acc, va, 1024, (tl - TL_V) * 256, row0, wc, fq);
        else if (tl < TL_XBC) ew<1>(acc, act, ACT_P, 1024 + (tl - TL_Z) * 256, row0, wc, fq);
        else if (tl < TL_DT) ew<0>(acc, xbc, 3072, (tl - TL_XBC) * 256, row0, wc, fq);
        else if (tl == TL_DT) {
            if (wc == 0) {
                f32x4 b0 = *(const f32x4*)(dtbias + 8 * fq), b1 = *(const f32x4*)(dtbias + 8 * fq + 4);
#pragma unroll
                for (int ai = 0; ai < 2; ++ai)
#pragma unroll
                    for (int m = 0; m < 4; ++m) { float* rowp = dt + (size_t)(row0 + ai * 128 + m * 16) * 32 + 8 * fq;
                        f32x4 v0 = acc[ai][0][m][0] + b0, v1 = acc[ai][0][m][1] + b1;
                        for (int e = 0; e < 4; ++e) { v0[e] = softplus_(v0[e]); v1[e] = softplus_(v1[e]); }
                        *(f32x4*)rowp = v0; *(f32x4*)(rowp + 4) = v1; }
            }
        }
        else if (tl < TL_G) ew<0>(acc, act, ACT_P, 3072 + (tl - TL_QX) * 256, row0, wc, fq);
        else ew<2>(acc, gates, 3072, (tl - TL_G) * 256, row0, wc, fq);
    }
};

struct SchedDense {
    int G, c, nM, nN, K; const char* bbase; int reps;
    DI bool next(int i, Unit& u) const { u.kind = 0; u.aux = 0; const int U = nM * nN; int L = i * G + c; if (L >= U * reps) return false; return pg8::static_tile(L % U, nM, nN, u.pm, u.pn); }
    DI unsigned arow(const Unit& u, int r) const { return (unsigned)(u.pm * 256 + r) * (unsigned)(K * 2); }
    DI const char* bptr(const Unit& u) const { return bbase + (size_t)u.pn * 256 * K * 2; }
};

struct EpiMerge {
    static constexpr bool SEGMENTED = true;
    const bf16_t* gates; const float* rstd; bf16_t* merged; int last_seg;
    DI bool boundary(int t) const { return t == 16 || t == 24 || t == 32 || t == 40 || t == 48; }
    DI void load8(const bf16_t* p, float (&g)[8]) const { const u32x4 w = *(const u32x4*)p; g[0] = bf_lo(w.x); g[1] = bf_hi(w.x); g[2] = bf_lo(w.y); g[3] = bf_hi(w.y); g[4] = bf_lo(w.z); g[5] = bf_hi(w.z); g[6] = bf_lo(w.w); g[7] = bf_hi(w.w); }
    DI void rescale(Acc& acc, const Unit& u, int t, int wr, int wc, int fr, int fq) const {
        int row0 = u.pm * 256 + wr * 64 + fr, col0 = u.pn * 256 + wc * 32 + 8 * fq;
        asm volatile("" : "+v"(row0), "+v"(col0));
        const int go = (t == 16) ? 0 : 1024, ri = (t == 16) ? 0 : 3, g = (t == 24) ? 0 : (t == 32) ? 1 : 2;
        asm volatile("s_nop 15" ::: "memory");
#pragma unroll
        for (int ai = 0; ai < 2; ++ai)
#pragma unroll
          for (int mp = 0; mp < 2; ++mp) {
            float f[2][2][8];
            if (t == 16 || t == 48) {
                u32x4 ga[2][2], gb[2][2]; float rsv[2];
#pragma unroll
                for (int mm = 0; mm < 2; ++mm) { const int row = row0 + ai * 128 + (2 * mp + mm) * 16; const bf16_t* gp = gates + (size_t)row * 3072 + col0 + go; rsv[mm] = rstd[(size_t)row * 4 + ri];
#pragma unroll
                    for (int bj = 0; bj < 2; ++bj) { ga[mm][bj] = *(const u32x4*)(gp + bj * 128); gb[mm][bj] = *(const u32x4*)(gp + 1024 + bj * 128); } }
#pragma unroll
                for (int mm = 0; mm < 2; ++mm)
#pragma unroll
                    for (int bj = 0; bj < 2; ++bj) { float a[8], b[8]; unpack8(ga[mm][bj], a); unpack8(gb[mm][bj], b);
#pragma unroll
                        for (int j = 0; j < 8; ++j) f[mm][bj][j] = (t == 16) ? a[j] * fast_rcp(b[j] * rsv[mm]) : a[j] * rsv[mm] * fast_rcp(b[j]); }
            } else {
#pragma unroll
                for (int mm = 0; mm < 2; ++mm) { const float* rp = rstd + (size_t)(row0 + ai * 128 + (2 * mp + mm) * 16) * 4 + g; const float fr_ = rp[0] * fast_rcp(rp[1]);
#pragma unroll
                    for (int bj = 0; bj < 2; ++bj)
#pragma unroll
                        for (int j = 0; j < 8; ++j) f[mm][bj][j] = fr_; }
            }
#pragma unroll
            for (int mm = 0; mm < 2; ++mm)
#pragma unroll
                for (int bj = 0; bj < 2; ++bj)
#pragma unroll
                    for (int e = 0; e < 4; ++e) { const int m = 2 * mp + mm;
                        asm volatile("v_mul_f32 %0, %0, %1" : "+v"(acc[ai][bj][m][0][e]) : "v"(f[mm][bj][e]));
                        asm volatile("v_mul_f32 %0, %0, %1" : "+v"(acc[ai][bj][m][1][e]) : "v"(f[mm][bj][4 + e])); }
            asm volatile("" ::: "memory");
          }
    }
    DI void unpack8(const u32x4 w, float (&g)[8]) const { g[0] = bf_lo(w.x); g[1] = bf_hi(w.x); g[2] = bf_lo(w.y); g[3] = bf_hi(w.y); g[4] = bf_lo(w.z); g[5] = bf_hi(w.z); g[6] = bf_lo(w.w); g[7] = bf_hi(w.w); }
    DI void operator()(const Acc& acc, const Unit& u, int wr, int wc, int fr, int fq) const {
        int row0 = u.pm * 256 + wr * 64 + fr, col0 = u.pn * 256 + wc * 32 + 8 * fq;
        asm volatile("" : "+v"(row0), "+v"(col0));
#pragma unroll
        for (int ai = 0; ai < 2; ++ai)
#pragma unroll
          for (int mp = 0; mp < 2; ++mp) {
            u32x4 gg[2][2]; float r3[2];
#pragma unroll
            for (int mm = 0; mm < 2; ++mm) { const int row = row0 + ai * 128 + (2 * mp + mm) * 16; r3[mm] = rstd[(size_t)row * 4 + 3]; const bf16_t* gp = gates + (size_t)row * 3072 + col0 + last_seg * 1024;
#pragma unroll
                for (int bj = 0; bj < 2; ++bj) gg[mm][bj] = *(const u32x4*)(gp + bj * 128); }
#pragma unroll
            for (int mm = 0; mm < 2; ++mm) { const int m = 2 * mp + mm; const int row = row0 + ai * 128 + m * 16; bf16_t* op = merged + (size_t)row * 1024 + col0;
#pragma unroll
                for (int bj = 0; bj < 2; ++bj) { float g[8]; unpack8(gg[mm][bj], g); const float s = (last_seg == 1) ? r3[mm] : 1.0f;
                    f32x4 v0 = acc[ai][bj][m][0], v1 = acc[ai][bj][m][1];
                    u32x4 w; w.x = pk2(v0[0] * g[0] * s, v0[1] * g[1] * s); w.y = pk2(v0[2] * g[2] * s, v0[3] * g[3] * s); w.z = pk2(v1[0] * g[4] * s, v1[1] * g[5] * s); w.w = pk2(v1[2] * g[6] * s, v1[3] * g[7] * s);
                    *(u32x4*)(op + bj * 128) = w; } }
            asm volatile("" ::: "memory");
          }
    }
};

struct EpiOut {
    static constexpr bool SEGMENTED = false;
    const float* x; float* out;
    DI void operator()(const Acc& acc, const Unit& u, int wr, int wc, int fr, int fq) const {
        const int row0 = u.pm * 256 + wr * 64 + fr, col0 = u.pn * 256 + wc * 32 + 8 * fq;
#pragma unroll
        for (int ai = 0; ai < 2; ++ai)
#pragma unroll
            for (int m = 0; m < 4; ++m) { const size_t off = (size_t)(row0 + ai * 128 + m * 16) * 1024 + col0;
#pragma unroll
                for (int bj = 0; bj < 2; ++bj) { const f32x4 x0 = *(const f32x4*)(x + off + bj * 128), x1 = *(const f32x4*)(x + off + bj * 128 + 4);
                    *(f32x4*)(out + off + bj * 128) = x0 + acc[ai][bj][m][0]; *(f32x4*)(out + off + bj * 128 + 4) = x1 + acc[ai][bj][m][1]; } }
    }
};

struct SchedMoE {
    int G, c, NC, tlo, thi; const LAS int* tstart; const LAS int* cnt; const int* tokl; const char* wbase; size_t wexp; int reps; unsigned rowb; unsigned ldbb;
    DI bool next(int i, Unit& u) const {
        const int n = (thi - tlo) * NC; int L = i * G + c; if (L >= n * reps) return false; L %= n;
        { const int q = n / 8, r = n % 8, xcd = L % 8, off = L / 8; L = (xcd < r ? xcd * (q + 1) : r * (q + 1) + (xcd - r) * q) + off; }
        const int rt = tlo + L / NC; u.pn = L % NC; u.pm = rt; int e = 0;
        for (int j = 1; j < NEXP; ++j) e += (tstart[j] <= rt) ? 1 : 0;
        u.aux = __builtin_amdgcn_readfirstlane(e); u.kind = 0; return true;
    }
    DI unsigned arow(const Unit& u, int r) const {
        if (tokl) { const int e = u.aux, idx = (u.pm - tstart[e]) * 256 + r; const int tok = idx < cnt[e] ? tokl[(size_t)e * T + idx] : 0; return (unsigned)tok * rowb; }
        return (unsigned)((u.pm - tlo) * 256 + r) * rowb;
    }
    DI const char* bptr(const Unit& u) const { return wbase + (size_t)u.aux * wexp + (size_t)u.pn * 256 * ldbb; }
};
struct EpiGU {
    static constexpr bool SEGMENTED = false;
    unsigned char* actm; const float *bg, *bu; int tlo;
    DI void operator()(const Acc& acc, const Unit& u, int wr, int wc, int fr, int fq) const {
        const int row0 = (u.pm - tlo) * 256 + wr * 64 + fr, col = u.pn * 128 + wc * 32 + 8 * fq; const size_t eb = (size_t)u.aux * 1024 + col;
        const f32x4 g0 = *(const f32x4*)(bg + eb), g1 = *(const f32x4*)(bg + eb + 4), u0 = *(const f32x4*)(bu + eb), u1 = *(const f32x4*)(bu + eb + 4);
#pragma unroll
        for (int ai = 0; ai < 2; ++ai)
#pragma unroll
            for (int m = 0; m < 4; ++m) { f32x4 a0 = acc[ai][0][m][0] + g0, a1 = acc[ai][0][m][1] + g1, b0 = acc[ai][1][m][0] + u0, b1 = acc[ai][1][m][1] + u1;
                for (int e = 0; e < 4; ++e) { float g = fminf(a0[e], 7.f), uu = fminf(fmaxf(b0[e], -7.f), 7.f); a0[e] = (uu + 1.f) * g * sigmoidf_(1.702f * g);
                                              g = fminf(a1[e], 7.f); uu = fminf(fmaxf(b1[e], -7.f), 7.f); a1[e] = (uu + 1.f) * g * sigmoidf_(1.702f * g); }
                u32x2 w; w.x = pk4_fp8(a0[0], a0[1], a0[2], a0[3]); w.y = pk4_fp8(a1[0], a1[1], a1[2], a1[3]);
                *(u32x2*)(actm + (size_t)(row0 + ai * 128 + m * 16) * 1024 + col) = w; }
    }
};
struct EpiDown {
    static constexpr bool SEGMENTED = false;
    bf16_t* y; const float* bd; int tlo;
    DI void operator()(const Acc& acc, const Unit& u, int wr, int wc, int fr, int fq) const {
        const int row0 = (u.pm - tlo) * 256 + wr * 64 + fr, col0 = u.pn * 256 + wc * 32 + 8 * fq; const float* bp = bd + (size_t)u.aux * 1024 + col0;
        f32x4 bv[2][2];
#pragma unroll
        for (int bj = 0; bj < 2; ++bj) { bv[bj][0] = *(const f32x4*)(bp + bj * 128); bv[bj][1] = *(const f32x4*)(bp + bj * 128 + 4); }
#pragma unroll
        for (int ai = 0; ai < 2; ++ai)
#pragma unroll
            for (int m = 0; m < 4; ++m) { bf16_t* rowp = y + (size_t)(row0 + ai * 128 + m * 16) * 1024 + col0;
#pragma unroll
                for (int bj = 0; bj < 2; ++bj) { const f32x4 v0 = acc[ai][bj][m][0] + bv[bj][0], v1 = acc[ai][bj][m][1] + bv[bj][1];
                    u32x4 w; w.x = pk2(v0[0], v0[1]); w.y = pk2(v0[2], v0[3]); w.z = pk2(v1[0], v1[1]); w.w = pk2(v1[2], v1[3]);
                    *(u32x4*)(rowp + bj * 128) = w; } }
    }
};
struct TrItem { const float* W; int Ns, k0, sc0, sc1; void* dst; int dpitch; const float* kscale; float mul; int fp8; };
DI void tr_load(const TrItem& it, f32x4 (&v)[16], int lane) {
    const int cl = lane & 15, kl = lane >> 4, sc = (cl < 8) ? it.sc0 : it.sc1, col = sc + 4 * (cl & 7);
#pragma unroll
    for (int i = 0; i < 16; ++i) { v[i] = (f32x4){0.f, 0.f, 0.f, 0.f}; if (sc >= 0) v[i] = *(const f32x4*)(it.W + (size_t)(it.k0 + 4 * i + kl) * it.Ns + col); }
}
DI void tr_store(const TrItem& it, const f32x4 (&v)[16], LAS float* scr, int lane) {
    const int cl = lane & 15, kl = lane >> 4;
#pragma unroll
    for (int i = 0; i < 16; ++i) { const int kk = 4 * i + kl; f32x4 x = v[i] * it.mul; if (it.kscale) x *= it.kscale[it.k0 + kk]; LAS float* p = scr + kk * 65 + 4 * cl; p[0] = x[0]; p[1] = x[1]; p[2] = x[2]; p[3] = x[3]; }
    asm volatile("s_waitcnt lgkmcnt(0)" ::: "memory");
    if (it.fp8) { const int c = lane & 3; unsigned char* dst = (unsigned char*)it.dst;
#pragma unroll
        for (int j = 0; j < 4; ++j) { const int n = (lane >> 2) + 16 * j; const LAS float* s = scr + (16 * c) * 65 + n;
            u32x4 o; o.x = pk4_fp8(s[0 * 65], s[1 * 65], s[2 * 65], s[3 * 65]); o.y = pk4_fp8(s[4 * 65], s[5 * 65], s[6 * 65], s[7 * 65]);
            o.z = pk4_fp8(s[8 * 65], s[9 * 65], s[10 * 65], s[11 * 65]); o.w = pk4_fp8(s[12 * 65], s[13 * 65], s[14 * 65], s[15 * 65]);
            *(u32x4*)(dst + (size_t)n * it.dpitch + 16 * c) = o; }
    } else { const int c = lane & 7; bf16_t* dst = (bf16_t*)it.dst;
#pragma unroll
        for (int j = 0; j < 8; ++j) { const int n = (lane >> 3) + 8 * j; const LAS float* s = scr + (8 * c) * 65 + n;
            u32x4 o; o.x = pk2(s[0 * 65], s[1 * 65]); o.y = pk2(s[2 * 65], s[3 * 65]); o.z = pk2(s[4 * 65], s[5 * 65]); o.w = pk2(s[6 * 65], s[7 * 65]);
            *(u32x4*)(dst + (size_t)n * it.dpitch + 8 * c) = o; }
    }
    asm volatile("s_waitcnt lgkmcnt(0)" ::: "memory");
}
DI int win_src_col(int nb) {
    const int tile = nb >> 3, sub = nb & 7;
    if (tile < TL_V) { const int base = tile < TL_K ? 256 * tile : 1024 + 256 * (tile - TL_K); return base + 32 * (2 * (sub & 3) + (sub >> 2)); }
    if (tile < TL_Z) return 2048 + 256 * (tile - TL_V) + 32 * sub;
    if (tile < TL_XBC) return 3072 + 256 * (tile - TL_Z) + 32 * sub;
    if (tile < TL_DT) return 5120 + 256 * (tile - TL_XBC) + 32 * sub;
    if (tile == TL_DT) return sub == 0 ? 8192 : -1;
    if (tile < TL_G) return 8224 + 256 * (tile - TL_QX) + 32 * sub;
    return 9248 + 256 * (tile - TL_G) + 32 * sub;
}
template <int NR> DI void rms_rows_to_bf16(const float* x, bf16_t* o, size_t row_stride, const float* gain, int lane) {
    f32x4 v[NR][4]; float s[NR];
#pragma unroll
    for (int r = 0; r < NR; ++r) { const f32x4* xr = (const f32x4*)(x + (size_t)r * row_stride * 1024) + lane; s[r] = 0.f;
#pragma unroll
        for (int j = 0; j < 4; ++j) { v[r][j] = xr[64 * j]; } }
#pragma unroll
    for (int r = 0; r < NR; ++r) {
#pragma unroll
        for (int j = 0; j < 4; ++j) s[r] += (v[r][j].x * v[r][j].x + v[r][j].y * v[r][j].y) + (v[r][j].z * v[r][j].z + v[r][j].w * v[r][j].w);
        s[r] = __builtin_amdgcn_rsqf(wave_sum(s[r]) * (1.f / 1024.f) + EPS); }
    const f32x4* gr = (const f32x4*)gain + lane;
#pragma unroll
    for (int j = 0; j < 4; ++j) { const f32x4 g = gr[64 * j];
#pragma unroll
        for (int r = 0; r < NR; ++r) { u32x2 w; w.x = pk2(v[r][j].x * s[r] * g.x, v[r][j].y * s[r] * g.y); w.y = pk2(v[r][j].z * s[r] * g.z, v[r][j].w * s[r] * g.w); ((u32x2*)(o + (size_t)r * row_stride * 1024) + lane)[64 * j] = w; } }
}


template <int NR> DI void rms_rows_to_fp8(const float* x, unsigned char* o, const float* gain, int lane) {
    f32x4 v[NR][4]; float s[NR];
#pragma unroll
    for (int r = 0; r < NR; ++r) { const f32x4* xr = (const f32x4*)(x + (size_t)r * 1024) + lane; s[r] = 0.f;
#pragma unroll
        for (int j = 0; j < 4; ++j) { v[r][j] = xr[64 * j]; } }
#pragma unroll
    for (int r = 0; r < NR; ++r) {
#pragma unroll
        for (int j = 0; j < 4; ++j) s[r] += (v[r][j].x * v[r][j].x + v[r][j].y * v[r][j].y) + (v[r][j].z * v[r][j].z + v[r][j].w * v[r][j].w);
        s[r] = __builtin_amdgcn_rsqf(wave_sum(s[r]) * (1.f / 1024.f) + EPS); }
    const f32x4* gr = (const f32x4*)gain + lane;
#pragma unroll
    for (int j = 0; j < 4; ++j) { const f32x4 g = gr[64 * j];
#pragma unroll
        for (int r = 0; r < NR; ++r) ((unsigned*)(o + (size_t)r * 1024) + lane)[64 * j] = pk4_fp8(v[r][j].x * s[r] * g.x, v[r][j].y * s[r] * g.y, v[r][j].z * s[r] * g.z, v[r][j].w * s[r] * g.w); }
}

DI int crow(int r, int hi) { return (r & 3) + 8 * (r >> 2) + 4 * hi; }
DI s16x4 vtr(const LAS unsigned char* p) { return __builtin_bit_cast(s16x4, __builtin_amdgcn_ds_read_tr16_b64_v4i16((LAS v4i16_t*)p)); }
#define MFMA32(a, b, c) __builtin_amdgcn_mfma_f32_32x32x16_bf16((a), (b), (c), 0, 0, 0)
#define MFMA16(a, b, c) __builtin_amdgcn_mfma_f32_16x16x32_bf16((a), (b), (c), 0, 0, 0)
DI void tile_load(u32x4 (&r)[4], const bf16_t* g, size_t pitch, int tid) {
#pragma unroll
    for (int i = 0; i < 4; ++i) { const int q = tid + 512 * i, row = q >> 5, ch = q & 31; r[i] = *(const u32x4*)(g + (size_t)row * pitch + ch * 8); }
}
DI void tile_store_k(LAS unsigned char* dst, const u32x4 (&r)[4], int tid) {
#pragma unroll
    for (int i = 0; i < 4; ++i) { const int q = tid + 512 * i, row = q >> 5, ch = q & 31; *(LAS u32x4*)(dst + row * 512 + ((ch ^ (row & 15)) << 4)) = r[i]; }
}
DI void tile_store_v(LAS unsigned char* dst, const u32x4 (&r)[4], int tid) {
#pragma unroll
    for (int i = 0; i < 4; ++i) { const int q = tid + 512 * i, row = q >> 5, ch = q & 31; *(LAS u32x4*)(dst + row * 512 + ((((ch >> 2) ^ (row & 3)) * 4 + (ch & 3)) << 4)) = r[i]; }
}
constexpr int AT_K = 0, AT_V = 32768, AT_BIAS = 65536, AT_BIAS_STRIDE = 260;

constexpr float SM_THR = 8.0f;
DI bool softmax_tile(f32x16& s0, f32x16& s1, float& m, float& l, bf16x8 (&pa)[4], float& alpha) {
    float mx = fmaxf(s0[0], s1[0]);
#pragma unroll
    for (int r = 1; r < 16; ++r) mx = fmaxf(mx, fmaxf(s0[r], s1[r]));
    mx = fmaxf(mx, __shfl_xor(mx, 32));
    bool moved = false; alpha = 1.0f;
    if (__builtin_expect(__any(mx > SM_THR), 0)) {
        const float dl = fmaxf(mx, 0.f); m += dl; alpha = fast_exp2(-dl); l *= alpha; moved = true;
#pragma unroll
        for (int r = 0; r < 16; ++r) { s0[r] -= dl; s1[r] -= dl; }
    }
    float sum = 0.f;
#pragma unroll
    for (int r = 0; r < 16; ++r) { s0[r] = fast_exp2(s0[r]); s1[r] = fast_exp2(s1[r]); sum += s0[r] + s1[r]; }
    l += sum;
    u32x4 w;
    w.x = pk2(s0[0], s0[1]); w.y = pk2(s0[2], s0[3]); w.z = pk2(s0[4], s0[5]); w.w = pk2(s0[6], s0[7]); pa[0] = __builtin_bit_cast(bf16x8, w);
    w.x = pk2(s0[8], s0[9]); w.y = pk2(s0[10], s0[11]); w.z = pk2(s0[12], s0[13]); w.w = pk2(s0[14], s0[15]); pa[1] = __builtin_bit_cast(bf16x8, w);
    w.x = pk2(s1[0], s1[1]); w.y = pk2(s1[2], s1[3]); w.z = pk2(s1[4], s1[5]); w.w = pk2(s1[6], s1[7]); pa[2] = __builtin_bit_cast(bf16x8, w);
    w.x = pk2(s1[8], s1[9]); w.y = pk2(s1[10], s1[11]); w.z = pk2(s1[12], s1[13]); w.w = pk2(s1[14], s1[15]); pa[3] = __builtin_bit_cast(bf16x8, w);
    return moved;
}
DI bf16x8 v_frag(const LAS unsigned char* vt, int s, int colbyte0, int lane) {
    const int hi = lane >> 5, q_ = (lane & 15) >> 2, p_ = lane & 3, blk = (lane >> 4) & 1;
    const int cb = colbyte0 + blk * 32 + p_ * 8, u = cb >> 6, within = cb & 63;
    const int R = 16 * s + 4 * hi + q_;
    const s16x4 lo = vtr(vt + R * 512 + ((u ^ q_) << 6) + within);
    const s16x4 h4 = vtr(vt + (R + 8) * 512 + ((u ^ q_) << 6) + within);
    return __builtin_shufflevector(lo, h4, 0, 1, 2, 3, 4, 5, 6, 7);
}

DI void attnA_unit(LAS unsigned char* lds, int b, int c, int hq, bf16_t* act, const bf16_t* ka, const bf16_t* va, bf16_t* outp, size_t opitch) {
    const int tid = threadIdx.x, lane = tid & 63, wid = __builtin_amdgcn_readfirstlane(tid >> 6), hl = wid >> 1, qh = wid & 1, head = 4 * hq + hl, l31 = lane & 31, hi = lane >> 5;
    const size_t trow = (size_t)b * SEQ + 64 * c + 32 * qh + l31;
    bf16_t* qp = act + trow * ACT_P + 64 * head;
    bf16x8 qf[4];
#pragma unroll
    for (int d0 = 0; d0 < 4; ++d0) qf[d0] = *(const bf16x8*)(qp + 16 * d0 + 8 * hi);
    f32x16 o0, o1;
#pragma unroll
    for (int r = 0; r < 16; ++r) { o0[r] = 0.f; o1[r] = 0.f; }
    float m = 0.f, l = 0.f;
    const int kc0 = c < 8 ? 0 : c - 8;
    const LAS float* bias = (const LAS float*)(lds + AT_BIAS) + head * AT_BIAS_STRIDE;
    const float b256 = bias[256];
    u32x4 rk[4], rv[4];
    const bf16_t* kb = ka + ((size_t)b * SEQ + 64 * kc0) * 1024 + 256 * hq; const bf16_t* vb = va + ((size_t)b * SEQ + 64 * kc0) * 1024 + 256 * hq;
    tile_load(rk, kb, 1024, tid); tile_load(rv, vb, 1024, tid);
    const int qi = 32 * qh + l31;
    for (int kc = kc0; kc <= c; ++kc) {
        __syncthreads();
        tile_store_k(lds + AT_K, rk, tid); tile_store_v(lds + AT_V, rv, tid);
        if (kc < c) { kb += 64 * 1024; vb += 64 * 1024; tile_load(rk, kb, 1024, tid); tile_load(rv, vb, 1024, tid); }
        __syncthreads();
        const int j = c - kc;
        f32x16 s0, s1;
        if (j >= 3) { const float c0 = b256 - m;
#pragma unroll
            for (int r = 0; r < 16; ++r) { s0[r] = c0; s1[r] = c0; }
        } else {
#pragma unroll
            for (int r = 0; r < 16; ++r) { const int rel0 = 64 * j + qi - crow(r, hi); s0[r] = bias[min(rel0, 128) + 128] - m; s1[r] = bias[min(rel0 - 32, 128) + 128] - m; }
        }
#pragma unroll
        for (int d0 = 0; d0 < 4; ++d0) {
            const int ch = 8 * hl + 2 * d0 + hi;
            const bf16x8 k0 = *(const LAS bf16x8*)(lds + AT_K + l31 * 512 + ((ch ^ (l31 & 15)) << 4));
            const bf16x8 k1 = *(const LAS bf16x8*)(lds + AT_K + (32 + l31) * 512 + ((ch ^ (l31 & 15)) << 4));
            s0 = MFMA32(k0, qf[d0], s0); s1 = MFMA32(k1, qf[d0], s1);
        }
        bf16x8 pa[4]; float alpha;
        if (softmax_tile(s0, s1, m, l, pa, alpha)) {
#pragma unroll
            for (int r = 0; r < 16; ++r) { o0[r] *= alpha; o1[r] *= alpha; } }
#pragma unroll
        for (int s = 0; s < 4; ++s) {
            const bf16x8 v0 = v_frag(lds + AT_V, s, (64 * hl) * 2, lane), v1 = v_frag(lds + AT_V, s, (64 * hl + 32) * 2, lane);
            o0 = MFMA32(v0, pa[s], o0); o1 = MFMA32(v1, pa[s], o1);
        }
    }
    const float lt = l + __shfl_xor(l, 32), inv = fast_rcp(lt);
#pragma unroll
    for (int rg = 0; rg < 4; ++rg) {
        u32x2 w0, w1; w0.x = pk2(o0[4 * rg] * inv, o0[4 * rg + 1] * inv); w0.y = pk2(o0[4 * rg + 2] * inv, o0[4 * rg + 3] * inv);
        w1.x = pk2(o1[4 * rg] * inv, o1[4 * rg + 1] * inv); w1.y = pk2(o1[4 * rg + 2] * inv, o1[4 * rg + 3] * inv);
        bf16_t* op = outp + trow * opitch + 64 * head; *(u32x2*)(op + 8 * rg + 4 * hi) = w0; *(u32x2*)(op + 32 + 8 * rg + 4 * hi) = w1;
    }
}

constexpr int AT_Q = 65536;
DI void attnC_phase(LAS unsigned char* lds, int vcu, int G, bf16_t* act, const bf16_t* kx, const bf16_t* memkv, bf16_t* outp, size_t opitch) {
    const int tid = threadIdx.x, lane = tid & 63, wid = __builtin_amdgcn_readfirstlane(tid >> 6), rg = wid >> 1, dh = wid & 1, l31 = lane & 31, hi = lane >> 5;
    constexpr int NU = NBATCH * 4 * 32;
    const int upw = (NU + G - 1) / G, u0 = vcu * upw, u1 = (u0 + upw < NU) ? u0 + upw : NU;
    if (u0 >= NU) return;
    const int nsteps = (u1 - u0) * 4;
    u32x4 rk[4], rv[4];
    { const int b = u0 >> 7, hx = (u0 >> 5) & 3;
      tile_load(rk, kx + ((size_t)b * MEMLEN) * 1024 + 256 * hx, 1024, tid); tile_load(rv, memkv + ((size_t)b * MEMLEN) * 2048 + 1024 + 256 * hx, 2048, tid); }
    f32x16 o[4]; float m = 0.f, l = 0.f, rstd = 1.f;
    for (int n = 0; n < nsteps; ++n) {
        const int u = u0 + (n >> 2), j = n & 3, rb = u & 31, hx = (u >> 5) & 3, b = u >> 7;
        const size_t trow = (size_t)b * SEQ + 128 * rb + 32 * rg + l31;
        u32x4 rq[8];
        if (j == 0) {
#pragma unroll
            for (int i = 0; i < 8; ++i) { const int q = tid + 512 * i, row = q >> 5, ch = q & 31; rq[i] = *(const u32x4*)(act + ((size_t)b * SEQ + 128 * rb + row) * ACT_P + 3072 + 256 * hx + ch * 8); }
#pragma unroll
            for (int i = 0; i < 4; ++i)
#pragma unroll
                for (int r = 0; r < 16; ++r) o[i][r] = 0.f;
            m = 0.f; l = 0.f;
        }
        __syncthreads();
        tile_store_k(lds + AT_K, rk, tid); tile_store_v(lds + AT_V, rv, tid);
        if (j == 0) {
#pragma unroll
            for (int i = 0; i < 8; ++i) { const int q = tid + 512 * i, row = q >> 5, ch = q & 31; *(LAS u32x4*)(lds + AT_Q + row * 512 + ((ch ^ (row & 15)) << 4)) = rq[i]; }
        }
        if (n + 1 < nsteps) { const int un = u0 + ((n + 1) >> 2), jn = (n + 1) & 3, hxn = (un >> 5) & 3, bn = un >> 7;
            tile_load(rk, kx + ((size_t)bn * MEMLEN + 64 * jn) * 1024 + 256 * hxn, 1024, tid); tile_load(rv, memkv + ((size_t)bn * MEMLEN + 64 * jn) * 2048 + 1024 + 256 * hxn, 2048, tid); }
        __syncthreads();
        f32x16 s0, s1;
#pragma unroll
        for (int r = 0; r < 16; ++r) { s0[r] = 0.f; s1[r] = 0.f; }
        float ssq = 0.f;
#pragma unroll
        for (int d0 = 0; d0 < 16; ++d0) {
            const int ch = 2 * d0 + hi;
            const bf16x8 qfr = *(const LAS bf16x8*)(lds + AT_Q + (32 * rg + l31) * 512 + ((ch ^ (l31 & 15)) << 4));
            const bf16x8 k0 = *(const LAS bf16x8*)(lds + AT_K + l31 * 512 + ((ch ^ (l31 & 15)) << 4));
            const bf16x8 k1 = *(const LAS bf16x8*)(lds + AT_K + (32 + l31) * 512 + ((ch ^ (l31 & 15)) << 4));
            if (j == 0) {
#pragma unroll
                for (int e = 0; e < 8; ++e) { const float v = bf2f((bf16_t)qfr[e]); ssq += v * v; } }
            s0 = MFMA32(k0, qfr, s0); s1 = MFMA32(k1, qfr, s1);
        }
        if (j == 0) { ssq += __shfl_xor(ssq, 32); rstd = __builtin_amdgcn_rsqf(ssq * (1.f / 256.f) + EPS); }
#pragma unroll
        for (int r = 0; r < 16; ++r) { s0[r] = s0[r] * rstd - m; s1[r] = s1[r] * rstd - m; }
        bf16x8 pa[4]; float alpha;
        if (softmax_tile(s0, s1, m, l, pa, alpha)) {
#pragma unroll
            for (int i = 0; i < 4; ++i)
#pragma unroll
                for (int r = 0; r < 16; ++r) o[i][r] *= alpha; }
#pragma unroll
        for (int s = 0; s < 4; ++s)
#pragma unroll
            for (int i = 0; i < 4; ++i) { const bf16x8 vf = v_frag(lds + AT_V, s, (128 * dh + 32 * i) * 2, lane); o[i] = MFMA32(vf, pa[s], o[i]); }
        if (j == 3) {
            const float lt = l + __shfl_xor(l, 32), inv = fast_rcp(lt);
            bf16_t* op = outp + trow * opitch + 256 * hx + 128 * dh;
#pragma unroll
            for (int i = 0; i < 4; ++i)
#pragma unroll
                for (int g4 = 0; g4 < 4; ++g4) { u32x2 w; w.x = pk2(o[i][4 * g4] * inv, o[i][4 * g4 + 1] * inv); w.y = pk2(o[i][4 * g4 + 2] * inv, o[i][4 * g4 + 3] * inv);
                    *(u32x2*)(op + 32 * i + 8 * g4 + 4 * hi) = w; }
        }
    }
    __syncthreads();
}

constexpr int MB_XDT = 0, MB_XDTW = 9216, MB_BM = 18432, MB_CM = 35840, MB_YD = 53248, MB_YO = 70656, MB_ACS = 88064, MB_YSTR = 272;
DI int mb_b256(int row, int col) { return row * 272 + col * 2; }
DI int mb_b128(int row, int col) { return row * 144 + col * 2; }
template <bool W256> DI bf16x8 tr_pair(const LAS unsigned char* base, int row_lo, int row_hi, int col0, int lane) {
    const int i = lane & 15, r = i >> 2, c = col0 + 4 * (i & 3);
    const s16x4 lo = vtr(base + (W256 ? mb_b256(row_lo + r, c) : mb_b128(row_lo + r, c))), h4 = vtr(base + (W256 ? mb_b256(row_hi + r, c) : mb_b128(row_hi + r, c)));
    return __builtin_shufflevector(lo, h4, 0, 1, 2, 3, 4, 5, 6, 7);
}
DI void bcconv_phase(int vcu, int G, const bf16_t* xbc, bf16_t* bc, const float* conv_w, const float* conv_b, const float* dtp, float* acsp, const float* a_log) {
    {
        const int lane = threadIdx.x & 63, wv = threadIdx.x >> 6;
        for (int ck = vcu * 8 + wv; ck < T / 64; ck += G * 8) {
            const float* dr = dtp + ((size_t)ck * 64 + lane) * 32; float* orow = acsp + ((size_t)ck * 64 + lane) * 32;
#pragma unroll
            for (int q = 0; q < 8; ++q) { f32x4 v = *(const f32x4*)(dr + 4 * q); const f32x4 al = *(const f32x4*)(a_log + 4 * q);
#pragma unroll
                for (int e = 0; e < 4; ++e) { float a = -v[e] * __expf(al[e]);
#pragma unroll
                    for (int o = 1; o < 64; o <<= 1) { const float u = __shfl_up(a, o); if (lane >= o) a += u; }
                    v[e] = a; }
                *(f32x4*)(orow + 4 * q) = v; }
        }
    }
    for (int task = vcu * 512 + threadIdx.x; task < (T / 16) * 128; task += G * 512) {
        const int cc = task & 127, run = task >> 7, g = cc >> 5, w = cc & 31;
        const int scol = (w < 16 ? 2048 + 128 * g + 8 * w : 2560 + 128 * g + 8 * (w - 16));
        const int t0 = run * 16, pos0 = t0 & (SEQ - 1);
        float cw[4][8], cb[8];
#pragma unroll
        for (int e = 0; e < 8; ++e) { cb[e] = conv_b[scol + e];
#pragma unroll
            for (int i = 0; i < 4; ++i) cw[i][e] = conv_w[i * 3072 + scol + e]; }
        float win[3][8];
#pragma unroll
        for (int k = 0; k < 3; ++k) { u32x4 wv = (u32x4){0u, 0u, 0u, 0u}; if (pos0 + k - 3 >= 0) wv = *(const u32x4*)(xbc + (size_t)(t0 + k - 3) * 3072 + scol);
            win[k][0] = bf_lo(wv.x); win[k][1] = bf_hi(wv.x); win[k][2] = bf_lo(wv.y); win[k][3] = bf_hi(wv.y); win[k][4] = bf_lo(wv.z); win[k][5] = bf_hi(wv.z); win[k][6] = bf_lo(wv.w); win[k][7] = bf_hi(wv.w); }
#pragma unroll 4
        for (int k = 0; k < 16; ++k) {
            const u32x4 wv = *(const u32x4*)(xbc + (size_t)(t0 + k) * 3072 + scol);
            const float cur[8] = {bf_lo(wv.x), bf_hi(wv.x), bf_lo(wv.y), bf_hi(wv.y), bf_lo(wv.z), bf_hi(wv.z), bf_lo(wv.w), bf_hi(wv.w)};
            float o[8];
#pragma unroll
            for (int e = 0; e < 8; ++e) { o[e] = silu_(cb[e] + cw[0][e] * win[0][e] + cw[1][e] * win[1][e] + cw[2][e] * win[2][e] + cw[3][e] * cur[e]); win[0][e] = win[1][e]; win[1][e] = win[2][e]; win[2][e] = cur[e]; }
            u32x4 ov; ov.x = pk2(o[0], o[1]); ov.y = pk2(o[2], o[3]); ov.z = pk2(o[4], o[5]); ov.w = pk2(o[6], o[7]);
            *(u32x4*)(bc + (size_t)(t0 + k) * 1024 + 8 * cc) = ov;
        }
    }
}
constexpr int MP_IMG = 44800, MP_XDT = 0, MP_BM = 9216, MP_CM = 26624, MP_ACS = 44032, MP_W = 44288, MP_Y0 = 2 * MP_IMG, MP_YSZ = 34816, MP_YD = 0, MP_YO = 17408, MP_CW = MP_Y0 + 2 * MP_YSZ;
DI void mamba_unit(LAS unsigned char* lds, int b, int h, const bf16_t* xbc, const bf16_t* bc, const float* dtp, const float* acsp, bf16_t* act, float* ssq_out, bf16_t* outp, size_t opitch,
                   const float* conv_w, const float* conv_b, const float* a_log, const float* d_skip) {
    const int tid = threadIdx.x, lane = tid & 63, wid = __builtin_amdgcn_readfirstlane(tid >> 6), fr = lane & 15, fq = lane >> 4, g = h >> 3;
    const float D_h = d_skip[h];
    const int l = tid >> 3, pc = tid & 7, xcol = 64 * h + 8 * pc;
    LAS float* cwl = (LAS float*)(lds + MP_CW);
    if (tid < 256) cwl[tid] = conv_w[(tid >> 6) * 3072 + 64 * h + (tid & 63)]; else if (tid < 320) cwl[tid] = conv_b[64 * h + (tid & 63)];
    f32x4 Z[8];
#pragma unroll
    for (int i = 0; i < 8; ++i) Z[i] = (f32x4){0.f, 0.f, 0.f, 0.f};
    const int frow0 = tid >> 4, fch = tid & 15;
    const size_t tb = (size_t)b * SEQ;
    u32x4 xr[4], bcr[4]; float dt_l, acs_l, acs63;
#define MB_LOAD(c_) do { const int p0_ = 64 * (c_); \
        _Pragma("unroll") for (int i_ = 0; i_ < 4; ++i_) { const int pos_ = p0_ + l - 3 + i_; xr[i_] = (u32x4){0u, 0u, 0u, 0u}; if (pos_ >= 0) xr[i_] = *(const u32x4*)(xbc + (tb + pos_) * 3072 + xcol); } \
        _Pragma("unroll") for (int i_ = 0; i_ < 4; ++i_) bcr[i_] = *(const u32x4*)(bc + (tb + p0_ + frow0 + 32 * (i_ & 1)) * 1024 + 256 * g + 128 * (i_ >> 1) + 8 * fch); \
        dt_l = dtp[(tb + p0_ + l) * 32 + h]; acs_l = acsp[(tb + p0_ + l) * 32 + h]; acs63 = acsp[(tb + p0_ + 63) * 32 + h]; } while (0)
    auto S1 = [&](const int cn, float (&xs)[8]) __attribute__((always_inline)) {
        LAS unsigned char* img = lds + (cn & 1) * MP_IMG;
        if (pc == 0) { ((LAS float*)(img + MP_ACS))[l] = acs_l; ((LAS float*)(img + MP_W))[l] = __expf(acs63 - acs_l); }
        { float r[4][8];
#pragma unroll
          for (int i = 0; i < 4; ++i) { r[i][0] = bf_lo(xr[i].x); r[i][1] = bf_hi(xr[i].x); r[i][2] = bf_lo(xr[i].y); r[i][3] = bf_hi(xr[i].y); r[i][4] = bf_lo(xr[i].z); r[i][5] = bf_hi(xr[i].z); r[i][6] = bf_lo(xr[i].w); r[i][7] = bf_hi(xr[i].w); }
          const f32x4 b0 = *(const LAS f32x4*)(cwl + 256 + 8 * pc), b1 = *(const LAS f32x4*)(cwl + 256 + 8 * pc + 4);
          float a[8] = {b0[0], b0[1], b0[2], b0[3], b1[0], b1[1], b1[2], b1[3]};
#pragma unroll
          for (int i = 0; i < 4; ++i) { const f32x4 w0 = *(const LAS f32x4*)(cwl + 64 * i + 8 * pc), w1 = *(const LAS f32x4*)(cwl + 64 * i + 8 * pc + 4);
              a[0] += w0[0] * r[i][0]; a[1] += w0[1] * r[i][1]; a[2] += w0[2] * r[i][2]; a[3] += w0[3] * r[i][3]; a[4] += w1[0] * r[i][4]; a[5] += w1[1] * r[i][5]; a[6] += w1[2] * r[i][6]; a[7] += w1[3] * r[i][7]; }
#pragma unroll
          for (int e = 0; e < 8; ++e) xs[e] = silu_(a[e]); }
        { const float d = dt_l; u32x4 av; av.x = pk2(xs[0] * d, xs[1] * d); av.y = pk2(xs[2] * d, xs[3] * d); av.z = pk2(xs[4] * d, xs[5] * d); av.w = pk2(xs[6] * d, xs[7] * d);
          *(LAS u32x4*)(img + MP_XDT + mb_b128(l, 8 * pc)) = av; }
#pragma unroll
        for (int i = 0; i < 4; ++i) *(LAS u32x4*)(img + (i < 2 ? MP_BM : MP_CM) + mb_b256(frow0 + 32 * (i & 1), 8 * fch)) = bcr[i];
        { const int cq = cn < 63 ? cn + 1 : 63; MB_LOAD(cq); }
    };
    auto S2 = [&](const int c) __attribute__((always_inline)) {
        const LAS unsigned char* img = lds + (c & 1) * MP_IMG; LAS unsigned char* yb = lds + MP_Y0 + (c & 1) * MP_YSZ;
        const LAS float* acs = (const LAS float*)(img + MP_ACS);
        if (wid >= 4) {
            const int d = wid - 4; const float la = acs[16 * d + fr];
            f32x4 X[4];
            bf16x8 cf[4];
#pragma unroll
            for (int ks = 0; ks < 4; ++ks) cf[ks] = *(const LAS bf16x8*)(img + MP_CM + mb_b256(16 * d + fr, 32 * ks + 8 * fq));
#pragma unroll
            for (int si = 0; si < 4; ++si) { X[si] = (f32x4){0.f, 0.f, 0.f, 0.f};
                if (si <= d) {
                    bf16x8 af[4];
#pragma unroll
                    for (int ks = 0; ks < 4; ++ks) af[ks] = *(const LAS bf16x8*)(img + MP_BM + mb_b256(16 * si + fr, 32 * ks + 8 * fq));
#pragma unroll
                    for (int ks = 0; ks < 4; ++ks) X[si] = MFMA16(af[ks], cf[ks], X[si]);
                    const f32x4 sa = *(const LAS f32x4*)(acs + 16 * si + 4 * fq);
#pragma unroll
                    for (int r = 0; r < 4; ++r) { const int s_abs = 16 * si + 4 * fq + r, l_abs = 16 * d + fr; X[si][r] = (s_abs <= l_abs) ? X[si][r] * __expf(la - sa[r]) : 0.f; }
                } }
            bf16x8 Xp[2];
#pragma unroll
            for (int sb = 0; sb < 2; ++sb) { u32x4 w; w.x = pk2(X[2 * sb][0], X[2 * sb][1]); w.y = pk2(X[2 * sb][2], X[2 * sb][3]); w.z = pk2(X[2 * sb + 1][0], X[2 * sb + 1][1]); w.w = pk2(X[2 * sb + 1][2], X[2 * sb + 1][3]); Xp[sb] = __builtin_bit_cast(bf16x8, w); }
#pragma unroll
            for (int ph = 0; ph < 2; ++ph) { bf16x8 xa[2][2];
#pragma unroll
                for (int q = 0; q < 2; ++q)
#pragma unroll
                    for (int sb = 0; sb < 2; ++sb) if (2 * sb <= d) xa[q][sb] = tr_pair<false>(img + MP_XDT, 32 * sb + 4 * fq, 32 * sb + 16 + 4 * fq, 16 * (2 * ph + q), lane);
#pragma unroll
                for (int q = 0; q < 2; ++q) { f32x4 y = (f32x4){0.f, 0.f, 0.f, 0.f};
#pragma unroll
                    for (int sb = 0; sb < 2; ++sb) { if (2 * sb <= d) y = MFMA16(xa[q][sb], Xp[sb], y); }
                    *(LAS f32x4*)(yb + MP_YD + (16 * d + fr) * MB_YSTR + (16 * (2 * ph + q) + 4 * fq) * 4) = y; } }
        } else {
            const int pw = wid;
            bf16x8 Zp[4];
#pragma unroll
            for (int nb = 0; nb < 4; ++nb) { u32x4 w; w.x = pk2(Z[2 * nb][0], Z[2 * nb][1]); w.y = pk2(Z[2 * nb][2], Z[2 * nb][3]); w.z = pk2(Z[2 * nb + 1][0], Z[2 * nb + 1][1]); w.w = pk2(Z[2 * nb + 1][2], Z[2 * nb + 1][3]); Zp[nb] = __builtin_bit_cast(bf16x8, w); }
#pragma unroll
            for (int lt = 0; lt < 4; ++lt) { f32x4 y = (f32x4){0.f, 0.f, 0.f, 0.f};
                bf16x8 bfr[4];
#pragma unroll
                for (int nb = 0; nb < 4; ++nb) { const s16x4 lo = *(const LAS s16x4*)(img + MP_CM + mb_b256(16 * lt + fr, 32 * nb + 4 * fq)), h4 = *(const LAS s16x4*)(img + MP_CM + mb_b256(16 * lt + fr, 32 * nb + 16 + 4 * fq));
                    bfr[nb] = __builtin_shufflevector(lo, h4, 0, 1, 2, 3, 4, 5, 6, 7); }
#pragma unroll
                for (int nb = 0; nb < 4; ++nb) y = MFMA16(Zp[nb], bfr[nb], y);
                const float ea = __expf(acs[16 * lt + fr]); y *= ea;
                *(LAS f32x4*)(yb + MP_YO + (16 * lt + fr) * MB_YSTR + (16 * pw + 4 * fq) * 4) = y; }
            const float dec = __expf(acs[63]);
            bf16x8 xw[2];
#pragma unroll
            for (int lb = 0; lb < 2; ++lb) { const bf16x8 xf = tr_pair<false>(img + MP_XDT, 32 * lb + 8 * fq, 32 * lb + 8 * fq + 4, 16 * pw, lane);
                const f32x4 w0 = *(const LAS f32x4*)((const LAS float*)(img + MP_W) + 32 * lb + 8 * fq), w1 = *(const LAS f32x4*)((const LAS float*)(img + MP_W) + 32 * lb + 8 * fq + 4);
                u32x4 o; o.x = pk2(bf2f((bf16_t)xf[0]) * w0[0], bf2f((bf16_t)xf[1]) * w0[1]); o.y = pk2(bf2f((bf16_t)xf[2]) * w0[2], bf2f((bf16_t)xf[3]) * w0[3]);
                o.z = pk2(bf2f((bf16_t)xf[4]) * w1[0], bf2f((bf16_t)xf[5]) * w1[1]); o.w = pk2(bf2f((bf16_t)xf[6]) * w1[2], bf2f((bf16_t)xf[7]) * w1[3]); xw[lb] = __builtin_bit_cast(bf16x8, o); }
#pragma unroll
            for (int np = 0; np < 4; ++np) { bf16x8 av[2][2];
#pragma unroll
                for (int q = 0; q < 2; ++q)
#pragma unroll
                    for (int lb = 0; lb < 2; ++lb) av[q][lb] = tr_pair<true>(img + MP_BM, 32 * lb + 8 * fq, 32 * lb + 8 * fq + 4, 16 * (2 * np + q), lane);
#pragma unroll
                for (int q = 0; q < 2; ++q) { Z[2 * np + q] *= dec;
#pragma unroll
                    for (int lb = 0; lb < 2; ++lb) Z[2 * np + q] = MFMA16(av[q][lb], xw[lb], Z[2 * np + q]); } }
        }
    };
    auto S3 = [&](const int cp, const float (&xs)[8], const u32x4 zw) __attribute__((always_inline)) {
        const LAS unsigned char* yb = lds + MP_Y0 + (cp & 1) * MP_YSZ; const size_t t0 = tb + 64 * cp;
        const f32x4 a0 = *(const LAS f32x4*)(yb + MP_YD + l * MB_YSTR + pc * 32), a1 = *(const LAS f32x4*)(yb + MP_YD + l * MB_YSTR + pc * 32 + 16);
        const f32x4 b0 = *(const LAS f32x4*)(yb + MP_YO + l * MB_YSTR + pc * 32), b1 = *(const LAS f32x4*)(yb + MP_YO + l * MB_YSTR + pc * 32 + 16);
        float y[8];
        y[0] = (a0[0] + b0[0] + D_h * xs[0]) * bf_lo(zw.x); y[1] = (a0[1] + b0[1] + D_h * xs[1]) * bf_hi(zw.x);
        y[2] = (a0[2] + b0[2] + D_h * xs[2]) * bf_lo(zw.y); y[3] = (a0[3] + b0[3] + D_h * xs[3]) * bf_hi(zw.y);
        y[4] = (a1[0] + b1[0] + D_h * xs[4]) * bf_lo(zw.z); y[5] = (a1[1] + b1[1] + D_h * xs[5]) * bf_hi(zw.z);
        y[6] = (a1[2] + b1[2] + D_h * xs[6]) * bf_lo(zw.w); y[7] = (a1[3] + b1[3] + D_h * xs[7]) * bf_hi(zw.w);
        float ss = 0.f;
#pragma unroll
        for (int e = 0; e < 8; ++e) ss += y[e] * y[e];
        ss += __shfl_xor(ss, 1); ss += __shfl_xor(ss, 2); ss += __shfl_xor(ss, 4);
        if (pc == 0) ssq_out[(t0 + l) * 32 + h] = ss;
        u32x4 w; w.x = pk2(y[0], y[1]); w.y = pk2(y[2], y[3]); w.z = pk2(y[4], y[5]); w.w = pk2(y[6], y[7]); *(u32x4*)(outp + (t0 + l) * opitch + 64 * h + 8 * pc) = w;
    };
#define MB_Z(c_) (*(const u32x4*)(act + (tb + 64 * (c_) + l) * ACT_P + 1024 + 64 * h + 8 * pc))
    float xsA[8], xsB[8]; u32x4 zA, zB;
    MB_LOAD(0);
    __syncthreads();
    S1(0, xsA); zA = MB_Z(0);
    __syncthreads();
#pragma unroll 1
    for (int c = 0; c < 64; c += 2) {
        if (wid < 4) S2(c);
        if (c > 0) S3(c - 1, xsB, zB);
        S1(c + 1, xsB); zB = MB_Z(c + 1);
        if (wid >= 4) S2(c);
        __syncthreads();
        if (wid < 4) S2(c + 1);
        S3(c, xsA, zA);
        if (c + 2 < 64) { S1(c + 2, xsA); zA = MB_Z(c + 2); }
        if (wid >= 4) S2(c + 1);
        __syncthreads();
    }
    S3(63, xsB, zB);
#undef MB_LOAD
#undef MB_Z
    __syncthreads();
}
constexpr int RT_W = 0, RT_CNT = 131072, RT_BASE = 131072 + 128;
constexpr int MO_TS = 131072 + 256, MO_CNT = 131072 + 512;

DI void router_phase(LAS unsigned char* lds, int vcu, int G, const float* x1, const float* norm_ffn, const float* w_router, const float* b_router,
                     unsigned char* h2, int* sel_e, int* sel_r, float* sel_w, int* tokl, unsigned* gcnt) {
    const int tid = threadIdx.x, lane = tid & 63, wid = __builtin_amdgcn_readfirstlane(tid >> 6), l31 = lane & 31, hi = lane >> 5;
    LAS float* Wl = (LAS float*)(lds + RT_W); LAS unsigned* lcnt = (LAS unsigned*)(lds + RT_CNT); LAS unsigned* lbase = (LAS unsigned*)(lds + RT_BASE);
    for (int idx = tid; idx < 1024 * 8; idx += 512) { const f32x4 w = *(const f32x4*)(w_router + 4 * idx); const float gk = norm_ffn[idx >> 3]; LAS float* p = Wl + 4 * idx; p[0] = w[0] * gk; p[1] = w[1] * gk; p[2] = w[2] * gk; p[3] = w[3] * gk; }
    if (tid < 32) lcnt[tid] = 0u;
    __syncthreads();
    if (wid >= 4) {
        for (int m = (vcu * 4 + (wid - 4)) * 4; m < T; m += G * 16) rms_rows_to_fp8<4>(x1 + (size_t)m * 1024, h2 + (size_t)m * 1024, norm_ffn, lane);
    } else
    for (int tile = vcu + G * wid; tile < T / 32; tile += G * 4) {
        const int t0 = tile * 32;
        f32x16 acc;
#pragma unroll
        for (int r = 0; r < 16; ++r) acc[r] = 0.f;
        float ssq = 0.f;
        const float* xr = x1 + (size_t)(t0 + l31) * 1024 + 4 * hi;
#pragma unroll 4
        for (int c = 0; c < 128; ++c) {
            const f32x4 xv = *(const f32x4*)(xr + 8 * c);
            ssq += (xv[0] * xv[0] + xv[1] * xv[1]) + (xv[2] * xv[2] + xv[3] * xv[3]);
#pragma unroll
            for (int u = 0; u < 4; ++u) { const float a = Wl[(8 * c + 4 * hi + u) * 32 + l31]; acc = __builtin_amdgcn_mfma_f32_32x32x2f32(a, xv[u], acc, 0, 0, 0); }
        }
        ssq += __shfl_xor(ssq, 32);
        const float rstd = __builtin_amdgcn_rsqf(ssq * (1.f / 1024.f) + EPS);
        float lg[16];
#pragma unroll
        for (int r = 0; r < 16; ++r) lg[r] = acc[r] * rstd + b_router[crow(r, hi)];
        float sv[4]; int si[4];
#pragma unroll
        for (int k = 0; k < 4; ++k) {
            float bv = lg[0]; int bi = crow(0, hi);
#pragma unroll
            for (int r = 1; r < 16; ++r) { const int id = crow(r, hi); if (lg[r] > bv) { bv = lg[r]; bi = id; } }
            const float pv = __shfl_xor(bv, 32); const int pi = __shfl_xor(bi, 32);
            if (pv > bv || (pv == bv && pi < bi)) { bv = pv; bi = pi; }
            sv[k] = bv; si[k] = bi;
#pragma unroll
            for (int r = 0; r < 16; ++r) if (crow(r, hi) == bi) lg[r] = -INFINITY;
        }
        const float e1 = __expf(sv[1] - sv[0]), e2 = __expf(sv[2] - sv[0]), e3 = __expf(sv[3] - sv[0]), inv = 1.0f / (1.0f + e1 + e2 + e3);
        if (hi == 0) {
            const int t = t0 + l31; const float wv[4] = {inv, e1 * inv, e2 * inv, e3 * inv};
#pragma unroll
            for (int k = 0; k < 4; ++k) { const unsigned lr = atomicAdd((unsigned*)&lcnt[si[k]], 1u); sel_e[t * 4 + k] = si[k]; sel_r[t * 4 + k] = (int)lr; sel_w[t * 4 + k] = wv[k]; }
        }
    }
    __syncthreads();
    if (tid < 32) lbase[tid] = atomicAdd(&gcnt[tid], lcnt[tid]);
    __syncthreads();
    if (wid < 4) for (int tile = vcu + G * wid; tile < T / 32; tile += G * 4) {
        if (hi == 0) { const int t = tile * 32 + l31;
#pragma unroll
            for (int k = 0; k < 4; ++k) { const int e = sel_e[t * 4 + k]; const int r = sel_r[t * 4 + k] + (int)lbase[e]; sel_r[t * 4 + k] = r; tokl[(size_t)e * T + r] = t; } }
    }
}

DI int moe_tables(LAS unsigned char* lds, const unsigned* gcnt) {
    LAS int* ts = (LAS int*)(lds + MO_TS); LAS int* cn = (LAS int*)(lds + MO_CNT);
    __syncthreads();
    if (threadIdx.x < 32) cn[threadIdx.x] = (int)gcnt[threadIdx.x];
    __syncthreads();
    if (threadIdx.x == 0) { int s = 0; for (int e = 0; e < NEXP; ++e) { ts[e] = s; s += (cn[e] + 255) >> 8; } ts[NEXP] = s; }
    __syncthreads();
    return ts[NEXP];
}

DI void combine_phase(LAS unsigned char* lds, int vcu, int G, int tlo, int thi, const bf16_t* y, const int* sel_e, const int* sel_r, const float* sel_w, float* out, float wscale) {
    const int lane = threadIdx.x & 63, wid = threadIdx.x >> 6; const LAS int* ts = (const LAS int*)(lds + MO_TS);
    for (int tb = (vcu * 8 + wid) * 4; tb < T; tb += G * 32) {
        int rowi[4][4]; float wv[4][4];
#pragma unroll
        for (int q = 0; q < 4; ++q) { const int4 e4 = *(const int4*)(sel_e + (tb + q) * 4), r4 = *(const int4*)(sel_r + (tb + q) * 4); const f32x4 w4 = *(const f32x4*)(sel_w + (tb + q) * 4);
            const int ee[4] = {e4.x, e4.y, e4.z, e4.w}, rr[4] = {r4.x, r4.y, r4.z, r4.w};
#pragma unroll
            for (int k = 0; k < 4; ++k) { const int row = ts[ee[k]] * 256 + rr[k], tile = row >> 8; const bool in = tile >= tlo && tile < thi; rowi[q][k] = in ? row - tlo * 256 : -1; wv[q][k] = w4[k] * wscale; } }
#pragma unroll
        for (int q = 0; q < 4; ++q) {
            float* op = out + (size_t)(tb + q) * 1024 + 8 * lane;
            f32x4 a0 = *(const f32x4*)op, a1 = *(const f32x4*)(op + 4), a2 = *(const f32x4*)(op + 512), a3 = *(const f32x4*)(op + 516);
            u32x4 v0[4], v1[4];
#pragma unroll
            for (int k = 0; k < 4; ++k) { v0[k] = (u32x4){0u, 0u, 0u, 0u}; v1[k] = v0[k]; if (rowi[q][k] >= 0) { const bf16_t* yp = y + (size_t)rowi[q][k] * 1024 + 8 * lane; v0[k] = *(const u32x4*)yp; v1[k] = *(const u32x4*)(yp + 512); } }
#pragma unroll
            for (int k = 0; k < 4; ++k) { const float w = wv[q][k];
                a0[0] += w * bf_lo(v0[k].x); a0[1] += w * bf_hi(v0[k].x); a0[2] += w * bf_lo(v0[k].y); a0[3] += w * bf_hi(v0[k].y);
                a1[0] += w * bf_lo(v0[k].z); a1[1] += w * bf_hi(v0[k].z); a1[2] += w * bf_lo(v0[k].w); a1[3] += w * bf_hi(v0[k].w);
                a2[0] += w * bf_lo(v1[k].x); a2[1] += w * bf_hi(v1[k].x); a2[2] += w * bf_lo(v1[k].y); a2[3] += w * bf_hi(v1[k].y);
                a3[0] += w * bf_lo(v1[k].z); a3[1] += w * bf_hi(v1[k].z); a3[2] += w * bf_lo(v1[k].w); a3[3] += w * bf_hi(v1[k].w); }
            *(f32x4*)op = a0; *(f32x4*)(op + 4) = a1; *(f32x4*)(op + 512) = a2; *(f32x4*)(op + 516) = a3;
        }
    }
}
#define XB_TMO      128
#define XB_XCNT(j)  (256  + 64 * (j))
#define XB_XSUB(j)  (1280 + 64 * (j))
#define XB_XGEN(j)  (2304 + 64 * (j))
#define XB_TOP      3328
#define XB_TOPGEN   3392
#define XCD_BAR_WORDS 3456
#define XB_SPIN_CAP (1u << 18)

__device__ __forceinline__ unsigned xb_ld(unsigned* p)              { return __hip_atomic_load(p, __ATOMIC_RELAXED, __HIP_MEMORY_SCOPE_AGENT); }
__device__ __forceinline__ unsigned xb_add(unsigned* p, unsigned v) { return __hip_atomic_fetch_add(p, v, __ATOMIC_RELAXED, __HIP_MEMORY_SCOPE_AGENT); }
__device__ __forceinline__ unsigned xb_xcc_id() { return (unsigned)__builtin_amdgcn_s_getreg((3 << 11) | 20) & 0xFu; }
#define XB_SPIN(cond, bar) do { unsigned _sp = 0; while (cond) { __builtin_amdgcn_s_sleep(1); \
    if ((++_sp & 255u) == 0u) { if (xb_ld(&(bar)[XB_TMO])) break; if (_sp > XB_SPIN_CAP) { atomicAdd(&(bar)[XB_TMO], 1u); break; } } } } while (0)

struct XcdBarrier {
    unsigned* bar; unsigned x;
    volatile LAS unsigned* st;
};

__device__ __forceinline__ XcdBarrier xcd_barrier_post(unsigned* bar, volatile LAS unsigned* st) {
    XcdBarrier b; b.bar = bar; b.x = xb_xcc_id(); b.st = st;
    if (threadIdx.x == 0) (void)xb_add(&bar[XB_XCNT(b.x)], 1u);
    return b;
}
__device__ __forceinline__ void xcd_barrier_complete(unsigned* bar, unsigned x, unsigned& nloc, unsigned& nx) {
    const unsigned G = gridDim.x * gridDim.y * gridDim.z;
    unsigned sum, cnt, mine, sp = 0u;
    for (;;) {
        sum = 0u; cnt = 0u; mine = 0u;
#pragma unroll
        for (unsigned j = 0; j < 16; ++j) { const unsigned c = xb_ld(&bar[XB_XCNT(j)]); sum += c; cnt += (c > 0u) ? 1u : 0u; mine = (j == x) ? c : mine; }
        if (sum == G) break;
        __builtin_amdgcn_s_sleep(1);
        if ((++sp & 255u) == 0u) { if (xb_ld(&bar[XB_TMO])) break; if (sp > XB_SPIN_CAP) { atomicAdd(&bar[XB_TMO], 1u); break; } }
    }
    nloc = mine > 0u ? mine : 1u; nx = cnt > 0u ? cnt : 1u;
}

__device__ __forceinline__ void xcd_barrier(const XcdBarrier& b) {
    asm volatile("s_waitcnt vmcnt(0)" ::: "memory");
    __syncthreads();
    if (threadIdx.x == 0) {
        unsigned* bar = b.bar;
        __builtin_amdgcn_s_waitcnt(0);
        unsigned nloc = b.st[0], nx = b.st[1];
        if (nloc == 0u) { xcd_barrier_complete(bar, b.x, nloc, nx); b.st[0] = nloc; b.st[1] = nx; }
        const unsigned old = xb_add(&bar[XB_XSUB(b.x)], 1u);
        const unsigned gen = old / nloc;
        if (old + 1u == (gen + 1u) * nloc) {
            __builtin_amdgcn_fence(__ATOMIC_RELEASE, "agent");
            asm volatile("s_waitcnt vmcnt(0)" ::: "memory");
            const unsigned og = xb_add(&bar[XB_TOP], 1u);
            const unsigned tg = og / nx;
            if (og + 1u == (tg + 1u) * nx) xb_add(&bar[XB_TOPGEN], 1u);
            else XB_SPIN(xb_ld(&bar[XB_TOPGEN]) == tg, bar);
            __builtin_amdgcn_fence(__ATOMIC_ACQUIRE, "agent");
            xb_add(&bar[XB_XGEN(b.x)], 1u);
            asm volatile("s_waitcnt vmcnt(0)" ::: "memory");
        } else {
            XB_SPIN(xb_ld(&bar[XB_XGEN(b.x)]) == gen, bar);
            __builtin_amdgcn_fence(__ATOMIC_ACQUIRE, "agent");
            asm volatile("s_waitcnt vmcnt(0)" ::: "memory");
        }
    }
    __syncthreads();
}


#ifndef MK_N_LAUNCHES
#define MK_N_LAUNCHES 1
#endif
#ifndef MK_BRANCHES
#define MK_BRANCHES 15
#endif
constexpr int N_PHASES = 12;
#ifndef MK_USE_CG
#define MK_USE_CG 0
#endif
constexpr int LDS_BARST = 163840 - 64;
constexpr int CW_BAR = 4096;
constexpr int LDS_BYTES = 163840;
constexpr int NTHREADS = 512;

struct Args { const float* in[30]; float* out; unsigned char* ws; int ph_lo, ph_hi; };
enum { I_x = 0, I_mem = 1, I_norm_mix = 2, I_w_in = 3, I_a_q_gain = 4, I_a_k_gain = 5, I_a_rel_bias = 6, I_conv_w = 7, I_conv_b = 8, I_dt_bias = 9, I_a_log = 10, I_d_skip = 11, I_ssm_norm = 12, I_norm_mem = 13, I_w_mem_kv = 14, I_x_q_gain = 15, I_x_k_gain = 16, I_w_br_a = 17, I_w_br_b = 18, I_w_br_c = 19, I_w_out = 20, I_norm_ffn = 21, I_w_router = 22, I_b_router = 23, I_w_gate = 24, I_b_gate = 25, I_w_up = 26, I_b_up = 27, I_w_down = 28, I_b_down = 29 };

#define WIN WSP(bf16_t, WS_WIN)
#define WCAT WSP(bf16_t, WS_WCAT)
#define WOUT WSP(bf16_t, WS_WOUT)
#define WMEM WSP(bf16_t, WS_WMEM)
#define DTB WSP(float, WS_DT)
#define SSQ WSP(float, WS_SSQ)
#define RSTD WSP(float, WS_RSTD)
#define KX WSP(bf16_t, WS_KX)
#define MEMKV WSP(bf16_t, WS_MEMKV)
#define XN WSP(bf16_t, WS_XN)
#define MEMN WSP(bf16_t, WS_MEMN)
#define ACT WSP(bf16_t, WS_ACT)
#define KA WSP(bf16_t, WS_KA)
#define VA WSP(bf16_t, WS_VA)
#define XBC WSP(bf16_t, WS_XBC)
#define GATES WSP(bf16_t, WS_GATES)
#define MERGED WSP(bf16_t, WS_MERGED)
#define H2 WSP(unsigned char, MOE_H2)
#define WGU WSP(unsigned char, MOE_WGU)
#define WD WSP(unsigned char, MOE_WD)
#define ACTM WSP(unsigned char, MOE_ACTM)
#define YB WSP(bf16_t, MOE_Y)
#define SELE WSP(int, MOE_SELE)
#define SELR WSP(int, MOE_SELR)
#define SELW WSP(float, MOE_SELW)
#define TOKL WSP(int, MOE_TOKL)
#define GCNT (WSP(unsigned, WS_CTL) + CW_CNT)
#define ACSB ((float*)(GAS float*)kq[30] + (size_t)T * 512)
#define BCC ((bf16_t*)(GAS bf16_t*)kq[30])
#define EI_INIT const EpiIn EI{ws, AP(a_q_gain), AP(a_k_gain), AP(dt_bias)}
typedef const __attribute__((address_space(4))) unsigned long long* KW;
DI KW launder(KW p) { asm volatile("" : "+s"(p)); return p; }
#define AP(name) ((const float*)(const GAS float*)kq[I_##name])
#define PHASE_ARGS const KW kq = launder(kp); unsigned char* const ws = (unsigned char*)(GAS unsigned char*)kq[31]; (void)ws
#define WSP(type, off) ((type*)(ws + (off)))
__global__ void __launch_bounds__(NTHREADS, 2) mega_fwd(Args a_unused) {
    extern __shared__ __attribute__((aligned(16))) unsigned char lds_raw[];
    LAS unsigned char* lds = (LAS unsigned char*)lds_raw;
    const KW kp = (KW)__builtin_amdgcn_kernarg_segment_ptr();
    const int tid = threadIdx.x, lane = tid & 63, wid = __builtin_amdgcn_readfirstlane(tid >> 6);
    const int G = gridDim.x, bx = blockIdx.x, vcu = (G % 8 == 0) ? (bx % 8) * (G / 8) + bx / 8 : bx;
    const int lo = (int)(unsigned)kp[32], hi = (int)(kp[32] >> 32);
#ifndef MK_PHASE_MASK
#define MK_PHASE_MASK 0x7fff
#endif
#define IN(k) (((MK_PHASE_MASK >> (k)) & 1) && lo <= (k) && (k) < hi)
#ifndef MK_REP_MASK
#define MK_REP_MASK 0
#endif
#define REPS(k) (((MK_REP_MASK >> (k)) & 1) + 1)
#if MK_USE_CG
#define SEAM(k) do { if (IN(k) && IN((k) + 1)) { cg::this_grid().sync(); } } while (0)
#else
#define SEAM(k) do { if (IN(k) && IN((k) + 1)) { xcd_barrier(bar); } } while (0)
#endif
    const int gw = vcu * 8 + wid, NGW = G * 8;
    for (int u = tid; u < 16; u += NTHREADS) ((LAS unsigned*)(lds + LDS_BARST))[u] = 0u;
    __syncthreads();
    XcdBarrier bar = xcd_barrier_post((unsigned*)(GAS unsigned*)(kp[31]) + CW_BAR, (volatile LAS unsigned*)(lds + LDS_BARST));
    LAS float* scr = (LAS float*)(lds + wid * 16896);

    if (IN(0)) { PHASE_ARGS;
        constexpr int I_IN = 16 * 196, I_MEM = 16 * 32, I_A = 16 * 16, I_B = 32 * 16, I_C = 16 * 16, I_O = 16 * 16, NIT = I_IN + I_MEM + I_A + I_B + I_C + I_O;
        auto mk = [&](int it0) -> TrItem { int r = it0 % NIT; TrItem t; t.kscale = nullptr; t.mul = 1.0f; t.fp8 = 0;
            if (r < I_IN) { const int kb = r / 196, nb = r % 196; t.W = AP(w_in); t.Ns = IN_COLS; t.k0 = 64 * kb; t.sc0 = win_src_col(2 * nb); t.sc1 = win_src_col(2 * nb + 1); t.dst = WIN + (size_t)(64 * nb) * 1024 + 64 * kb; t.dpitch = 1024; return t; } r -= I_IN;
            if (r < I_MEM) { const int kb = r / 32, nb = r % 32; t.W = AP(w_mem_kv); t.Ns = 2048; t.k0 = 64 * kb; t.sc0 = 64 * nb; t.sc1 = 64 * nb + 32; t.dst = WMEM + (size_t)(64 * nb) * 1024 + 64 * kb; t.dpitch = 1024; return t; } r -= I_MEM;
            if (r < I_A) { const int kb = r / 16, nb = r % 16; t.W = AP(w_br_a); t.Ns = 1024; t.k0 = 64 * kb; t.sc0 = 64 * nb; t.sc1 = 64 * nb + 32; t.dst = WCAT + (size_t)(64 * nb) * 4096 + 64 * kb; t.dpitch = 4096; return t; } r -= I_A;
            if (r < I_B) { const int kb = r / 16, nb = r % 16; t.W = AP(w_br_b); t.Ns = 1024; t.k0 = 64 * kb; t.sc0 = 64 * nb; t.sc1 = 64 * nb + 32; t.dst = WCAT + (size_t)(64 * nb) * 4096 + 1024 + 64 * kb; t.dpitch = 4096; t.kscale = AP(ssm_norm); return t; } r -= I_B;
            if (r < I_C) { const int kb = r / 16, nb = r % 16; t.W = AP(w_br_c); t.Ns = 1024; t.k0 = 64 * kb; t.sc0 = 64 * nb; t.sc1 = 64 * nb + 32; t.dst = WCAT + (size_t)(64 * nb) * 4096 + 3072 + 64 * kb; t.dpitch = 4096; return t; } r -= I_C;
            { const int kb = r / 16, nb = r % 16; t.W = AP(w_out); t.Ns = 1024; t.k0 = 64 * kb; t.sc0 = 64 * nb; t.sc1 = 64 * nb + 32; t.dst = WOUT + (size_t)(64 * nb) * 1024 + 64 * kb; t.dpitch = 1024; return t; } };
        { const int nitems = NIT * REPS(0); f32x4 va[16], vb[16]; TrItem ia, ib; int it = gw;
          if (it < nitems) { ia = mk(it); tr_load(ia, va, lane); }
          while (it < nitems) {
              const int i2 = it + NGW; if (i2 < nitems) { ib = mk(i2); tr_load(ib, vb, lane); }
              tr_store(ia, va, scr, lane);
              if (i2 >= nitems) break;
              const int i3 = i2 + NGW; if (i3 < nitems) { ia = mk(i3); tr_load(ia, va, lane); }
              tr_store(ib, vb, scr, lane);
              it = i3; } }
        for (int m0 = gw * 4; m0 < T * REPS(0); m0 += NGW * 4) { const int m = m0 % T; rms_rows_to_bf16<4>(AP(x) + (size_t)m * 1024, XN + (size_t)m * 1024, 1, AP(norm_mix), lane); }
        for (int m = gw; m < NBATCH * MEMLEN; m += NGW) rms_rows_to_bf16<1>(AP(mem) + (size_t)m * 1024, MEMN + (size_t)m * 1024, 1, AP(norm_mem), lane);
    }
    SEAM(0);
    if (IN(1)) { PHASE_ARGS; EI_INIT;
        const SchedIn S{G, bx, 16, TL_Q, 12, TL_QX, 0, (const char*)WIN, (const char*)WMEM, REPS(1)};
        pg8::gemm_phase<false>(lds, (const char*)XN, 2048, 2048, S, EI);
    }
    SEAM(1);
    if (IN(2)) { PHASE_ARGS;
        if (MK_BRANCHES & 1) {
            LAS float* bl = (LAS float*)(lds + AT_BIAS);
            for (int i = tid; i < 16 * 257; i += NTHREADS) bl[(i / 257) * AT_BIAS_STRIDE + (i % 257)] = AP(a_rel_bias)[i] * LOG2E;
            __syncthreads();
            for (int u = vcu; u < 4 * NBATCH * 64; u += G) { const int c = u & 63, b = (u >> 6) & 7, hq = u >> 9; attnA_unit(lds, b, c, hq, ACT, KA, VA, (MK_REP_MASK >> 2 & 1) ? (bf16_t*)(ws + WS_BUF + 128 * MiB) : ACT, (MK_REP_MASK >> 2 & 1) ? 1024 : ACT_P);
                if (MK_REP_MASK >> 2 & 1) attnA_unit(lds, b, c, hq, ACT, KA, VA, ACT, ACT_P); }
        } else {
            for (int idx = vcu * NTHREADS + tid; idx < T * 128; idx += G * NTHREADS) { const int t = idx >> 7, ch = idx & 127; *(u32x4*)(ACT + (size_t)t * ACT_P + ch * 8) = (u32x4){0u, 0u, 0u, 0u}; }
        }
    }
    SEAM(2);
    if (IN(3)) { PHASE_ARGS; EI_INIT;
        const SchedIn S{G, bx, 21, TL_Z, 21, 0, 64, (const char*)WIN, (const char*)WMEM, REPS(3)};
        pg8::gemm_phase<false>(lds, (const char*)XN, 2048, 2048, S, EI);
    }
    SEAM(3);
    if (IN(4)) { PHASE_ARGS;
        if (MK_BRANCHES & 2) bcconv_phase(vcu, G, XBC, BCC, AP(conv_w), AP(conv_b), DTB, ACSB, AP(a_log));
        for (int w = gw; w < NBATCH * MEMLEN * 4; w += NGW) {
            const int row = w >> 2, hx = w & 3; const u32x2 kv = *(const u32x2*)(MEMKV + (size_t)row * 2048 + 256 * hx + 4 * lane);
            const float k0 = bf_lo(kv.x), k1 = bf_hi(kv.x), k2 = bf_lo(kv.y), k3 = bf_hi(kv.y);
            const float rs = __builtin_amdgcn_rsqf(wave_sum(k0 * k0 + k1 * k1 + k2 * k2 + k3 * k3) * (1.f / 256.f) + EPS) * (0.0625f * LOG2E);
            const f32x4 gk = *(const f32x4*)(AP(x_k_gain) + 4 * lane), gq = *(const f32x4*)(AP(x_q_gain) + 4 * lane);
            u32x2 o; o.x = pk2(k0 * rs * gk.x * gq.x, k1 * rs * gk.y * gq.y); o.y = pk2(k2 * rs * gk.z * gq.z, k3 * rs * gk.w * gq.w);
            *(u32x2*)(KX + (size_t)row * 1024 + 256 * hx + 4 * lane) = o;
        }
        xcd_barrier(bar);
        if (MK_BRANCHES & 4) attnC_phase(lds, vcu, G, ACT, KX, MEMKV, ACT + 3072, ACT_P);
        if (MK_BRANCHES & 2) { int nrep = 1 + (MK_REP_MASK >> 4 & 1); asm volatile("" : "+s"(nrep));
#pragma unroll 1
            for (int rep = 0; rep < nrep; ++rep) { const bool real = rep == nrep - 1;
                for (int u = vcu; u < NBATCH * 32; u += G) mamba_unit(lds, u >> 5, u & 31, XBC, BCC, DTB, ACSB, ACT, SSQ, real ? ACT + 1024 : (bf16_t*)RSTD, real ? (size_t)ACT_P : (size_t)0, AP(conv_w), AP(conv_b), AP(a_log), AP(d_skip)); } }
    }
    SEAM(4);
    if (IN(5)) { PHASE_ARGS; EI_INIT;
        for (int idx = vcu * NTHREADS + tid; idx < T * 4; idx += G * NTHREADS) { const int t = idx >> 2, g = idx & 3; const f32x4 s0 = *(const f32x4*)(SSQ + (size_t)t * 32 + 8 * g), s1 = *(const f32x4*)(SSQ + (size_t)t * 32 + 8 * g + 4);
            RSTD[idx] = __builtin_amdgcn_rsqf(((s0[0] + s0[1]) + (s0[2] + s0[3]) + (s1[0] + s1[1]) + (s1[2] + s1[3])) * (1.f / 512.f) + EPS); }
        const SchedIn S{G, bx, 12, TL_G, 12, 0, 0, (const char*)WIN, (const char*)WMEM, REPS(5)};
        pg8::gemm_phase<false>(lds, (const char*)XN, 2048, 2048, S, EI);
    }
    SEAM(5);
    if (IN(6)) { PHASE_ARGS;
        constexpr int LASTSEG = (MK_BRANCHES & 4) ? 2 : ((MK_BRANCHES & 2) ? 1 : 0);
        constexpr int KM = LASTSEG == 2 ? 4096 : (LASTSEG == 1 ? 3072 : 1024);
        const SchedDense S{G, bx, T / 256, 4, 4096, (const char*)WCAT, REPS(6)};
        const EpiMerge E{GATES, RSTD, MERGED, LASTSEG};
        pg8::gemm_phase<false>(lds, (const char*)ACT, KM * 2, 8192, S, E);
    }
    SEAM(6);
    if (IN(7)) { PHASE_ARGS;
        const SchedDense S{G, bx, T / 256, 4, 1024, (const char*)WOUT, REPS(7)};
        const EpiOut E{AP(x), ((float*)(GAS float*)kq[30])};
        pg8::gemm_phase<false>(lds, (const char*)MERGED, 2048, 2048, S, E);
    }
    SEAM(7);
    if (IN(8) && (MK_BRANCHES & 8)) { PHASE_ARGS;
        { int nrep = 1 + (MK_REP_MASK >> 11 & 1); asm volatile("" : "+s"(nrep));
#pragma unroll 1
          for (int rep = 0; rep < nrep; ++rep) { const bool real = rep == nrep - 1; const size_t dm = real ? 0 : (MOE_ACTM - MOE_SELE);
            router_phase(lds, vcu, G, ((float*)(GAS float*)kq[30]), AP(norm_ffn), AP(w_router), AP(b_router), H2, (int*)((char*)SELE + dm), (int*)((char*)SELR + dm), (float*)((char*)SELW + dm), (int*)((char*)TOKL + dm), GCNT + (real ? 0 : 64));
            __syncthreads(); } }
        auto mk = [&](int it0) -> TrItem { const int it = it0 % (NEXP * 768); const int e = it / 768, r = it % 768, which = r >> 8, kb = (r & 255) >> 4, nb = r & 15; TrItem t;
            t.W = (which == 0 ? AP(w_gate) : which == 1 ? AP(w_up) : AP(w_down)) + (size_t)e * 1024 * 1024; t.Ns = 1024; t.k0 = 64 * kb; t.sc0 = 64 * nb; t.sc1 = 64 * nb + 32; t.dpitch = 1024; t.kscale = nullptr; t.mul = 32.0f; t.fp8 = 1;
            t.dst = which == 2 ? (void*)(WD + ((size_t)e * 1024 + 64 * nb) * 1024 + 64 * kb) : (void*)(WGU + ((size_t)e * 2048 + 256 * (nb >> 1) + 128 * which + 64 * (nb & 1)) * 1024 + 64 * kb); return t; };
        { const int nitems = NEXP * 768 * REPS(8); f32x4 va[16], vb[16]; TrItem ia, ib; int it = gw;
          if (it < nitems) { ia = mk(it); tr_load(ia, va, lane); }
          while (it < nitems) {
              const int i2 = it + NGW; if (i2 < nitems) { ib = mk(i2); tr_load(ib, vb, lane); }
              tr_store(ia, va, scr, lane);
              if (i2 >= nitems) break;
              const int i3 = i2 + NGW; if (i3 < nitems) { ia = mk(i3); tr_load(ia, va, lane); }
              tr_store(ib, vb, scr, lane);
              it = i3; } }
    }
    SEAM(8);
    {
        if ((MK_BRANCHES & 8) && (IN(9) || IN(10) || IN(11))) { PHASE_ARGS;
            const int total = moe_tables(lds, GCNT), tlo = 0, thi = total;
            const LAS int* ts = (const LAS int*)(lds + MO_TS); const LAS int* cn = (const LAS int*)(lds + MO_CNT);
            if (IN(9)) { const SchedMoE S{G, bx, 8, tlo, thi, ts, cn, TOKL, (const char*)WGU, (size_t)2048 * 1024, REPS(9), 1024u, 1024u}; const EpiGU E{ACTM, AP(b_gate), AP(b_up), tlo};
                pg8::gemm_phase<true>(lds, (const char*)H2, 1024, 1024, S, E); }
            SEAM(9);
            if (IN(10)) { const SchedMoE S{G, bx, 4, tlo, thi, ts, cn, nullptr, (const char*)WD, (size_t)1024 * 1024, REPS(10), 1024u, 1024u}; const EpiDown E{YB, AP(b_down), tlo};
                pg8::gemm_phase<true>(lds, (const char*)ACTM, 1024, 1024, S, E); }
            SEAM(10);
            if (IN(11)) { int nrep = 1 + (MK_REP_MASK >> 12 & 1); asm volatile("" : "+s"(nrep));
#pragma unroll 1
                for (int rep = 0; rep < nrep; ++rep) combine_phase(lds, vcu, G, tlo, thi, YB, SELE, SELR, SELW, ((float*)(GAS float*)kq[30]), 1.0f / (float)nrep); }
        } else { SEAM(9); SEAM(10); }
    }
#undef IN
#undef SEAM
}

extern "C" void kernel_launch(void* const* d_in, const int* in_sizes, int n_in, void* d_out, int out_size, void* d_ws, size_t ws_size, hipStream_t stream) {
    static int grid = 0;
    if (grid == 0) {
        if (n_in != 30 || ws_size < WS_MIX_END || ws_size < WS_END) { fprintf(stderr, "kernel_launch: unexpected n_in %d / ws_size %zu\n", n_in, ws_size); grid = -1; return; }
        int dev = 0, cus = 0, per_cu = 0;
        (void)hipGetDevice(&dev); (void)hipDeviceGetAttribute(&cus, hipDeviceAttributeMultiprocessorCount, dev);
        (void)hipFuncSetAttribute((const void*)mega_fwd, hipFuncAttributeMaxDynamicSharedMemorySize, LDS_BYTES);
        (void)hipOccupancyMaxActiveBlocksPerMultiprocessor(&per_cu, (const void*)mega_fwd, NTHREADS, LDS_BYTES);
        if (per_cu < 1) { fprintf(stderr, "kernel_launch: occupancy query reports %d blocks per CU\n", per_cu); grid = -1; return; }
        grid = cus;
    }
    if (grid < 0) return;
    (void)hipMemsetAsync((char*)d_ws + WS_CTL, 0, 65536, stream);
    Args a{};
    for (int i = 0; i < 30; ++i) a.in[i] = (const float*)d_in[i];
    a.out = (float*)d_out; a.ws = (unsigned char*)d_ws;
    if (MK_N_LAUNCHES == 1) {
        a.ph_lo = 0; a.ph_hi = N_PHASES;
        void* args[] = {&a};
        hipError_t e = hipLaunchCooperativeKernel((void*)mega_fwd, dim3(grid), dim3(NTHREADS), args, LDS_BYTES, stream);
        if (e != hipSuccess) fprintf(stderr, "cooperative launch failed: %s (grid %d)\n", hipGetErrorString(e), grid);
    } else {
        for (int ph = 0; ph < N_PHASES; ++ph) { a.ph_lo = ph; a.ph_hi = ph + 1; hipLaunchKernelGGL(mega_fwd, dim3(grid), dim3(NTHREADS), LDS_BYTES, stream, a); }
    }
}
```

```cpp
#include <hip/hip_runtime.h>
#include <hip/hip_cooperative_groups.h>
#include <cstdio>
#include <cstdint>
namespace cg = cooperative_groups;

#define LAS __attribute__((address_space(3)))
#define GAS __attribute__((address_space(1)))
#define DI __device__ __forceinline__
typedef unsigned short bf16_t;
typedef short bf16x8 __attribute__((ext_vector_type(8)));
typedef short s16x4 __attribute__((ext_vector_type(4)));
typedef float f32x2 __attribute__((ext_vector_type(2)));
typedef float f32x4 __attribute__((ext_vector_type(4)));
typedef float f32x16 __attribute__((ext_vector_type(16)));
typedef unsigned u32x2 __attribute__((ext_vector_type(2)));
typedef unsigned u32x4 __attribute__((ext_vector_type(4)));
typedef __bf16 bf16x2_t __attribute__((ext_vector_type(2)));
typedef short v4i16_t __attribute__((ext_vector_type(4)));

DI unsigned pk2(float lo, float hi) { f32x2 v = {lo, hi}; bf16x2_t b = __builtin_convertvector(v, bf16x2_t); return __builtin_bit_cast(unsigned, b); }
DI float bf_lo(unsigned w) { return __uint_as_float(w << 16); }
DI float bf_hi(unsigned w) { return __uint_as_float(w & 0xffff0000u); }
DI float bf2f(bf16_t b) { return __uint_as_float(((unsigned)b) << 16); }
DI float wave_sum(float v) {
#pragma unroll
    for (int o = 1; o < 64; o <<= 1) v += __shfl_xor(v, o);
    return v;
}
DI float fast_exp2(float x) { return __builtin_amdgcn_exp2f(x); }
DI float fast_rcp(float x) { return __builtin_amdgcn_rcpf(x); }
DI float sigmoidf_(float x) { return fast_rcp(1.0f + fast_exp2(-1.4426950408889634f * x)); }

constexpr int NBATCH = 8, SEQ = 4096, T = NBATCH * SEQ, DM = 1024;
constexpr int NWIN_TILES = 49, NWIN = NWIN_TILES * 256;
constexpr int IN_COLS = 12320;
constexpr float EPS = 1e-6f;
constexpr float LOG2E = 1.4426950408889634f;
constexpr int NEXP = 32, TOPK = 4;
constexpr int MEMLEN = 256;
constexpr int ACT_P = 4096;
constexpr int TL_Q = 0, TL_K = 4, TL_V = 8, TL_Z = 12, TL_XBC = 20, TL_DT = 32, TL_QX = 33, TL_G = 37;

constexpr size_t MiB = (size_t)1 << 20;
constexpr size_t WS_CTL = 0, CTL_BYTES = 1 * MiB;
constexpr size_t WS_WIN = 1 * MiB, WS_WCAT = 26 * MiB, WS_WOUT = 34 * MiB, WS_WMEM = 36 * MiB;
constexpr size_t WS_DT = 40 * MiB, WS_SSQ = 44 * MiB, WS_RSTD = 48 * MiB, WS_KX = 49 * MiB, WS_MEMKV = 53 * MiB;
constexpr size_t WS_XN = 61 * MiB, WS_MEMN = 125 * MiB, WS_ACT = 129 * MiB, WS_BUF = 385 * MiB, WS_MIX_END = 577 * MiB;
constexpr size_t WS_KA = WS_BUF, WS_VA = WS_BUF + 64 * MiB, WS_XBC = WS_BUF, WS_GATES = WS_BUF, WS_MERGED = WS_XN;
constexpr int MOE_TILE_CAP = 280;
constexpr size_t MOE_H2 = 1 * MiB, MOE_WGU = 33 * MiB, MOE_WD = 97 * MiB, MOE_ACTM = 129 * MiB, MOE_Y = 265 * MiB;
constexpr size_t MOE_SELE = 537 * MiB, MOE_SELR = 537 * MiB + 512 * 1024, MOE_SELW = 538 * MiB, MOE_TOKL = 539 * MiB, WS_END = 543 * MiB;
constexpr int CW_CNT = 64;

#ifndef MK_KREP
#define MK_KREP 1
#endif
#ifndef MK_NT_STORES
#define MK_NT_STORES 0
#endif
namespace pg8 {
constexpr int BM = 256, BK = 64, HALF = 128, HTB = HALF * BK * 2, STAGE_BYTES = 8 * HTB;
__host__ __device__ __forceinline__ int lds_byte(int r, int c) { const int st = (r >> 4) * 2 + (c >> 5), rr = r & 15, cc = c & 31, ob = rr * 64 + cc * 2; return st * 1024 + (ob ^ (((ob >> 9) & 1) << 5)); }
__host__ __device__ __forceinline__ void stage_rc(int b, int& R, int& C) { const int st = b / 1024, sb = b % 1024, swz = sb ^ (((sb >> 9) & 1) << 5); R = (st >> 1) * 16 + swz / 64; C = (st & 1) * 32 + (swz % 64) / 2; }
__host__ __device__ __forceinline__ int perm32(int rho) { const int n = rho >> 4, i = rho & 15; return 8 * (i >> 2) + 4 * n + (i & 3); }

struct Unit { int kind, pm, pn, aux; };

typedef f32x4 Acc[2][2][4][2];

typedef int v8i_t __attribute__((ext_vector_type(8)));
template <bool FP8, class Epi, class Sched>
DI void gemm_phase(LAS unsigned char* lds, const char* Abase, const int Kb, const int ldbb, const Sched& S, const Epi& E) {
    int tid_ = threadIdx.x; asm volatile("" : "+v"(tid_));
    const int tid = tid_, wid = __builtin_amdgcn_readfirstlane(tid >> 6), lane = tid & 63, wr = wid >> 2, wc = wid & 3, fr = lane & 15, fq = lane >> 4;
    const int nt = Kb / (BK * 2);
    int Rr[2], Cc2[2]; unsigned voffB[2];
#pragma unroll
    for (int i = 0; i < 2; ++i) { int R, C; stage_rc(tid * 16 + i * 8192, R, C); Rr[i] = R; Cc2[i] = C * 2; const int Rb = (R & ~31) + perm32(R & 31); voffB[i] = (unsigned)(Rb * ldbb + C * 2); }
    const unsigned kstep = (unsigned)(BK * 2);
    const size_t hstepB = (size_t)HALF * ldbb;
    const unsigned ldsw = (unsigned)wid * 1024u;
    const int aoff0 = lds_byte(wr * 64 + fr, fq * 8), aoff1 = aoff0 + 1024;
    const int boff0 = lds_byte(wc * 32 + fr, fq * 8), boff1 = boff0 + 1024;
#define PG8_SA(b, h) (((b) * 2 + (h)) * HTB)
#define PG8_SB(b, h) ((4 + (b) * 2 + (h)) * HTB)
#define PG8_GLDS(src, dstoff) __builtin_amdgcn_global_load_lds((const unsigned*)(src), (LAS unsigned*)(lds + (dstoff)), 16, 0, 0)
#define PG8_STAGE_B(bufoff, ptr) do { _Pragma("unroll") for (int _i = 0; _i < 2; ++_i) PG8_GLDS((const char*)(ptr) + voffB[_i], (bufoff) + ldsw + _i * 8192); } while (0)
#define PG8_STAGE_A(bufoff, kb, v0, v1) do { PG8_GLDS(Abase + (size_t)(v0) + (kb), (bufoff) + ldsw); PG8_GLDS(Abase + (size_t)(v1) + (kb), (bufoff) + ldsw + 8192); } while (0)
#define PG8_LDA(dst, b, h) do { _Pragma("unroll") for (int m = 0; m < 4; ++m) { dst[m][0] = *(const LAS u32x4*)(lds + PG8_SA(b, h) + aoff0 + m * 2048); dst[m][1] = *(const LAS u32x4*)(lds + PG8_SA(b, h) + aoff1 + m * 2048); } } while (0)
#define PG8_LDB(dst, b, h) do { _Pragma("unroll") for (int n = 0; n < 2; ++n) { dst[n][0] = *(const LAS u32x4*)(lds + PG8_SB(b, h) + boff0 + n * 2048); dst[n][1] = *(const LAS u32x4*)(lds + PG8_SB(b, h) + boff1 + n * 2048); } } while (0)
#define PG8_CAT(x) __builtin_bit_cast(v8i_t, __builtin_shufflevector((x)[0], (x)[1], 0, 1, 2, 3, 4, 5, 6, 7))
#define PG8_MMA(ai, bj, At, Bt) do { __builtin_amdgcn_s_setprio(1); _Pragma("unroll") for (int m = 0; m < 4; ++m) _Pragma("unroll") for (int n = 0; n < 2; ++n) { \
        if constexpr (FP8) asm volatile("v_mfma_scale_f32_16x16x128_f8f6f4 %0, %1, %2, %0, %3, %4 op_sel_hi:[0,0,0]" : "+v"(acc[ai][bj][m][n]) : "v"(PG8_CAT(Bt[n])), "v"(PG8_CAT(At[m])), "v"(sclB), "v"(sclA)); \
        else { _Pragma("unroll") for (int k = 0; k < 2; ++k) acc[ai][bj][m][n] = __builtin_amdgcn_mfma_f32_16x16x32_bf16(__builtin_bit_cast(bf16x8, Bt[n][k]), __builtin_bit_cast(bf16x8, At[m][k]), acc[ai][bj][m][n], 0, 0, 0); } } \
        __builtin_amdgcn_s_setprio(0); } while (0)
#define PG8_WAIT_V(n) asm volatile("s_waitcnt vmcnt(" #n ")" ::: "memory")
#define PG8_WAIT_L(n) asm volatile("s_waitcnt lgkmcnt(" #n ")" ::: "memory")
#define PG8_BAR __builtin_amdgcn_s_barrier()
#define PG8_SCHED __builtin_amdgcn_sched_barrier(0)
    Unit cur, nxt; int ui = 0;
    if (!S.next(0, cur)) return;
    Acc acc;
#pragma unroll
    for (int a = 0; a < 2; ++a)
#pragma unroll
        for (int b = 0; b < 2; ++b)
#pragma unroll
            for (int m = 0; m < 4; ++m)
#pragma unroll
                for (int n = 0; n < 2; ++n) acc[a][b][m][n] = (f32x4){0.f, 0.f, 0.f, 0.f};
    u32x4 At[4][2], B0[2][2], B1[2][2];
    int sclB = 0x7a7a7a7a, sclA = 0x7f7f7f7f;
    asm volatile("" : "+v"(sclB), "+v"(sclA));
    unsigned vA00 = S.arow(cur, Rr[0]) + Cc2[0], vA01 = S.arow(cur, Rr[1]) + Cc2[1], vA10 = S.arow(cur, HALF + Rr[0]) + Cc2[0], vA11 = S.arow(cur, HALF + Rr[1]) + Cc2[1];
    const char* cB = S.bptr(cur);
    PG8_STAGE_B(PG8_SB(0, 0), cB); PG8_STAGE_B(PG8_SB(0, 1), cB + hstepB); PG8_STAGE_A(PG8_SA(0, 0), 0, vA00, vA01); PG8_STAGE_A(PG8_SA(0, 1), 0, vA10, vA11);
    if (wr == 1) PG8_BAR;
    PG8_WAIT_V(2); PG8_BAR;
    PG8_STAGE_B(PG8_SB(1, 0), cB + kstep); PG8_STAGE_A(PG8_SA(1, 0), kstep, vA00, vA01); PG8_STAGE_B(PG8_SB(1, 1), cB + hstepB + kstep);
    PG8_WAIT_V(6); PG8_BAR;
    for (;;) {
        const bool has_next = S.next(ui + 1, nxt);
        const char* nB = has_next ? S.bptr(nxt) : cB;
        constexpr int KREP = (MK_KREP > 1 && !Epi::SEGMENTED) ? MK_KREP : 1;
        for (int tt = 0; tt < nt * KREP; tt += 2) {
            const int t = KREP > 1 ? tt % nt : tt;
            const bool last = (tt == nt * KREP - 2);
            if constexpr (Epi::SEGMENTED) { if (t > 0 && E.boundary(t)) E.rescale(acc, cur, t, wr, wc, fr, fq); }
            const unsigned k1 = (unsigned)(t + 1) * kstep;
            const unsigned t2 = (KREP > 1) ? (unsigned)((t + 2) % nt) : (unsigned)(t + 2);
            const unsigned k2 = last ? 0u : t2 * kstep, k3 = k2 + kstep;
            const char* b2 = last ? nB : cB + t2 * kstep; const char* b3 = b2 + kstep;
            unsigned w00 = vA00, w01 = vA01, w10 = vA10, w11 = vA11;
            if (last && has_next) { w00 = S.arow(nxt, Rr[0]) + Cc2[0]; w01 = S.arow(nxt, Rr[1]) + Cc2[1]; w10 = S.arow(nxt, HALF + Rr[0]) + Cc2[0]; w11 = S.arow(nxt, HALF + Rr[1]) + Cc2[1]; }
            PG8_LDB(B0, 0, 0); PG8_LDB(B1, 0, 1); PG8_SCHED; PG8_LDA(At, 0, 0); PG8_STAGE_A(PG8_SA(1, 1), k1, vA10, vA11);
            PG8_WAIT_V(8); PG8_WAIT_L(0); PG8_BAR; PG8_MMA(0, 0, At, B0); PG8_MMA(0, 1, At, B1); PG8_BAR; PG8_SCHED;
            PG8_LDA(At, 0, 1); PG8_STAGE_B(PG8_SB(0, 0), b2); PG8_STAGE_B(PG8_SB(0, 1), b2 + hstepB); PG8_STAGE_A(PG8_SA(0, 0), k2, w00, w01);
            PG8_WAIT_V(8); PG8_WAIT_L(0); PG8_BAR; PG8_MMA(1, 0, At, B0); PG8_MMA(1, 1, At, B1); PG8_BAR; PG8_SCHED;
            PG8_LDB(B0, 1, 0); PG8_LDB(B1, 1, 1); PG8_SCHED; PG8_LDA(At, 1, 0); PG8_STAGE_A(PG8_SA(0, 1), k2, w10, w11);
            PG8_WAIT_V(8); PG8_WAIT_L(0); PG8_BAR; PG8_MMA(0, 0, At, B0); PG8_MMA(0, 1, At, B1); PG8_BAR; PG8_SCHED;
            PG8_LDA(At, 1, 1); PG8_STAGE_B(PG8_SB(1, 0), b3); PG8_STAGE_B(PG8_SB(1, 1), b3 + hstepB); PG8_STAGE_A(PG8_SA(1, 0), k3, w00, w01);
            PG8_WAIT_V(8); PG8_WAIT_L(0); PG8_BAR; PG8_MMA(1, 0, At, B0); PG8_MMA(1, 1, At, B1); PG8_BAR; PG8_SCHED;
            if (last) { vA00 = w00; vA01 = w01; vA10 = w10; vA11 = w11; }
        }
        if (wr == 0) PG8_BAR;
        if constexpr (FP8) asm volatile("s_nop 15\n\ts_nop 7" ::: "memory");
        if constexpr (KREP > 1) {
#pragma unroll
            for (int a = 0; a < 2; ++a)
#pragma unroll
                for (int b = 0; b < 2; ++b)
#pragma unroll
                    for (int m = 0; m < 4; ++m)
#pragma unroll
                        for (int n = 0; n < 2; ++n) acc[a][b][m][n] *= (1.0f / KREP); }
        E(acc, cur, wr, wc, fr, fq);
        if (!has_next) break;
#pragma unroll
        for (int a = 0; a < 2; ++a)
#pragma unroll
            for (int b = 0; b < 2; ++b)
#pragma unroll
                for (int m = 0; m < 4; ++m)
#pragma unroll
                    for (int n = 0; n < 2; ++n) acc[a][b][m][n] = (f32x4){0.f, 0.f, 0.f, 0.f};
        cur = nxt; cB = nB; ++ui;
        if (wr == 1) PG8_BAR;
    }
    PG8_WAIT_V(0);
    PG8_BAR;
#undef PG8_SA
#undef PG8_SB
#undef PG8_GLDS
#undef PG8_STAGE_A
#undef PG8_STAGE_B
#undef PG8_LDA
#undef PG8_LDB
#undef PG8_MMA
#undef PG8_CAT
#undef PG8_WAIT_V
#undef PG8_WAIT_L
#undef PG8_BAR
#undef PG8_SCHED
}

DI bool static_tile(int L, int nM, int nN, int& pm, int& pn) {
    const int nwg = nM * nN; if (L >= nwg) return false;
    int wgid = L; { const int q = nwg / 8, r = nwg % 8, xcd = wgid % 8, off = wgid / 8; wgid = (xcd < r ? xcd * (q + 1) : r * (q + 1) + (xcd - r) * q) + off; }
    const int nig = 8 * nN, gid = wgid / nig, fm = gid * 8, gsz = (nM - fm) < 8 ? (nM - fm) : 8;
    pm = fm + ((wgid % nig) % gsz); pn = (wgid % nig) / gsz; return true;
}
}
using pg8::Unit; using pg8::Acc;

DI unsigned pk4_fp8(float a, float b, float c, float d) { int p = 0; p = __builtin_amdgcn_cvt_pk_fp8_f32(a, b, p, false); p = __builtin_amdgcn_cvt_pk_fp8_f32(c, d, p, true); return (unsigned)p; }
DI float silu_(float v) { return v * sigmoidf_(v); }
DI float softplus_(float x) { return fmaxf(x, 0.f) + __logf(1.0f + __expf(-fabsf(x))); }

struct SchedIn {
    int G, c, ncol, t0, nsplit, t1, nextra; const char* win; const char* wmem; int reps;
    DI bool next(int i, Unit& u) const {
        const int U = (T / 256) * ncol + nextra; int L = i * G + c; if (L >= U * reps) return false; L %= U; int pm, pn;
        if (pg8::static_tile(L, T / 256, ncol, pm, pn)) { u.kind = 0; u.pm = pm; u.pn = pn < nsplit ? t0 + pn : t1 + (pn - nsplit); u.aux = 0; return true; }
        const int j = L - (T / 256) * ncol; if (j < nextra) { u.kind = 1; u.pm = j >> 3; u.pn = j & 7; u.aux = 0; return true; }
        return false;
    }
    DI unsigned arow(const Unit& u, int r) const { return (u.kind == 0 ? 0u : (unsigned)(WS_MEMN - WS_XN)) + (unsigned)(u.pm * 256 + r) * 2048u; }
    DI const char* bptr(const Unit& u) const { return (u.kind == 0 ? win : wmem) + (size_t)u.pn * (256 * 1024 * 2); }
};

struct EpiIn {
    static constexpr bool SEGMENTED = false;
    unsigned char* ws; const float *qgain, *kgain, *dtbias;
    template <int OP> DI void ew(const Acc& acc, bf16_t* dst, size_t pitch, int col0, int row0, int wc, int fq) const {
#pragma unroll
        for (int ai = 0; ai < 2; ++ai)
#pragma unroll
            for (int m = 0; m < 4; ++m) { bf16_t* rowp = dst + (size_t)(row0 + ai * 128 + m * 16) * pitch + col0 + wc * 32 + 8 * fq;
#pragma unroll
                for (int bj = 0; bj < 2; ++bj) { f32x4 v0 = acc[ai][bj][m][0], v1 = acc[ai][bj][m][1];
                    if (OP == 1) { for (int e = 0; e < 4; ++e) { v0[e] = silu_(v0[e]); v1[e] = silu_(v1[e]); } }
                    if (OP == 2) { for (int e = 0; e < 4; ++e) { v0[e] = sigmoidf_(fminf(fmaxf(v0[e], -30.f), 30.f)); v1[e] = sigmoidf_(fminf(fmaxf(v1[e], -30.f), 30.f)); } }
                    u32x4 w; w.x = pk2(v0[0], v0[1]); w.y = pk2(v0[2], v0[3]); w.z = pk2(v1[0], v1[1]); w.w = pk2(v1[2], v1[3]);
                    *(u32x4*)(rowp + bj * 128) = w; }
                asm volatile("" ::: "memory"); }
    }
    DI void headnorm(const Acc& acc, bf16_t* dst, size_t pitch, int col0, int row0, int wc, int fq, const float* gain, float mul) const {
#pragma unroll
        for (int ai = 0; ai < 2; ++ai)
#pragma unroll
            for (int m = 0; m < 4; ++m) {
                float ss = 0.f;
#pragma unroll
                for (int bj = 0; bj < 2; ++bj)
#pragma unroll
                    for (int n = 0; n < 2; ++n) { const f32x4 x = acc[ai][bj][m][n]; ss += (x[0] * x[0] + x[1] * x[1]) + (x[2] * x[2] + x[3] * x[3]); }
                ss += __shfl_xor(ss, 16); ss += __shfl_xor(ss, 32);
                const float rs = __builtin_amdgcn_rsqf(ss * (1.0f / 64.0f) + EPS) * mul;
                bf16_t* rowp = dst + (size_t)(row0 + ai * 128 + m * 16) * pitch + col0 + wc * 64 + 8 * fq;
#pragma unroll
                for (int bj = 0; bj < 2; ++bj) { const f32x4 g0 = *(const f32x4*)(gain + 32 * bj + 8 * fq), g1 = *(const f32x4*)(gain + 32 * bj + 8 * fq + 4);
                    const f32x4 v0 = acc[ai][bj][m][0] * rs * g0, v1 = acc[ai][bj][m][1] * rs * g1;
                    u32x4 w; w.x = pk2(v0[0], v0[1]); w.y = pk2(v0[2], v0[3]); w.z = pk2(v1[0], v1[1]); w.w = pk2(v1[2], v1[3]);
                    *(u32x4*)(rowp + bj * 32) = w; }
                asm volatile("" ::: "memory"); }
    }
    DI void operator()(const Acc& acc, const Unit& u, int wr, int wc, int fr, int fq) const {
        const int row0 = u.pm * 256 + wr * 64 + fr;
        bf16_t* const act = (bf16_t*)(ws + WS_ACT); bf16_t* const ka = (bf16_t*)(ws + WS_KA); bf16_t* const va = (bf16_t*)(ws + WS_VA); bf16_t* const xbc = (bf16_t*)(ws + WS_XBC);
        bf16_t* const gates = (bf16_t*)(ws + WS_GATES); bf16_t* const memkv = (bf16_t*)(ws + WS_MEMKV); float* const dt = (float*)(ws + WS_DT);
        if (u.kind == 1) { ew<0>(acc, memkv, 2048, u.pn * 256, row0, wc, fq); return; }
        const int tl = u.pn;
        if (tl < TL_K) headnorm(acc, act, ACT_P, (tl - TL_Q) * 256, row0, wc, fq, qgain, 0.125f * LOG2E);
        else if (tl < TL_V) headnorm(acc, ka, 1024, (tl - TL_K) * 256, row0, wc, fq, kgain, 1.0f);
        else if (tl < TL_Z) ew<0>(acc, va, 1024, (tl - TL_V) * 256, row0, wc, fq);
        else if (tl < TL_XBC) ew<1>(acc, act, ACT_P, 1024 + (tl - TL_Z) * 256, row0, wc, fq);
        else if (tl < TL_DT) ew<0>(acc, xbc, 3072, (tl - TL_XBC) * 256, row0, wc, fq);
        else if (tl == TL_DT) {
            if (wc == 0) {
                f32x4 b0 = *(const f32x4*)(dtbias + 8 * fq), b1 = *(const f32x4*)(dtbias + 8 * fq + 4);
#pragma unroll
                for (int ai = 0; ai < 2; ++ai)
#pragma unroll
                    for (int m = 0; m < 4; ++m) { float* rowp = dt + (size_t)(row0 + ai * 128 + m * 16) * 32 + 8 * fq;
                        f32x4 v0 = acc[ai][0][m][0] + b0, v1 = acc[ai][0][m][1] + b1;
                        for (int e = 0; e < 4; ++e) { v0[e] = softplus_(v0[e]); v1[e] = softplus_(v1[e]); }
                        *(f32x4*)rowp = v0; *(f32x4*)(rowp + 4) = v1; }
            }
        }
        else if (tl < TL_G) ew<0>(acc, act, ACT_P, 3072 + (tl - TL_QX) * 256, row0, wc, fq);
        else ew<2>(acc, gates, 3072, (tl - TL_G) * 256, row0, wc, fq);
    }
};

struct SchedDense {
    int G, c, nM, nN, K; const char* bbase; int reps;
    DI bool next(int i, Unit& u) const { u.kind = 0; u.aux = 0; const int U = nM * nN; int L = i * G + c; if (L >= U * reps) return false; return pg8::static_tile(L % U, nM, nN, u.pm, u.pn); }
    DI unsigned arow(const Unit& u, int r) const { return (unsigned)(u.pm * 256 + r) * (unsigned)(K * 2); }
    DI const char* bptr(const Unit& u) const { return bbase + (size_t)u.pn * 256 * K * 2; }
};

struct EpiMerge {
    static constexpr bool SEGMENTED = true;
    const bf16_t* gates; const float* rstd; bf16_t* merged; int last_seg;
    DI bool boundary(int t) const { return t == 16 || t == 24 || t == 32 || t == 40 || t == 48; }
    DI void load8(const bf16_t* p, float (&g)[8]) const { const u32x4 w = *(const u32x4*)p; g[0] = bf_lo(w.x); g[1] = bf_hi(w.x); g[2] = bf_lo(w.y); g[3] = bf_hi(w.y); g[4] = bf_lo(w.z); g[5] = bf_hi(w.z); g[6] = bf_lo(w.w); g[7] = bf_hi(w.w); }
    DI void rescale(Acc& acc, const Unit& u, int t, int wr, int wc, int fr, int fq) const {
        int row0 = u.pm * 256 + wr * 64 + fr, col0 = u.pn * 256 + wc * 32 + 8 * fq;
        asm volatile("" : "+v"(row0), "+v"(col0));
        const int go = (t == 16) ? 0 : 1024, ri = (t == 16) ? 0 : 3, g = (t == 24) ? 0 : (t == 32) ? 1 : 2;
        asm volatile("s_nop 15" ::: "memory");
#pragma unroll
        for (int ai = 0; ai < 2; ++ai)
#pragma unroll
          for (int mp = 0; mp < 2; ++mp) {
            float f[2][2][8];
            if (t == 16 || t == 48) {
                u32x4 ga[2][2], gb[2][2]; float rsv[2];
#pragma unroll
                for (int mm = 0; mm < 2; ++mm) { const int row = row0 + ai * 128 + (2 * mp + mm) * 16; const bf16_t* gp = gates + (size_t)row * 3072 + col0 + go; rsv[mm] = rstd[(size_t)row * 4 + ri];
#pragma unroll
                    for (int bj = 0; bj < 2; ++bj) { ga[mm][bj] = *(const u32x4*)(gp + bj * 128); gb[mm][bj] = *(const u32x4*)(gp + 1024 + bj * 128); } }
#pragma unroll
                for (int mm = 0; mm < 2; ++mm)
#pragma unroll
                    for (int bj = 0; bj < 2; ++bj) { float a[8], b[8]; unpack8(ga[mm][bj], a); unpack8(gb[mm][bj], b);
#pragma unroll
                        for (int j = 0; j < 8; ++j) f[mm][bj][j] = (t == 16) ? a[j] * fast_rcp(b[j] * rsv[mm]) : a[j] * rsv[mm] * fast_rcp(b[j]); }
            } else {
#pragma unroll
                for (int mm = 0; mm < 2; ++mm) { const float* rp = rstd + (size_t)(row0 + ai * 128 + (2 * mp + mm) * 16) * 4 + g; const float fr_ = rp[0] * fast_rcp(rp[1]);
#pragma unroll
                    for (int bj = 0; bj < 2; ++bj)
#pragma unroll
                        for (int j = 0; j < 8; ++j) f[mm][bj][j] = fr_; }
            }
#pragma unroll
            for (int mm = 0; mm < 2; ++mm)
#pragma unroll
                for (int bj = 0; bj < 2; ++bj)
#pragma unroll
                    for (int e = 0; e < 4; ++e) { const int m = 2 * mp + mm;
                        asm volatile("v_mul_f32 %0, %0, %1" : "+v"(acc[ai][bj][m][0][e]) : "v"(f[mm][bj][e]));
                        asm volatile("v_mul_f32 %0, %0, %1" : "+v"(acc[ai][bj][m][1][e]) : "v"(f[mm][bj][4 + e])); }
            asm volatile("" ::: "memory");
          }
    }
    DI void unpack8(const u32x4 w, float (&g)[8]) const { g[0] = bf_lo(w.x); g[1] = bf_hi(w.x); g[2] = bf_lo(w.y); g[3] = bf_hi(w.y); g[4] = bf_lo(w.z); g[5] = bf_hi(w.z); g[6] = bf_lo(w.w); g[7] = bf_hi(w.w); }
    DI void operator()(const Acc& acc, const Unit& u, int wr, int wc, int fr, int fq) const {
        int row0 = u.pm * 256 + wr * 64 + fr, col0 = u.pn * 256 + wc * 32 + 8 * fq;
        asm volatile("" : "+v"(row0), "+v"(col0));
#pragma unroll
        for (int ai = 0; ai < 2; ++ai)
#pragma unroll
          for (int mp = 0; mp < 2; ++mp) {
            u32x4 gg[2][2]; float r3[2];
#pragma unroll
            for (int mm = 0; mm < 2; ++mm) { const int row = row0 + ai * 128 + (2 * mp + mm) * 16; r3[mm] = rstd[(size_t)row * 4 + 3]; const bf16_t* gp = gates + (size_t)row * 3072 + col0 + last_seg * 1024;
#pragma unroll
                for (int bj = 0; bj < 2; ++bj) gg[mm][bj] = *(const u32x4*)(gp + bj * 128); }
#pragma unroll
            for (int mm = 0; mm < 2; ++mm) { const int m = 2 * mp + mm; const int row = row0 + ai * 128 + m * 16; bf16_t* op = merged + (size_t)row * 1024 + col0;
#pragma unroll
                for (int bj = 0; bj < 2; ++bj) { float g[8]; unpack8(gg[mm][bj], g); const float s = (last_seg == 1) ? r3[mm] : 1.0f;
                    f32x4 v0 = acc[ai][bj][m][0], v1 = acc[ai][bj][m][1];
                    u32x4 w; w.x = pk2(v0[0] * g[0] * s, v0[1] * g[1] * s); w.y = pk2(v0[2] * g[2] * s, v0[3] * g[3] * s); w.z = pk2(v1[0] * g[4] * s, v1[1] * g[5] * s); w.w = pk2(v1[2] * g[6] * s, v1[3] * g[7] * s);
                    *(u32x4*)(op + bj * 128) = w; } }
            asm volatile("" ::: "memory");
          }
    }
};

struct EpiOut {
    static constexpr bool SEGMENTED = false;
    const float* x; float* out;
    DI void operator()(const Acc& acc, const Unit& u, int wr, int wc, int fr, int fq) const {
        const int row0 = u.pm * 256 + wr * 64 + fr, col0 = u.pn * 256 + wc * 32 + 8 * fq;
#pragma unroll
        for (int ai = 0; ai < 2; ++ai)
#pragma unroll
            for (int m = 0; m < 4; ++m) { const size_t off = (size_t)(row0 + ai * 128 + m * 16) * 1024 + col0;
#pragma unroll
                for (int bj = 0; bj < 2; ++bj) { const f32x4 x0 = __builtin_nontemporal_load((const f32x4*)(x + off + bj * 128)), x1 = __builtin_nontemporal_load((const f32x4*)(x + off + bj * 128 + 4));
                    *(f32x4*)(out + off + bj * 128) = x0 + acc[ai][bj][m][0]; *(f32x4*)(out + off + bj * 128 + 4) = x1 + acc[ai][bj][m][1]; } }
    }
};

struct SchedMoE {
    int G, c, NC, tlo, thi; const LAS int* tstart; const LAS int* cnt; const int* tokl; const char* wbase; size_t wexp; int reps; unsigned rowb; unsigned ldbb;
    DI bool next(int i, Unit& u) const {
        const int n = (thi - tlo) * NC; int L = i * G + c; if (L >= n * reps) return false; L %= n;
        { const int q = n / 8, r = n % 8, xcd = L % 8, off = L / 8; L = (xcd < r ? xcd * (q + 1) : r * (q + 1) + (xcd - r) * q) + off; }
        const int rt = tlo + L / NC; u.pn = L % NC; u.pm = rt; int e = 0;
        for (int j = 1; j < NEXP; ++j) e += (tstart[j] <= rt) ? 1 : 0;
        u.aux = __builtin_amdgcn_readfirstlane(e); u.kind = 0; return true;
    }
    DI unsigned arow(const Unit& u, int r) const {
        if (tokl) { const int e = u.aux, idx = (u.pm - tstart[e]) * 256 + r; const int tok = idx < cnt[e] ? tokl[(size_t)e * T + idx] : 0; return (unsigned)tok * rowb; }
        return (unsigned)((u.pm - tlo) * 256 + r) * rowb;
    }
    DI const char* bptr(const Unit& u) const { return wbase + (size_t)u.aux * wexp + (size_t)u.pn * 256 * ldbb; }
};
struct EpiGU {
    static constexpr bool SEGMENTED = false;
    unsigned char* actm; const float *bg, *bu; int tlo;
    DI void operator()(const Acc& acc, const Unit& u, int wr, int wc, int fr, int fq) const {
        const int row0 = (u.pm - tlo) * 256 + wr * 64 + fr, col = u.pn * 128 + wc * 32 + 8 * fq; const size_t eb = (size_t)u.aux * 1024 + col;
        const f32x4 g0 = *(const f32x4*)(bg + eb), g1 = *(const f32x4*)(bg + eb + 4), u0 = *(const f32x4*)(bu + eb), u1 = *(const f32x4*)(bu + eb + 4);
#pragma unroll
        for (int ai = 0; ai < 2; ++ai)
#pragma unroll
            for (int m = 0; m < 4; ++m) { f32x4 a0 = acc[ai][0][m][0] + g0, a1 = acc[ai][0][m][1] + g1, b0 = acc[ai][1][m][0] + u0, b1 = acc[ai][1][m][1] + u1;
                for (int e = 0; e < 4; ++e) { float g = fminf(a0[e], 7.f), uu = fminf(fmaxf(b0[e], -7.f), 7.f); a0[e] = (uu + 1.f) * g * sigmoidf_(1.702f * g);
                                              g = fminf(a1[e], 7.f); uu = fminf(fmaxf(b1[e], -7.f), 7.f); a1[e] = (uu + 1.f) * g * sigmoidf_(1.702f * g); }
                u32x2 w; w.x = pk4_fp8(a0[0], a0[1], a0[2], a0[3]); w.y = pk4_fp8(a1[0], a1[1], a1[2], a1[3]);
                *(u32x2*)(actm + (size_t)(row0 + ai * 128 + m * 16) * 1024 + col) = w; }
    }
};
struct EpiDown {
    static constexpr bool SEGMENTED = false;
    bf16_t* y; const float* bd; int tlo;
    DI void operator()(const Acc& acc, const Unit& u, int wr, int wc, int fr, int fq) const {
        const int row0 = (u.pm - tlo) * 256 + wr * 64 + fr, col0 = u.pn * 256 + wc * 32 + 8 * fq; const float* bp = bd + (size_t)u.aux * 1024 + col0;
        f32x4 bv[2][2];
#pragma unroll
        for (int bj = 0; bj < 2; ++bj) { bv[bj][0] = *(const f32x4*)(bp + bj * 128); bv[bj][1] = *(const f32x4*)(bp + bj * 128 + 4); }
#pragma unroll
        for (int ai = 0; ai < 2; ++ai)
#pragma unroll
            for (int m = 0; m < 4; ++m) { bf16_t* rowp = y + (size_t)(row0 + ai * 128 + m * 16) * 1024 + col0;
#pragma unroll
                for (int bj = 0; bj < 2; ++bj) { const f32x4 v0 = acc[ai][bj][m][0] + bv[bj][0], v1 = acc[ai][bj][m][1] + bv[bj][1];
                    u32x4 w; w.x = pk2(v0[0], v0[1]); w.y = pk2(v0[2], v0[3]); w.z = pk2(v1[0], v1[1]); w.w = pk2(v1[2], v1[3]);
                    *(u32x4*)(rowp + bj * 128) = w; } }
    }
};
struct TrItem { const float* W; int Ns, k0, sc0, sc1; void* dst; int dpitch; const float* kscale; float mul; int fp8; };
DI void tr_load(const TrItem& it, f32x4 (&v)[16], int lane) {
    const int cl = lane & 15, kl = lane >> 4, sc = (cl < 8) ? it.sc0 : it.sc1, col = sc + 4 * (cl & 7);
#pragma unroll
    for (int i = 0; i < 16; ++i) { v[i] = (f32x4){0.f, 0.f, 0.f, 0.f}; if (sc >= 0) v[i] = __builtin_nontemporal_load((const f32x4*)(it.W + (size_t)(it.k0 + 4 * i + kl) * it.Ns + col)); }
}
DI void tr_store(const TrItem& it, const f32x4 (&v)[16], LAS float* scr, int lane) {
    const int cl = lane & 15, kl = lane >> 4;
#pragma unroll
    for (int i = 0; i < 16; ++i) { const int kk = 4 * i + kl; f32x4 x = v[i] * it.mul; if (it.kscale) x *= it.kscale[it.k0 + kk]; LAS float* p = scr + kk * 65 + 4 * cl; p[0] = x[0]; p[1] = x[1]; p[2] = x[2]; p[3] = x[3]; }
    asm volatile("s_waitcnt lgkmcnt(0)" ::: "memory");
    if (it.fp8) { const int c = lane & 3; unsigned char* dst = (unsigned char*)it.dst;
#pragma unroll
        for (int j = 0; j < 4; ++j) { const int n = (lane >> 2) + 16 * j; const LAS float* s = scr + (16 * c) * 65 + n;
            u32x4 o; o.x = pk4_fp8(s[0 * 65], s[1 * 65], s[2 * 65], s[3 * 65]); o.y = pk4_fp8(s[4 * 65], s[5 * 65], s[6 * 65], s[7 * 65]);
            o.z = pk4_fp8(s[8 * 65], s[9 * 65], s[10 * 65], s[11 * 65]); o.w = pk4_fp8(s[12 * 65], s[13 * 65], s[14 * 65], s[15 * 65]);
            *(u32x4*)(dst + (size_t)n * it.dpitch + 16 * c) = o; }
    } else { const int c = lane & 7; bf16_t* dst = (bf16_t*)it.dst;
#pragma unroll
        for (int j = 0; j < 8; ++j) { const int n = (lane >> 3) + 8 * j; const LAS float* s = scr + (8 * c) * 65 + n;
            u32x4 o; o.x = pk2(s[0 * 65], s[1 * 65]); o.y = pk2(s[2 * 65], s[3 * 65]); o.z = pk2(s[4 * 65], s[5 * 65]); o.w = pk2(s[6 * 65], s[7 * 65]);
            *(u32x4*)(dst + (size_t)n * it.dpitch + 8 * c) = o; }
    }
    asm volatile("s_waitcnt lgkmcnt(0)" ::: "memory");
}
DI int win_src_col(int nb) {
    const int tile = nb >> 3, sub = nb & 7;
    if (tile < TL_V) { const int base = tile < TL_K ? 256 * tile : 1024 + 256 * (tile - TL_K); return base + 32 * (2 * (sub & 3) + (sub >> 2)); }
    if (tile < TL_Z) return 2048 + 256 * (tile - TL_V) + 32 * sub;
    if (tile < TL_XBC) return 3072 + 256 * (tile - TL_Z) + 32 * sub;
    if (tile < TL_DT) return 5120 + 256 * (tile - TL_XBC) + 32 * sub;
    if (tile == TL_DT) return sub == 0 ? 8192 : -1;
    if (tile < TL_G) return 8224 + 256 * (tile - TL_QX) + 32 * sub;
    return 9248 + 256 * (tile - TL_G) + 32 * sub;
}
template <int NR> DI void rms_rows_to_bf16(const float* x, bf16_t* o, size_t row_stride, const float* gain, int lane) {
    f32x4 v[NR][4]; float s[NR];
#pragma unroll
    for (int r = 0; r < NR; ++r) { const f32x4* xr = (const f32x4*)(x + (size_t)r * row_stride * 1024) + lane; s[r] = 0.f;
#pragma unroll
        for (int j = 0; j < 4; ++j) { v[r][j] = __builtin_nontemporal_load(xr + 64 * j); } }
#pragma unroll
    for (int r = 0; r < NR; ++r) {
#pragma unroll
        for (int j = 0; j < 4; ++j) s[r] += (v[r][j].x * v[r][j].x + v[r][j].y * v[r][j].y) + (v[r][j].z * v[r][j].z + v[r][j].w * v[r][j].w);
        s[r] = __builtin_amdgcn_rsqf(wave_sum(s[r]) * (1.f / 1024.f) + EPS); }
    const f32x4* gr = (const f32x4*)gain + lane;
#pragma unroll
    for (int j = 0; j < 4; ++j) { const f32x4 g = gr[64 * j];
#pragma unroll
        for (int r = 0; r < NR; ++r) { u32x2 w; w.x = pk2(v[r][j].x * s[r] * g.x, v[r][j].y * s[r] * g.y); w.y = pk2(v[r][j].z * s[r] * g.z, v[r][j].w * s[r] * g.w); ((u32x2*)(o + (size_t)r * row_stride * 1024) + lane)[64 * j] = w; } }
}


template <int NR> DI void rms_rows_to_fp8(const float* x, unsigned char* o, const float* gain, int lane) {
    f32x4 v[NR][4]; float s[NR];
#pragma unroll
    for (int r = 0; r < NR; ++r) { const f32x4* xr = (const f32x4*)(x + (size_t)r * 1024) + lane; s[r] = 0.f;
#pragma unroll
        for (int j = 0; j < 4; ++j) { v[r][j] = xr[64 * j]; } }
#pragma unroll
    for (int r = 0; r < NR; ++r) {
#pragma unroll
        for (int j = 0; j < 4; ++j) s[r] += (v[r][j].x * v[r][j].x + v[r][j].y * v[r][j].y) + (v[r][j].z * v[r][j].z + v[r][j].w * v[r][j].w);
        s[r] = __builtin_amdgcn_rsqf(wave_sum(s[r]) * (1.f / 1024.f) + EPS); }
    const f32x4* gr = (const f32x4*)gain + lane;
#pragma unroll
    for (int j = 0; j < 4; ++j) { const f32x4 g = gr[64 * j];
#pragma unroll
        for (int r = 0; r < NR; ++r) ((unsigned*)(o + (size_t)r * 1024) + lane)[64 * j] = pk4_fp8(v[r][j].x * s[r] * g.x, v[r][j].y * s[r] * g.y, v[r][j].z * s[r] * g.z, v[r][j].w * s[r] * g.w); }
}

DI int crow(int r, int hi) { return (r & 3) + 8 * (r >> 2) + 4 * hi; }
DI s16x4 vtr(const LAS unsigned char* p) { return __builtin_bit_cast(s16x4, __builtin_amdgcn_ds_read_tr16_b64_v4i16((LAS v4i16_t*)p)); }
#define MFMA32(a, b, c) __builtin_amdgcn_mfma_f32_32x32x16_bf16((a), (b), (c), 0, 0, 0)
#define MFMA16(a, b, c) __builtin_amdgcn_mfma_f32_16x16x32_bf16((a), (b), (c), 0, 0, 0)
DI void tile_load(u32x4 (&r)[4], const bf16_t* g, size_t pitch, int tid) {
#pragma unroll
    for (int i = 0; i < 4; ++i) { const int q = tid + 512 * i, row = q >> 5, ch = q & 31; r[i] = *(const u32x4*)(g + (size_t)row * pitch + ch * 8); }
}
DI void tile_store_k(LAS unsigned char* dst, const u32x4 (&r)[4], int tid) {
#pragma unroll
    for (int i = 0; i < 4; ++i) { const int q = tid + 512 * i, row = q >> 5, ch = q & 31; *(LAS u32x4*)(dst + row * 512 + ((ch ^ (row & 15)) << 4)) = r[i]; }
}
DI void tile_store_v(LAS unsigned char* dst, const u32x4 (&r)[4], int tid) {
#pragma unroll
    for (int i = 0; i < 4; ++i) { const int q = tid + 512 * i, row = q >> 5, ch = q & 31; *(LAS u32x4*)(dst + row * 512 + ((((ch >> 2) ^ (row & 3)) * 4 + (ch & 3)) << 4)) = r[i]; }
}
constexpr int AT_K = 0, AT_V = 32768, AT_BIAS = 65536, AT_BIAS_STRIDE = 260;

constexpr float SM_THR = 8.0f;
DI bool softmax_tile(f32x16& s0, f32x16& s1, float& m, float& l, bf16x8 (&pa)[4], float& alpha) {
    float mx = fmaxf(s0[0], s1[0]);
#pragma unroll
    for (int r = 1; r < 16; ++r) mx = fmaxf(mx, fmaxf(s0[r], s1[r]));
    mx = fmaxf(mx, __shfl_xor(mx, 32));
    bool moved = false; alpha = 1.0f;
    if (__builtin_expect(__any(mx > SM_THR), 0)) {
        const float dl = fmaxf(mx, 0.f); m += dl; alpha = fast_exp2(-dl); l *= alpha; moved = true;
#pragma unroll
        for (int r = 0; r < 16; ++r) { s0[r] -= dl; s1[r] -= dl; }
    }
    float sum = 0.f;
#pragma unroll
    for (int r = 0; r < 16; ++r) { s0[r] = fast_exp2(s0[r]); s1[r] = fast_exp2(s1[r]); sum += s0[r] + s1[r]; }
    l += sum;
    u32x4 w;
    w.x = pk2(s0[0], s0[1]); w.y = pk2(s0[2], s0[3]); w.z = pk2(s0[4], s0[5]); w.w = pk2(s0[6], s0[7]); pa[0] = __builtin_bit_cast(bf16x8, w);
    w.x = pk2(s0[8], s0[9]); w.y = pk2(s0[10], s0[11]); w.z = pk2(s0[12], s0[13]); w.w = pk2(s0[14], s0[15]); pa[1] = __builtin_bit_cast(bf16x8, w);
    w.x = pk2(s1[0], s1[1]); w.y = pk2(s1[2], s1[3]); w.z = pk2(s1[4], s1[5]); w.w = pk2(s1[6], s1[7]); pa[2] = __builtin_bit_cast(bf16x8, w);
    w.x = pk2(s1[8], s1[9]); w.y = pk2(s1[10], s1[11]); w.z = pk2(s1[12], s1[13]); w.w = pk2(s1[14], s1[15]); pa[3] = __builtin_bit_cast(bf16x8, w);
    return moved;
}
DI bf16x8 v_frag(const LAS unsigned char* vt, int s, int colbyte0, int lane) {
    const int hi = lane >> 5, q_ = (lane & 15) >> 2, p_ = lane & 3, blk = (lane >> 4) & 1;
    const int cb = colbyte0 + blk * 32 + p_ * 8, u = cb >> 6, within = cb & 63;
    const int R = 16 * s + 4 * hi + q_;
    const s16x4 lo = vtr(vt + R * 512 + ((u ^ q_) << 6) + within);
    const s16x4 h4 = vtr(vt + (R + 8) * 512 + ((u ^ q_) << 6) + within);
    return __builtin_shufflevector(lo, h4, 0, 1, 2, 3, 4, 5, 6, 7);
}

DI void attnA_unit(LAS unsigned char* lds, int b, int c, int hq, bf16_t* act, const bf16_t* ka, const bf16_t* va, bf16_t* outp, size_t opitch) {
    const int tid = threadIdx.x, lane = tid & 63, wid = __builtin_amdgcn_readfirstlane(tid >> 6), hl = wid >> 1, qh = wid & 1, head = 4 * hq + hl, l31 = lane & 31, hi = lane >> 5;
    const size_t trow = (size_t)b * SEQ + 64 * c + 32 * qh + l31;
    bf16_t* qp = act + trow * ACT_P + 64 * head;
    bf16x8 qf[4];
#pragma unroll
    for (int d0 = 0; d0 < 4; ++d0) qf[d0] = *(const bf16x8*)(qp + 16 * d0 + 8 * hi);
    f32x16 o0, o1;
#pragma unroll
    for (int r = 0; r < 16; ++r) { o0[r] = 0.f; o1[r] = 0.f; }
    float m = 0.f, l = 0.f;
    const int kc0 = c < 8 ? 0 : c - 8;
    const LAS float* bias = (const LAS float*)(lds + AT_BIAS) + head * AT_BIAS_STRIDE;
    const float b256 = bias[256];
    u32x4 rk[4], rv[4];
    const bf16_t* kb = ka + ((size_t)b * SEQ + 64 * kc0) * 1024 + 256 * hq; const bf16_t* vb = va + ((size_t)b * SEQ + 64 * kc0) * 1024 + 256 * hq;
    tile_load(rk, kb, 1024, tid); tile_load(rv, vb, 1024, tid);
    const int qi = 32 * qh + l31;
    for (int kc = kc0; kc <= c; ++kc) {
        __syncthreads();
        tile_store_k(lds + AT_K, rk, tid); tile_store_v(lds + AT_V, rv, tid);
        if (kc < c) { kb += 64 * 1024; vb += 64 * 1024; tile_load(rk, kb, 1024, tid); tile_load(rv, vb, 1024, tid); }
        __syncthreads();
        const int j = c - kc;
        f32x16 s0, s1;
        if (j >= 3) { const float c0 = b256 - m;
#pragma unroll
            for (int r = 0; r < 16; ++r) { s0[r] = c0; s1[r] = c0; }
        } else {
#pragma unroll
            for (int r = 0; r < 16; ++r) { const int rel0 = 64 * j + qi - crow(r, hi); s0[r] = bias[min(rel0, 128) + 128] - m; s1[r] = bias[min(rel0 - 32, 128) + 128] - m; }
        }
#pragma unroll
        for (int d0 = 0; d0 < 4; ++d0) {
            const int ch = 8 * hl + 2 * d0 + hi;
            const bf16x8 k0 = *(const LAS bf16x8*)(lds + AT_K + l31 * 512 + ((ch ^ (l31 & 15)) << 4));
            const bf16x8 k1 = *(const LAS bf16x8*)(lds + AT_K + (32 + l31) * 512 + ((ch ^ (l31 & 15)) << 4));
            s0 = MFMA32(k0, qf[d0], s0); s1 = MFMA32(k1, qf[d0], s1);
        }
        bf16x8 pa[4]; float alpha;
        if (softmax_tile(s0, s1, m, l, pa, alpha)) {
#pragma unroll
            for (int r = 0; r < 16; ++r) { o0[r] *= alpha; o1[r] *= alpha; } }
#pragma unroll
        for (int s = 0; s < 4; ++s) {
            const bf16x8 v0 = v_frag(lds + AT_V, s, (64 * hl) * 2, lane), v1 = v_frag(lds + AT_V, s, (64 * hl + 32) * 2, lane);
            o0 = MFMA32(v0, pa[s], o0); o1 = MFMA32(v1, pa[s], o1);
        }
    }
    const float lt = l + __shfl_xor(l, 32), inv = fast_rcp(lt);
#pragma unroll
    for (int rg = 0; rg < 4; ++rg) {
        u32x2 w0, w1; w0.x = pk2(o0[4 * rg] * inv, o0[4 * rg + 1] * inv); w0.y = pk2(o0[4 * rg + 2] * inv, o0[4 * rg + 3] * inv);
        w1.x = pk2(o1[4 * rg] * inv, o1[4 * rg + 1] * inv); w1.y = pk2(o1[4 * rg + 2] * inv, o1[4 * rg + 3] * inv);
        bf16_t* op = outp + trow * opitch + 64 * head; *(u32x2*)(op + 8 * rg + 4 * hi) = w0; *(u32x2*)(op + 32 + 8 * rg + 4 * hi) = w1;
    }
}

constexpr int AT_Q = 65536;
DI void attnC_phase(LAS unsigned char* lds, int vcu, int G, bf16_t* act, const bf16_t* kx, const bf16_t* memkv, bf16_t* outp, size_t opitch) {
    const int tid = threadIdx.x, lane = tid & 63, wid = __builtin_amdgcn_readfirstlane(tid >> 6), rg = wid >> 1, dh = wid & 1, l31 = lane & 31, hi = lane >> 5;
    constexpr int NU = NBATCH * 4 * 32;
    const int upw = (NU + G - 1) / G, u0 = vcu * upw, u1 = (u0 + upw < NU) ? u0 + upw : NU;
    if (u0 >= NU) return;
    const int nsteps = (u1 - u0) * 4;
    u32x4 rk[4], rv[4];
    { const int b = u0 >> 7, hx = (u0 >> 5) & 3;
      tile_load(rk, kx + ((size_t)b * MEMLEN) * 1024 + 256 * hx, 1024, tid); tile_load(rv, memkv + ((size_t)b * MEMLEN) * 2048 + 1024 + 256 * hx, 2048, tid); }
    f32x16 o[4]; float m = 0.f, l = 0.f, rstd = 1.f;
    for (int n = 0; n < nsteps; ++n) {
        const int u = u0 + (n >> 2), j = n & 3, rb = u & 31, hx = (u >> 5) & 3, b = u >> 7;
        const size_t trow = (size_t)b * SEQ + 128 * rb + 32 * rg + l31;
        u32x4 rq[8];
        if (j == 0) {
#pragma unroll
            for (int i = 0; i < 8; ++i) { const int q = tid + 512 * i, row = q >> 5, ch = q & 31; rq[i] = *(const u32x4*)(act + ((size_t)b * SEQ + 128 * rb + row) * ACT_P + 3072 + 256 * hx + ch * 8); }
#pragma unroll
            for (int i = 0; i < 4; ++i)
#pragma unroll
                for (int r = 0; r < 16; ++r) o[i][r] = 0.f;
            m = 0.f; l = 0.f;
        }
        __syncthreads();
        tile_store_k(lds + AT_K, rk, tid); tile_store_v(lds + AT_V, rv, tid);
        if (j == 0) {
#pragma unroll
            for (int i = 0; i < 8; ++i) { const int q = tid + 512 * i, row = q >> 5, ch = q & 31; *(LAS u32x4*)(lds + AT_Q + row * 512 + ((ch ^ (row & 15)) << 4)) = rq[i]; }
        }
        if (n + 1 < nsteps) { const int un = u0 + ((n + 1) >> 2), jn = (n + 1) & 3, hxn = (un >> 5) & 3, bn = un >> 7;
            tile_load(rk, kx + ((size_t)bn * MEMLEN + 64 * jn) * 1024 + 256 * hxn, 1024, tid); tile_load(rv, memkv + ((size_t)bn * MEMLEN + 64 * jn) * 2048 + 1024 + 256 * hxn, 2048, tid); }
        __syncthreads();
        f32x16 s0, s1;
#pragma unroll
        for (int r = 0; r < 16; ++r) { s0[r] = 0.f; s1[r] = 0.f; }
        float ssq = 0.f;
#pragma unroll
        for (int d0 = 0; d0 < 16; ++d0) {
            const int ch = 2 * d0 + hi;
            const bf16x8 qfr = *(const LAS bf16x8*)(lds + AT_Q + (32 * rg + l31) * 512 + ((ch ^ (l31 & 15)) << 4));
            const bf16x8 k0 = *(const LAS bf16x8*)(lds + AT_K + l31 * 512 + ((ch ^ (l31 & 15)) << 4));
            const bf16x8 k1 = *(const LAS bf16x8*)(lds + AT_K + (32 + l31) * 512 + ((ch ^ (l31 & 15)) << 4));
            if (j == 0) {
#pragma unroll
                for (int e = 0; e < 8; ++e) { const float v = bf2f((bf16_t)qfr[e]); ssq += v * v; } }
            s0 = MFMA32(k0, qfr, s0); s1 = MFMA32(k1, qfr, s1);
        }
        if (j == 0) { ssq += __shfl_xor(ssq, 32); rstd = __builtin_amdgcn_rsqf(ssq * (1.f / 256.f) + EPS); }
#pragma unroll
        for (int r = 0; r < 16; ++r) { s0[r] = s0[r] * rstd - m; s1[r] = s1[r] * rstd - m; }
        bf16x8 pa[4]; float alpha;
        if (softmax_tile(s0, s1, m, l, pa, alpha)) {
#pragma unroll
            for (int i = 0; i < 4; ++i)
#pragma unroll
                for (int r = 0; r < 16; ++r) o[i][r] *= alpha; }
#pragma unroll
        for (int s = 0; s < 4; ++s)
#pragma unroll
            for (int i = 0; i < 4; ++i) { const bf16x8 vf = v_frag(lds + AT_V, s, (128 * dh + 32 * i) * 2, lane); o[i] = MFMA32(vf, pa[s], o[i]); }
        if (j == 3) {
            const float lt = l + __shfl_xor(l, 32), inv = fast_rcp(lt);
            bf16_t* op = outp + trow * opitch + 256 * hx + 128 * dh;
#pragma unroll
            for (int i = 0; i < 4; ++i)
#pragma unroll
                for (int g4 = 0; g4 < 4; ++g4) { u32x2 w; w.x = pk2(o[i][4 * g4] * inv, o[i][4 * g4 + 1] * inv); w.y = pk2(o[i][4 * g4 + 2] * inv, o[i][4 * g4 + 3] * inv);
                    *(u32x2*)(op + 32 * i + 8 * g4 + 4 * hi) = w; }
        }
    }
    __syncthreads();
}

constexpr int MB_XDT = 0, MB_XDTW = 9216, MB_BM = 18432, MB_CM = 35840, MB_YD = 53248, MB_YO = 70656, MB_ACS = 88064, MB_YSTR = 272;
DI int mb_b256(int row, int col) { return row * 272 + col * 2; }
DI int mb_b128(int row, int col) { return row * 144 + col * 2; }
template <bool W256> DI bf16x8 tr_pair(const LAS unsigned char* base, int row_lo, int row_hi, int col0, int lane) {
    const int i = lane & 15, r = i >> 2, c = col0 + 4 * (i & 3);
    const s16x4 lo = vtr(base + (W256 ? mb_b256(row_lo + r, c) : mb_b128(row_lo + r, c))), h4 = vtr(base + (W256 ? mb_b256(row_hi + r, c) : mb_b128(row_hi + r, c)));
    return __builtin_shufflevector(lo, h4, 0, 1, 2, 3, 4, 5, 6, 7);
}
DI void bcconv_phase(int vcu, int G, const bf16_t* xbc, bf16_t* bc, const float* conv_w, const float* conv_b, const float* dtp, float* acsp, const float* a_log) {
    {
        const int lane = threadIdx.x & 63, wv = threadIdx.x >> 6;
        for (int ck = vcu * 8 + wv; ck < T / 64; ck += G * 8) {
            const float* dr = dtp + ((size_t)ck * 64 + lane) * 32; float* orow = acsp + ((size_t)ck * 64 + lane) * 32;
#pragma unroll
            for (int q = 0; q < 8; ++q) { f32x4 v = *(const f32x4*)(dr + 4 * q); const f32x4 al = *(const f32x4*)(a_log + 4 * q);
#pragma unroll
                for (int e = 0; e < 4; ++e) { float a = -v[e] * __expf(al[e]);
#pragma unroll
                    for (int o = 1; o < 64; o <<= 1) { const float u = __shfl_up(a, o); if (lane >= o) a += u; }
                    v[e] = a; }
                *(f32x4*)(orow + 4 * q) = v; }
        }
    }
    for (int task = vcu * 512 + threadIdx.x; task < (T / 16) * 128; task += G * 512) {
        const int cc = task & 127, run = task >> 7, g = cc >> 5, w = cc & 31;
        const int scol = (w < 16 ? 2048 + 128 * g + 8 * w : 2560 + 128 * g + 8 * (w - 16));
        const int t0 = run * 16, pos0 = t0 & (SEQ - 1);
        float cw[4][8], cb[8];
#pragma unroll
        for (int e = 0; e < 8; ++e) { cb[e] = conv_b[scol + e];
#pragma unroll
            for (int i = 0; i < 4; ++i) cw[i][e] = conv_w[i * 3072 + scol + e]; }
        float win[3][8];
#pragma unroll
        for (int k = 0; k < 3; ++k) { u32x4 wv = (u32x4){0u, 0u, 0u, 0u}; if (pos0 + k - 3 >= 0) wv = *(const u32x4*)(xbc + (size_t)(t0 + k - 3) * 3072 + scol);
            win[k][0] = bf_lo(wv.x); win[k][1] = bf_hi(wv.x); win[k][2] = bf_lo(wv.y); win[k][3] = bf_hi(wv.y); win[k][4] = bf_lo(wv.z); win[k][5] = bf_hi(wv.z); win[k][6] = bf_lo(wv.w); win[k][7] = bf_hi(wv.w); }
#pragma unroll 4
        for (int k = 0; k < 16; ++k) {
            const u32x4 wv = __builtin_nontemporal_load((const u32x4*)(xbc + (size_t)(t0 + k) * 3072 + scol));
            const float cur[8] = {bf_lo(wv.x), bf_hi(wv.x), bf_lo(wv.y), bf_hi(wv.y), bf_lo(wv.z), bf_hi(wv.z), bf_lo(wv.w), bf_hi(wv.w)};
            float o[8];
#pragma unroll
            for (int e = 0; e < 8; ++e) { o[e] = silu_(cb[e] + cw[0][e] * win[0][e] + cw[1][e] * win[1][e] + cw[2][e] * win[2][e] + cw[3][e] * cur[e]); win[0][e] = win[1][e]; win[1][e] = win[2][e]; win[2][e] = cur[e]; }
            u32x4 ov; ov.x = pk2(o[0], o[1]); ov.y = pk2(o[2], o[3]); ov.z = pk2(o[4], o[5]); ov.w = pk2(o[6], o[7]);
            *(u32x4*)(bc + (size_t)(t0 + k) * 1024 + 8 * cc) = ov;
        }
    }
}
constexpr int MP_IMG = 44800, MP_XDT = 0, MP_BM = 9216, MP_CM = 26624, MP_ACS = 44032, MP_W = 44288, MP_Y0 = 2 * MP_IMG, MP_YSZ = 34816, MP_YD = 0, MP_YO = 17408, MP_CW = MP_Y0 + 2 * MP_YSZ;
DI void mamba_unit(LAS unsigned char* lds, int b, int h, const bf16_t* xbc, const bf16_t* bc, const float* dtp, const float* acsp, bf16_t* act, float* ssq_out, bf16_t* outp, size_t opitch,
                   const float* conv_w, const float* conv_b, const float* a_log, const float* d_skip) {
    const int tid = threadIdx.x, lane = tid & 63, wid = __builtin_amdgcn_readfirstlane(tid >> 6), fr = lane & 15, fq = lane >> 4, g = h >> 3;
    const float D_h = d_skip[h];
    const int l = tid >> 3, pc = tid & 7, xcol = 64 * h + 8 * pc;
    LAS float* cwl = (LAS float*)(lds + MP_CW);
    if (tid < 256) cwl[tid] = conv_w[(tid >> 6) * 3072 + 64 * h + (tid & 63)]; else if (tid < 320) cwl[tid] = conv_b[64 * h + (tid & 63)];
    f32x4 Z[8];
#pragma unroll
    for (int i = 0; i < 8; ++i) Z[i] = (f32x4){0.f, 0.f, 0.f, 0.f};
    const int frow0 = tid >> 4, fch = tid & 15;
    const size_t tb = (size_t)b * SEQ;
    u32x4 xr[4], bcr[4]; float dt_l, acs_l, acs63;
#define MB_LOAD(c_) do { const int p0_ = 64 * (c_); \
        _Pragma("unroll") for (int i_ = 0; i_ < 4; ++i_) { const int pos_ = p0_ + l - 3 + i_; xr[i_] = (u32x4){0u, 0u, 0u, 0u}; if (pos_ >= 0) xr[i_] = *(const u32x4*)(xbc + (tb + pos_) * 3072 + xcol); } \
        _Pragma("unroll") for (int i_ = 0; i_ < 4; ++i_) bcr[i_] = *(const u32x4*)(bc + (tb + p0_ + frow0 + 32 * (i_ & 1)) * 1024 + 256 * g + 128 * (i_ >> 1) + 8 * fch); \
        dt_l = dtp[(tb + p0_ + l) * 32 + h]; acs_l = acsp[(tb + p0_ + l) * 32 + h]; acs63 = acsp[(tb + p0_ + 63) * 32 + h]; } while (0)
    auto S1 = [&](const int cn, float (&xs)[8]) __attribute__((always_inline)) {
        LAS unsigned char* img = lds + (cn & 1) * MP_IMG;
        if (pc == 0) { ((LAS float*)(img + MP_ACS))[l] = acs_l; ((LAS float*)(img + MP_W))[l] = __expf(acs63 - acs_l); }
        { float r[4][8];
#pragma unroll
          for (int i = 0; i < 4; ++i) { r[i][0] = bf_lo(xr[i].x); r[i][1] = bf_hi(xr[i].x); r[i][2] = bf_lo(xr[i].y); r[i][3] = bf_hi(xr[i].y); r[i][4] = bf_lo(xr[i].z); r[i][5] = bf_hi(xr[i].z); r[i][6] = bf_lo(xr[i].w); r[i][7] = bf_hi(xr[i].w); }
          const f32x4 b0 = *(const LAS f32x4*)(cwl + 256 + 8 * pc), b1 = *(const LAS f32x4*)(cwl + 256 + 8 * pc + 4);
          float a[8] = {b0[0], b0[1], b0[2], b0[3], b1[0], b1[1], b1[2], b1[3]};
#pragma unroll
          for (int i = 0; i < 4; ++i) { const f32x4 w0 = *(const LAS f32x4*)(cwl + 64 * i + 8 * pc), w1 = *(const LAS f32x4*)(cwl + 64 * i + 8 * pc + 4);
              a[0] += w0[0] * r[i][0]; a[1] += w0[1] * r[i][1]; a[2] += w0[2] * r[i][2]; a[3] += w0[3] * r[i][3]; a[4] += w1[0] * r[i][4]; a[5] += w1[1] * r[i][5]; a[6] += w1[2] * r[i][6]; a[7] += w1[3] * r[i][7]; }
#pragma unroll
          for (int e = 0; e < 8; ++e) xs[e] = silu_(a[e]); }
        { const float d = dt_l; u32x4 av; av.x = pk2(xs[0] * d, xs[1] * d); av.y = pk2(xs[2] * d, xs[3] * d); av.z = pk2(xs[4] * d, xs[5] * d); av.w = pk2(xs[6] * d, xs[7] * d);
          *(LAS u32x4*)(img + MP_XDT + mb_b128(l, 8 * pc)) = av; }
#pragma unroll
        for (int i = 0; i < 4; ++i) *(LAS u32x4*)(img + (i < 2 ? MP_BM : MP_CM) + mb_b256(frow0 + 32 * (i & 1), 8 * fch)) = bcr[i];
        { const int cq = cn < 63 ? cn + 1 : 63; MB_LOAD(cq); }
    };
    auto S2 = [&](const int c) __attribute__((always_inline)) {
        const LAS unsigned char* img = lds + (c & 1) * MP_IMG; LAS unsigned char* yb = lds + MP_Y0 + (c & 1) * MP_YSZ;
        const LAS float* acs = (const LAS float*)(img + MP_ACS);
        if (wid >= 4) {
            const int d = wid - 4; const float la = acs[16 * d + fr];
            f32x4 X[4];
            bf16x8 cf[4];
#pragma unroll
            for (int ks = 0; ks < 4; ++ks) cf[ks] = *(const LAS bf16x8*)(img + MP_CM + mb_b256(16 * d + fr, 32 * ks + 8 * fq));
#pragma unroll
            for (int si = 0; si < 4; ++si) { X[si] = (f32x4){0.f, 0.f, 0.f, 0.f};
                if (si <= d) {
                    bf16x8 af[4];
#pragma unroll
                    for (int ks = 0; ks < 4; ++ks) af[ks] = *(const LAS bf16x8*)(img + MP_BM + mb_b256(16 * si + fr, 32 * ks + 8 * fq));
#pragma unroll
                    for (int ks = 0; ks < 4; ++ks) X[si] = MFMA16(af[ks], cf[ks], X[si]);
                    const f32x4 sa = *(const LAS f32x4*)(acs + 16 * si + 4 * fq);
#pragma unroll
                    for (int r = 0; r < 4; ++r) { const int s_abs = 16 * si + 4 * fq + r, l_abs = 16 * d + fr; X[si][r] = (s_abs <= l_abs) ? X[si][r] * __expf(la - sa[r]) : 0.f; }
                } }
            bf16x8 Xp[2];
#pragma unroll
            for (int sb = 0; sb < 2; ++sb) { u32x4 w; w.x = pk2(X[2 * sb][0], X[2 * sb][1]); w.y = pk2(X[2 * sb][2], X[2 * sb][3]); w.z = pk2(X[2 * sb + 1][0], X[2 * sb + 1][1]); w.w = pk2(X[2 * sb + 1][2], X[2 * sb + 1][3]); Xp[sb] = __builtin_bit_cast(bf16x8, w); }
#pragma unroll
            for (int ph = 0; ph < 2; ++ph) { bf16x8 xa[2][2];
#pragma unroll
                for (int q = 0; q < 2; ++q)
#pragma unroll
                    for (int sb = 0; sb < 2; ++sb) if (2 * sb <= d) xa[q][sb] = tr_pair<false>(img + MP_XDT, 32 * sb + 4 * fq, 32 * sb + 16 + 4 * fq, 16 * (2 * ph + q), lane);
#pragma unroll
                for (int q = 0; q < 2; ++q) { f32x4 y = (f32x4){0.f, 0.f, 0.f, 0.f};
#pragma unroll
                    for (int sb = 0; sb < 2; ++sb) { if (2 * sb <= d) y = MFMA16(xa[q][sb], Xp[sb], y); }
                    *(LAS f32x4*)(yb + MP_YD + (16 * d + fr) * MB_YSTR + (16 * (2 * ph + q) + 4 * fq) * 4) = y; } }
        } else {
            const int pw = wid;
            bf16x8 Zp[4];
#pragma unroll
            for (int nb = 0; nb < 4; ++nb) { u32x4 w; w.x = pk2(Z[2 * nb][0], Z[2 * nb][1]); w.y = pk2(Z[2 * nb][2], Z[2 * nb][3]); w.z = pk2(Z[2 * nb + 1][0], Z[2 * nb + 1][1]); w.w = pk2(Z[2 * nb + 1][2], Z[2 * nb + 1][3]); Zp[nb] = __builtin_bit_cast(bf16x8, w); }
#pragma unroll
            for (int lt = 0; lt < 4; ++lt) { f32x4 y = (f32x4){0.f, 0.f, 0.f, 0.f};
                bf16x8 bfr[4];
#pragma unroll
                for (int nb = 0; nb < 4; ++nb) { const s16x4 lo = *(const LAS s16x4*)(img + MP_CM + mb_b256(16 * lt + fr, 32 * nb + 4 * fq)), h4 = *(const LAS s16x4*)(img + MP_CM + mb_b256(16 * lt + fr, 32 * nb + 16 + 4 * fq));
                    bfr[nb] = __builtin_shufflevector(lo, h4, 0, 1, 2, 3, 4, 5, 6, 7); }
#pragma unroll
                for (int nb = 0; nb < 4; ++nb) y = MFMA16(Zp[nb], bfr[nb], y);
                const float ea = __expf(acs[16 * lt + fr]); y *= ea;
                *(LAS f32x4*)(yb + MP_YO + (16 * lt + fr) * MB_YSTR + (16 * pw + 4 * fq) * 4) = y; }
            const float dec = __expf(acs[63]);
            bf16x8 xw[2];
#pragma unroll
            for (int lb = 0; lb < 2; ++lb) { const bf16x8 xf = tr_pair<false>(img + MP_XDT, 32 * lb + 8 * fq, 32 * lb + 8 * fq + 4, 16 * pw, lane);
                const f32x4 w0 = *(const LAS f32x4*)((const LAS float*)(img + MP_W) + 32 * lb + 8 * fq), w1 = *(const LAS f32x4*)((const LAS float*)(img + MP_W) + 32 * lb + 8 * fq + 4);
                u32x4 o; o.x = pk2(bf2f((bf16_t)xf[0]) * w0[0], bf2f((bf16_t)xf[1]) * w0[1]); o.y = pk2(bf2f((bf16_t)xf[2]) * w0[2], bf2f((bf16_t)xf[3]) * w0[3]);
                o.z = pk2(bf2f((bf16_t)xf[4]) * w1[0], bf2f((bf16_t)xf[5]) * w1[1]); o.w = pk2(bf2f((bf16_t)xf[6]) * w1[2], bf2f((bf16_t)xf[7]) * w1[3]); xw[lb] = __builtin_bit_cast(bf16x8, o); }
#pragma unroll
            for (int np = 0; np < 4; ++np) { bf16x8 av[2][2];
#pragma unroll
                for (int q = 0; q < 2; ++q)
#pragma unroll
                    for (int lb = 0; lb < 2; ++lb) av[q][lb] = tr_pair<true>(img + MP_BM, 32 * lb + 8 * fq, 32 * lb + 8 * fq + 4, 16 * (2 * np + q), lane);
#pragma unroll
                for (int q = 0; q < 2; ++q) { Z[2 * np + q] *= dec;
#pragma unroll
                    for (int lb = 0; lb < 2; ++lb) Z[2 * np + q] = MFMA16(av[q][lb], xw[lb], Z[2 * np + q]); } }
        }
    };
    auto S3 = [&](const int cp, const float (&xs)[8], const u32x4 zw) __attribute__((always_inline)) {
        const LAS unsigned char* yb = lds + MP_Y0 + (cp & 1) * MP_YSZ; const size_t t0 = tb + 64 * cp;
        const f32x4 a0 = *(const LAS f32x4*)(yb + MP_YD + l * MB_YSTR + pc * 32), a1 = *(const LAS f32x4*)(yb + MP_YD + l * MB_YSTR + pc * 32 + 16);
        const f32x4 b0 = *(const LAS f32x4*)(yb + MP_YO + l * MB_YSTR + pc * 32), b1 = *(const LAS f32x4*)(yb + MP_YO + l * MB_YSTR + pc * 32 + 16);
        float y[8];
        y[0] = (a0[0] + b0[0] + D_h * xs[0]) * bf_lo(zw.x); y[1] = (a0[1] + b0[1] + D_h * xs[1]) * bf_hi(zw.x);
        y[2] = (a0[2] + b0[2] + D_h * xs[2]) * bf_lo(zw.y); y[3] = (a0[3] + b0[3] + D_h * xs[3]) * bf_hi(zw.y);
        y[4] = (a1[0] + b1[0] + D_h * xs[4]) * bf_lo(zw.z); y[5] = (a1[1] + b1[1] + D_h * xs[5]) * bf_hi(zw.z);
        y[6] = (a1[2] + b1[2] + D_h * xs[6]) * bf_lo(zw.w); y[7] = (a1[3] + b1[3] + D_h * xs[7]) * bf_hi(zw.w);
        float ss = 0.f;
#pragma unroll
        for (int e = 0; e < 8; ++e) ss += y[e] * y[e];
        ss += __shfl_xor(ss, 1); ss += __shfl_xor(ss, 2); ss += __shfl_xor(ss, 4);
        if (pc == 0) ssq_out[(t0 + l) * 32 + h] = ss;
        u32x4 w; w.x = pk2(y[0], y[1]); w.y = pk2(y[2], y[3]); w.z = pk2(y[4], y[5]); w.w = pk2(y[6], y[7]); *(u32x4*)(outp + (t0 + l) * opitch + 64 * h + 8 * pc) = w;
    };
#define MB_Z(c_) __builtin_nontemporal_load((const u32x4*)(act + (tb + 64 * (c_) + l) * ACT_P + 1024 + 64 * h + 8 * pc))
    float xsA[8], xsB[8]; u32x4 zA, zB;
    MB_LOAD(0);
    __syncthreads();
    S1(0, xsA); zA = MB_Z(0);
    __syncthreads();
#pragma unroll 1
    for (int c = 0; c < 64; c += 2) {
        if (wid < 4) S2(c);
        if (c > 0) S3(c - 1, xsB, zB);
        S1(c + 1, xsB); zB = MB_Z(c + 1);
        if (wid >= 4) S2(c);
        __syncthreads();
        if (wid < 4) S2(c + 1);
        S3(c, xsA, zA);
        if (c + 2 < 64) { S1(c + 2, xsA); zA = MB_Z(c + 2); }
        if (wid >= 4) S2(c + 1);
        __syncthreads();
    }
    S3(63, xsB, zB);
#undef MB_LOAD
#undef MB_Z
    __syncthreads();
}
constexpr int RT_W = 0, RT_CNT = 131072, RT_BASE = 131072 + 128;
constexpr int MO_TS = 131072 + 256, MO_CNT = 131072 + 512;

DI void router_phase(LAS unsigned char* lds, int vcu, int G, const float* x1, const float* norm_ffn, const float* w_router, const float* b_router,
                     unsigned char* h2, int* sel_e, int* sel_r, float* sel_w, int* tokl, unsigned* gcnt) {
    const int tid = threadIdx.x, lane = tid & 63, wid = __builtin_amdgcn_readfirstlane(tid >> 6), l31 = lane & 31, hi = lane >> 5;
    LAS float* Wl = (LAS float*)(lds + RT_W); LAS unsigned* lcnt = (LAS unsigned*)(lds + RT_CNT); LAS unsigned* lbase = (LAS unsigned*)(lds + RT_BASE);
    for (int idx = tid; idx < 1024 * 8; idx += 512) { const f32x4 w = *(const f32x4*)(w_router + 4 * idx); const float gk = norm_ffn[idx >> 3]; LAS float* p = Wl + 4 * idx; p[0] = w[0] * gk; p[1] = w[1] * gk; p[2] = w[2] * gk; p[3] = w[3] * gk; }
    if (tid < 32) lcnt[tid] = 0u;
    __syncthreads();
    if (wid >= 4) {
        for (int m = (vcu * 4 + (wid - 4)) * 4; m < T; m += G * 16) rms_rows_to_fp8<4>(x1 + (size_t)m * 1024, h2 + (size_t)m * 1024, norm_ffn, lane);
    } else
    for (int tile = vcu + G * wid; tile < T / 32; tile += G * 4) {
        const int t0 = tile * 32;
        f32x16 acc;
#pragma unroll
        for (int r = 0; r < 16; ++r) acc[r] = 0.f;
        float ssq = 0.f;
        const float* xr = x1 + (size_t)(t0 + l31) * 1024 + 4 * hi;
#pragma unroll 4
        for (int c = 0; c < 128; ++c) {
            const f32x4 xv = *(const f32x4*)(xr + 8 * c);
            ssq += (xv[0] * xv[0] + xv[1] * xv[1]) + (xv[2] * xv[2] + xv[3] * xv[3]);
#pragma unroll
            for (int u = 0; u < 4; ++u) { const float a = Wl[(8 * c + 4 * hi + u) * 32 + l31]; acc = __builtin_amdgcn_mfma_f32_32x32x2f32(a, xv[u], acc, 0, 0, 0); }
        }
        ssq += __shfl_xor(ssq, 32);
        const float rstd = __builtin_amdgcn_rsqf(ssq * (1.f / 1024.f) + EPS);
        float lg[16];
#pragma unroll
        for (int r = 0; r < 16; ++r) lg[r] = acc[r] * rstd + b_router[crow(r, hi)];
        float sv[4]; int si[4];
#pragma unroll
        for (int k = 0; k < 4; ++k) {
            float bv = lg[0]; int bi = crow(0, hi);
#pragma unroll
            for (int r = 1; r < 16; ++r) { const int id = crow(r, hi); if (lg[r] > bv) { bv = lg[r]; bi = id; } }
            const float pv = __shfl_xor(bv, 32); const int pi = __shfl_xor(bi, 32);
            if (pv > bv || (pv == bv && pi < bi)) { bv = pv; bi = pi; }
            sv[k] = bv; si[k] = bi;
#pragma unroll
            for (int r = 0; r < 16; ++r) if (crow(r, hi) == bi) lg[r] = -INFINITY;
        }
        const float e1 = __expf(sv[1] - sv[0]), e2 = __expf(sv[2] - sv[0]), e3 = __expf(sv[3] - sv[0]), inv = 1.0f / (1.0f + e1 + e2 + e3);
        if (hi == 0) {
            const int t = t0 + l31; const float wv[4] = {inv, e1 * inv, e2 * inv, e3 * inv};
#pragma unroll
            for (int k = 0; k < 4; ++k) { const unsigned lr = atomicAdd((unsigned*)&lcnt[si[k]], 1u); sel_e[t * 4 + k] = si[k]; sel_r[t * 4 + k] = (int)lr; sel_w[t * 4 + k] = wv[k]; }
        }
    }
    __syncthreads();
    if (tid < 32) lbase[tid] = atomicAdd(&gcnt[tid], lcnt[tid]);
    __syncthreads();
    if (wid < 4) for (int tile = vcu + G * wid; tile < T / 32; tile += G * 4) {
        if (hi == 0) { const int t = tile * 32 + l31;
#pragma unroll
            for (int k = 0; k < 4; ++k) { const int e = sel_e[t * 4 + k]; const int r = sel_r[t * 4 + k] + (int)lbase[e]; sel_r[t * 4 + k] = r; tokl[(size_t)e * T + r] = t; } }
    }
}

DI int moe_tables(LAS unsigned char* lds, const unsigned* gcnt) {
    LAS int* ts = (LAS int*)(lds + MO_TS); LAS int* cn = (LAS int*)(lds + MO_CNT);
    __syncthreads();
    if (threadIdx.x < 32) cn[threadIdx.x] = (int)gcnt[threadIdx.x];
    __syncthreads();
    if (threadIdx.x == 0) { int s = 0; for (int e = 0; e < NEXP; ++e) { ts[e] = s; s += (cn[e] + 255) >> 8; } ts[NEXP] = s; }
    __syncthreads();
    return ts[NEXP];
}

DI void combine_phase(LAS unsigned char* lds, int vcu, int G, int tlo, int thi, const bf16_t* y, const int* sel_e, const int* sel_r, const float* sel_w, float* out, float wscale) {
    const int lane = threadIdx.x & 63, wid = threadIdx.x >> 6; const LAS int* ts = (const LAS int*)(lds + MO_TS);
    for (int tb = (vcu * 8 + wid) * 4; tb < T; tb += G * 32) {
        int rowi[4][4]; float wv[4][4];
#pragma unroll
        for (int q = 0; q < 4; ++q) { const int4 e4 = *(const int4*)(sel_e + (tb + q) * 4), r4 = *(const int4*)(sel_r + (tb + q) * 4); const f32x4 w4 = *(const f32x4*)(sel_w + (tb + q) * 4);
            const int ee[4] = {e4.x, e4.y, e4.z, e4.w}, rr[4] = {r4.x, r4.y, r4.z, r4.w};
#pragma unroll
            for (int k = 0; k < 4; ++k) { const int row = ts[ee[k]] * 256 + rr[k], tile = row >> 8; const bool in = tile >= tlo && tile < thi; rowi[q][k] = in ? row - tlo * 256 : -1; wv[q][k] = w4[k] * wscale; } }
#pragma unroll
        for (int q = 0; q < 4; ++q) {
            float* op = out + (size_t)(tb + q) * 1024 + 8 * lane;
            f32x4 a0 = __builtin_nontemporal_load((const f32x4*)op), a1 = __builtin_nontemporal_load((const f32x4*)(op + 4)), a2 = __builtin_nontemporal_load((const f32x4*)(op + 512)), a3 = __builtin_nontemporal_load((const f32x4*)(op + 516));
            u32x4 v0[4], v1[4];
#pragma unroll
            for (int k = 0; k < 4; ++k) { v0[k] = (u32x4){0u, 0u, 0u, 0u}; v1[k] = v0[k]; if (rowi[q][k] >= 0) { const bf16_t* yp = y + (size_t)rowi[q][k] * 1024 + 8 * lane; v0[k] = __builtin_nontemporal_load((const u32x4*)yp); v1[k] = __builtin_nontemporal_load((const u32x4*)(yp + 512)); } }
#pragma unroll
            for (int k = 0; k < 4; ++k) { const float w = wv[q][k];
                a0[0] += w * bf_lo(v0[k].x); a0[1] += w * bf_hi(v0[k].x); a0[2] += w * bf_lo(v0[k].y); a0[3] += w * bf_hi(v0[k].y);
                a1[0] += w * bf_lo(v0[k].z); a1[1] += w * bf_hi(v0[k].z); a1[2] += w * bf_lo(v0[k].w); a1[3] += w * bf_hi(v0[k].w);
                a2[0] += w * bf_lo(v1[k].x); a2[1] += w * bf_hi(v1[k].x); a2[2] += w * bf_lo(v1[k].y); a2[3] += w * bf_hi(v1[k].y);
                a3[0] += w * bf_lo(v1[k].z); a3[1] += w * bf_hi(v1[k].z); a3[2] += w * bf_lo(v1[k].w); a3[3] += w * bf_hi(v1[k].w); }
            __builtin_nontemporal_store(a0, (f32x4*)op); __builtin_nontemporal_store(a1, (f32x4*)(op + 4)); __builtin_nontemporal_store(a2, (f32x4*)(op + 512)); __builtin_nontemporal_store(a3, (f32x4*)(op + 516));
        }
    }
}
#define XB_TMO      128
#define XB_XCNT(j)  (256  + 64 * (j))
#define XB_XSUB(j)  (1280 + 64 * (j))
#define XB_XGEN(j)  (2304 + 64 * (j))
#define XB_TOP      3328
#define XB_TOPGEN   3392
#define XCD_BAR_WORDS 3456
#define XB_SPIN_CAP (1u << 18)

__device__ __forceinline__ unsigned xb_ld(unsigned* p)              { return __hip_atomic_load(p, __ATOMIC_RELAXED, __HIP_MEMORY_SCOPE_AGENT); }
__device__ __forceinline__ unsigned xb_add(unsigned* p, unsigned v) { return __hip_atomic_fetch_add(p, v, __ATOMIC_RELAXED, __HIP_MEMORY_SCOPE_AGENT); }
__device__ __forceinline__ unsigned xb_xcc_id() { return (unsigned)__builtin_amdgcn_s_getreg((3 << 11) | 20) & 0xFu; }
#define XB_SPIN(cond, bar) do { unsigned _sp = 0; while (cond) { __builtin_amdgcn_s_sleep(1); \
    if ((++_sp & 255u) == 0u) { if (xb_ld(&(bar)[XB_TMO])) break; if (_sp > XB_SPIN_CAP) { atomicAdd(&(bar)[XB_TMO], 1u); break; } } } } while (0)

struct XcdBarrier {
    unsigned* bar; unsigned x;
    volatile LAS unsigned* st;
};

__device__ __forceinline__ XcdBarrier xcd_barrier_post(unsigned* bar, volatile LAS unsigned* st) {
    XcdBarrier b; b.bar = bar; b.x = xb_xcc_id(); b.st = st;
    if (threadIdx.x == 0) (void)xb_add(&bar[XB_XCNT(b.x)], 1u);
    return b;
}
__device__ __forceinline__ void xcd_barrier_complete(unsigned* bar, unsigned x, unsigned& nloc, unsigned& nx) {
    const unsigned G = gridDim.x * gridDim.y * gridDim.z;
    unsigned sum, cnt, mine, sp = 0u;
    for (;;) {
        sum = 0u; cnt = 0u; mine = 0u;
#pragma unroll
        for (unsigned j = 0; j < 16; ++j) { const unsigned c = xb_ld(&bar[XB_XCNT(j)]); sum += c; cnt += (c > 0u) ? 1u : 0u; mine = (j == x) ? c : mine; }
        if (sum == G) break;
        __builtin_amdgcn_s_sleep(1);
        if ((++sp & 255u) == 0u) { if (xb_ld(&bar[XB_TMO])) break; if (sp > XB_SPIN_CAP) { atomicAdd(&bar[XB_TMO], 1u); break; } }
    }
    nloc = mine > 0u ? mine : 1u; nx = cnt > 0u ? cnt : 1u;
}

__device__ __forceinline__ void xcd_barrier(const XcdBarrier& b) {
    asm volatile("s_waitcnt vmcnt(0)" ::: "memory");
    __syncthreads();
    if (threadIdx.x == 0) {
        unsigned* bar = b.bar;
        __builtin_amdgcn_s_waitcnt(0);
        unsigned nloc = b.st[0], nx = b.st[1];
        if (nloc == 0u) { xcd_barrier_complete(bar, b.x, nloc, nx); b.st[0] = nloc; b.st[1] = nx; }
        const unsigned old = xb_add(&bar[XB_XSUB(b.x)], 1u);
        const unsigned gen = old / nloc;
        if (old + 1u == (gen + 1u) * nloc) {
            __builtin_amdgcn_fence(__ATOMIC_RELEASE, "agent");
            asm volatile("s_waitcnt vmcnt(0)" ::: "memory");
            const unsigned og = xb_add(&bar[XB_TOP], 1u);
            const unsigned tg = og / nx;
            if (og + 1u == (tg + 1u) * nx) xb_add(&bar[XB_TOPGEN], 1u);
            else XB_SPIN(xb_ld(&bar[XB_TOPGEN]) == tg, bar);
            __builtin_amdgcn_fence(__ATOMIC_ACQUIRE, "agent");
            xb_add(&bar[XB_XGEN(b.x)], 1u);
            asm volatile("s_waitcnt vmcnt(0)" ::: "memory");
        } else {
            XB_SPIN(xb_ld(&bar[XB_XGEN(b.x)]) == gen, bar);
            __builtin_amdgcn_fence(__ATOMIC_ACQUIRE, "agent");
            asm volatile("s_waitcnt vmcnt(0)" ::: "memory");
        }
    }
    __syncthreads();
}


#ifndef MK_N_LAUNCHES
#define MK_N_LAUNCHES 1
#endif
#ifndef MK_BRANCHES
#define MK_BRANCHES 15
#endif
constexpr int N_PHASES = 12;
#ifndef MK_USE_CG
#define MK_USE_CG 0
#endif
constexpr int LDS_BARST = 163840 - 64;
constexpr int CW_BAR = 4096;
constexpr int LDS_BYTES = 163840;
constexpr int NTHREADS = 512;

struct Args { const float* in[30]; float* out; unsigned char* ws; int ph_lo, ph_hi; };
enum { I_x = 0, I_mem = 1, I_norm_mix = 2, I_w_in = 3, I_a_q_gain = 4, I_a_k_gain = 5, I_a_rel_bias = 6, I_conv_w = 7, I_conv_b = 8, I_dt_bias = 9, I_a_log = 10, I_d_skip = 11, I_ssm_norm = 12, I_norm_mem = 13, I_w_mem_kv = 14, I_x_q_gain = 15, I_x_k_gain = 16, I_w_br_a = 17, I_w_br_b = 18, I_w_br_c = 19, I_w_out = 20, I_norm_ffn = 21, I_w_router = 22, I_b_router = 23, I_w_gate = 24, I_b_gate = 25, I_w_up = 26, I_b_up = 27, I_w_down = 28, I_b_down = 29 };

#define WIN WSP(bf16_t, WS_WIN)
#define WCAT WSP(bf16_t, WS_WCAT)
#define WOUT WSP(bf16_t, WS_WOUT)
#define WMEM WSP(bf16_t, WS_WMEM)
#define DTB WSP(float, WS_DT)
#define SSQ WSP(float, WS_SSQ)
#define RSTD WSP(float, WS_RSTD)
#define KX WSP(bf16_t, WS_KX)
#define MEMKV WSP(bf16_t, WS_MEMKV)
#define XN WSP(bf16_t, WS_XN)
#define MEMN WSP(bf16_t, WS_MEMN)
#define ACT WSP(bf16_t, WS_ACT)
#define KA WSP(bf16_t, WS_KA)
#define VA WSP(bf16_t, WS_VA)
#define XBC WSP(bf16_t, WS_XBC)
#define GATES WSP(bf16_t, WS_GATES)
#define MERGED WSP(bf16_t, WS_MERGED)
#define H2 WSP(unsigned char, MOE_H2)
#define WGU WSP(unsigned char, MOE_WGU)
#define WD WSP(unsigned char, MOE_WD)
#define ACTM WSP(unsigned char, MOE_ACTM)
#define YB WSP(bf16_t, MOE_Y)
#define SELE WSP(int, MOE_SELE)
#define SELR WSP(int, MOE_SELR)
#define SELW WSP(float, MOE_SELW)
#define TOKL WSP(int, MOE_TOKL)
#define GCNT (WSP(unsigned, WS_CTL) + CW_CNT)
#define ACSB ((float*)(GAS float*)kq[30] + (size_t)T * 512)
#define BCC ((bf16_t*)(GAS bf16_t*)kq[30])
#define EI_INIT const EpiIn EI{ws, AP(a_q_gain), AP(a_k_gain), AP(dt_bias)}
typedef const __attribute__((address_space(4))) unsigned long long* KW;
DI KW launder(KW p) { asm volatile("" : "+s"(p)); return p; }
#define AP(name) ((const float*)(const GAS float*)kq[I_##name])
#define PHASE_ARGS const KW kq = launder(kp); unsigned char* const ws = (unsigned char*)(GAS unsigned char*)kq[31]; (void)ws
#define WSP(type, off) ((type*)(ws + (off)))
__global__ void __launch_bounds__(NTHREADS, 2) mega_fwd(Args a_unused) {
    extern __shared__ __attribute__((aligned(16))) unsigned char lds_raw[];
    LAS unsigned char* lds = (LAS unsigned char*)lds_raw;
    const KW kp = (KW)__builtin_amdgcn_kernarg_segment_ptr();
    const int tid = threadIdx.x, lane = tid & 63, wid = __builtin_amdgcn_readfirstlane(tid >> 6);
    const int G = gridDim.x, bx = blockIdx.x, vcu = (G % 8 == 0) ? (bx % 8) * (G / 8) + bx / 8 : bx;
    const int lo = (int)(unsigned)kp[32], hi = (int)(kp[32] >> 32);
#ifndef MK_PHASE_MASK
#define MK_PHASE_MASK 0x7fff
#endif
#define IN(k) (((MK_PHASE_MASK >> (k)) & 1) && lo <= (k) && (k) < hi)
#ifndef MK_REP_MASK
#define MK_REP_MASK 0
#endif
#define REPS(k) (((MK_REP_MASK >> (k)) & 1) + 1)
#if MK_USE_CG
#define SEAM(k) do { if (IN(k) && IN((k) + 1)) { cg::this_grid().sync(); } } while (0)
#else
#define SEAM(k) do { if (IN(k) && IN((k) + 1)) { xcd_barrier(bar); } } while (0)
#endif
    const int gw = vcu * 8 + wid, NGW = G * 8;
    for (int u = tid; u < 16; u += NTHREADS) ((LAS unsigned*)(lds + LDS_BARST))[u] = 0u;
    __syncthreads();
    XcdBarrier bar = xcd_barrier_post((unsigned*)(GAS unsigned*)(kp[31]) + CW_BAR, (volatile LAS unsigned*)(lds + LDS_BARST));
    LAS float* scr = (LAS float*)(lds + wid * 16896);

    if (IN(0)) { PHASE_ARGS;
        constexpr int I_IN = 16 * 196, I_MEM = 16 * 32, I_A = 16 * 16, I_B = 32 * 16, I_C = 16 * 16, I_O = 16 * 16, NIT = I_IN + I_MEM + I_A + I_B + I_C + I_O;
        auto mk = [&](int it0) -> TrItem { int r = it0 % NIT; TrItem t; t.kscale = nullptr; t.mul = 1.0f; t.fp8 = 0;
            if (r < I_IN) { const int kb = r / 196, nb = r % 196; t.W = AP(w_in); t.Ns = IN_COLS; t.k0 = 64 * kb; t.sc0 = win_src_col(2 * nb); t.sc1 = win_src_col(2 * nb + 1); t.dst = WIN + (size_t)(64 * nb) * 1024 + 64 * kb; t.dpitch = 1024; return t; } r -= I_IN;
            if (r < I_MEM) { const int kb = r / 32, nb = r % 32; t.W = AP(w_mem_kv); t.Ns = 2048; t.k0 = 64 * kb; t.sc0 = 64 * nb; t.sc1 = 64 * nb + 32; t.dst = WMEM + (size_t)(64 * nb) * 1024 + 64 * kb; t.dpitch = 1024; return t; } r -= I_MEM;
            if (r < I_A) { const int kb = r / 16, nb = r % 16; t.W = AP(w_br_a); t.Ns = 1024; t.k0 = 64 * kb; t.sc0 = 64 * nb; t.sc1 = 64 * nb + 32; t.dst = WCAT + (size_t)(64 * nb) * 4096 + 64 * kb; t.dpitch = 4096; return t; } r -= I_A;
            if (r < I_B) { const int kb = r / 16, nb = r % 16; t.W = AP(w_br_b); t.Ns = 1024; t.k0 = 64 * kb; t.sc0 = 64 * nb; t.sc1 = 64 * nb + 32; t.dst = WCAT + (size_t)(64 * nb) * 4096 + 1024 + 64 * kb; t.dpitch = 4096; t.kscale = AP(ssm_norm); return t; } r -= I_B;
            if (r < I_C) { const int kb = r / 16, nb = r % 16; t.W = AP(w_br_c); t.Ns = 1024; t.k0 = 64 * kb; t.sc0 = 64 * nb; t.sc1 = 64 * nb + 32; t.dst = WCAT + (size_t)(64 * nb) * 4096 + 3072 + 64 * kb; t.dpitch = 4096; return t; } r -= I_C;
            { const int kb = r / 16, nb = r % 16; t.W = AP(w_out); t.Ns = 1024; t.k0 = 64 * kb; t.sc0 = 64 * nb; t.sc1 = 64 * nb + 32; t.dst = WOUT + (size_t)(64 * nb) * 1024 + 64 * kb; t.dpitch = 1024; return t; } };
        { const int nitems = NIT * REPS(0); f32x4 va[16], vb[16]; TrItem ia, ib; int it = gw;
          if (it < nitems) { ia = mk(it); tr_load(ia, va, lane); }
          while (it < nitems) {
              const int i2 = it + NGW; if (i2 < nitems) { ib = mk(i2); tr_load(ib, vb, lane); }
              tr_store(ia, va, scr, lane);
              if (i2 >= nitems) break;
              const int i3 = i2 + NGW; if (i3 < nitems) { ia = mk(i3); tr_load(ia, va, lane); }
              tr_store(ib, vb, scr, lane);
              it = i3; } }
        for (int m0 = gw * 4; m0 < T * REPS(0); m0 += NGW * 4) { const int m = m0 % T; rms_rows_to_bf16<4>(AP(x) + (size_t)m * 1024, XN + (size_t)m * 1024, 1, AP(norm_mix), lane); }
        for (int m = gw; m < NBATCH * MEMLEN; m += NGW) rms_rows_to_bf16<1>(AP(mem) + (size_t)m * 1024, MEMN + (size_t)m * 1024, 1, AP(norm_mem), lane);
    }
    SEAM(0);
    if (IN(1)) { PHASE_ARGS; EI_INIT;
        const SchedIn S{G, bx, 16, TL_Q, 12, TL_QX, 0, (const char*)WIN, (const char*)WMEM, REPS(1)};
        pg8::gemm_phase<false>(lds, (const char*)XN, 2048, 2048, S, EI);
    }
    SEAM(1);
    if (IN(2)) { PHASE_ARGS;
        if (MK_BRANCHES & 1) {
            LAS float* bl = (LAS float*)(lds + AT_BIAS);
            for (int i = tid; i < 16 * 257; i += NTHREADS) bl[(i / 257) * AT_BIAS_STRIDE + (i % 257)] = AP(a_rel_bias)[i] * LOG2E;
            __syncthreads();
            for (int u = vcu; u < 4 * NBATCH * 64; u += G) { const int c = u & 63, b = (u >> 6) & 7, hq = u >> 9; attnA_unit(lds, b, c, hq, ACT, KA, VA, (MK_REP_MASK >> 2 & 1) ? (bf16_t*)(ws + WS_BUF + 128 * MiB) : ACT, (MK_REP_MASK >> 2 & 1) ? 1024 : ACT_P);
                if (MK_REP_MASK >> 2 & 1) attnA_unit(lds, b, c, hq, ACT, KA, VA, ACT, ACT_P); }
        } else {
            for (int idx = vcu * NTHREADS + tid; idx < T * 128; idx += G * NTHREADS) { const int t = idx >> 7, ch = idx & 127; *(u32x4*)(ACT + (size_t)t * ACT_P + ch * 8) = (u32x4){0u, 0u, 0u, 0u}; }
        }
    }
    SEAM(2);
    if (IN(3)) { PHASE_ARGS; EI_INIT;
        const SchedIn S{G, bx, 21, TL_Z, 21, 0, 64, (const char*)WIN, (const char*)WMEM, REPS(3)};
        pg8::gemm_phase<false>(lds, (const char*)XN, 2048, 2048, S, EI);
    }
    SEAM(3);
    if (IN(4)) { PHASE_ARGS;
        if (MK_BRANCHES & 2) bcconv_phase(vcu, G, XBC, BCC, AP(conv_w), AP(conv_b), DTB, ACSB, AP(a_log));
        for (int w = gw; w < NBATCH * MEMLEN * 4; w += NGW) {
            const int row = w >> 2, hx = w & 3; const u32x2 kv = *(const u32x2*)(MEMKV + (size_t)row * 2048 + 256 * hx + 4 * lane);
            const float k0 = bf_lo(kv.x), k1 = bf_hi(kv.x), k2 = bf_lo(kv.y), k3 = bf_hi(kv.y);
            const float rs = __builtin_amdgcn_rsqf(wave_sum(k0 * k0 + k1 * k1 + k2 * k2 + k3 * k3) * (1.f / 256.f) + EPS) * (0.0625f * LOG2E);
            const f32x4 gk = *(const f32x4*)(AP(x_k_gain) + 4 * lane), gq = *(const f32x4*)(AP(x_q_gain) + 4 * lane);
            u32x2 o; o.x = pk2(k0 * rs * gk.x * gq.x, k1 * rs * gk.y * gq.y); o.y = pk2(k2 * rs * gk.z * gq.z, k3 * rs * gk.w * gq.w);
            *(u32x2*)(KX + (size_t)row * 1024 + 256 * hx + 4 * lane) = o;
        }
        xcd_barrier(bar);
        if (MK_BRANCHES & 4) attnC_phase(lds, vcu, G, ACT, KX, MEMKV, ACT + 3072, ACT_P);
        if (MK_BRANCHES & 2) { int nrep = 1 + (MK_REP_MASK >> 4 & 1); asm volatile("" : "+s"(nrep));
#pragma unroll 1
            for (int rep = 0; rep < nrep; ++rep) { const bool real = rep == nrep - 1;
                for (int u = vcu; u < NBATCH * 32; u += G) mamba_unit(lds, u >> 5, u & 31, XBC, BCC, DTB, ACSB, ACT, SSQ, real ? ACT + 1024 : (bf16_t*)RSTD, real ? (size_t)ACT_P : (size_t)0, AP(conv_w), AP(conv_b), AP(a_log), AP(d_skip)); } }
    }
    SEAM(4);
    if (IN(5)) { PHASE_ARGS; EI_INIT;
        for (int idx = vcu * NTHREADS + tid; idx < T * 4; idx += G * NTHREADS) { const int t = idx >> 2, g = idx & 3; const f32x4 s0 = *(const f32x4*)(SSQ + (size_t)t * 32 + 8 * g), s1 = *(const f32x4*)(SSQ + (size_t)t * 32 + 8 * g + 4);
            RSTD[idx] = __builtin_amdgcn_rsqf(((s0[0] + s0[1]) + (s0[2] + s0[3]) + (s1[0] + s1[1]) + (s1[2] + s1[3])) * (1.f / 512.f) + EPS); }
        const SchedIn S{G, bx, 12, TL_G, 12, 0, 0, (const char*)WIN, (const char*)WMEM, REPS(5)};
        pg8::gemm_phase<false>(lds, (const char*)XN, 2048, 2048, S, EI);
    }
    SEAM(5);
    if (IN(6)) { PHASE_ARGS;
        constexpr int LASTSEG = (MK_BRANCHES & 4) ? 2 : ((MK_BRANCHES & 2) ? 1 : 0);
        constexpr int KM = LASTSEG == 2 ? 4096 : (LASTSEG == 1 ? 3072 : 1024);
        const SchedDense S{G, bx, T / 256, 4, 4096, (const char*)WCAT, REPS(6)};
        const EpiMerge E{GATES, RSTD, MERGED, LASTSEG};
        pg8::gemm_phase<false>(lds, (const char*)ACT, KM * 2, 8192, S, E);
    }
    SEAM(6);
    if (IN(7)) { PHASE_ARGS;
        const SchedDense S{G, bx, T / 256, 4, 1024, (const char*)WOUT, REPS(7)};
        const EpiOut E{AP(x), ((float*)(GAS float*)kq[30])};
        pg8::gemm_phase<false>(lds, (const char*)MERGED, 2048, 2048, S, E);
    }
    SEAM(7);
    if (IN(8) && (MK_BRANCHES & 8)) { PHASE_ARGS;
        { int nrep = 1 + (MK_REP_MASK >> 11 & 1); asm volatile("" : "+s"(nrep));
#pragma unroll 1
          for (int rep = 0; rep < nrep; ++rep) { const bool real = rep == nrep - 1; const size_t dm = real ? 0 : (MOE_ACTM - MOE_SELE);
            router_phase(lds, vcu, G, ((float*)(GAS float*)kq[30]), AP(norm_ffn), AP(w_router), AP(b_router), H2, (int*)((char*)SELE + dm), (int*)((char*)SELR + dm), (float*)((char*)SELW + dm), (int*)((char*)TOKL + dm), GCNT + (real ? 0 : 64));
            __syncthreads(); } }
        auto mk = [&](int it0) -> TrItem { const int it = it0 % (NEXP * 768); const int e = it / 768, r = it % 768, which = r >> 8, kb = (r & 255) >> 4, nb = r & 15; TrItem t;
            t.W = (which == 0 ? AP(w_gate) : which == 1 ? AP(w_up) : AP(w_down)) + (size_t)e * 1024 * 1024; t.Ns = 1024; t.k0 = 64 * kb; t.sc0 = 64 * nb; t.sc1 = 64 * nb + 32; t.dpitch = 1024; t.kscale = nullptr; t.mul = 32.0f; t.fp8 = 1;
            t.dst = which == 2 ? (void*)(WD + ((size_t)e * 1024 + 64 * nb) * 1024 + 64 * kb) : (void*)(WGU + ((size_t)e * 2048 + 256 * (nb >> 1) + 128 * which + 64 * (nb & 1)) * 1024 + 64 * kb); return t; };
        { const int nitems = NEXP * 768 * REPS(8); f32x4 va[16], vb[16]; TrItem ia, ib; int it = gw;
          if (it < nitems) { ia = mk(it); tr_load(ia, va, lane); }
          while (it < nitems) {
              const int i2 = it + NGW; if (i2 < nitems) { ib = mk(i2); tr_load(ib, vb, lane); }
              tr_store(ia, va, scr, lane);
              if (i2 >= nitems) break;
              const int i3 = i2 + NGW; if (i3 < nitems) { ia = mk(i3); tr_load(ia, va, lane); }
              tr_store(ib, vb, scr, lane);
              it = i3; } }
    }
    SEAM(8);
    {
        if ((MK_BRANCHES & 8) && (IN(9) || IN(10) || IN(11))) { PHASE_ARGS;
            const int total = moe_tables(lds, GCNT), tlo = 0, thi = total;
            const LAS int* ts = (const LAS int*)(lds + MO_TS); const LAS int* cn = (const LAS int*)(lds + MO_CNT);
            if (IN(9)) { const SchedMoE S{G, bx, 8, tlo, thi, ts, cn, TOKL, (const char*)WGU, (size_t)2048 * 1024, REPS(9), 1024u, 1024u}; const EpiGU E{ACTM, AP(b_gate), AP(b_up), tlo};
                pg8::gemm_phase<true>(lds, (const char*)H2, 1024, 1024, S, E); }
            SEAM(9);
            if (IN(10)) { const SchedMoE S{G, bx, 4, tlo, thi, ts, cn, nullptr, (const char*)WD, (size_t)1024 * 1024, REPS(10), 1024u, 1024u}; const EpiDown E{YB, AP(b_down), tlo};
                pg8::gemm_phase<true>(lds, (const char*)ACTM, 1024, 1024, S, E); }
            SEAM(10);
            if (IN(11)) { int nrep = 1 + (MK_REP_MASK >> 12 & 1); asm volatile("" : "+s"(nrep));
#pragma unroll 1
                for (int rep = 0; rep < nrep; ++rep) combine_phase(lds, vcu, G, tlo, thi, YB, SELE, SELR, SELW, ((float*)(GAS float*)kq[30]), 1.0f / (float)nrep); }
        } else { SEAM(9); SEAM(10); }
    }
#undef IN
#undef SEAM
}

extern "C" void kernel_launch(void* const* d_in, const int* in_sizes, int n_in, void* d_out, int out_size, void* d_ws, size_t ws_size, hipStream_t stream) {
    static int grid = 0;
    if (grid == 0) {
        if (n_in != 30 || ws_size < WS_MIX_END || ws_size < WS_END) { fprintf(stderr, "kernel_launch: unexpected n_in %d / ws_size %zu\n", n_in, ws_size); grid = -1; return; }
        int dev = 0, cus = 0, per_cu = 0;
        (void)hipGetDevice(&dev); (void)hipDeviceGetAttribute(&cus, hipDeviceAttributeMultiprocessorCount, dev);
        (void)hipFuncSetAttribute((const void*)mega_fwd, hipFuncAttributeMaxDynamicSharedMemorySize, LDS_BYTES);
        (void)hipOccupancyMaxActiveBlocksPerMultiprocessor(&per_cu, (const void*)mega_fwd, NTHREADS, LDS_BYTES);
        if (per_cu < 1) { fprintf(stderr, "kernel_launch: occupancy query reports %d blocks per CU\n", per_cu); grid = -1; return; }
        grid = cus;
    }
    if (grid < 0) return;
    (void)hipMemsetAsync((char*)d_ws + WS_CTL, 0, 65536, stream);
    Args a{};
    for (int i = 0; i < 30; ++i) a.in[i] = (const float*)d_in[i];
    a.out = (float*)d_out; a.ws = (unsigned char*)d_ws;
    if (MK_N_LAUNCHES == 1) {
        a.ph_lo = 0; a.ph_hi = N_PHASES;
        void* args[] = {&a};
        hipError_t e = hipLaunchCooperativeKernel((void*)mega_fwd, dim3(grid), dim3(NTHREADS), args, LDS_BYTES, stream);
        if (e != hipSuccess) fprintf(stderr, "cooperative launch failed: %s (grid %d)\n", hipGetErrorString(e), grid);
    } else {
        for (int ph = 0; ph < N_PHASES; ++ph) { a.ph_lo = ph; a.ph_hi = ph + 1; hipLaunchKernelGGL(mega_fwd, dim3(grid), dim3(NTHREADS), LDS_BYTES, stream, a); }
    }
}
```

```cpp
#include <hip/hip_runtime.h>
#include <hip/hip_cooperative_groups.h>
#include <cstdio>
#include <cstdint>
namespace cg = cooperative_groups;

#define LAS __attribute__((address_space(3)))
#define GAS __attribute__((address_space(1)))
#define DI __device__ __forceinline__
typedef unsigned short bf16_t;
typedef short bf16x8 __attribute__((ext_vector_type(8)));
typedef short s16x4 __attribute__((ext_vector_type(4)));
typedef float f32x2 __attribute__((ext_vector_type(2)));
typedef float f32x4 __attribute__((ext_vector_type(4)));
typedef float f32x16 __attribute__((ext_vector_type(16)));
typedef unsigned u32x2 __attribute__((ext_vector_type(2)));
typedef unsigned u32x4 __attribute__((ext_vector_type(4)));
typedef __bf16 bf16x2_t __attribute__((ext_vector_type(2)));
typedef short v4i16_t __attribute__((ext_vector_type(4)));

DI unsigned pk2(float lo, float hi) { f32x2 v = {lo, hi}; bf16x2_t b = __builtin_convertvector(v, bf16x2_t); return __builtin_bit_cast(unsigned, b); }
DI float bf_lo(unsigned w) { return __uint_as_float(w << 16); }
DI float bf_hi(unsigned w) { return __uint_as_float(w & 0xffff0000u); }
DI float bf2f(bf16_t b) { return __uint_as_float(((unsigned)b) << 16); }
DI float wave_sum(float v) {
#pragma unroll
    for (int o = 1; o < 64; o <<= 1) v += __shfl_xor(v, o);
    return v;
}
DI float fast_exp2(float x) { return __builtin_amdgcn_exp2f(x); }
DI float fast_rcp(float x) { return __builtin_amdgcn_rcpf(x); }
DI float sigmoidf_(float x) { return fast_rcp(1.0f + fast_exp2(-1.4426950408889634f * x)); }

constexpr int NBATCH = 8, SEQ = 4096, T = NBATCH * SEQ, DM = 1024;
constexpr int NWIN_TILES = 49, NWIN = NWIN_TILES * 256;
constexpr int IN_COLS = 12320;
constexpr float EPS = 1e-6f;
constexpr float LOG2E = 1.4426950408889634f;
constexpr int NEXP = 32, TOPK = 4;
constexpr int MEMLEN = 256;
constexpr int ACT_P = 4096;
constexpr int TL_Q = 0, TL_K = 4, TL_V = 8, TL_Z = 12, TL_XBC = 20, TL_DT = 32, TL_QX = 33, TL_G = 37;

constexpr size_t MiB = (size_t)1 << 20;
constexpr size_t WS_CTL = 0, CTL_BYTES = 1 * MiB;
constexpr size_t WS_WIN = 1 * MiB, WS_WCAT = 26 * MiB, WS_WOUT = 34 * MiB, WS_WMEM = 36 * MiB;
constexpr size_t WS_DT = 40 * MiB, WS_SSQ = 44 * MiB, WS_RSTD = 48 * MiB, WS_KX = 49 * MiB, WS_MEMKV = 53 * MiB;
constexpr size_t WS_XN = 61 * MiB, WS_MEMN = 125 * MiB, WS_ACT = 129 * MiB, WS_BUF = 385 * MiB, WS_MIX_END = 577 * MiB;
constexpr size_t WS_KA = WS_BUF, WS_VA = WS_BUF + 64 * MiB, WS_XBC = WS_BUF, WS_GATES = WS_BUF, WS_MERGED = WS_XN;
constexpr int MOE_TILE_CAP = 280;
constexpr size_t MOE_H2 = 1 * MiB, MOE_ACTM = 33 * MiB, MOE_Y = 169 * MiB, WS_X1 = 441 * MiB;
constexpr size_t OUT_WGU = 0, OUT_WD = 64 * MiB;
constexpr size_t MOE_SELE = 569 * MiB, MOE_SELR = 569 * MiB + 512 * 1024, MOE_SELW = 570 * MiB, MOE_TOKL = 571 * MiB, WS_END = 575 * MiB;
constexpr int CW_CNT = 64;

#ifndef MK_KREP
#define MK_KREP 1
#endif
#ifndef MK_PROBE
#define MK_PROBE 0
#endif
DI unsigned long long rtc() { return __builtin_amdgcn_s_memrealtime(); }
#ifndef MK_NT_STORES
#define MK_NT_STORES 0
#endif
namespace pg8 {
constexpr int BM = 256, BK = 64, HALF = 128, HTB = HALF * BK * 2, STAGE_BYTES = 8 * HTB;
__host__ __device__ __forceinline__ int lds_byte(int r, int c) { const int st = (r >> 4) * 2 + (c >> 5), rr = r & 15, cc = c & 31, ob = rr * 64 + cc * 2; return st * 1024 + (ob ^ (((ob >> 9) & 1) << 5)); }
__host__ __device__ __forceinline__ void stage_rc(int b, int& R, int& C) { const int st = b / 1024, sb = b % 1024, swz = sb ^ (((sb >> 9) & 1) << 5); R = (st >> 1) * 16 + swz / 64; C = (st & 1) * 32 + (swz % 64) / 2; }
__host__ __device__ __forceinline__ int perm32(int rho) { const int n = rho >> 4, i = rho & 15; return 8 * (i >> 2) + 4 * n + (i & 3); }

struct Unit { int kind, pm, pn, aux; };

typedef f32x4 Acc[2][2][4][2];

typedef int v8i_t __attribute__((ext_vector_type(8)));
template <bool FP8, class Epi, class Sched>
DI void gemm_phase(LAS unsigned char* lds, const char* Abase, const int Kb, const int ldbb, const Sched& S, const Epi& E) {
    int tid_ = threadIdx.x; asm volatile("" : "+v"(tid_));
    const int tid = tid_, wid = __builtin_amdgcn_readfirstlane(tid >> 6), lane = tid & 63, wr = wid >> 2, wc = wid & 3, fr = lane & 15, fq = lane >> 4;
    const int nt = Kb / (BK * 2);
    int Rr[2], Cc2[2]; unsigned voffB[2];
#pragma unroll
    for (int i = 0; i < 2; ++i) { int R, C; stage_rc(tid * 16 + i * 8192, R, C); Rr[i] = R; Cc2[i] = C * 2; const int Rb = (R & ~31) + perm32(R & 31); voffB[i] = (unsigned)(Rb * ldbb + C * 2); }
    const unsigned kstep = (unsigned)(BK * 2);
    const size_t hstepB = (size_t)HALF * ldbb;
    const unsigned ldsw = (unsigned)wid * 1024u;
    const int aoff0 = lds_byte(wr * 64 + fr, fq * 8), aoff1 = aoff0 + 1024;
    const int boff0 = lds_byte(wc * 32 + fr, fq * 8), boff1 = boff0 + 1024;
#define PG8_SA(b, h) (((b) * 2 + (h)) * HTB)
#define PG8_SB(b, h) ((4 + (b) * 2 + (h)) * HTB)
#define PG8_GLDS(src, dstoff) __builtin_amdgcn_global_load_lds((const unsigned*)(src), (LAS unsigned*)(lds + (dstoff)), 16, 0, 0)
#define PG8_STAGE_B(bufoff, ptr) do { _Pragma("unroll") for (int _i = 0; _i < 2; ++_i) PG8_GLDS((const char*)(ptr) + voffB[_i], (bufoff) + ldsw + _i * 8192); } while (0)
#define PG8_STAGE_A(bufoff, kb, v0, v1) do { PG8_GLDS(Abase + (size_t)(v0) + (kb), (bufoff) + ldsw); PG8_GLDS(Abase + (size_t)(v1) + (kb), (bufoff) + ldsw + 8192); } while (0)
#define PG8_LDA(dst, b, h) do { _Pragma("unroll") for (int m = 0; m < 4; ++m) { dst[m][0] = *(const LAS u32x4*)(lds + PG8_SA(b, h) + aoff0 + m * 2048); dst[m][1] = *(const LAS u32x4*)(lds + PG8_SA(b, h) + aoff1 + m * 2048); } } while (0)
#define PG8_LDB(dst, b, h) do { _Pragma("unroll") for (int n = 0; n < 2; ++n) { dst[n][0] = *(const LAS u32x4*)(lds + PG8_SB(b, h) + boff0 + n * 2048); dst[n][1] = *(const LAS u32x4*)(lds + PG8_SB(b, h) + boff1 + n * 2048); } } while (0)
#define PG8_CAT(x) __builtin_bit_cast(v8i_t, __builtin_shufflevector((x)[0], (x)[1], 0, 1, 2, 3, 4, 5, 6, 7))
#define PG8_MMA(ai, bj, At, Bt) do { __builtin_amdgcn_s_setprio(1); _Pragma("unroll") for (int m = 0; m < 4; ++m) _Pragma("unroll") for (int n = 0; n < 2; ++n) { \
        if constexpr (FP8) asm volatile("v_mfma_scale_f32_16x16x128_f8f6f4 %0, %1, %2, %0, %3, %4 op_sel_hi:[0,0,0]" : "+v"(acc[ai][bj][m][n]) : "v"(PG8_CAT(Bt[n])), "v"(PG8_CAT(At[m])), "v"(sclB), "v"(sclA)); \
        else { _Pragma("unroll") for (int k = 0; k < 2; ++k) acc[ai][bj][m][n] = __builtin_amdgcn_mfma_f32_16x16x32_bf16(__builtin_bit_cast(bf16x8, Bt[n][k]), __builtin_bit_cast(bf16x8, At[m][k]), acc[ai][bj][m][n], 0, 0, 0); } } \
        __builtin_amdgcn_s_setprio(0); } while (0)
#define PG8_WAIT_V(n) asm volatile("s_waitcnt vmcnt(" #n ")" ::: "memory")
#define PG8_WAIT_L(n) asm volatile("s_waitcnt lgkmcnt(" #n ")" ::: "memory")
#define PG8_BAR __builtin_amdgcn_s_barrier()
#define PG8_SCHED __builtin_amdgcn_sched_barrier(0)
    Unit cur, nxt; int ui = 0;
    if (!S.next(0, cur)) return;
    Acc acc;
#pragma unroll
    for (int a = 0; a < 2; ++a)
#pragma unroll
        for (int b = 0; b < 2; ++b)
#pragma unroll
            for (int m = 0; m < 4; ++m)
#pragma unroll
                for (int n = 0; n < 2; ++n) acc[a][b][m][n] = (f32x4){0.f, 0.f, 0.f, 0.f};
    u32x4 At[4][2], B0[2][2], B1[2][2];
    int sclB = 0x7a7a7a7a, sclA = 0x7f7f7f7f;
    asm volatile("" : "+v"(sclB), "+v"(sclA));
    unsigned vA00 = S.arow(cur, Rr[0]) + Cc2[0], vA01 = S.arow(cur, Rr[1]) + Cc2[1], vA10 = S.arow(cur, HALF + Rr[0]) + Cc2[0], vA11 = S.arow(cur, HALF + Rr[1]) + Cc2[1];
    const char* cB = S.bptr(cur);
    PG8_STAGE_B(PG8_SB(0, 0), cB); PG8_STAGE_B(PG8_SB(0, 1), cB + hstepB); PG8_STAGE_A(PG8_SA(0, 0), 0, vA00, vA01); PG8_STAGE_A(PG8_SA(0, 1), 0, vA10, vA11);
    if (wr == 1) PG8_BAR;
    PG8_WAIT_V(2); PG8_BAR;
    PG8_STAGE_B(PG8_SB(1, 0), cB + kstep); PG8_STAGE_A(PG8_SA(1, 0), kstep, vA00, vA01); PG8_STAGE_B(PG8_SB(1, 1), cB + hstepB + kstep);
    PG8_WAIT_V(6); PG8_BAR;
    for (;;) {
        const bool has_next = S.next(ui + 1, nxt);
        const char* nB = has_next ? S.bptr(nxt) : cB;
        constexpr int KREP = (MK_KREP > 1 && !Epi::SEGMENTED) ? MK_KREP : 1;
        for (int tt = 0; tt < nt * KREP; tt += 2) {
            const int t = KREP > 1 ? tt % nt : tt;
            const bool last = (tt == nt * KREP - 2);
            if constexpr (Epi::SEGMENTED) { if (t > 0 && E.boundary(t)) E.rescale(acc, cur, t, wr, wc, fr, fq); }
            const unsigned k1 = (unsigned)(t + 1) * kstep;
            const unsigned t2 = (KREP > 1) ? (unsigned)((t + 2) % nt) : (unsigned)(t + 2);
            const unsigned k2 = last ? 0u : t2 * kstep, k3 = k2 + kstep;
            const char* b2 = last ? nB : cB + t2 * kstep; const char* b3 = b2 + kstep;
            unsigned w00 = vA00, w01 = vA01, w10 = vA10, w11 = vA11;
            if (last && has_next) { w00 = S.arow(nxt, Rr[0]) + Cc2[0]; w01 = S.arow(nxt, Rr[1]) + Cc2[1]; w10 = S.arow(nxt, HALF + Rr[0]) + Cc2[0]; w11 = S.arow(nxt, HALF + Rr[1]) + Cc2[1]; }
            PG8_LDB(B0, 0, 0); PG8_LDB(B1, 0, 1); PG8_SCHED; PG8_LDA(At, 0, 0); PG8_STAGE_A(PG8_SA(1, 1), k1, vA10, vA11);
            PG8_WAIT_V(8); PG8_WAIT_L(0); PG8_BAR; PG8_MMA(0, 0, At, B0); PG8_MMA(0, 1, At, B1); PG8_BAR; PG8_SCHED;
            PG8_LDA(At, 0, 1); PG8_STAGE_B(PG8_SB(0, 0), b2); PG8_STAGE_B(PG8_SB(0, 1), b2 + hstepB); PG8_STAGE_A(PG8_SA(0, 0), k2, w00, w01);
            PG8_WAIT_V(8); PG8_WAIT_L(0); PG8_BAR; PG8_MMA(1, 0, At, B0); PG8_MMA(1, 1, At, B1); PG8_BAR; PG8_SCHED;
            PG8_LDB(B0, 1, 0); PG8_LDB(B1, 1, 1); PG8_SCHED; PG8_LDA(At, 1, 0); PG8_STAGE_A(PG8_SA(0, 1), k2, w10, w11);
            PG8_WAIT_V(8); PG8_WAIT_L(0); PG8_BAR; PG8_MMA(0, 0, At, B0); PG8_MMA(0, 1, At, B1); PG8_BAR; PG8_SCHED;
            PG8_LDA(At, 1, 1); PG8_STAGE_B(PG8_SB(1, 0), b3); PG8_STAGE_B(PG8_SB(1, 1), b3 + hstepB); PG8_STAGE_A(PG8_SA(1, 0), k3, w00, w01);
            PG8_WAIT_V(8); PG8_WAIT_L(0); PG8_BAR; PG8_MMA(1, 0, At, B0); PG8_MMA(1, 1, At, B1); PG8_BAR; PG8_SCHED;
            if (last) { vA00 = w00; vA01 = w01; vA10 = w10; vA11 = w11; }
        }
        if (wr == 0) PG8_BAR;
        if constexpr (FP8) asm volatile("s_nop 15\n\ts_nop 7" ::: "memory");
        if constexpr (KREP > 1) {
#pragma unroll
            for (int a = 0; a < 2; ++a)
#pragma unroll
                for (int b = 0; b < 2; ++b)
#pragma unroll
                    for (int m = 0; m < 4; ++m)
#pragma unroll
                        for (int n = 0; n < 2; ++n) acc[a][b][m][n] *= (1.0f / KREP); }
        E(acc, cur, wr, wc, fr, fq);
        if (!has_next) break;
#pragma unroll
        for (int a = 0; a < 2; ++a)
#pragma unroll
            for (int b = 0; b < 2; ++b)
#pragma unroll
                for (int m = 0; m < 4; ++m)
#pragma unroll
                    for (int n = 0; n < 2; ++n) acc[a][b][m][n] = (f32x4){0.f, 0.f, 0.f, 0.f};
        cur = nxt; cB = nB; ++ui;
        if (wr == 1) PG8_BAR;
    }
    PG8_WAIT_V(0);
    PG8_BAR;
#undef PG8_SA
#undef PG8_SB
#undef PG8_GLDS
#undef PG8_STAGE_A
#undef PG8_STAGE_B
#undef PG8_LDA
#undef PG8_LDB
#undef PG8_MMA
#undef PG8_CAT
#undef PG8_WAIT_V
#undef PG8_WAIT_L
#undef PG8_BAR
#undef PG8_SCHED
}

DI bool static_tile(int L, int nM, int nN, int& pm, int& pn) {
    const int nwg = nM * nN; if (L >= nwg) return false;
    int wgid = L; { const int q = nwg / 8, r = nwg % 8, xcd = wgid % 8, off = wgid / 8; wgid = (xcd < r ? xcd * (q + 1) : r * (q + 1) + (xcd - r) * q) + off; }
    const int nig = 8 * nN, gid = wgid / nig, fm = gid * 8, gsz = (nM - fm) < 8 ? (nM - fm) : 8;
    pm = fm + ((wgid % nig) % gsz); pn = (wgid % nig) / gsz; return true;
}
}
using pg8::Unit; using pg8::Acc;

DI unsigned pk4_fp8(float a, float b, float c, float d) { int p = 0; p = __builtin_amdgcn_cvt_pk_fp8_f32(a, b, p, false); p = __builtin_amdgcn_cvt_pk_fp8_f32(c, d, p, true); return (unsigned)p; }
DI float silu_(float v) { return v * sigmoidf_(v); }
DI float softplus_(float x) { return fmaxf(x, 0.f) + __logf(1.0f + __expf(-fabsf(x))); }

struct SchedIn {
    int G, c, ncol, t0, nsplit, t1, nextra; const char* win; const char* wmem; int reps; int ibeg, iend;
    DI bool next(int i0, Unit& u) const {
        const int i = i0 + ibeg; if (i >= iend) return false;
        const int U = (T / 256) * ncol + nextra; int L = i * G + c; if (L >= U * reps) return false; L %= U; int pm, pn;
        if (pg8::static_tile(L, T / 256, ncol, pm, pn)) { u.kind = 0; u.pm = pm; u.pn = pn < nsplit ? t0 + pn : t1 + (pn - nsplit); u.aux = 0; return true; }
        const int j = L - (T / 256) * ncol; if (j < nextra) { u.kind = 1; u.pm = j >> 3; u.pn = j & 7; u.aux = 0; return true; }
        return false;
    }
    DI unsigned arow(const Unit& u, int r) const { return (u.kind == 0 ? 0u : (unsigned)(WS_MEMN - WS_XN)) + (unsigned)(u.pm * 256 + r) * 2048u; }
    DI const char* bptr(const Unit& u) const { return (u.kind == 0 ? win : wmem) + (size_t)u.pn * (256 * 1024 * 2); }
};

struct EpiIn {
    static constexpr bool SEGMENTED = false;
    unsigned char* ws; const float *qgain, *kgain, *dtbias;
    template <int OP> DI void ew(const Acc& acc, bf16_t* dst, size_t pitch, int col0, int row0, int wc, int fq) const {
#pragma unroll
        for (int ai = 0; ai < 2; ++ai)
#pragma unroll
            for (int m = 0; m < 4; ++m) { bf16_t* rowp = dst + (size_t)(row0 + ai * 128 + m * 16) * pitch + col0 + wc * 32 + 8 * fq;
#pragma unroll
                for (int bj = 0; bj < 2; ++bj) { f32x4 v0 = acc[ai][bj][m][0], v1 = acc[ai][bj][m][1];
                    if (OP == 1) { for (int e = 0; e < 4; ++e) { v0[e] = silu_(v0[e]); v1[e] = silu_(v1[e]); } }
                    if (OP == 2) { for (int e = 0; e < 4; ++e) { v0[e] = sigmoidf_(fminf(fmaxf(v0[e], -30.f), 30.f)); v1[e] = sigmoidf_(fminf(fmaxf(v1[e], -30.f), 30.f)); } }
                    u32x4 w; w.x = pk2(v0[0], v0[1]); w.y = pk2(v0[2], v0[3]); w.z = pk2(v1[0], v1[1]); w.w = pk2(v1[2], v1[3]);
                    *(u32x4*)(rowp + bj * 128) = w; }
                asm volatile("" ::: "memory"); }
    }
    DI void headnorm(const Acc& acc, bf16_t* dst, size_t pitch, int col0, int row0, int wc, int fq, const float* gain, float mul) const {
#pragma unroll
        for (int ai = 0; ai < 2; ++ai)
#pragma unroll
            for (int m = 0; m < 4; ++m) {
                float ss = 0.f;
#pragma unroll
                for (int bj = 0; bj < 2; ++bj)
#pragma unroll
                    for (int n = 0; n < 2; ++n) { const f32x4 x = acc[ai][bj][m][n]; ss += (x[0] * x[0] + x[1] * x[1]) + (x[2] * x[2] + x[3] * x[3]); }
                ss += __shfl_xor(ss, 16); ss += __shfl_xor(ss, 32);
                const float rs = __builtin_amdgcn_rsqf(ss * (1.0f / 64.0f) + EPS) * mul;
                bf16_t* rowp = dst + (size_t)(row0 + ai * 128 + m * 16) * pitch + col0 + wc * 64 + 8 * fq;
#pragma unroll
                for (int bj = 0; bj < 2; ++bj) { const f32x4 g0 = *(const f32x4*)(gain + 32 * bj + 8 * fq), g1 = *(const f32x4*)(gain + 32 * bj + 8 * fq + 4);
                    const f32x4 v0 = acc[ai][bj][m][0] * rs * g0, v1 = acc[ai][bj][m][1] * rs * g1;
                    u32x4 w; w.x = pk2(v0[0], v0[1]); w.y = pk2(v0[2], v0[3]); w.z = pk2(v1[0], v1[1]); w.w = pk2(v1[2], v1[3]);
                    *(u32x4*)(rowp + bj * 32) = w; }
                asm volatile("" ::: "memory"); }
    }
    DI void operator()(const Acc& acc, const Unit& u, int wr, int wc, int fr, int fq) const {
        const int row0 = u.pm * 256 + wr * 64 + fr;
        bf16_t* const act = (bf16_t*)(ws + WS_ACT); bf16_t* const ka = (bf16_t*)(ws + WS_KA); bf16_t* const va = (bf16_t*)(ws + WS_VA); bf16_t* const xbc = (bf16_t*)(ws + WS_XBC);
        bf16_t* const gates = (bf16_t*)(ws + WS_GATES); bf16_t* const memkv = (bf16_t*)(ws + WS_MEMKV); float* const dt = (float*)(ws + WS_DT);
        if (u.kind == 1) { ew<0>(acc, memkv, 2048, u.pn * 256, row0, wc, fq); return; }
        const int tl = u.pn;
        if (tl < TL_K) headnorm(acc, act, ACT_P, (tl - TL_Q) * 256, row0, wc, fq, qgain, 0.125f * LOG2E);
        else if (tl < TL_V) headnorm(acc, ka, 1024, (tl - TL_K) * 256, row0, wc, fq, kgain, 1.0f);
        else if (tl < TL_Z) ew<0>(acc, va, 1024, (tl - TL_V) * 256, row0, wc, fq);
        else if (tl < TL_XBC) ew<1>(acc, act, ACT_P, 1024 + (tl - TL_Z) * 256, row0, wc, fq);
        else if (tl < TL_DT) ew<0>(acc, xbc, 3072, (tl - TL_XBC) * 256, row0, wc, fq);
        else if (tl == TL_DT) {
            if (wc == 0) {
                f32x4 b0 = *(const f32x4*)(dtbias + 8 * fq), b1 = *(const f32x4*)(dtbias + 8 * fq + 4);
#pragma unroll
                for (int ai = 0; ai < 2; ++ai)
#pragma unroll
                    for (int m = 0; m < 4; ++m) { float* rowp = dt + (size_t)(row0 + ai * 128 + m * 16) * 32 + 8 * fq;
                        f32x4 v0 = acc[ai][0][m][0] + b0, v1 = acc[ai][0][m][1] + b1;
                        for (int e = 0; e < 4; ++e) { v0[e] = softplus_(v0[e]); v1[e] = softplus_(v1[e]); }
                        *(f32x4*)rowp = v0; *(f32x4*)(rowp + 4) = v1; }
            }
        }
        else if (tl < TL_G) ew<0>(acc, act, ACT_P, 3072 + (tl - TL_QX) * 256, row0, wc, fq);
        else ew<2>(acc, gates, 3072, (tl - TL_G) * 256, row0, wc, fq);
    }
};

struct SchedDense {
    int G, c, nM, nN, K; const char* bbase; int reps;
    DI bool next(int i, Unit& u) const { u.kind = 0; u.aux = 0; const int U = nM * nN; int L = i * G + c; if (L >= U * reps) return false; return pg8::static_tile(L % U, nM, nN, u.pm, u.pn); }
    DI unsigned arow(const Unit& u, int r) const { return (unsigned)(u.pm * 256 + r) * (unsigned)(K * 2); }
    DI const char* bptr(const Unit& u) const { return bbase + (size_t)u.pn * 256 * K * 2; }
};

struct EpiMerge {
    static constexpr bool SEGMENTED = true;
    const bf16_t* gates; const float* rstd; bf16_t* merged; int last_seg;
    DI bool boundary(int t) const { return t == 16 || t == 24 || t == 32 || t == 40 || t == 48; }
    DI void load8(const bf16_t* p, float (&g)[8]) const { const u32x4 w = *(const u32x4*)p; g[0] = bf_lo(w.x); g[1] = bf_hi(w.x); g[2] = bf_lo(w.y); g[3] = bf_hi(w.y); g[4] = bf_lo(w.z); g[5] = bf_hi(w.z); g[6] = bf_lo(w.w); g[7] = bf_hi(w.w); }
    DI void rescale(Acc& acc, const Unit& u, int t, int wr, int wc, int fr, int fq) const {
        int row0 = u.pm * 256 + wr * 64 + fr, col0 = u.pn * 256 + wc * 32 + 8 * fq;
        asm volatile("" : "+v"(row0), "+v"(col0));
        const int go = (t == 16) ? 0 : 1024, ri = (t == 16) ? 0 : 3, g = (t == 24) ? 0 : (t == 32) ? 1 : 2;
        asm volatile("s_nop 15" ::: "memory");
        f32x2 rr[2][4];
        if (!(t == 16 || t == 48)) {
#pragma unroll
            for (int ai = 0; ai < 2; ++ai)
#pragma unroll
                for (int m = 0; m < 4; ++m) rr[ai][m] = *(const f32x2*)(rstd + (size_t)(row0 + ai * 128 + m * 16) * 4 + g);
        }
#pragma unroll
        for (int ai = 0; ai < 2; ++ai)
#pragma unroll
          for (int mp = 0; mp < 2; ++mp) {
            float f[2][2][8];
            if (t == 16 || t == 48) {
                u32x4 ga[2][2], gb[2][2]; float rsv[2];
#pragma unroll
                for (int mm = 0; mm < 2; ++mm) { const int row = row0 + ai * 128 + (2 * mp + mm) * 16; const bf16_t* gp = gates + (size_t)row * 3072 + col0 + go; rsv[mm] = rstd[(size_t)row * 4 + ri];
#pragma unroll
                    for (int bj = 0; bj < 2; ++bj) { ga[mm][bj] = *(const u32x4*)(gp + bj * 128); gb[mm][bj] = *(const u32x4*)(gp + 1024 + bj * 128); } }
#pragma unroll
                for (int mm = 0; mm < 2; ++mm)
#pragma unroll
                    for (int bj = 0; bj < 2; ++bj) { float a[8], b[8]; unpack8(ga[mm][bj], a); unpack8(gb[mm][bj], b);
#pragma unroll
                        for (int j = 0; j < 8; ++j) f[mm][bj][j] = (t == 16) ? a[j] * fast_rcp(b[j] * rsv[mm]) : a[j] * rsv[mm] * fast_rcp(b[j]); }
            } else {
#pragma unroll
                for (int mm = 0; mm < 2; ++mm) { const float fr_ = rr[ai][2 * mp + mm][0] * fast_rcp(rr[ai][2 * mp + mm][1]);
#pragma unroll
                    for (int bj = 0; bj < 2; ++bj)
#pragma unroll
                        for (int j = 0; j < 8; ++j) f[mm][bj][j] = fr_; }
            }
#pragma unroll
            for (int mm = 0; mm < 2; ++mm)
#pragma unroll
                for (int bj = 0; bj < 2; ++bj)
#pragma unroll
                    for (int e = 0; e < 4; ++e) { const int m = 2 * mp + mm;
                        asm volatile("v_mul_f32 %0, %0, %1" : "+v"(acc[ai][bj][m][0][e]) : "v"(f[mm][bj][e]));
                        asm volatile("v_mul_f32 %0, %0, %1" : "+v"(acc[ai][bj][m][1][e]) : "v"(f[mm][bj][4 + e])); }
            asm volatile("" ::: "memory");
          }
    }
    DI void unpack8(const u32x4 w, float (&g)[8]) const { g[0] = bf_lo(w.x); g[1] = bf_hi(w.x); g[2] = bf_lo(w.y); g[3] = bf_hi(w.y); g[4] = bf_lo(w.z); g[5] = bf_hi(w.z); g[6] = bf_lo(w.w); g[7] = bf_hi(w.w); }
    DI void operator()(const Acc& acc, const Unit& u, int wr, int wc, int fr, int fq) const {
        int row0 = u.pm * 256 + wr * 64 + fr, col0 = u.pn * 256 + wc * 32 + 8 * fq;
        asm volatile("" : "+v"(row0), "+v"(col0));
        u32x4 gg[2][4][2]; float r3[2][4];
#pragma unroll
        for (int ai = 0; ai < 2; ++ai)
#pragma unroll
            for (int m = 0; m < 4; ++m) { const int row = row0 + ai * 128 + m * 16; r3[ai][m] = (last_seg == 1) ? rstd[(size_t)row * 4 + 3] : 1.0f; const bf16_t* gp = gates + (size_t)row * 3072 + col0 + last_seg * 1024;
#pragma unroll
                for (int bj = 0; bj < 2; ++bj) gg[ai][m][bj] = *(const u32x4*)(gp + bj * 128); }
#pragma unroll
        for (int ai = 0; ai < 2; ++ai)
#pragma unroll
            for (int m = 0; m < 4; ++m) { const int row = row0 + ai * 128 + m * 16; bf16_t* op = merged + (size_t)row * 1024 + col0;
#pragma unroll
                for (int bj = 0; bj < 2; ++bj) { float g[8]; unpack8(gg[ai][m][bj], g); const float s = r3[ai][m];
                    f32x4 v0 = acc[ai][bj][m][0], v1 = acc[ai][bj][m][1];
                    u32x4 w; w.x = pk2(v0[0] * g[0] * s, v0[1] * g[1] * s); w.y = pk2(v0[2] * g[2] * s, v0[3] * g[3] * s); w.z = pk2(v1[0] * g[4] * s, v1[1] * g[5] * s); w.w = pk2(v1[2] * g[6] * s, v1[3] * g[7] * s);
                    *(u32x4*)(op + bj * 128) = w; }
                asm volatile("" ::: "memory"); }
    }
};

struct EpiOut {
    static constexpr bool SEGMENTED = false;
    const float* x; float* out;
    DI void operator()(const Acc& acc, const Unit& u, int wr, int wc, int fr, int fq) const {
        const int row0 = u.pm * 256 + wr * 64 + fr, col0 = u.pn * 256 + wc * 32 + 8 * fq;
#pragma unroll
        for (int ai = 0; ai < 2; ++ai)
#pragma unroll
            for (int m = 0; m < 4; ++m) { const size_t off = (size_t)(row0 + ai * 128 + m * 16) * 1024 + col0;
#pragma unroll
                for (int bj = 0; bj < 2; ++bj) { const f32x4 x0 = __builtin_nontemporal_load((const f32x4*)(x + off + bj * 128)), x1 = __builtin_nontemporal_load((const f32x4*)(x + off + bj * 128 + 4));
                    *(f32x4*)(out + off + bj * 128) = x0 + acc[ai][bj][m][0]; *(f32x4*)(out + off + bj * 128 + 4) = x1 + acc[ai][bj][m][1]; } }
    }
};

struct SchedMoE {
    int G, c, NC, tlo, thi; const LAS int* tstart; const LAS int* cnt; const int* tokl; const char* wbase; size_t wexp; int reps; unsigned rowb; unsigned ldbb;
    DI bool next(int i, Unit& u) const {
        const int n = (thi - tlo) * NC; int L = i * G + c; if (L >= n * reps) return false; L %= n;
        { const int q = n / 8, r = n % 8, xcd = L % 8, off = L / 8; L = (xcd < r ? xcd * (q + 1) : r * (q + 1) + (xcd - r) * q) + off; }
        const int rt = tlo + L / NC; u.pn = L % NC; u.pm = rt; int e = 0;
        for (int j = 1; j < NEXP; ++j) e += (tstart[j] <= rt) ? 1 : 0;
        u.aux = __builtin_amdgcn_readfirstlane(e); u.kind = 0; return true;
    }
    DI unsigned arow(const Unit& u, int r) const {
        if (tokl) { const int e = u.aux, idx = (u.pm - tstart[e]) * 256 + r; const int tok = idx < cnt[e] ? tokl[(size_t)e * T + idx] : 0; return (unsigned)tok * rowb; }
        return (unsigned)((u.pm - tlo) * 256 + r) * rowb;
    }
    DI const char* bptr(const Unit& u) const { return wbase + (size_t)u.aux * wexp + (size_t)u.pn * 256 * ldbb; }
};
struct EpiGU {
    static constexpr bool SEGMENTED = false;
    unsigned char* actm; const float *bg, *bu; int tlo;
    DI void operator()(const Acc& acc, const Unit& u, int wr, int wc, int fr, int fq) const {
        const int row0 = (u.pm - tlo) * 256 + wr * 64 + fr, col = u.pn * 128 + wc * 32 + 8 * fq; const size_t eb = (size_t)u.aux * 1024 + col;
        const f32x4 g0 = *(const f32x4*)(bg + eb), g1 = *(const f32x4*)(bg + eb + 4), u0 = *(const f32x4*)(bu + eb), u1 = *(const f32x4*)(bu + eb + 4);
#pragma unroll
        for (int ai = 0; ai < 2; ++ai)
#pragma unroll
            for (int m = 0; m < 4; ++m) { f32x4 a0 = acc[ai][0][m][0] + g0, a1 = acc[ai][0][m][1] + g1, b0 = acc[ai][1][m][0] + u0, b1 = acc[ai][1][m][1] + u1;
#define GU_PAIR(A, B, h) do { f32x2 g_ = {fminf(A[2 * (h)], 7.f), fminf(A[2 * (h) + 1], 7.f)}, u_ = {fminf(fmaxf(B[2 * (h)], -7.f), 7.f), fminf(fmaxf(B[2 * (h) + 1], -7.f), 7.f)}; \
                    const f32x2 t_ = g_ * (-1.702f * 1.4426950408889634f); f32x2 d_ = {fast_exp2(t_[0]), fast_exp2(t_[1])}; d_ = d_ + 1.0f; const f32x2 r_ = {fast_rcp(d_[0]), fast_rcp(d_[1])}; \
                    const f32x2 o_ = (u_ * g_ + g_) * r_; A[2 * (h)] = o_[0]; A[2 * (h) + 1] = o_[1]; } while (0)
                GU_PAIR(a0, b0, 0); GU_PAIR(a0, b0, 1); GU_PAIR(a1, b1, 0); GU_PAIR(a1, b1, 1);
#undef GU_PAIR
                u32x2 w; w.x = pk4_fp8(a0[0], a0[1], a0[2], a0[3]); w.y = pk4_fp8(a1[0], a1[1], a1[2], a1[3]);
                *(u32x2*)(actm + (size_t)(row0 + ai * 128 + m * 16) * 1024 + col) = w; }
    }
};
struct EpiDown {
    static constexpr bool SEGMENTED = false;
    bf16_t* y; const float* bd; int tlo;
    DI void operator()(const Acc& acc, const Unit& u, int wr, int wc, int fr, int fq) const {
        const int row0 = (u.pm - tlo) * 256 + wr * 64 + fr, col0 = u.pn * 256 + wc * 32 + 8 * fq; const float* bp = bd + (size_t)u.aux * 1024 + col0;
        f32x4 bv[2][2];
#pragma unroll
        for (int bj = 0; bj < 2; ++bj) { bv[bj][0] = *(const f32x4*)(bp + bj * 128); bv[bj][1] = *(const f32x4*)(bp + bj * 128 + 4); }
#pragma unroll
        for (int ai = 0; ai < 2; ++ai)
#pragma unroll
            for (int m = 0; m < 4; ++m) { bf16_t* rowp = y + (size_t)(row0 + ai * 128 + m * 16) * 1024 + col0;
#pragma unroll
                for (int bj = 0; bj < 2; ++bj) { const f32x4 v0 = acc[ai][bj][m][0] + bv[bj][0], v1 = acc[ai][bj][m][1] + bv[bj][1];
                    u32x4 w; w.x = pk2(v0[0], v0[1]); w.y = pk2(v0[2], v0[3]); w.z = pk2(v1[0], v1[1]); w.w = pk2(v1[2], v1[3]);
                    *(u32x4*)(rowp + bj * 128) = w; } }
    }
};
struct TrItem { const float* W; int Ns, k0, sc0, sc1; void* dst; int dpitch; const float* kscale; float mul; int fp8; };
DI void tr_load(const TrItem& it, f32x4 (&v)[16], int lane) {
    const int cl = lane & 15, kl = lane >> 4, sc = (cl < 8) ? it.sc0 : it.sc1, col = sc + 4 * (cl & 7);
#pragma unroll
    for (int i = 0; i < 16; ++i) { v[i] = (f32x4){0.f, 0.f, 0.f, 0.f}; if (sc >= 0) v[i] = __builtin_nontemporal_load((const f32x4*)(it.W + (size_t)(it.k0 + 4 * i + kl) * it.Ns + col)); }
}
DI void tr_store(const TrItem& it, const f32x4 (&v)[16], LAS float* scr, int lane) {
    const int cl = lane & 15, kl = lane >> 4;
#pragma unroll
    for (int i = 0; i < 16; ++i) { const int kk = 4 * i + kl; f32x4 x = v[i] * it.mul; if (it.kscale) x *= it.kscale[it.k0 + kk]; LAS float* p = scr + kk * 65 + 4 * cl; p[0] = x[0]; p[1] = x[1]; p[2] = x[2]; p[3] = x[3]; }
    asm volatile("s_waitcnt lgkmcnt(0)" ::: "memory");
    if (it.fp8) { const int c = lane & 3; unsigned char* dst = (unsigned char*)it.dst;
#pragma unroll
        for (int j = 0; j < 4; ++j) { const int n = (lane >> 2) + 16 * j; const LAS float* s = scr + (16 * c) * 65 + n;
            u32x4 o; o.x = pk4_fp8(s[0 * 65], s[1 * 65], s[2 * 65], s[3 * 65]); o.y = pk4_fp8(s[4 * 65], s[5 * 65], s[6 * 65], s[7 * 65]);
            o.z = pk4_fp8(s[8 * 65], s[9 * 65], s[10 * 65], s[11 * 65]); o.w = pk4_fp8(s[12 * 65], s[13 * 65], s[14 * 65], s[15 * 65]);
            *(u32x4*)(dst + (size_t)n * it.dpitch + 16 * c) = o; }
    } else { const int c = lane & 7; bf16_t* dst = (bf16_t*)it.dst;
#pragma unroll
        for (int j = 0; j < 8; ++j) { const int n = (lane >> 3) + 8 * j; const LAS float* s = scr + (8 * c) * 65 + n;
            u32x4 o; o.x = pk2(s[0 * 65], s[1 * 65]); o.y = pk2(s[2 * 65], s[3 * 65]); o.z = pk2(s[4 * 65], s[5 * 65]); o.w = pk2(s[6 * 65], s[7 * 65]);
            *(u32x4*)(dst + (size_t)n * it.dpitch + 8 * c) = o; }
    }
    asm volatile("s_waitcnt lgkmcnt(0)" ::: "memory");
}
template <class MK> DI void tr_run(const MK& mk, int nitems, int gw, int NGW, LAS float* scr, int lane) {
    f32x4 va[16], vb[16]; TrItem ia, ib; int it = gw;
    if (it < nitems) { ia = mk(it); tr_load(ia, va, lane); }
    while (it < nitems) {
        const int i2 = it + NGW; if (i2 < nitems) { ib = mk(i2); tr_load(ib, vb, lane); }
        tr_store(ia, va, scr, lane);
        if (i2 >= nitems) break;
        const int i3 = i2 + NGW; if (i3 < nitems) { ia = mk(i3); tr_load(ia, va, lane); }
        tr_store(ib, vb, scr, lane);
        it = i3; }
}
DI int win_src_col(int nb) {
    const int tile = nb >> 3, sub = nb & 7;
    if (tile < TL_V) { const int base = tile < TL_K ? 256 * tile : 1024 + 256 * (tile - TL_K); return base + 32 * (2 * (sub & 3) + (sub >> 2)); }
    if (tile < TL_Z) return 2048 + 256 * (tile - TL_V) + 32 * sub;
    if (tile < TL_XBC) return 3072 + 256 * (tile - TL_Z) + 32 * sub;
    if (tile < TL_DT) return 5120 + 256 * (tile - TL_XBC) + 32 * sub;
    if (tile == TL_DT) return sub == 0 ? 8192 : -1;
    if (tile < TL_G) return 8224 + 256 * (tile - TL_QX) + 32 * sub;
    return 9248 + 256 * (tile - TL_G) + 32 * sub;
}
template <int NR> DI void rms_rows_to_bf16(const float* x, bf16_t* o, size_t row_stride, const float* gain, int lane) {
    f32x4 v[NR][4]; float s[NR];
#pragma unroll
    for (int r = 0; r < NR; ++r) { const f32x4* xr = (const f32x4*)(x + (size_t)r * row_stride * 1024) + lane; s[r] = 0.f;
#pragma unroll
        for (int j = 0; j < 4; ++j) { v[r][j] = __builtin_nontemporal_load(xr + 64 * j); } }
#pragma unroll
    for (int r = 0; r < NR; ++r) {
#pragma unroll
        for (int j = 0; j < 4; ++j) s[r] += (v[r][j].x * v[r][j].x + v[r][j].y * v[r][j].y) + (v[r][j].z * v[r][j].z + v[r][j].w * v[r][j].w);
        s[r] = __builtin_amdgcn_rsqf(wave_sum(s[r]) * (1.f / 1024.f) + EPS); }
    const f32x4* gr = (const f32x4*)gain + lane;
#pragma unroll
    for (int j = 0; j < 4; ++j) { const f32x4 g = gr[64 * j];
#pragma unroll
        for (int r = 0; r < NR; ++r) { u32x2 w; w.x = pk2(v[r][j].x * s[r] * g.x, v[r][j].y * s[r] * g.y); w.y = pk2(v[r][j].z * s[r] * g.z, v[r][j].w * s[r] * g.w); ((u32x2*)(o + (size_t)r * row_stride * 1024) + lane)[64 * j] = w; } }
}


template <int NR> DI void rms_rows_to_fp8(const float* x, unsigned char* o, const float* gain, int lane) {
    f32x4 v[NR][4]; float s[NR];
#pragma unroll
    for (int r = 0; r < NR; ++r) { const f32x4* xr = (const f32x4*)(x + (size_t)r * 1024) + lane; s[r] = 0.f;
#pragma unroll
        for (int j = 0; j < 4; ++j) { v[r][j] = xr[64 * j]; } }
#pragma unroll
    for (int r = 0; r < NR; ++r) {
#pragma unroll
        for (int j = 0; j < 4; ++j) s[r] += (v[r][j].x * v[r][j].x + v[r][j].y * v[r][j].y) + (v[r][j].z * v[r][j].z + v[r][j].w * v[r][j].w);
        s[r] = __builtin_amdgcn_rsqf(wave_sum(s[r]) * (1.f / 1024.f) + EPS); }
    const f32x4* gr = (const f32x4*)gain + lane;
#pragma unroll
    for (int j = 0; j < 4; ++j) { const f32x4 g = gr[64 * j];
#pragma unroll
        for (int r = 0; r < NR; ++r) ((unsigned*)(o + (size_t)r * 1024) + lane)[64 * j] = pk4_fp8(v[r][j].x * s[r] * g.x, v[r][j].y * s[r] * g.y, v[r][j].z * s[r] * g.z, v[r][j].w * s[r] * g.w); }
}

DI int crow(int r, int hi) { return (r & 3) + 8 * (r >> 2) + 4 * hi; }
DI s16x4 vtr(const LAS unsigned char* p) { return __builtin_bit_cast(s16x4, __builtin_amdgcn_ds_read_tr16_b64_v4i16((LAS v4i16_t*)p)); }
#define MFMA32(a, b, c) __builtin_amdgcn_mfma_f32_32x32x16_bf16((a), (b), (c), 0, 0, 0)
#define MFMA16(a, b, c) __builtin_amdgcn_mfma_f32_16x16x32_bf16((a), (b), (c), 0, 0, 0)
DI void tile_load(u32x4 (&r)[4], const bf16_t* g, size_t pitch, int tid) {
#pragma unroll
    for (int i = 0; i < 4; ++i) { const int q = tid + 512 * i, row = q >> 5, ch = q & 31; r[i] = *(const u32x4*)(g + (size_t)row * pitch + ch * 8); }
}
DI void tile_store_k(LAS unsigned char* dst, const u32x4 (&r)[4], int tid) {
#pragma unroll
    for (int i = 0; i < 4; ++i) { const int q = tid + 512 * i, row = q >> 5, ch = q & 31; *(LAS u32x4*)(dst + row * 512 + ((ch ^ (row & 15)) << 4)) = r[i]; }
}
DI void tile_store_v(LAS unsigned char* dst, const u32x4 (&r)[4], int tid) {
#pragma unroll
    for (int i = 0; i < 4; ++i) { const int q = tid + 512 * i, row = q >> 5, ch = q & 31; *(LAS u32x4*)(dst + row * 512 + ((((ch >> 2) ^ (row & 3)) * 4 + (ch & 3)) << 4)) = r[i]; }
}
constexpr int AT_K = 0, AT_V = 32768, AT_BIAS = 65536, AT_QA = 90112, AT_BIAS_STRIDE = 260;

constexpr float SM_THR = 8.0f;
DI bool softmax_tile(f32x16& s0, f32x16& s1, float& m, float& l, bf16x8 (&pa)[4], float& alpha) {
    float mx = fmaxf(s0[0], s1[0]);
#pragma unroll
    for (int r = 1; r < 16; ++r) mx = fmaxf(mx, fmaxf(s0[r], s1[r]));
    mx = fmaxf(mx, __shfl_xor(mx, 32));
    bool moved = false; alpha = 1.0f;
    if (__builtin_expect(__any(mx > SM_THR), 0)) {
        const float dl = fmaxf(mx, 0.f); m += dl; alpha = fast_exp2(-dl); l *= alpha; moved = true;
#pragma unroll
        for (int r = 0; r < 16; ++r) { s0[r] -= dl; s1[r] -= dl; }
    }
    float sum = 0.f;
#pragma unroll
    for (int r = 0; r < 16; ++r) { s0[r] = fast_exp2(s0[r]); s1[r] = fast_exp2(s1[r]); sum += s0[r] + s1[r]; }
    l += sum;
    u32x4 w;
    w.x = pk2(s0[0], s0[1]); w.y = pk2(s0[2], s0[3]); w.z = pk2(s0[4], s0[5]); w.w = pk2(s0[6], s0[7]); pa[0] = __builtin_bit_cast(bf16x8, w);
    w.x = pk2(s0[8], s0[9]); w.y = pk2(s0[10], s0[11]); w.z = pk2(s0[12], s0[13]); w.w = pk2(s0[14], s0[15]); pa[1] = __builtin_bit_cast(bf16x8, w);
    w.x = pk2(s1[0], s1[1]); w.y = pk2(s1[2], s1[3]); w.z = pk2(s1[4], s1[5]); w.w = pk2(s1[6], s1[7]); pa[2] = __builtin_bit_cast(bf16x8, w);
    w.x = pk2(s1[8], s1[9]); w.y = pk2(s1[10], s1[11]); w.z = pk2(s1[12], s1[13]); w.w = pk2(s1[14], s1[15]); pa[3] = __builtin_bit_cast(bf16x8, w);
    return moved;
}
DI bf16x8 v_frag(const LAS unsigned char* vt, int s, int colbyte0, int lane) {
    const int hi = lane >> 5, q_ = (lane & 15) >> 2, p_ = lane & 3, blk = (lane >> 4) & 1;
    const int cb = colbyte0 + blk * 32 + p_ * 8, u = cb >> 6, within = cb & 63;
    const int R = 16 * s + 4 * hi + q_;
    const s16x4 lo = vtr(vt + R * 512 + ((u ^ q_) << 6) + within);
    const s16x4 h4 = vtr(vt + (R + 8) * 512 + ((u ^ q_) << 6) + within);
    return __builtin_shufflevector(lo, h4, 0, 1, 2, 3, 4, 5, 6, 7);
}

DI void attnA_unit(LAS unsigned char* lds, int b, int cp, int hq, bf16_t* act, const bf16_t* ka, const bf16_t* va, bf16_t* outp, size_t opitch) {
    const int tid = threadIdx.x, lane = tid & 63, wid = __builtin_amdgcn_readfirstlane(tid >> 6), hl = wid >> 1, qh = wid & 1, head = 4 * hq + hl, l31 = lane & 31, hi = lane >> 5;
    const int c0 = 2 * cp, c1 = c0 + 1;
    const size_t trow0 = (size_t)b * SEQ + 64 * c0 + 32 * qh + l31;
    __syncthreads();
    { u32x4 rq[4];
#pragma unroll
      for (int i = 0; i < 2; ++i) { tile_load(rq, act + ((size_t)b * SEQ + 64 * (c0 + i)) * ACT_P + 256 * hq, ACT_P, tid); tile_store_k(lds + AT_QA + i * 32768, rq, tid); } }
    f32x16 o0[2], o1[2];
#pragma unroll
    for (int i = 0; i < 2; ++i)
#pragma unroll
        for (int r = 0; r < 16; ++r) { o0[i][r] = 0.f; o1[i][r] = 0.f; }
    float m[2] = {0.f, 0.f}, l[2] = {0.f, 0.f};
    const int kc0 = c0 < 8 ? 0 : c0 - 8;
    const LAS float* bias = (const LAS float*)(lds + AT_BIAS) + head * AT_BIAS_STRIDE;
    const float b256 = bias[256];
    u32x4 rkA[4], rvA[4], rkB[4], rvB[4];
    const bf16_t* kb = ka + ((size_t)b * SEQ + 64 * kc0) * 1024 + 256 * hq; const bf16_t* vb = va + ((size_t)b * SEQ + 64 * kc0) * 1024 + 256 * hq;
    tile_load(rkA, kb, 1024, tid); tile_load(rvA, vb, 1024, tid);
    if (kc0 < c1) { tile_load(rkB, kb + 64 * 1024, 1024, tid); tile_load(rvB, vb + 64 * 1024, 1024, tid); }
    const int qi = 32 * qh + l31;
    auto compute = [&](const int kc) __attribute__((always_inline)) {
#pragma unroll
        for (int i = 0; i < 2; ++i) {
            const int j = c0 + i - kc;
            if (j < 0 || j > 8) continue;
            f32x16 s0, s1;
            if (j >= 3) { const float cc = b256 - m[i];
#pragma unroll
                for (int r = 0; r < 16; ++r) { s0[r] = cc; s1[r] = cc; }
            } else {
#pragma unroll
                for (int r = 0; r < 16; ++r) { const int rel0 = 64 * j + qi - crow(r, hi); s0[r] = bias[min(rel0, 128) + 128] - m[i]; s1[r] = bias[min(rel0 - 32, 128) + 128] - m[i]; }
            }
#pragma unroll
            for (int d0 = 0; d0 < 4; ++d0) {
                const int ch = 8 * hl + 2 * d0 + hi;
                const bf16x8 k0 = *(const LAS bf16x8*)(lds + AT_K + l31 * 512 + ((ch ^ (l31 & 15)) << 4));
                const bf16x8 k1 = *(const LAS bf16x8*)(lds + AT_K + (32 + l31) * 512 + ((ch ^ (l31 & 15)) << 4));
                const int qrow = 32 * qh + l31; const bf16x8 qv = *(const LAS bf16x8*)(lds + AT_QA + i * 32768 + qrow * 512 + ((ch ^ (qrow & 15)) << 4));
                s0 = MFMA32(k0, qv, s0); s1 = MFMA32(k1, qv, s1);
            }
            bf16x8 pa[4]; float alpha;
            if (softmax_tile(s0, s1, m[i], l[i], pa, alpha)) {
#pragma unroll
                for (int r = 0; r < 16; ++r) { o0[i][r] *= alpha; o1[i][r] *= alpha; } }
#pragma unroll
            for (int s = 0; s < 4; ++s) {
                const bf16x8 v0 = v_frag(lds + AT_V, s, (64 * hl) * 2, lane), v1 = v_frag(lds + AT_V, s, (64 * hl + 32) * 2, lane);
                o0[i] = MFMA32(v0, pa[s], o0[i]); o1[i] = MFMA32(v1, pa[s], o1[i]);
            }
        }
    };
#pragma unroll 1
    for (int kc = kc0; kc <= c1; kc += 2) {
        __syncthreads();
        tile_store_k(lds + AT_K, rkA, tid); tile_store_v(lds + AT_V, rvA, tid);
        if (kc + 2 <= c1) { tile_load(rkA, kb + (size_t)(kc + 2 - kc0) * 64 * 1024, 1024, tid); tile_load(rvA, vb + (size_t)(kc + 2 - kc0) * 64 * 1024, 1024, tid); }
        __syncthreads();
        compute(kc);
        if (kc + 1 > c1) break;
        __syncthreads();
        tile_store_k(lds + AT_K, rkB, tid); tile_store_v(lds + AT_V, rvB, tid);
        if (kc + 3 <= c1) { tile_load(rkB, kb + (size_t)(kc + 3 - kc0) * 64 * 1024, 1024, tid); tile_load(rvB, vb + (size_t)(kc + 3 - kc0) * 64 * 1024, 1024, tid); }
        __syncthreads();
        compute(kc + 1);
    }
#pragma unroll
    for (int i = 0; i < 2; ++i) {
        const float lt = l[i] + __shfl_xor(l[i], 32), inv = fast_rcp(lt);
#pragma unroll
        for (int rg = 0; rg < 4; ++rg) {
            u32x2 w0, w1; w0.x = pk2(o0[i][4 * rg] * inv, o0[i][4 * rg + 1] * inv); w0.y = pk2(o0[i][4 * rg + 2] * inv, o0[i][4 * rg + 3] * inv);
            w1.x = pk2(o1[i][4 * rg] * inv, o1[i][4 * rg + 1] * inv); w1.y = pk2(o1[i][4 * rg + 2] * inv, o1[i][4 * rg + 3] * inv);
            bf16_t* op = outp + (trow0 + 64 * i) * opitch + 64 * head; *(u32x2*)(op + 8 * rg + 4 * hi) = w0; *(u32x2*)(op + 32 + 8 * rg + 4 * hi) = w1;
        }
    }
}

constexpr int AT_Q = 65536;
DI void attnC_phase(LAS unsigned char* lds, int vcu, int G, bf16_t* act, const bf16_t* kx, const bf16_t* memkv, bf16_t* outp, size_t opitch) {
    const int tid = threadIdx.x, lane = tid & 63, wid = __builtin_amdgcn_readfirstlane(tid >> 6), rg = wid >> 1, dh = wid & 1, l31 = lane & 31, hi = lane >> 5;
    constexpr int NU = NBATCH * 4 * 32;
    const int upw = (NU + G - 1) / G, u0 = vcu * upw, u1 = (u0 + upw < NU) ? u0 + upw : NU;
    if (u0 >= NU) return;
    const int nsteps = (u1 - u0) * 4;
    u32x4 rk[4], rv[4];
    { const int b = u0 >> 7, hx = (u0 >> 5) & 3;
      tile_load(rk, kx + ((size_t)b * MEMLEN) * 1024 + 256 * hx, 1024, tid); tile_load(rv, memkv + ((size_t)b * MEMLEN) * 2048 + 1024 + 256 * hx, 2048, tid); }
    f32x16 o[4]; float m = 0.f, l = 0.f, rstd = 1.f;
    for (int n = 0; n < nsteps; ++n) {
        const int u = u0 + (n >> 2), j = n & 3, rb = u & 31, hx = (u >> 5) & 3, b = u >> 7;
        const size_t trow = (size_t)b * SEQ + 128 * rb + 32 * rg + l31;
        u32x4 rq[8];
        if (j == 0) {
#pragma unroll
            for (int i = 0; i < 8; ++i) { const int q = tid + 512 * i, row = q >> 5, ch = q & 31; rq[i] = *(const u32x4*)(act + ((size_t)b * SEQ + 128 * rb + row) * ACT_P + 3072 + 256 * hx + ch * 8); }
#pragma unroll
            for (int i = 0; i < 4; ++i)
#pragma unroll
                for (int r = 0; r < 16; ++r) o[i][r] = 0.f;
            m = 0.f; l = 0.f;
        }
        __syncthreads();
        tile_store_k(lds + AT_K, rk, tid); tile_store_v(lds + AT_V, rv, tid);
        if (j == 0) {
#pragma unroll
            for (int i = 0; i < 8; ++i) { const int q = tid + 512 * i, row = q >> 5, ch = q & 31; *(LAS u32x4*)(lds + AT_Q + row * 512 + ((ch ^ (row & 15)) << 4)) = rq[i]; }
        }
        if (n + 1 < nsteps) { const int un = u0 + ((n + 1) >> 2), jn = (n + 1) & 3, hxn = (un >> 5) & 3, bn = un >> 7;
            tile_load(rk, kx + ((size_t)bn * MEMLEN + 64 * jn) * 1024 + 256 * hxn, 1024, tid); tile_load(rv, memkv + ((size_t)bn * MEMLEN + 64 * jn) * 2048 + 1024 + 256 * hxn, 2048, tid); }
        __syncthreads();
        f32x16 s0, s1;
#pragma unroll
        for (int r = 0; r < 16; ++r) { s0[r] = 0.f; s1[r] = 0.f; }
        float ssq = 0.f;
#pragma unroll
        for (int d0 = 0; d0 < 16; ++d0) {
            const int ch = 2 * d0 + hi;
            const bf16x8 qfr = *(const LAS bf16x8*)(lds + AT_Q + (32 * rg + l31) * 512 + ((ch ^ (l31 & 15)) << 4));
            const bf16x8 k0 = *(const LAS bf16x8*)(lds + AT_K + l31 * 512 + ((ch ^ (l31 & 15)) << 4));
            const bf16x8 k1 = *(const LAS bf16x8*)(lds + AT_K + (32 + l31) * 512 + ((ch ^ (l31 & 15)) << 4));
            if (j == 0) {
#pragma unroll
                for (int e = 0; e < 8; ++e) { const float v = bf2f((bf16_t)qfr[e]); ssq += v * v; } }
            s0 = MFMA32(k0, qfr, s0); s1 = MFMA32(k1, qfr, s1);
        }
        if (j == 0) { ssq += __shfl_xor(ssq, 32); rstd = __builtin_amdgcn_rsqf(ssq * (1.f / 256.f) + EPS); }
#pragma unroll
        for (int r = 0; r < 16; ++r) { s0[r] = s0[r] * rstd - m; s1[r] = s1[r] * rstd - m; }
        bf16x8 pa[4]; float alpha;
        if (softmax_tile(s0, s1, m, l, pa, alpha)) {
#pragma unroll
            for (int i = 0; i < 4; ++i)
#pragma unroll
                for (int r = 0; r < 16; ++r) o[i][r] *= alpha; }
#pragma unroll
        for (int s = 0; s < 4; ++s)
#pragma unroll
            for (int i = 0; i < 4; ++i) { const bf16x8 vf = v_frag(lds + AT_V, s, (128 * dh + 32 * i) * 2, lane); o[i] = MFMA32(vf, pa[s], o[i]); }
        if (j == 3) {
            const float lt = l + __shfl_xor(l, 32), inv = fast_rcp(lt);
            bf16_t* op = outp + trow * opitch + 256 * hx + 128 * dh;
#pragma unroll
            for (int i = 0; i < 4; ++i)
#pragma unroll
                for (int g4 = 0; g4 < 4; ++g4) { u32x2 w; w.x = pk2(o[i][4 * g4] * inv, o[i][4 * g4 + 1] * inv); w.y = pk2(o[i][4 * g4 + 2] * inv, o[i][4 * g4 + 3] * inv);
                    *(u32x2*)(op + 32 * i + 8 * g4 + 4 * hi) = w; }
        }
    }
    __syncthreads();
}

constexpr int MB_XDT = 0, MB_XDTW = 9216, MB_BM = 18432, MB_CM = 35840, MB_YD = 53248, MB_YO = 70656, MB_ACS = 88064, MB_YSTR = 272;
DI int mb_b256(int row, int col) { return row * 272 + col * 2; }
DI int mb_b128(int row, int col) { return row * 144 + col * 2; }
template <bool W256> DI bf16x8 tr_pair(const LAS unsigned char* base, int row_lo, int row_hi, int col0, int lane) {
    const int i = lane & 15, r = i >> 2, c = col0 + 4 * (i & 3);
    const s16x4 lo = vtr(base + (W256 ? mb_b256(row_lo + r, c) : mb_b128(row_lo + r, c))), h4 = vtr(base + (W256 ? mb_b256(row_hi + r, c) : mb_b128(row_hi + r, c)));
    return __builtin_shufflevector(lo, h4, 0, 1, 2, 3, 4, 5, 6, 7);
}
DI void bcconv_phase(int vcu, int G, const bf16_t* xbc, bf16_t* bc, const float* conv_w, const float* conv_b, const float* dtp, float* acsp, const float* a_log) {
    {
        const int lane = threadIdx.x & 63, wv = threadIdx.x >> 6;
        for (int ck = vcu * 8 + wv; ck < T / 64; ck += G * 8) {
            const float* dr = dtp + ((size_t)ck * 64 + lane) * 32; float* orow = acsp + ((size_t)ck * 64 + lane) * 32;
#pragma unroll
            for (int q = 0; q < 8; ++q) { f32x4 v = *(const f32x4*)(dr + 4 * q); const f32x4 al = *(const f32x4*)(a_log + 4 * q);
#pragma unroll
                for (int e = 0; e < 4; ++e) { float a = -v[e] * __expf(al[e]);
#pragma unroll
                    for (int o = 1; o < 64; o <<= 1) { const float u = __shfl_up(a, o); if (lane >= o) a += u; }
                    v[e] = a; }
                *(f32x4*)(orow + 4 * q) = v; }
        }
    }
    for (int task = vcu * 512 + threadIdx.x; task < (T / 16) * 128; task += G * 512) {
        const int cc = task & 127, run = task >> 7, g = cc >> 5, w = cc & 31;
        const int scol = (w < 16 ? 2048 + 128 * g + 8 * w : 2560 + 128 * g + 8 * (w - 16));
        const int t0 = run * 16, pos0 = t0 & (SEQ - 1);
        float cw[4][8], cb[8];
#pragma unroll
        for (int e = 0; e < 8; ++e) { cb[e] = conv_b[scol + e];
#pragma unroll
            for (int i = 0; i < 4; ++i) cw[i][e] = conv_w[i * 3072 + scol + e]; }
        float win[3][8];
#pragma unroll
        for (int k = 0; k < 3; ++k) { u32x4 wv = (u32x4){0u, 0u, 0u, 0u}; if (pos0 + k - 3 >= 0) wv = *(const u32x4*)(xbc + (size_t)(t0 + k - 3) * 3072 + scol);
            win[k][0] = bf_lo(wv.x); win[k][1] = bf_hi(wv.x); win[k][2] = bf_lo(wv.y); win[k][3] = bf_hi(wv.y); win[k][4] = bf_lo(wv.z); win[k][5] = bf_hi(wv.z); win[k][6] = bf_lo(wv.w); win[k][7] = bf_hi(wv.w); }
#pragma unroll 4
        for (int k = 0; k < 16; ++k) {
            const u32x4 wv = __builtin_nontemporal_load((const u32x4*)(xbc + (size_t)(t0 + k) * 3072 + scol));
            const float cur[8] = {bf_lo(wv.x), bf_hi(wv.x), bf_lo(wv.y), bf_hi(wv.y), bf_lo(wv.z), bf_hi(wv.z), bf_lo(wv.w), bf_hi(wv.w)};
            float o[8];
#pragma unroll
            for (int e = 0; e < 8; ++e) { o[e] = silu_(cb[e] + cw[0][e] * win[0][e] + cw[1][e] * win[1][e] + cw[2][e] * win[2][e] + cw[3][e] * cur[e]); win[0][e] = win[1][e]; win[1][e] = win[2][e]; win[2][e] = cur[e]; }
            u32x4 ov; ov.x = pk2(o[0], o[1]); ov.y = pk2(o[2], o[3]); ov.z = pk2(o[4], o[5]); ov.w = pk2(o[6], o[7]);
            *(u32x4*)(bc + (size_t)(t0 + k) * 1024 + 8 * cc) = ov;
        }
    }
}
constexpr int MP_IMG = 44800, MP_XDT = 0, MP_BM = 9216, MP_CM = 26624, MP_ACS = 44032, MP_W = 44288, MP_Y0 = 2 * MP_IMG, MP_YSZ = 34816, MP_YD = 0, MP_YO = 17408, MP_CW = MP_Y0 + 2 * MP_YSZ;
DI void mamba_unit(LAS unsigned char* lds, int b, int h, const bf16_t* xbc, const bf16_t* bc, const float* dtp, const float* acsp, bf16_t* act, float* ssq_out, bf16_t* outp, size_t opitch,
                   const float* conv_w, const float* conv_b, const float* a_log, const float* d_skip) {
    const int tid = threadIdx.x, lane = tid & 63, wid = __builtin_amdgcn_readfirstlane(tid >> 6), fr = lane & 15, fq = lane >> 4, g = h >> 3;
    const float D_h = d_skip[h];
    const int l = tid >> 3, pc = tid & 7, xcol = 64 * h + 8 * pc;
    LAS float* cwl = (LAS float*)(lds + MP_CW);
    if (tid < 256) cwl[tid] = conv_w[(tid >> 6) * 3072 + 64 * h + (tid & 63)]; else if (tid < 320) cwl[tid] = conv_b[64 * h + (tid & 63)];
    f32x4 Z[8];
#pragma unroll
    for (int i = 0; i < 8; ++i) Z[i] = (f32x4){0.f, 0.f, 0.f, 0.f};
    const int frow0 = tid >> 4, fch = tid & 15;
    const size_t tb = (size_t)b * SEQ;
    u32x4 xr[4], bcr[4]; float dt_l, acs_l, acs63;
#define MB_LOAD(c_) do { const int p0_ = 64 * (c_); \
        _Pragma("unroll") for (int i_ = 0; i_ < 4; ++i_) { const int pos_ = p0_ + l - 3 + i_; xr[i_] = (u32x4){0u, 0u, 0u, 0u}; if (pos_ >= 0) xr[i_] = *(const u32x4*)(xbc + (tb + pos_) * 3072 + xcol); } \
        _Pragma("unroll") for (int i_ = 0; i_ < 4; ++i_) bcr[i_] = *(const u32x4*)(bc + (tb + p0_ + frow0 + 32 * (i_ & 1)) * 1024 + 256 * g + 128 * (i_ >> 1) + 8 * fch); \
        dt_l = dtp[(tb + p0_ + l) * 32 + h]; acs_l = acsp[(tb + p0_ + l) * 32 + h]; acs63 = acsp[(tb + p0_ + 63) * 32 + h]; } while (0)
    auto S1 = [&](const int cn, float (&xs)[8]) __attribute__((always_inline)) {
        LAS unsigned char* img = lds + (cn & 1) * MP_IMG;
        if (pc == 0) { ((LAS float*)(img + MP_ACS))[l] = acs_l; ((LAS float*)(img + MP_W))[l] = __expf(acs63 - acs_l); }
        { float r[4][8];
#pragma unroll
          for (int i = 0; i < 4; ++i) { r[i][0] = bf_lo(xr[i].x); r[i][1] = bf_hi(xr[i].x); r[i][2] = bf_lo(xr[i].y); r[i][3] = bf_hi(xr[i].y); r[i][4] = bf_lo(xr[i].z); r[i][5] = bf_hi(xr[i].z); r[i][6] = bf_lo(xr[i].w); r[i][7] = bf_hi(xr[i].w); }
          const f32x4 b0 = *(const LAS f32x4*)(cwl + 256 + 8 * pc), b1 = *(const LAS f32x4*)(cwl + 256 + 8 * pc + 4);
          float a[8] = {b0[0], b0[1], b0[2], b0[3], b1[0], b1[1], b1[2], b1[3]};
#pragma unroll
          for (int i = 0; i < 4; ++i) { const f32x4 w0 = *(const LAS f32x4*)(cwl + 64 * i + 8 * pc), w1 = *(const LAS f32x4*)(cwl + 64 * i + 8 * pc + 4);
              a[0] += w0[0] * r[i][0]; a[1] += w0[1] * r[i][1]; a[2] += w0[2] * r[i][2]; a[3] += w0[3] * r[i][3]; a[4] += w1[0] * r[i][4]; a[5] += w1[1] * r[i][5]; a[6] += w1[2] * r[i][6]; a[7] += w1[3] * r[i][7]; }
#pragma unroll
          for (int e = 0; e < 8; ++e) xs[e] = silu_(a[e]); }
        { const float d = dt_l; u32x4 av; av.x = pk2(xs[0] * d, xs[1] * d); av.y = pk2(xs[2] * d, xs[3] * d); av.z = pk2(xs[4] * d, xs[5] * d); av.w = pk2(xs[6] * d, xs[7] * d);
          *(LAS u32x4*)(img + MP_XDT + mb_b128(l, 8 * pc)) = av; }
#pragma unroll
        for (int i = 0; i < 4; ++i) *(LAS u32x4*)(img + (i < 2 ? MP_BM : MP_CM) + mb_b256(frow0 + 32 * (i & 1), 8 * fch)) = bcr[i];
        { const int cq = cn < 63 ? cn + 1 : 63; MB_LOAD(cq); }
    };
    auto S2 = [&](const int c) __attribute__((always_inline)) {
        const LAS unsigned char* img = lds + (c & 1) * MP_IMG; LAS unsigned char* yb = lds + MP_Y0 + (c & 1) * MP_YSZ;
        const LAS float* acs = (const LAS float*)(img + MP_ACS);
        if (wid >= 4) {
            const int d = wid - 4; const float la = acs[16 * d + fr];
            f32x4 X[4];
            bf16x8 cf[4];
#pragma unroll
            for (int ks = 0; ks < 4; ++ks) cf[ks] = *(const LAS bf16x8*)(img + MP_CM + mb_b256(16 * d + fr, 32 * ks + 8 * fq));
#pragma unroll
            for (int si = 0; si < 4; ++si) { X[si] = (f32x4){0.f, 0.f, 0.f, 0.f};
                if (si <= d) {
                    bf16x8 af[4];
#pragma unroll
                    for (int ks = 0; ks < 4; ++ks) af[ks] = *(const LAS bf16x8*)(img + MP_BM + mb_b256(16 * si + fr, 32 * ks + 8 * fq));
#pragma unroll
                    for (int ks = 0; ks < 4; ++ks) X[si] = MFMA16(af[ks], cf[ks], X[si]);
                    const f32x4 sa = *(const LAS f32x4*)(acs + 16 * si + 4 * fq);
#pragma unroll
                    for (int r = 0; r < 4; ++r) { const int s_abs = 16 * si + 4 * fq + r, l_abs = 16 * d + fr; X[si][r] = (s_abs <= l_abs) ? X[si][r] * __expf(la - sa[r]) : 0.f; }
                } }
            bf16x8 Xp[2];
#pragma unroll
            for (int sb = 0; sb < 2; ++sb) { u32x4 w; w.x = pk2(X[2 * sb][0], X[2 * sb][1]); w.y = pk2(X[2 * sb][2], X[2 * sb][3]); w.z = pk2(X[2 * sb + 1][0], X[2 * sb + 1][1]); w.w = pk2(X[2 * sb + 1][2], X[2 * sb + 1][3]); Xp[sb] = __builtin_bit_cast(bf16x8, w); }
#pragma unroll
            for (int ph = 0; ph < 2; ++ph) { bf16x8 xa[2][2];
#pragma unroll
                for (int q = 0; q < 2; ++q)
#pragma unroll
                    for (int sb = 0; sb < 2; ++sb) if (2 * sb <= d) xa[q][sb] = tr_pair<false>(img + MP_XDT, 32 * sb + 4 * fq, 32 * sb + 16 + 4 * fq, 16 * (2 * ph + q), lane);
#pragma unroll
                for (int q = 0; q < 2; ++q) { f32x4 y = (f32x4){0.f, 0.f, 0.f, 0.f};
#pragma unroll
                    for (int sb = 0; sb < 2; ++sb) { if (2 * sb <= d) y = MFMA16(xa[q][sb], Xp[sb], y); }
                    *(LAS f32x4*)(yb + MP_YD + (16 * d + fr) * MB_YSTR + (16 * (2 * ph + q) + 4 * fq) * 4) = y; } }
        } else {
            const int pw = wid;
            bf16x8 Zp[4];
#pragma unroll
            for (int nb = 0; nb < 4; ++nb) { u32x4 w; w.x = pk2(Z[2 * nb][0], Z[2 * nb][1]); w.y = pk2(Z[2 * nb][2], Z[2 * nb][3]); w.z = pk2(Z[2 * nb + 1][0], Z[2 * nb + 1][1]); w.w = pk2(Z[2 * nb + 1][2], Z[2 * nb + 1][3]); Zp[nb] = __builtin_bit_cast(bf16x8, w); }
#pragma unroll
            for (int lt = 0; lt < 4; ++lt) { f32x4 y = (f32x4){0.f, 0.f, 0.f, 0.f};
                bf16x8 bfr[4];
#pragma unroll
                for (int nb = 0; nb < 4; ++nb) { const s16x4 lo = *(const LAS s16x4*)(img + MP_CM + mb_b256(16 * lt + fr, 32 * nb + 4 * fq)), h4 = *(const LAS s16x4*)(img + MP_CM + mb_b256(16 * lt + fr, 32 * nb + 16 + 4 * fq));
                    bfr[nb] = __builtin_shufflevector(lo, h4, 0, 1, 2, 3, 4, 5, 6, 7); }
#pragma unroll
                for (int nb = 0; nb < 4; ++nb) y = MFMA16(Zp[nb], bfr[nb], y);
                const float ea = __expf(acs[16 * lt + fr]); y *= ea;
                *(LAS f32x4*)(yb + MP_YO + (16 * lt + fr) * MB_YSTR + (16 * pw + 4 * fq) * 4) = y; }
            const float dec = __expf(acs[63]);
            bf16x8 xw[2];
#pragma unroll
            for (int lb = 0; lb < 2; ++lb) { const bf16x8 xf = tr_pair<false>(img + MP_XDT, 32 * lb + 8 * fq, 32 * lb + 8 * fq + 4, 16 * pw, lane);
                const f32x4 w0 = *(const LAS f32x4*)((const LAS float*)(img + MP_W) + 32 * lb + 8 * fq), w1 = *(const LAS f32x4*)((const LAS float*)(img + MP_W) + 32 * lb + 8 * fq + 4);
                u32x4 o; o.x = pk2(bf2f((bf16_t)xf[0]) * w0[0], bf2f((bf16_t)xf[1]) * w0[1]); o.y = pk2(bf2f((bf16_t)xf[2]) * w0[2], bf2f((bf16_t)xf[3]) * w0[3]);
                o.z = pk2(bf2f((bf16_t)xf[4]) * w1[0], bf2f((bf16_t)xf[5]) * w1[1]); o.w = pk2(bf2f((bf16_t)xf[6]) * w1[2], bf2f((bf16_t)xf[7]) * w1[3]); xw[lb] = __builtin_bit_cast(bf16x8, o); }
#pragma unroll
            for (int np = 0; np < 4; ++np) { bf16x8 av[2][2];
#pragma unroll
                for (int q = 0; q < 2; ++q)
#pragma unroll
                    for (int lb = 0; lb < 2; ++lb) av[q][lb] = tr_pair<true>(img + MP_BM, 32 * lb + 8 * fq, 32 * lb + 8 * fq + 4, 16 * (2 * np + q), lane);
#pragma unroll
                for (int q = 0; q < 2; ++q) { Z[2 * np + q] *= dec;
#pragma unroll
                    for (int lb = 0; lb < 2; ++lb) Z[2 * np + q] = MFMA16(av[q][lb], xw[lb], Z[2 * np + q]); } }
        }
    };
    auto S3 = [&](const int cp, const float (&xs)[8], const u32x4 zw) __attribute__((always_inline)) {
        const LAS unsigned char* yb = lds + MP_Y0 + (cp & 1) * MP_YSZ; const size_t t0 = tb + 64 * cp;
        const f32x4 a0 = *(const LAS f32x4*)(yb + MP_YD + l * MB_YSTR + pc * 32), a1 = *(const LAS f32x4*)(yb + MP_YD + l * MB_YSTR + pc * 32 + 16);
        const f32x4 b0 = *(const LAS f32x4*)(yb + MP_YO + l * MB_YSTR + pc * 32), b1 = *(const LAS f32x4*)(yb + MP_YO + l * MB_YSTR + pc * 32 + 16);
        float y[8];
        y[0] = (a0[0] + b0[0] + D_h * xs[0]) * bf_lo(zw.x); y[1] = (a0[1] + b0[1] + D_h * xs[1]) * bf_hi(zw.x);
        y[2] = (a0[2] + b0[2] + D_h * xs[2]) * bf_lo(zw.y); y[3] = (a0[3] + b0[3] + D_h * xs[3]) * bf_hi(zw.y);
        y[4] = (a1[0] + b1[0] + D_h * xs[4]) * bf_lo(zw.z); y[5] = (a1[1] + b1[1] + D_h * xs[5]) * bf_hi(zw.z);
        y[6] = (a1[2] + b1[2] + D_h * xs[6]) * bf_lo(zw.w); y[7] = (a1[3] + b1[3] + D_h * xs[7]) * bf_hi(zw.w);
        float ss = 0.f;
#pragma unroll
        for (int e = 0; e < 8; ++e) ss += y[e] * y[e];
        ss += __shfl_xor(ss, 1); ss += __shfl_xor(ss, 2); ss += __shfl_xor(ss, 4);
        if (pc == 0) ssq_out[(t0 + l) * 32 + h] = ss;
        u32x4 w; w.x = pk2(y[0], y[1]); w.y = pk2(y[2], y[3]); w.z = pk2(y[4], y[5]); w.w = pk2(y[6], y[7]); *(u32x4*)(outp + (t0 + l) * opitch + 64 * h + 8 * pc) = w;
    };
#define MB_Z(c_) __builtin_nontemporal_load((const u32x4*)(act + (tb + 64 * (c_) + l) * ACT_P + 1024 + 64 * h + 8 * pc))
    float xsA[8], xsB[8]; u32x4 zA, zB;
    MB_LOAD(0);
    __syncthreads();
    S1(0, xsA); zA = MB_Z(0);
    __syncthreads();
#pragma unroll 1
    for (int c = 0; c < 64; c += 2) {
        if (wid < 4) S2(c);
        if (c > 0) S3(c - 1, xsB, zB);
        S1(c + 1, xsB); zB = MB_Z(c + 1);
        if (wid >= 4) S2(c);
        __syncthreads();
        if (wid < 4) S2(c + 1);
        S3(c, xsA, zA);
        if (c + 2 < 64) { S1(c + 2, xsA); zA = MB_Z(c + 2); }
        if (wid >= 4) S2(c + 1);
        __syncthreads();
    }
    S3(63, xsB, zB);
#undef MB_LOAD
#undef MB_Z
    __syncthreads();
}
constexpr int RT_W = 0, RT_CNT = 131072, RT_BASE = 131072 + 128;
constexpr int MO_TS = 131072 + 256, MO_CNT = 131072 + 512;

DI void router_phase(LAS unsigned char* lds, int vcu, int G, const float* x1, const float* norm_ffn, const float* w_router, const float* b_router,
                     unsigned char* h2, int* sel_e, int* sel_r, float* sel_w, int* tokl, unsigned* gcnt) {
    const int tid = threadIdx.x, lane = tid & 63, wid = __builtin_amdgcn_readfirstlane(tid >> 6), l31 = lane & 31, hi = lane >> 5;
    LAS float* Wl = (LAS float*)(lds + RT_W); LAS unsigned* lcnt = (LAS unsigned*)(lds + RT_CNT); LAS unsigned* lbase = (LAS unsigned*)(lds + RT_BASE);
    for (int idx = tid; idx < 1024 * 8; idx += 512) { const f32x4 w = *(const f32x4*)(w_router + 4 * idx); const float gk = norm_ffn[idx >> 3]; LAS float* p = Wl + 4 * idx; p[0] = w[0] * gk; p[1] = w[1] * gk; p[2] = w[2] * gk; p[3] = w[3] * gk; }
    if (tid < 32) lcnt[tid] = 0u;
    __syncthreads();
    if (wid >= 4) {
        for (int m = (vcu * 4 + (wid - 4)) * 4; m < T; m += G * 16) rms_rows_to_fp8<4>(x1 + (size_t)m * 1024, h2 + (size_t)m * 1024, norm_ffn, lane);
    } else
    for (int tile = vcu + G * wid; tile < T / 32; tile += G * 4) {
        const int t0 = tile * 32;
        f32x16 acc;
#pragma unroll
        for (int r = 0; r < 16; ++r) acc[r] = 0.f;
        float ssq = 0.f;
        const float* xr = x1 + (size_t)(t0 + l31) * 1024 + 4 * hi;
#pragma unroll 4
        for (int c = 0; c < 128; ++c) {
            const f32x4 xv = *(const f32x4*)(xr + 8 * c);
            ssq += (xv[0] * xv[0] + xv[1] * xv[1]) + (xv[2] * xv[2] + xv[3] * xv[3]);
#pragma unroll
            for (int u = 0; u < 4; ++u) { const float a = Wl[(8 * c + 4 * hi + u) * 32 + l31]; acc = __builtin_amdgcn_mfma_f32_32x32x2f32(a, xv[u], acc, 0, 0, 0); }
        }
        ssq += __shfl_xor(ssq, 32);
        const float rstd = __builtin_amdgcn_rsqf(ssq * (1.f / 1024.f) + EPS);
        float lg[16];
#pragma unroll
        for (int r = 0; r < 16; ++r) lg[r] = acc[r] * rstd + b_router[crow(r, hi)];
        float sv[4]; int si[4];
#pragma unroll
        for (int k = 0; k < 4; ++k) {
            float bv = lg[0]; int bi = crow(0, hi);
#pragma unroll
            for (int r = 1; r < 16; ++r) { const int id = crow(r, hi); if (lg[r] > bv) { bv = lg[r]; bi = id; } }
            const float pv = __shfl_xor(bv, 32); const int pi = __shfl_xor(bi, 32);
            if (pv > bv || (pv == bv && pi < bi)) { bv = pv; bi = pi; }
            sv[k] = bv; si[k] = bi;
#pragma unroll
            for (int r = 0; r < 16; ++r) if (crow(r, hi) == bi) lg[r] = -INFINITY;
        }
        const float e1 = __expf(sv[1] - sv[0]), e2 = __expf(sv[2] - sv[0]), e3 = __expf(sv[3] - sv[0]), inv = 1.0f / (1.0f + e1 + e2 + e3);
        if (hi == 0) {
            const int t = t0 + l31; const float wv[4] = {inv, e1 * inv, e2 * inv, e3 * inv};
#pragma unroll
            for (int k = 0; k < 4; ++k) { const unsigned lr = atomicAdd((unsigned*)&lcnt[si[k]], 1u); sel_e[t * 4 + k] = si[k]; sel_r[t * 4 + k] = (int)lr; sel_w[t * 4 + k] = wv[k]; }
        }
    }
    __syncthreads();
    if (tid < 32) lbase[tid] = atomicAdd(&gcnt[tid], lcnt[tid]);
    __syncthreads();
    if (wid < 4) for (int tile = vcu + G * wid; tile < T / 32; tile += G * 4) {
        if (hi == 0) { const int t = tile * 32 + l31;
#pragma unroll
            for (int k = 0; k < 4; ++k) { const int e = sel_e[t * 4 + k]; const int r = sel_r[t * 4 + k] + (int)lbase[e]; sel_r[t * 4 + k] = r; tokl[(size_t)e * T + r] = t; } }
    }
}

DI int moe_tables(LAS unsigned char* lds, const unsigned* gcnt) {
    LAS int* ts = (LAS int*)(lds + MO_TS); LAS int* cn = (LAS int*)(lds + MO_CNT);
    __syncthreads();
    if (threadIdx.x < 32) cn[threadIdx.x] = (int)gcnt[threadIdx.x];
    __syncthreads();
    if (threadIdx.x == 0) { int s = 0; for (int e = 0; e < NEXP; ++e) { ts[e] = s; s += (cn[e] + 255) >> 8; } ts[NEXP] = s; }
    __syncthreads();
    return ts[NEXP];
}

DI void combine_phase(LAS unsigned char* lds, int vcu, int G, int tlo, int thi, const bf16_t* y, const int* sel_e, const int* sel_r, const float* sel_w, const float* x1, float* out, float wscale) {
    const int lane = threadIdx.x & 63, wid = threadIdx.x >> 6; const LAS int* ts = (const LAS int*)(lds + MO_TS);
    for (int tb = (vcu * 8 + wid) * 4; tb < T; tb += G * 32) {
        int rowi[4][4]; float wv[4][4];
#pragma unroll
        for (int q = 0; q < 4; ++q) { const int4 e4 = *(const int4*)(sel_e + (tb + q) * 4), r4 = *(const int4*)(sel_r + (tb + q) * 4); const f32x4 w4 = *(const f32x4*)(sel_w + (tb + q) * 4);
            const int ee[4] = {e4.x, e4.y, e4.z, e4.w}, rr[4] = {r4.x, r4.y, r4.z, r4.w};
#pragma unroll
            for (int k = 0; k < 4; ++k) { const int row = ts[ee[k]] * 256 + rr[k], tile = row >> 8; const bool in = tile >= tlo && tile < thi; rowi[q][k] = in ? row - tlo * 256 : -1; wv[q][k] = w4[k] * wscale; } }
#pragma unroll
        for (int q = 0; q < 4; ++q) {
            float* op = out + (size_t)(tb + q) * 1024 + 8 * lane; const float* xp = x1 + (size_t)(tb + q) * 1024 + 8 * lane;
            f32x4 a0 = __builtin_nontemporal_load((const f32x4*)xp), a1 = __builtin_nontemporal_load((const f32x4*)(xp + 4)), a2 = __builtin_nontemporal_load((const f32x4*)(xp + 512)), a3 = __builtin_nontemporal_load((const f32x4*)(xp + 516));
            u32x4 v0[4], v1[4];
#pragma unroll
            for (int k = 0; k < 4; ++k) { v0[k] = (u32x4){0u, 0u, 0u, 0u}; v1[k] = v0[k]; if (rowi[q][k] >= 0) { const bf16_t* yp = y + (size_t)rowi[q][k] * 1024 + 8 * lane; v0[k] = __builtin_nontemporal_load((const u32x4*)yp); v1[k] = __builtin_nontemporal_load((const u32x4*)(yp + 512)); } }
#pragma unroll
            for (int k = 0; k < 4; ++k) { const float w = wv[q][k];
                a0[0] += w * bf_lo(v0[k].x); a0[1] += w * bf_hi(v0[k].x); a0[2] += w * bf_lo(v0[k].y); a0[3] += w * bf_hi(v0[k].y);
                a1[0] += w * bf_lo(v0[k].z); a1[1] += w * bf_hi(v0[k].z); a1[2] += w * bf_lo(v0[k].w); a1[3] += w * bf_hi(v0[k].w);
                a2[0] += w * bf_lo(v1[k].x); a2[1] += w * bf_hi(v1[k].x); a2[2] += w * bf_lo(v1[k].y); a2[3] += w * bf_hi(v1[k].y);
                a3[0] += w * bf_lo(v1[k].z); a3[1] += w * bf_hi(v1[k].z); a3[2] += w * bf_lo(v1[k].w); a3[3] += w * bf_hi(v1[k].w); }
            __builtin_nontemporal_store(a0, (f32x4*)op); __builtin_nontemporal_store(a1, (f32x4*)(op + 4)); __builtin_nontemporal_store(a2, (f32x4*)(op + 512)); __builtin_nontemporal_store(a3, (f32x4*)(op + 516));
        }
    }
}
#define XB_TMO      128
#define XB_XCNT(j)  (256  + 64 * (j))
#define XB_XSUB(j)  (1280 + 64 * (j))
#define XB_XGEN(j)  (2304 + 64 * (j))
#define XB_TOP      3328
#define XB_TOPGEN   3392
#define XCD_BAR_WORDS 3456
#define XB_SPIN_CAP (1u << 18)

__device__ __forceinline__ unsigned xb_ld(unsigned* p)              { return __hip_atomic_load(p, __ATOMIC_RELAXED, __HIP_MEMORY_SCOPE_AGENT); }
__device__ __forceinline__ unsigned xb_add(unsigned* p, unsigned v) { return __hip_atomic_fetch_add(p, v, __ATOMIC_RELAXED, __HIP_MEMORY_SCOPE_AGENT); }
__device__ __forceinline__ unsigned xb_xcc_id() { return (unsigned)__builtin_amdgcn_s_getreg((3 << 11) | 20) & 0xFu; }
#define XB_SPIN(cond, bar) do { unsigned _sp = 0; while (cond) { __builtin_amdgcn_s_sleep(1); \
    if ((++_sp & 255u) == 0u) { if (xb_ld(&(bar)[XB_TMO])) break; if (_sp > XB_SPIN_CAP) { atomicAdd(&(bar)[XB_TMO], 1u); break; } } } } while (0)

struct XcdBarrier {
    unsigned* bar; unsigned x;
    volatile LAS unsigned* st;
};

__device__ __forceinline__ XcdBarrier xcd_barrier_post(unsigned* bar, volatile LAS unsigned* st) {
    XcdBarrier b; b.bar = bar; b.x = xb_xcc_id(); b.st = st;
    if (threadIdx.x == 0) (void)xb_add(&bar[XB_XCNT(b.x)], 1u);
    return b;
}
__device__ __forceinline__ void xcd_barrier_complete(unsigned* bar, unsigned x, unsigned& nloc, unsigned& nx) {
    const unsigned G = gridDim.x * gridDim.y * gridDim.z;
    unsigned sum, cnt, mine, sp = 0u;
    for (;;) {
        sum = 0u; cnt = 0u; mine = 0u;
#pragma unroll
        for (unsigned j = 0; j < 16; ++j) { const unsigned c = xb_ld(&bar[XB_XCNT(j)]); sum += c; cnt += (c > 0u) ? 1u : 0u; mine = (j == x) ? c : mine; }
        if (sum == G) break;
        __builtin_amdgcn_s_sleep(1);
        if ((++sp & 255u) == 0u) { if (xb_ld(&bar[XB_TMO])) break; if (sp > XB_SPIN_CAP) { atomicAdd(&bar[XB_TMO], 1u); break; } }
    }
    nloc = mine > 0u ? mine : 1u; nx = cnt > 0u ? cnt : 1u;
}

__device__ __forceinline__ void xcd_barrier(const XcdBarrier& b) {
    asm volatile("s_waitcnt vmcnt(0)" ::: "memory");
    __syncthreads();
    if (threadIdx.x == 0) {
        unsigned* bar = b.bar;
        __builtin_amdgcn_s_waitcnt(0);
        unsigned nloc = b.st[0], nx = b.st[1];
        if (nloc == 0u) { xcd_barrier_complete(bar, b.x, nloc, nx); b.st[0] = nloc; b.st[1] = nx; }
        const unsigned old = xb_add(&bar[XB_XSUB(b.x)], 1u);
        const unsigned gen = old / nloc;
        if (old + 1u == (gen + 1u) * nloc) {
            __builtin_amdgcn_fence(__ATOMIC_RELEASE, "agent");
            asm volatile("s_waitcnt vmcnt(0)" ::: "memory");
            const unsigned og = xb_add(&bar[XB_TOP], 1u);
            const unsigned tg = og / nx;
            if (og + 1u == (tg + 1u) * nx) xb_add(&bar[XB_TOPGEN], 1u);
            else XB_SPIN(xb_ld(&bar[XB_TOPGEN]) == tg, bar);
            __builtin_amdgcn_fence(__ATOMIC_ACQUIRE, "agent");
            xb_add(&bar[XB_XGEN(b.x)], 1u);
            asm volatile("s_waitcnt vmcnt(0)" ::: "memory");
        } else {
            XB_SPIN(xb_ld(&bar[XB_XGEN(b.x)]) == gen, bar);
            __builtin_amdgcn_fence(__ATOMIC_ACQUIRE, "agent");
            asm volatile("s_waitcnt vmcnt(0)" ::: "memory");
        }
    }
    __syncthreads();
}


#ifndef MK_N_LAUNCHES
#define MK_N_LAUNCHES 1
#endif
#ifndef MK_BRANCHES
#define MK_BRANCHES 15
#endif
constexpr int N_PHASES = 12;
#ifndef MK_PROBE_BLOCK
#define MK_PROBE_BLOCK 65
#endif
#ifndef MK_USE_CG
#define MK_USE_CG 0
#endif
constexpr int LDS_BARST = 163840 - 64;
constexpr int CW_BAR = 4096;
constexpr int LDS_BYTES = 163840;
constexpr int NTHREADS = 512;

struct Args { const float* in[30]; float* out; unsigned char* ws; int ph_lo, ph_hi; };
enum { I_x = 0, I_mem = 1, I_norm_mix = 2, I_w_in = 3, I_a_q_gain = 4, I_a_k_gain = 5, I_a_rel_bias = 6, I_conv_w = 7, I_conv_b = 8, I_dt_bias = 9, I_a_log = 10, I_d_skip = 11, I_ssm_norm = 12, I_norm_mem = 13, I_w_mem_kv = 14, I_x_q_gain = 15, I_x_k_gain = 16, I_w_br_a = 17, I_w_br_b = 18, I_w_br_c = 19, I_w_out = 20, I_norm_ffn = 21, I_w_router = 22, I_b_router = 23, I_w_gate = 24, I_b_gate = 25, I_w_up = 26, I_b_up = 27, I_w_down = 28, I_b_down = 29 };

#define WIN WSP(bf16_t, WS_WIN)
#define WCAT WSP(bf16_t, WS_WCAT)
#define WOUT WSP(bf16_t, WS_WOUT)
#define WMEM WSP(bf16_t, WS_WMEM)
#define DTB WSP(float, WS_DT)
#define SSQ WSP(float, WS_SSQ)
#define RSTD WSP(float, WS_RSTD)
#define KX WSP(bf16_t, WS_KX)
#define MEMKV WSP(bf16_t, WS_MEMKV)
#define XN WSP(bf16_t, WS_XN)
#define MEMN WSP(bf16_t, WS_MEMN)
#define ACT WSP(bf16_t, WS_ACT)
#define KA WSP(bf16_t, WS_KA)
#define VA WSP(bf16_t, WS_VA)
#define XBC WSP(bf16_t, WS_XBC)
#define GATES WSP(bf16_t, WS_GATES)
#define MERGED WSP(bf16_t, WS_MERGED)
#define H2 WSP(unsigned char, MOE_H2)
#define WGU ((unsigned char*)(GAS unsigned char*)kq[30] + OUT_WGU)
#define WD ((unsigned char*)(GAS unsigned char*)kq[30] + OUT_WD)
#define X1 WSP(float, WS_X1)
#define ACTM WSP(unsigned char, MOE_ACTM)
#define YB WSP(bf16_t, MOE_Y)
#define SELE WSP(int, MOE_SELE)
#define SELR WSP(int, MOE_SELR)
#define SELW WSP(float, MOE_SELW)
#define TOKL WSP(int, MOE_TOKL)
#define GCNT (WSP(unsigned, WS_CTL) + CW_CNT)
#define ACSB ((float*)(GAS float*)kq[30] + (size_t)T * 512)
#define BCC ((bf16_t*)(GAS bf16_t*)kq[30])
#define EI_INIT const EpiIn EI{ws, AP(a_q_gain), AP(a_k_gain), AP(dt_bias)}
typedef const __attribute__((address_space(4))) unsigned long long* KW;
DI KW launder(KW p) { asm volatile("" : "+s"(p)); return p; }
#define AP(name) ((const float*)(const GAS float*)kq[I_##name])
#define PHASE_ARGS const KW kq = launder(kp); unsigned char* const ws = (unsigned char*)(GAS unsigned char*)kq[31]; (void)ws
#define WSP(type, off) ((type*)(ws + (off)))
__global__ void __launch_bounds__(NTHREADS, 2) mega_fwd(Args a_unused) {
    extern __shared__ __attribute__((aligned(16))) unsigned char lds_raw[];
    LAS unsigned char* lds = (LAS unsigned char*)lds_raw;
    const KW kp = (KW)__builtin_amdgcn_kernarg_segment_ptr();
    const int tid = threadIdx.x, lane = tid & 63, wid = __builtin_amdgcn_readfirstlane(tid >> 6);
    const int G = gridDim.x, bx = blockIdx.x, vcu = (G % 8 == 0) ? (bx % 8) * (G / 8) + bx / 8 : bx;
    const int lo = (int)(unsigned)kp[32], hi = (int)(kp[32] >> 32);
#ifndef MK_PHASE_MASK
#define MK_PHASE_MASK 0x7fff
#endif
#define IN(k) (((MK_PHASE_MASK >> (k)) & 1) && lo <= (k) && (k) < hi)
#ifndef MK_REP_MASK
#define MK_REP_MASK 0
#endif
#define REPS(k) (((MK_REP_MASK >> (k)) & 1) + 1)
#if MK_USE_CG
#define SEAM(k) do { if (IN(k) && IN((k) + 1)) { cg::this_grid().sync(); } } while (0)
#else
#define GEMM_SEAM(k) ((k) == 1 || (k) == 3 || (k) == 5 || (k) == 6 || (k) == 7 || (k) == 9 || (k) == 10)
#define SEAM(k) do { if (IN(k) && IN((k) + 1)) { const bool pr_ = (MK_PROBE == 901 && GEMM_SEAM(k)) || (MK_PROBE == 902 && !GEMM_SEAM(k)) || (MK_PROBE == 910 + (k)); unsigned long long t0_ = 0; if (pr_) t0_ = rtc(); xcd_barrier(bar); if (pr_) pacc += rtc() - t0_; } } while (0)
#endif
    const int gw = vcu * 8 + wid, NGW = G * 8;
    unsigned long long pacc = 0;
    for (int u = tid; u < 16; u += NTHREADS) ((LAS unsigned*)(lds + LDS_BARST))[u] = 0u;
    __syncthreads();
    XcdBarrier bar = xcd_barrier_post((unsigned*)(GAS unsigned*)(kp[31]) + CW_BAR, (volatile LAS unsigned*)(lds + LDS_BARST));
    LAS float* scr = (LAS float*)(lds + wid * 16896);

    if (IN(0)) { PHASE_ARGS;
        constexpr int I_IN = 16 * 196, I_MEM = 16 * 32, I_A = 16 * 16, I_B = 32 * 16, I_C = 16 * 16, I_O = 16 * 16, NIT = I_IN + I_MEM + I_A + I_B + I_C + I_O;
        auto mk = [&](int it0) -> TrItem { int r = it0 % NIT; TrItem t; t.kscale = nullptr; t.mul = 1.0f; t.fp8 = 0;
            if (r < I_IN) { const int kb = r / 196, nb = r % 196; t.W = AP(w_in); t.Ns = IN_COLS; t.k0 = 64 * kb; t.sc0 = win_src_col(2 * nb); t.sc1 = win_src_col(2 * nb + 1); t.dst = WIN + (size_t)(64 * nb) * 1024 + 64 * kb; t.dpitch = 1024; return t; } r -= I_IN;
            if (r < I_MEM) { const int kb = r / 32, nb = r % 32; t.W = AP(w_mem_kv); t.Ns = 2048; t.k0 = 64 * kb; t.sc0 = 64 * nb; t.sc1 = 64 * nb + 32; t.dst = WMEM + (size_t)(64 * nb) * 1024 + 64 * kb; t.dpitch = 1024; return t; } r -= I_MEM;
            if (r < I_A) { const int kb = r / 16, nb = r % 16; t.W = AP(w_br_a); t.Ns = 1024; t.k0 = 64 * kb; t.sc0 = 64 * nb; t.sc1 = 64 * nb + 32; t.dst = WCAT + (size_t)(64 * nb) * 4096 + 64 * kb; t.dpitch = 4096; return t; } r -= I_A;
            if (r < I_B) { const int kb = r / 16, nb = r % 16; t.W = AP(w_br_b); t.Ns = 1024; t.k0 = 64 * kb; t.sc0 = 64 * nb; t.sc1 = 64 * nb + 32; t.dst = WCAT + (size_t)(64 * nb) * 4096 + 1024 + 64 * kb; t.dpitch = 4096; t.kscale = AP(ssm_norm); return t; } r -= I_B;
            if (r < I_C) { const int kb = r / 16, nb = r % 16; t.W = AP(w_br_c); t.Ns = 1024; t.k0 = 64 * kb; t.sc0 = 64 * nb; t.sc1 = 64 * nb + 32; t.dst = WCAT + (size_t)(64 * nb) * 4096 + 3072 + 64 * kb; t.dpitch = 4096; return t; } r -= I_C;
            { const int kb = r / 16, nb = r % 16; t.W = AP(w_out); t.Ns = 1024; t.k0 = 64 * kb; t.sc0 = 64 * nb; t.sc1 = 64 * nb + 32; t.dst = WOUT + (size_t)(64 * nb) * 1024 + 64 * kb; t.dpitch = 1024; return t; } };
        { const int nitems = NIT * REPS(0); f32x4 va[16], vb[16]; TrItem ia, ib; int it = gw;
          if (it < nitems) { ia = mk(it); tr_load(ia, va, lane); }
          while (it < nitems) {
              const int i2 = it + NGW; if (i2 < nitems) { ib = mk(i2); tr_load(ib, vb, lane); }
              tr_store(ia, va, scr, lane);
              if (i2 >= nitems) break;
              const int i3 = i2 + NGW; if (i3 < nitems) { ia = mk(i3); tr_load(ia, va, lane); }
              tr_store(ib, vb, scr, lane);
              it = i3; } }
        for (int m0 = gw * 4; m0 < T * REPS(0); m0 += NGW * 4) { const int m = m0 % T; rms_rows_to_bf16<4>(AP(x) + (size_t)m * 1024, XN + (size_t)m * 1024, 1, AP(norm_mix), lane); }
        for (int m = gw; m < NBATCH * MEMLEN; m += NGW) rms_rows_to_bf16<1>(AP(mem) + (size_t)m * 1024, MEMN + (size_t)m * 1024, 1, AP(norm_mem), lane);
    }
    SEAM(0);
    if (IN(1)) { PHASE_ARGS; EI_INIT;
        const SchedIn S{G, bx, 16, TL_Q, 12, TL_QX, 0, (const char*)WIN, (const char*)WMEM, REPS(1), 0, 1 << 30};
        pg8::gemm_phase<false>(lds, (const char*)XN, 2048, 2048, S, EI);
    }
    SEAM(1);
    if (IN(2)) { PHASE_ARGS;
        if (MK_BRANCHES & 1) {
            LAS float* bl = (LAS float*)(lds + AT_BIAS);
            for (int i = tid; i < 16 * 257; i += NTHREADS) bl[(i / 257) * AT_BIAS_STRIDE + (i % 257)] = AP(a_rel_bias)[i] * LOG2E;
            __syncthreads();
            for (int u = vcu; u < 4 * NBATCH * 32; u += G) { const int cp = u & 31, b = (u >> 5) & 7, hq = u >> 8; attnA_unit(lds, b, cp, hq, ACT, KA, VA, ACT, ACT_P); }
        } else {
            for (int idx = vcu * NTHREADS + tid; idx < T * 128; idx += G * NTHREADS) { const int t = idx >> 7, ch = idx & 127; *(u32x4*)(ACT + (size_t)t * ACT_P + ch * 8) = (u32x4){0u, 0u, 0u, 0u}; }
        }
    }
    SEAM(2);
    if (IN(3)) { PHASE_ARGS; EI_INIT;
        const SchedIn S{G, bx, 21, TL_Z, 21, 0, 64, (const char*)WIN, (const char*)WMEM, REPS(3), 0, 1 << 30};
        pg8::gemm_phase<false>(lds, (const char*)XN, 2048, 2048, S, EI);
    }
    SEAM(3);
    if (IN(4)) { PHASE_ARGS;
        if (MK_BRANCHES & 2) bcconv_phase(vcu, G, XBC, BCC, AP(conv_w), AP(conv_b), DTB, ACSB, AP(a_log));
        for (int w = gw; w < NBATCH * MEMLEN * 4; w += NGW) {
            const int row = w >> 2, hx = w & 3; const u32x2 kv = *(const u32x2*)(MEMKV + (size_t)row * 2048 + 256 * hx + 4 * lane);
            const float k0 = bf_lo(kv.x), k1 = bf_hi(kv.x), k2 = bf_lo(kv.y), k3 = bf_hi(kv.y);
            const float rs = __builtin_amdgcn_rsqf(wave_sum(k0 * k0 + k1 * k1 + k2 * k2 + k3 * k3) * (1.f / 256.f) + EPS) * (0.0625f * LOG2E);
            const f32x4 gk = *(const f32x4*)(AP(x_k_gain) + 4 * lane), gq = *(const f32x4*)(AP(x_q_gain) + 4 * lane);
            u32x2 o; o.x = pk2(k0 * rs * gk.x * gq.x, k1 * rs * gk.y * gq.y); o.y = pk2(k2 * rs * gk.z * gq.z, k3 * rs * gk.w * gq.w);
            *(u32x2*)(KX + (size_t)row * 1024 + 256 * hx + 4 * lane) = o;
        }
        xcd_barrier(bar);
        if (MK_BRANCHES & 4) attnC_phase(lds, vcu, G, ACT, KX, MEMKV, ACT + 3072, ACT_P);
        if (MK_BRANCHES & 2) { int nrep = 1 + (MK_REP_MASK >> 4 & 1); asm volatile("" : "+s"(nrep));
#pragma unroll 1
            for (int rep = 0; rep < nrep; ++rep) { const bool real = rep == nrep - 1;
                for (int u = vcu; u < NBATCH * 32; u += G) mamba_unit(lds, u >> 5, u & 31, XBC, BCC, DTB, ACSB, ACT, SSQ, real ? ACT + 1024 : (bf16_t*)RSTD, real ? (size_t)ACT_P : (size_t)0, AP(conv_w), AP(conv_b), AP(a_log), AP(d_skip)); } }
    }
    SEAM(4);
    if (IN(5)) { PHASE_ARGS; EI_INIT;
        for (int idx = vcu * NTHREADS + tid; idx < T * 4; idx += G * NTHREADS) { const int t = idx >> 2, g = idx & 3; const f32x4 s0 = *(const f32x4*)(SSQ + (size_t)t * 32 + 8 * g), s1 = *(const f32x4*)(SSQ + (size_t)t * 32 + 8 * g + 4);
            RSTD[idx] = __builtin_amdgcn_rsqf(((s0[0] + s0[1]) + (s0[2] + s0[3]) + (s1[0] + s1[1]) + (s1[2] + s1[3])) * (1.f / 512.f) + EPS); }
        int jslot = (bx >> 3) % 7; asm volatile("" : "+s"(jslot));
        { const SchedIn S{G, bx, 12, TL_G, 12, 0, 0, (const char*)WIN, (const char*)WMEM, REPS(5), 0, jslot};
          pg8::gemm_phase<false>(lds, (const char*)XN, 2048, 2048, S, EI); }
        if (MK_BRANCHES & 8) {
            auto mk = [&](int it) -> TrItem { const int e = it / 768, r = it % 768, which = r >> 8, kb = (r & 255) >> 4, nb = r & 15; TrItem t;
                t.W = (which == 0 ? AP(w_gate) : which == 1 ? AP(w_up) : AP(w_down)) + (size_t)e * 1024 * 1024; t.Ns = 1024; t.k0 = 64 * kb; t.sc0 = 64 * nb; t.sc1 = 64 * nb + 32; t.dpitch = 1024; t.kscale = nullptr; t.mul = 32.0f; t.fp8 = 1;
                t.dst = which == 2 ? (void*)(WD + ((size_t)e * 1024 + 64 * nb) * 1024 + 64 * kb) : (void*)(WGU + ((size_t)e * 2048 + 256 * (nb >> 1) + 128 * which + 64 * (nb & 1)) * 1024 + 64 * kb); return t; };
            __syncthreads(); tr_run(mk, NEXP * 768, gw, NGW, scr, lane); __syncthreads();
        }
        { const KW kq2 = launder(kp); int js2 = (bx >> 3) % 7; asm volatile("" : "+s"(js2));
          const EpiIn EI2{(unsigned char*)(GAS unsigned char*)kq2[31], (const float*)(const GAS float*)kq2[I_a_q_gain], (const float*)(const GAS float*)kq2[I_a_k_gain], (const float*)(const GAS float*)kq2[I_dt_bias]};
          const SchedIn S{G, bx, 12, TL_G, 12, 0, 0, (const char*)((unsigned char*)(GAS unsigned char*)kq2[31] + WS_WIN), (const char*)((unsigned char*)(GAS unsigned char*)kq2[31] + WS_WMEM), REPS(5), js2, 1 << 30};
          pg8::gemm_phase<false>(lds, (const char*)((unsigned char*)(GAS unsigned char*)kq2[31] + WS_XN), 2048, 2048, S, EI2); }
    }
    SEAM(5);
    if (IN(6)) { PHASE_ARGS;
        constexpr int LASTSEG = (MK_BRANCHES & 4) ? 2 : ((MK_BRANCHES & 2) ? 1 : 0);
        constexpr int KM = LASTSEG == 2 ? 4096 : (LASTSEG == 1 ? 3072 : 1024);
        const SchedDense S{G, bx, T / 256, 4, 4096, (const char*)WCAT, REPS(6)};
        const EpiMerge E{GATES, RSTD, MERGED, LASTSEG};
        pg8::gemm_phase<false>(lds, (const char*)ACT, KM * 2, 8192, S, E);
    }
    SEAM(6);
    if (IN(7)) { PHASE_ARGS;
        const SchedDense S{G, bx, T / 256, 4, 1024, (const char*)WOUT, REPS(7)};
        const EpiOut E{AP(x), X1};
        pg8::gemm_phase<false>(lds, (const char*)MERGED, 2048, 2048, S, E);
    }
    SEAM(7);
    if (IN(8) && (MK_BRANCHES & 8)) { PHASE_ARGS;
        { int nrep = 1 + (MK_REP_MASK >> 11 & 1); asm volatile("" : "+s"(nrep));
#pragma unroll 1
          for (int rep = 0; rep < nrep; ++rep) { const bool real = rep == nrep - 1; const size_t dm = real ? 0 : (MOE_ACTM - MOE_SELE);
            router_phase(lds, vcu, G, X1, AP(norm_ffn), AP(w_router), AP(b_router), H2, (int*)((char*)SELE + dm), (int*)((char*)SELR + dm), (float*)((char*)SELW + dm), (int*)((char*)TOKL + dm), GCNT + (real ? 0 : 64));
            __syncthreads(); } }
    }
    SEAM(8);
    {
        if ((MK_BRANCHES & 8) && (IN(9) || IN(10) || IN(11))) { PHASE_ARGS;
            const int total = moe_tables(lds, GCNT), tlo = 0, thi = total;
            const LAS int* ts = (const LAS int*)(lds + MO_TS); const LAS int* cn = (const LAS int*)(lds + MO_CNT);
            if (IN(9)) { const SchedMoE S{G, bx, 8, tlo, thi, ts, cn, TOKL, (const char*)WGU, (size_t)2048 * 1024, REPS(9), 1024u, 1024u}; const EpiGU E{ACTM, AP(b_gate), AP(b_up), tlo};
                pg8::gemm_phase<true>(lds, (const char*)H2, 1024, 1024, S, E); }
            SEAM(9);
            if (IN(10)) { const SchedMoE S{G, bx, 4, tlo, thi, ts, cn, nullptr, (const char*)WD, (size_t)1024 * 1024, REPS(10), 1024u, 1024u}; const EpiDown E{YB, AP(b_down), tlo};
                pg8::gemm_phase<true>(lds, (const char*)ACTM, 1024, 1024, S, E); }
            SEAM(10);
            if (IN(11)) { int nrep = 1 + (MK_REP_MASK >> 12 & 1); asm volatile("" : "+s"(nrep));
#pragma unroll 1
                for (int rep = 0; rep < nrep; ++rep) combine_phase(lds, vcu, G, tlo, thi, YB, SELE, SELR, SELW, X1, ((float*)(GAS float*)kq[30]), 1.0f / (float)nrep); }
        } else { SEAM(9); SEAM(10); }
    }
    if (MK_PROBE && blockIdx.x == MK_PROBE_BLOCK && wid == 0) { const unsigned long long t_end = rtc() + pacc * 10ull; while (rtc() < t_end) __builtin_amdgcn_s_sleep(8); }
#undef IN
#undef SEAM
}

extern "C" void kernel_launch(void* const* d_in, const int* in_sizes, int n_in, void* d_out, int out_size, void* d_ws, size_t ws_size, hipStream_t stream) {
    static int grid = 0;
    if (grid == 0) {
        if (n_in != 30 || ws_size < WS_MIX_END || ws_size < WS_END) { fprintf(stderr, "kernel_launch: unexpected n_in %d / ws_size %zu\n", n_in, ws_size); grid = -1; return; }
        int dev = 0, cus = 0, per_cu = 0;
        (void)hipGetDevice(&dev); (void)hipDeviceGetAttribute(&cus, hipDeviceAttributeMultiprocessorCount, dev);
        (void)hipFuncSetAttribute((const void*)mega_fwd, hipFuncAttributeMaxDynamicSharedMemorySize, LDS_BYTES);
        (void)hipOccupancyMaxActiveBlocksPerMultiprocessor(&per_cu, (const void*)mega_fwd, NTHREADS, LDS_BYTES);
        if (per_cu < 1) { fprintf(stderr, "kernel_launch: occupancy query reports %d blocks per CU\n", per_cu); grid = -1; return; }
        grid = cus;
    }
    if (grid < 0) return;
    (void)hipMemsetAsync((char*)d_ws + WS_CTL, 0, 65536, stream);
    Args a{};
    for (int i = 0; i < 30; ++i) a.in[i] = (const float*)d_in[i];
    a.out = (float*)d_out; a.ws = (unsigned char*)d_ws;
    if (MK_N_LAUNCHES == 1) {
        a.ph_lo = 0; a.ph_hi = N_PHASES;
        void* args[] = {&a};
        hipError_t e = hipLaunchCooperativeKernel((void*)mega_fwd, dim3(grid), dim3(NTHREADS), args, LDS_BYTES, stream);
        if (e != hipSuccess) fprintf(stderr, "cooperative launch failed: %s (grid %d)\n", hipGetErrorString(e), grid);
    } else {
        for (int ph = 0; ph < N_PHASES; ++ph) { a.ph_lo = ph; a.ph_hi = ph + 1; hipLaunchKernelGGL(mega_fwd, dim3(grid), dim3(NTHREADS), LDS_BYTES, stream, a); }
    }
}
```

```cpp
#include <hip/hip_runtime.h>
#include <hip/hip_cooperative_groups.h>
#include <cstdio>
#include <cstdint>
namespace cg = cooperative_groups;

#define LAS __attribute__((address_space(3)))
#define GAS __attribute__((address_space(1)))
#define DI __device__ __forceinline__
typedef unsigned short bf16_t;
typedef short bf16x8 __attribute__((ext_vector_type(8)));
typedef short s16x4 __attribute__((ext_vector_type(4)));
typedef float f32x2 __attribute__((ext_vector_type(2)));
typedef float f32x4 __attribute__((ext_vector_type(4)));
typedef float f32x16 __attribute__((ext_vector_type(16)));
typedef unsigned u32x2 __attribute__((ext_vector_type(2)));
typedef unsigned u32x4 __attribute__((ext_vector_type(4)));
typedef __bf16 bf16x2_t __attribute__((ext_vector_type(2)));
typedef short v4i16_t __attribute__((ext_vector_type(4)));

DI unsigned pk2(float lo, float hi) { f32x2 v = {lo, hi}; bf16x2_t b = __builtin_convertvector(v, bf16x2_t); return __builtin_bit_cast(unsigned, b); }
DI float bf_lo(unsigned w) { return __uint_as_float(w << 16); }
DI float bf_hi(unsigned w) { return __uint_as_float(w & 0xffff0000u); }
DI float bf2f(bf16_t b) { return __uint_as_float(((unsigned)b) << 16); }
DI float wave_sum(float v) {
#pragma unroll
    for (int o = 1; o < 64; o <<= 1) v += __shfl_xor(v, o);
    return v;
}
DI float fast_exp2(float x) { return __builtin_amdgcn_exp2f(x); }
DI float fast_rcp(float x) { return __builtin_amdgcn_rcpf(x); }
DI float sigmoidf_(float x) { return fast_rcp(1.0f + fast_exp2(-1.4426950408889634f * x)); }

constexpr int NBATCH = 8, SEQ = 4096, T = NBATCH * SEQ, DM = 1024;
constexpr int NWIN_TILES = 49, NWIN = NWIN_TILES * 256;
constexpr int IN_COLS = 12320;
constexpr float EPS = 1e-6f;
constexpr float LOG2E = 1.4426950408889634f;
constexpr int NEXP = 32, TOPK = 4;
constexpr int MEMLEN = 256;
constexpr int ACT_P = 4096;
constexpr int TL_Q = 0, TL_K = 4, TL_V = 8, TL_Z = 12, TL_XBC = 20, TL_DT = 32, TL_QX = 33, TL_G = 37;

constexpr size_t MiB = (size_t)1 << 20;
constexpr size_t WS_CTL = 0, CTL_BYTES = 1 * MiB;
constexpr size_t WS_WIN = 1 * MiB, WS_WCAT = 26 * MiB, WS_WOUT = 34 * MiB, WS_WMEM = 36 * MiB;
constexpr size_t WS_DT = 40 * MiB, WS_SSQ = 44 * MiB, WS_RSTD = 48 * MiB, WS_KX = 49 * MiB, WS_MEMKV = 53 * MiB;
constexpr size_t WS_XN = 61 * MiB, WS_MEMN = 125 * MiB, WS_ACT = 129 * MiB, WS_BUF = 385 * MiB, WS_MIX_END = 577 * MiB;
constexpr size_t WS_KA = WS_BUF, WS_VA = WS_BUF + 64 * MiB, WS_XBC = WS_BUF, WS_GATES = WS_BUF, WS_MERGED = WS_XN;
constexpr int MOE_TILE_CAP = 280;
constexpr size_t MOE_H2 = 1 * MiB, MOE_ACTM = 33 * MiB, MOE_Y = 169 * MiB, WS_X1 = 441 * MiB;
constexpr size_t OUT_WGU = 0, OUT_WD = 64 * MiB;
constexpr size_t MOE_SELE = 569 * MiB, MOE_SELR = 569 * MiB + 512 * 1024, MOE_SELW = 570 * MiB, MOE_TOKL = 571 * MiB, WS_END = 575 * MiB;
constexpr int CW_CNT = 64;

#ifndef MK_KREP
#define MK_KREP 1
#endif
#ifndef MK_PROBE
#define MK_PROBE 0
#endif
DI unsigned long long rtc() { return __builtin_amdgcn_s_memrealtime(); }
#ifndef MK_NT_STORES
#define MK_NT_STORES 0
#endif
namespace pg8 {
constexpr int BM = 256, BK = 64, HALF = 128, HTB = HALF * BK * 2, STAGE_BYTES = 8 * HTB;
__host__ __device__ __forceinline__ int lds_byte(int r, int c) { const int st = (r >> 4) * 2 + (c >> 5), rr = r & 15, cc = c & 31, ob = rr * 64 + cc * 2; return st * 1024 + (ob ^ (((ob >> 9) & 1) << 5)); }
__host__ __device__ __forceinline__ void stage_rc(int b, int& R, int& C) { const int st = b / 1024, sb = b % 1024, swz = sb ^ (((sb >> 9) & 1) << 5); R = (st >> 1) * 16 + swz / 64; C = (st & 1) * 32 + (swz % 64) / 2; }
__host__ __device__ __forceinline__ int perm32(int rho) { const int n = rho >> 4, i = rho & 15; return 8 * (i >> 2) + 4 * n + (i & 3); }

struct Unit { int kind, pm, pn, aux; };

typedef f32x4 Acc[2][2][4][2];

typedef int v8i_t __attribute__((ext_vector_type(8)));
template <bool FP8, class Epi, class Sched>
DI void gemm_phase(LAS unsigned char* lds, const char* Abase, const int Kb, const int ldbb, const Sched& S, const Epi& E) {
    int tid_ = threadIdx.x; asm volatile("" : "+v"(tid_));
    const int tid = tid_, wid = __builtin_amdgcn_readfirstlane(tid >> 6), lane = tid & 63, wr = wid >> 2, wc = wid & 3, fr = lane & 15, fq = lane >> 4;
    const int nt = Kb / (BK * 2);
    int Rr[2], Cc2[2]; unsigned voffB[2];
#pragma unroll
    for (int i = 0; i < 2; ++i) { int R, C; stage_rc(tid * 16 + i * 8192, R, C); Rr[i] = R; Cc2[i] = C * 2; const int Rb = (R & ~31) + perm32(R & 31); voffB[i] = (unsigned)(Rb * ldbb + C * 2); }
    const unsigned kstep = (unsigned)(BK * 2);
    const size_t hstepB = (size_t)HALF * ldbb;
    const unsigned ldsw = (unsigned)wid * 1024u;
    const int aoff0 = lds_byte(wr * 64 + fr, fq * 8), aoff1 = aoff0 + 1024;
    const int boff0 = lds_byte(wc * 32 + fr, fq * 8), boff1 = boff0 + 1024;
#define PG8_SA(b, h) (((b) * 2 + (h)) * HTB)
#define PG8_SB(b, h) ((4 + (b) * 2 + (h)) * HTB)
#define PG8_GLDS(src, dstoff) __builtin_amdgcn_global_load_lds((const unsigned*)(src), (LAS unsigned*)(lds + (dstoff)), 16, 0, 0)
#define PG8_STAGE_B(bufoff, ptr) do { _Pragma("unroll") for (int _i = 0; _i < 2; ++_i) PG8_GLDS((const char*)(ptr) + voffB[_i], (bufoff) + ldsw + _i * 8192); } while (0)
#define PG8_STAGE_A(bufoff, kb, v0, v1) do { PG8_GLDS(Abase + (size_t)(v0) + (kb), (bufoff) + ldsw); PG8_GLDS(Abase + (size_t)(v1) + (kb), (bufoff) + ldsw + 8192); } while (0)
#define PG8_LDA(dst, b, h) do { _Pragma("unroll") for (int m = 0; m < 4; ++m) { dst[m][0] = *(const LAS u32x4*)(lds + PG8_SA(b, h) + aoff0 + m * 2048); dst[m][1] = *(const LAS u32x4*)(lds + PG8_SA(b, h) + aoff1 + m * 2048); } } while (0)
#define PG8_LDB(dst, b, h) do { _Pragma("unroll") for (int n = 0; n < 2; ++n) { dst[n][0] = *(const LAS u32x4*)(lds + PG8_SB(b, h) + boff0 + n * 2048); dst[n][1] = *(const LAS u32x4*)(lds + PG8_SB(b, h) + boff1 + n * 2048); } } while (0)
#define PG8_CAT(x) __builtin_bit_cast(v8i_t, __builtin_shufflevector((x)[0], (x)[1], 0, 1, 2, 3, 4, 5, 6, 7))
#define PG8_MMA(ai, bj, At, Bt) do { __builtin_amdgcn_s_setprio(1); _Pragma("unroll") for (int m = 0; m < 4; ++m) _Pragma("unroll") for (int n = 0; n < 2; ++n) { \
        if constexpr (FP8) asm volatile("v_mfma_scale_f32_16x16x128_f8f6f4 %0, %1, %2, %0, %3, %4 op_sel_hi:[0,0,0]" : "+v"(acc[ai][bj][m][n]) : "v"(PG8_CAT(Bt[n])), "v"(PG8_CAT(At[m])), "v"(sclB), "v"(sclA)); \
        else { _Pragma("unroll") for (int k = 0; k < 2; ++k) acc[ai][bj][m][n] = __builtin_amdgcn_mfma_f32_16x16x32_bf16(__builtin_bit_cast(bf16x8, Bt[n][k]), __builtin_bit_cast(bf16x8, At[m][k]), acc[ai][bj][m][n], 0, 0, 0); } } \
        __builtin_amdgcn_s_setprio(0); } while (0)
#define PG8_WAIT_V(n) asm volatile("s_waitcnt vmcnt(" #n ")" ::: "memory")
#define PG8_WAIT_L(n) asm volatile("s_waitcnt lgkmcnt(" #n ")" ::: "memory")
#define PG8_BAR __builtin_amdgcn_s_barrier()
#define PG8_SCHED __builtin_amdgcn_sched_barrier(0)
    Unit cur, nxt; int ui = 0;
    if (!S.next(0, cur)) return;
    Acc acc;
#pragma unroll
    for (int a = 0; a < 2; ++a)
#pragma unroll
        for (int b = 0; b < 2; ++b)
#pragma unroll
            for (int m = 0; m < 4; ++m)
#pragma unroll
                for (int n = 0; n < 2; ++n) acc[a][b][m][n] = (f32x4){0.f, 0.f, 0.f, 0.f};
    u32x4 At[4][2], B0[2][2], B1[2][2];
    int sclB = 0x7a7a7a7a, sclA = 0x7f7f7f7f;
    asm volatile("" : "+v"(sclB), "+v"(sclA));
    unsigned vA00 = S.arow(cur, Rr[0]) + Cc2[0], vA01 = S.arow(cur, Rr[1]) + Cc2[1], vA10 = S.arow(cur, HALF + Rr[0]) + Cc2[0], vA11 = S.arow(cur, HALF + Rr[1]) + Cc2[1];
    const char* cB = S.bptr(cur);
    PG8_STAGE_B(PG8_SB(0, 0), cB); PG8_STAGE_B(PG8_SB(0, 1), cB + hstepB); PG8_STAGE_A(PG8_SA(0, 0), 0, vA00, vA01); PG8_STAGE_A(PG8_SA(0, 1), 0, vA10, vA11);
    if (wr == 1) PG8_BAR;
    PG8_WAIT_V(2); PG8_BAR;
    PG8_STAGE_B(PG8_SB(1, 0), cB + kstep); PG8_STAGE_A(PG8_SA(1, 0), kstep, vA00, vA01); PG8_STAGE_B(PG8_SB(1, 1), cB + hstepB + kstep);
    PG8_WAIT_V(6); PG8_BAR;
    for (;;) {
        const bool has_next = S.next(ui + 1, nxt);
        const char* nB = has_next ? S.bptr(nxt) : cB;
        constexpr int KREP = (MK_KREP > 1 && !Epi::SEGMENTED) ? MK_KREP : 1;
        for (int tt = 0; tt < nt * KREP; tt += 2) {
            const int t = KREP > 1 ? tt % nt : tt;
            const bool last = (tt == nt * KREP - 2);
            if constexpr (Epi::SEGMENTED) { if (t > 0 && E.boundary(t)) E.rescale(acc, cur, t, wr, wc, fr, fq); }
            const unsigned k1 = (unsigned)(t + 1) * kstep;
            const unsigned t2 = (KREP > 1) ? (unsigned)((t + 2) % nt) : (unsigned)(t + 2);
            const unsigned k2 = last ? 0u : t2 * kstep, k3 = k2 + kstep;
            const char* b2 = last ? nB : cB + t2 * kstep; const char* b3 = b2 + kstep;
            unsigned w00 = vA00, w01 = vA01, w10 = vA10, w11 = vA11;
            if (last && has_next) { w00 = S.arow(nxt, Rr[0]) + Cc2[0]; w01 = S.arow(nxt, Rr[1]) + Cc2[1]; w10 = S.arow(nxt, HALF + Rr[0]) + Cc2[0]; w11 = S.arow(nxt, HALF + Rr[1]) + Cc2[1]; }
            PG8_LDB(B0, 0, 0); PG8_LDB(B1, 0, 1); PG8_SCHED; PG8_LDA(At, 0, 0); PG8_STAGE_A(PG8_SA(1, 1), k1, vA10, vA11);
            PG8_WAIT_V(8); PG8_WAIT_L(0); PG8_BAR; PG8_MMA(0, 0, At, B0); PG8_MMA(0, 1, At, B1); PG8_BAR; PG8_SCHED;
            PG8_LDA(At, 0, 1); PG8_STAGE_B(PG8_SB(0, 0), b2); PG8_STAGE_B(PG8_SB(0, 1), b2 + hstepB); PG8_STAGE_A(PG8_SA(0, 0), k2, w00, w01);
            PG8_WAIT_V(8); PG8_WAIT_L(0); PG8_BAR; PG8_MMA(1, 0, At, B0); PG8_MMA(1, 1, At, B1); PG8_BAR; PG8_SCHED;
            PG8_LDB(B0, 1, 0); PG8_LDB(B1, 1, 1); PG8_SCHED; PG8_LDA(At, 1, 0); PG8_STAGE_A(PG8_SA(0, 1), k2, w10, w11);
            PG8_WAIT_V(8); PG8_WAIT_L(0); PG8_BAR; PG8_MMA(0, 0, At, B0); PG8_MMA(0, 1, At, B1); PG8_BAR; PG8_SCHED;
            PG8_LDA(At, 1, 1); PG8_STAGE_B(PG8_SB(1, 0), b3); PG8_STAGE_B(PG8_SB(1, 1), b3 + hstepB); PG8_STAGE_A(PG8_SA(1, 0), k3, w00, w01);
            PG8_WAIT_V(8); PG8_WAIT_L(0); PG8_BAR; PG8_MMA(1, 0, At, B0); PG8_MMA(1, 1, At, B1); PG8_BAR; PG8_SCHED;
            if (last) { vA00 = w00; vA01 = w01; vA10 = w10; vA11 = w11; }
        }
        if (wr == 0) PG8_BAR;
        if constexpr (FP8) asm volatile("s_nop 15\n\ts_nop 7" ::: "memory");
        if constexpr (KREP > 1) {
#pragma unroll
            for (int a = 0; a < 2; ++a)
#pragma unroll
                for (int b = 0; b < 2; ++b)
#pragma unroll
                    for (int m = 0; m < 4; ++m)
#pragma unroll
                        for (int n = 0; n < 2; ++n) acc[a][b][m][n] *= (1.0f / KREP); }
        E(acc, cur, wr, wc, fr, fq);
        if (!has_next) break;
#pragma unroll
        for (int a = 0; a < 2; ++a)
#pragma unroll
            for (int b = 0; b < 2; ++b)
#pragma unroll
                for (int m = 0; m < 4; ++m)
#pragma unroll
                    for (int n = 0; n < 2; ++n) acc[a][b][m][n] = (f32x4){0.f, 0.f, 0.f, 0.f};
        cur = nxt; cB = nB; ++ui;
        if (wr == 1) PG8_BAR;
    }
    PG8_WAIT_V(0);
    PG8_BAR;
#undef PG8_SA
#undef PG8_SB
#undef PG8_GLDS
#undef PG8_STAGE_A
#undef PG8_STAGE_B
#undef PG8_LDA
#undef PG8_LDB
#undef PG8_MMA
#undef PG8_CAT
#undef PG8_WAIT_V
#undef PG8_WAIT_L
#undef PG8_BAR
#undef PG8_SCHED
}

DI bool static_tile(int L, int nM, int nN, int& pm, int& pn) {
    const int nwg = nM * nN; if (L >= nwg) return false;
    int wgid = L; { const int q = nwg / 8, r = nwg % 8, xcd = wgid % 8, off = wgid / 8; wgid = (xcd < r ? xcd * (q + 1) : r * (q + 1) + (xcd - r) * q) + off; }
    const int nig = 8 * nN, gid = wgid / nig, fm = gid * 8, gsz = (nM - fm) < 8 ? (nM - fm) : 8;
    pm = fm + ((wgid % nig) % gsz); pn = (wgid % nig) / gsz; return true;
}
}
using pg8::Unit; using pg8::Acc;

DI unsigned pk4_fp8(float a, float b, float c, float d) { int p = 0; p = __builtin_amdgcn_cvt_pk_fp8_f32(a, b, p, false); p = __builtin_amdgcn_cvt_pk_fp8_f32(c, d, p, true); return (unsigned)p; }
DI float silu_(float v) { return v * sigmoidf_(v); }
DI float softplus_(float x) { return fmaxf(x, 0.f) + __logf(1.0f + __expf(-fabsf(x))); }

struct SchedIn {
    int G, c, ncol, t0, nsplit, t1, nextra; const char* win; const char* wmem; int reps; int ibeg, iend;
    DI bool next(int i0, Unit& u) const {
        const int i = i0 + ibeg; if (i >= iend) return false;
        const int U = (T / 256) * ncol + nextra; int L = i * G + c; if (L >= U * reps) return false; L %= U; int pm, pn;
        if (pg8::static_tile(L, T / 256, ncol, pm, pn)) { u.kind = 0; u.pm = pm; u.pn = pn < nsplit ? t0 + pn : t1 + (pn - nsplit); u.aux = 0; return true; }
        const int j = L - (T / 256) * ncol; if (j < nextra) { u.kind = 1; u.pm = j >> 3; u.pn = j & 7; u.aux = 0; return true; }
        return false;
    }
    DI unsigned arow(const Unit& u, int r) const { return (u.kind == 0 ? 0u : (unsigned)(WS_MEMN - WS_XN)) + (unsigned)(u.pm * 256 + r) * 2048u; }
    DI const char* bptr(const Unit& u) const { return (u.kind == 0 ? win : wmem) + (size_t)u.pn * (256 * 1024 * 2); }
};

struct EpiIn {
    static constexpr bool SEGMENTED = false;
    unsigned char* ws; const float *qgain, *kgain, *dtbias;
    template <int OP> DI void ew(const Acc& acc, bf16_t* dst, size_t pitch, int col0, int row0, int wc, int fq) const {
#pragma unroll
        for (int ai = 0; ai < 2; ++ai)
#pragma unroll
            for (int m = 0; m < 4; ++m) { bf16_t* rowp = dst + (size_t)(row0 + ai * 128 + m * 16) * pitch + col0 + wc * 32 + 8 * fq;
#pragma unroll
                for (int bj = 0; bj < 2; ++bj) { f32x4 v0 = acc[ai][bj][m][0], v1 = acc[ai][bj][m][1];
                    if (OP == 1) { for (int e = 0; e < 4; ++e) { v0[e] = silu_(v0[e]); v1[e] = silu_(v1[e]); } }
                    if (OP == 2) { for (int e = 0; e < 4; ++e) { v0[e] = sigmoidf_(fminf(fmaxf(v0[e], -30.f), 30.f)); v1[e] = sigmoidf_(fminf(fmaxf(v1[e], -30.f), 30.f)); } }
                    u32x4 w; w.x = pk2(v0[0], v0[1]); w.y = pk2(v0[2], v0[3]); w.z = pk2(v1[0], v1[1]); w.w = pk2(v1[2], v1[3]);
                    *(u32x4*)(rowp + bj * 128) = w; }
                asm volatile("" ::: "memory"); }
    }
    DI void headnorm(const Acc& acc, bf16_t* dst, size_t pitch, int col0, int row0, int wc, int fq, const float* gain, float mul) const {
#pragma unroll
        for (int ai = 0; ai < 2; ++ai)
#pragma unroll
            for (int m = 0; m < 4; ++m) {
                float ss = 0.f;
#pragma unroll
                for (int bj = 0; bj < 2; ++bj)
#pragma unroll
                    for (int n = 0; n < 2; ++n) { const f32x4 x = acc[ai][bj][m][n]; ss += (x[0] * x[0] + x[1] * x[1]) + (x[2] * x[2] + x[3] * x[3]); }
                ss += __shfl_xor(ss, 16); ss += __shfl_xor(ss, 32);
                const float rs = __builtin_amdgcn_rsqf(ss * (1.0f / 64.0f) + EPS) * mul;
                bf16_t* rowp = dst + (size_t)(row0 + ai * 128 + m * 16) * pitch + col0 + wc * 64 + 8 * fq;
#pragma unroll
                for (int bj = 0; bj < 2; ++bj) { const f32x4 g0 = *(const f32x4*)(gain + 32 * bj + 8 * fq), g1 = *(const f32x4*)(gain + 32 * bj + 8 * fq + 4);
                    const f32x4 v0 = acc[ai][bj][m][0] * rs * g0, v1 = acc[ai][bj][m][1] * rs * g1;
                    u32x4 w; w.x = pk2(v0[0], v0[1]); w.y = pk2(v0[2], v0[3]); w.z = pk2(v1[0], v1[1]); w.w = pk2(v1[2], v1[3]);
                    *(u32x4*)(rowp + bj * 32) = w; }
                asm volatile("" ::: "memory"); }
    }
    DI void operator()(const Acc& acc, const Unit& u, int wr, int wc, int fr, int fq) const {
        const int row0 = u.pm * 256 + wr * 64 + fr;
        bf16_t* const act = (bf16_t*)(ws + WS_ACT); bf16_t* const ka = (bf16_t*)(ws + WS_KA); bf16_t* const va = (bf16_t*)(ws + WS_VA); bf16_t* const xbc = (bf16_t*)(ws + WS_XBC);
        bf16_t* const gates = (bf16_t*)(ws + WS_GATES); bf16_t* const memkv = (bf16_t*)(ws + WS_MEMKV); float* const dt = (float*)(ws + WS_DT);
        if (u.kind == 1) { ew<0>(acc, memkv, 2048, u.pn * 256, row0, wc, fq); return; }
        const int tl = u.pn;
        if (tl < TL_K) headnorm(acc, act, ACT_P, (tl - TL_Q) * 256, row0, wc, fq, qgain, 0.125f * LOG2E);
        else if (tl < TL_V) headnorm(acc, ka, 1024, (tl - TL_K) * 256, row0, wc, fq, kgain, 1.0f);
        else if (tl < TL_Z) ew<0>(acc, va, 1024, (tl - TL_V) * 256, row0, wc, fq);
        else if (tl < TL_XBC) ew<1>(acc, act, ACT_P, 1024 + (tl - TL_Z) * 256, row0, wc, fq);
        else if (tl < TL_DT) ew<0>(acc, xbc, 3072, (tl - TL_XBC) * 256, row0, wc, fq);
        else if (tl == TL_DT) {
            if (wc == 0) {
                f32x4 b0 = *(const f32x4*)(dtbias + 8 * fq), b1 = *(const f32x4*)(dtbias + 8 * fq + 4);
#pragma unroll
                for (int ai = 0; ai < 2; ++ai)
#pragma unroll
                    for (int m = 0; m < 4; ++m) { float* rowp = dt + (size_t)(row0 + ai * 128 + m * 16) * 32 + 8 * fq;
                        f32x4 v0 = acc[ai][0][m][0] + b0, v1 = acc[ai][0][m][1] + b1;
                        for (int e = 0; e < 4; ++e) { v0[e] = softplus_(v0[e]); v1[e] = softplus_(v1[e]); }
                        *(f32x4*)rowp = v0; *(f32x4*)(rowp + 4) = v1; }
            }
        }
        else if (tl < TL_G) ew<0>(acc, act, ACT_P, 3072 + (tl - TL_QX) * 256, row0, wc, fq);
        else ew<2>(acc, gates, 3072, (tl - TL_G) * 256, row0, wc, fq);
    }
};

struct SchedDense {
    int G, c, nM, nN, K; const char* bbase; int reps;
    DI bool next(int i, Unit& u) const { u.kind = 0; u.aux = 0; const int U = nM * nN; int L = i * G + c; if (L >= U * reps) return false; return pg8::static_tile(L % U, nM, nN, u.pm, u.pn); }
    DI unsigned arow(const Unit& u, int r) const { return (unsigned)(u.pm * 256 + r) * (unsigned)(K * 2); }
    DI const char* bptr(const Unit& u) const { return bbase + (size_t)u.pn * 256 * K * 2; }
};

struct EpiMerge {
    static constexpr bool SEGMENTED = true;
    const bf16_t* gates; const float* rstd; bf16_t* merged; int last_seg;
    DI bool boundary(int t) const { return t == 16 || t == 24 || t == 32 || t == 40 || t == 48; }
    DI void load8(const bf16_t* p, float (&g)[8]) const { const u32x4 w = *(const u32x4*)p; g[0] = bf_lo(w.x); g[1] = bf_hi(w.x); g[2] = bf_lo(w.y); g[3] = bf_hi(w.y); g[4] = bf_lo(w.z); g[5] = bf_hi(w.z); g[6] = bf_lo(w.w); g[7] = bf_hi(w.w); }
    DI void rescale(Acc& acc, const Unit& u, int t, int wr, int wc, int fr, int fq) const {
        int row0 = u.pm * 256 + wr * 64 + fr, col0 = u.pn * 256 + wc * 32 + 8 * fq;
        asm volatile("" : "+v"(row0), "+v"(col0));
        const int go = (t == 16) ? 0 : 1024, ri = (t == 16) ? 0 : 3, g = (t == 24) ? 0 : (t == 32) ? 1 : 2;
        asm volatile("s_nop 15" ::: "memory");
        f32x2 rr[2][4];
        if (!(t == 16 || t == 48)) {
#pragma unroll
            for (int ai = 0; ai < 2; ++ai)
#pragma unroll
                for (int m = 0; m < 4; ++m) rr[ai][m] = *(const f32x2*)(rstd + (size_t)(row0 + ai * 128 + m * 16) * 4 + g);
        }
#pragma unroll
        for (int ai = 0; ai < 2; ++ai)
#pragma unroll
          for (int mp = 0; mp < 2; ++mp) {
            float f[2][2][8];
            if (t == 16 || t == 48) {
                u32x4 ga[2][2], gb[2][2]; float rsv[2];
#pragma unroll
                for (int mm = 0; mm < 2; ++mm) { const int row = row0 + ai * 128 + (2 * mp + mm) * 16; const bf16_t* gp = gates + (size_t)row * 3072 + col0 + go; rsv[mm] = rstd[(size_t)row * 4 + ri];
#pragma unroll
                    for (int bj = 0; bj < 2; ++bj) { ga[mm][bj] = *(const u32x4*)(gp + bj * 128); gb[mm][bj] = *(const u32x4*)(gp + 1024 + bj * 128); } }
#pragma unroll
                for (int mm = 0; mm < 2; ++mm)
#pragma unroll
                    for (int bj = 0; bj < 2; ++bj) { float a[8], b[8]; unpack8(ga[mm][bj], a); unpack8(gb[mm][bj], b);
#pragma unroll
                        for (int j = 0; j < 8; ++j) f[mm][bj][j] = (t == 16) ? a[j] * fast_rcp(b[j] * rsv[mm]) : a[j] * rsv[mm] * fast_rcp(b[j]); }
            } else {
#pragma unroll
                for (int mm = 0; mm < 2; ++mm) { const float fr_ = rr[ai][2 * mp + mm][0] * fast_rcp(rr[ai][2 * mp + mm][1]);
#pragma unroll
                    for (int bj = 0; bj < 2; ++bj)
#pragma unroll
                        for (int j = 0; j < 8; ++j) f[mm][bj][j] = fr_; }
            }
#pragma unroll
            for (int mm = 0; mm < 2; ++mm)
#pragma unroll
                for (int bj = 0; bj < 2; ++bj)
#pragma unroll
                    for (int e = 0; e < 4; ++e) { const int m = 2 * mp + mm;
                        asm volatile("v_mul_f32 %0, %0, %1" : "+v"(acc[ai][bj][m][0][e]) : "v"(f[mm][bj][e]));
                        asm volatile("v_mul_f32 %0, %0, %1" : "+v"(acc[ai][bj][m][1][e]) : "v"(f[mm][bj][4 + e])); }
            asm volatile("" ::: "memory");
          }
    }
    DI void unpack8(const u32x4 w, float (&g)[8]) const { g[0] = bf_lo(w.x); g[1] = bf_hi(w.x); g[2] = bf_lo(w.y); g[3] = bf_hi(w.y); g[4] = bf_lo(w.z); g[5] = bf_hi(w.z); g[6] = bf_lo(w.w); g[7] = bf_hi(w.w); }
    DI void operator()(const Acc& acc, const Unit& u, int wr, int wc, int fr, int fq) const {
        int row0 = u.pm * 256 + wr * 64 + fr, col0 = u.pn * 256 + wc * 32 + 8 * fq;
        asm volatile("" : "+v"(row0), "+v"(col0));
        u32x4 gg[2][4][2]; float r3[2][4];
#pragma unroll
        for (int ai = 0; ai < 2; ++ai)
#pragma unroll
            for (int m = 0; m < 4; ++m) { const int row = row0 + ai * 128 + m * 16; r3[ai][m] = (last_seg == 1) ? rstd[(size_t)row * 4 + 3] : 1.0f; const bf16_t* gp = gates + (size_t)row * 3072 + col0 + last_seg * 1024;
#pragma unroll
                for (int bj = 0; bj < 2; ++bj) gg[ai][m][bj] = *(const u32x4*)(gp + bj * 128); }
#pragma unroll
        for (int ai = 0; ai < 2; ++ai)
#pragma unroll
            for (int m = 0; m < 4; ++m) { const int row = row0 + ai * 128 + m * 16; bf16_t* op = merged + (size_t)row * 1024 + col0;
#pragma unroll
                for (int bj = 0; bj < 2; ++bj) { float g[8]; unpack8(gg[ai][m][bj], g); const float s = r3[ai][m];
                    f32x4 v0 = acc[ai][bj][m][0], v1 = acc[ai][bj][m][1];
                    u32x4 w; w.x = pk2(v0[0] * g[0] * s, v0[1] * g[1] * s); w.y = pk2(v0[2] * g[2] * s, v0[3] * g[3] * s); w.z = pk2(v1[0] * g[4] * s, v1[1] * g[5] * s); w.w = pk2(v1[2] * g[6] * s, v1[3] * g[7] * s);
                    *(u32x4*)(op + bj * 128) = w; }
                asm volatile("" ::: "memory"); }
    }
};

struct EpiOut {
    static constexpr bool SEGMENTED = false;
    const float* x; float* out;
    DI void operator()(const Acc& acc, const Unit& u, int wr, int wc, int fr, int fq) const {
        const int row0 = u.pm * 256 + wr * 64 + fr, col0 = u.pn * 256 + wc * 32 + 8 * fq;
#pragma unroll
        for (int ai = 0; ai < 2; ++ai)
#pragma unroll
            for (int m = 0; m < 4; ++m) { const size_t off = (size_t)(row0 + ai * 128 + m * 16) * 1024 + col0;
#pragma unroll
                for (int bj = 0; bj < 2; ++bj) { const f32x4 x0 = __builtin_nontemporal_load((const f32x4*)(x + off + bj * 128)), x1 = __builtin_nontemporal_load((const f32x4*)(x + off + bj * 128 + 4));
                    *(f32x4*)(out + off + bj * 128) = x0 + acc[ai][bj][m][0]; *(f32x4*)(out + off + bj * 128 + 4) = x1 + acc[ai][bj][m][1]; } }
    }
};

struct SchedMoE {
    int G, c, NC, tlo, thi; const LAS int* tstart; const LAS int* cnt; const int* tokl; const char* wbase; size_t wexp; int reps; unsigned rowb; unsigned ldbb;
    DI bool next(int i, Unit& u) const {
        const int n = (thi - tlo) * NC; int L = i * G + c; if (L >= n * reps) return false; L %= n;
        { const int q = n / 8, r = n % 8, xcd = L % 8, off = L / 8; L = (xcd < r ? xcd * (q + 1) : r * (q + 1) + (xcd - r) * q) + off; }
        const int rt = tlo + L / NC; u.pn = L % NC; u.pm = rt; int e = 0;
        for (int j = 1; j < NEXP; ++j) e += (tstart[j] <= rt) ? 1 : 0;
        u.aux = __builtin_amdgcn_readfirstlane(e); u.kind = 0; return true;
    }
    DI unsigned arow(const Unit& u, int r) const {
        if (tokl) { const int e = u.aux, idx = (u.pm - tstart[e]) * 256 + r; const int tok = idx < cnt[e] ? tokl[(size_t)e * T + idx] : 0; return (unsigned)tok * rowb; }
        return (unsigned)((u.pm - tlo) * 256 + r) * rowb;
    }
    DI const char* bptr(const Unit& u) const { return wbase + (size_t)u.aux * wexp + (size_t)u.pn * 256 * ldbb; }
};
struct EpiGU {
    static constexpr bool SEGMENTED = false;
    unsigned char* actm; const float *bg, *bu; int tlo;
    DI void operator()(const Acc& acc, const Unit& u, int wr, int wc, int fr, int fq) const {
        const int row0 = (u.pm - tlo) * 256 + wr * 64 + fr, col = u.pn * 128 + wc * 32 + 8 * fq; const size_t eb = (size_t)u.aux * 1024 + col;
        const f32x4 g0 = *(const f32x4*)(bg + eb), g1 = *(const f32x4*)(bg + eb + 4), u0 = *(const f32x4*)(bu + eb), u1 = *(const f32x4*)(bu + eb + 4);
#pragma unroll
        for (int ai = 0; ai < 2; ++ai)
#pragma unroll
            for (int m = 0; m < 4; ++m) { f32x4 a0 = acc[ai][0][m][0] + g0, a1 = acc[ai][0][m][1] + g1, b0 = acc[ai][1][m][0] + u0, b1 = acc[ai][1][m][1] + u1;
#define GU_PAIR(A, B, h) do { f32x2 g_ = {fminf(A[2 * (h)], 7.f), fminf(A[2 * (h) + 1], 7.f)}, u_ = {fminf(fmaxf(B[2 * (h)], -7.f), 7.f), fminf(fmaxf(B[2 * (h) + 1], -7.f), 7.f)}; \
                    const f32x2 t_ = g_ * (-1.702f * 1.4426950408889634f); f32x2 d_ = {fast_exp2(t_[0]), fast_exp2(t_[1])}; d_ = d_ + 1.0f; const f32x2 r_ = {fast_rcp(d_[0]), fast_rcp(d_[1])}; \
                    const f32x2 o_ = (u_ * g_ + g_) * r_; A[2 * (h)] = o_[0]; A[2 * (h) + 1] = o_[1]; } while (0)
                GU_PAIR(a0, b0, 0); GU_PAIR(a0, b0, 1); GU_PAIR(a1, b1, 0); GU_PAIR(a1, b1, 1);
#undef GU_PAIR
                u32x2 w; w.x = pk4_fp8(a0[0], a0[1], a0[2], a0[3]); w.y = pk4_fp8(a1[0], a1[1], a1[2], a1[3]);
                *(u32x2*)(actm + (size_t)(row0 + ai * 128 + m * 16) * 1024 + col) = w; }
    }
};
struct EpiDown {
    static constexpr bool SEGMENTED = false;
    bf16_t* y; const float* bd; int tlo;
    DI void operator()(const Acc& acc, const Unit& u, int wr, int wc, int fr, int fq) const {
        const int row0 = (u.pm - tlo) * 256 + wr * 64 + fr, col0 = u.pn * 256 + wc * 32 + 8 * fq; const float* bp = bd + (size_t)u.aux * 1024 + col0;
        f32x4 bv[2][2];
#pragma unroll
        for (int bj = 0; bj < 2; ++bj) { bv[bj][0] = *(const f32x4*)(bp + bj * 128); bv[bj][1] = *(const f32x4*)(bp + bj * 128 + 4); }
#pragma unroll
        for (int ai = 0; ai < 2; ++ai)
#pragma unroll
            for (int m = 0; m < 4; ++m) { bf16_t* rowp = y + (size_t)(row0 + ai * 128 + m * 16) * 1024 + col0;
#pragma unroll
                for (int bj = 0; bj < 2; ++bj) { const f32x4 v0 = acc[ai][bj][m][0] + bv[bj][0], v1 = acc[ai][bj][m][1] + bv[bj][1];
                    u32x4 w; w.x = pk2(v0[0], v0[1]); w.y = pk2(v0[2], v0[3]); w.z = pk2(v1[0], v1[1]); w.w = pk2(v1[2], v1[3]);
                    *(u32x4*)(rowp + bj * 128) = w; } }
    }
};
struct TrItem { const float* W; int Ns, k0, sc0, sc1; void* dst; int dpitch; const float* kscale; float mul; int fp8; };
DI void tr_load(const TrItem& it, f32x4 (&v)[16], int lane) {
    const int cl = lane & 15, kl = lane >> 4, sc = (cl < 8) ? it.sc0 : it.sc1, col = sc + 4 * (cl & 7);
#pragma unroll
    for (int i = 0; i < 16; ++i) { v[i] = (f32x4){0.f, 0.f, 0.f, 0.f}; if (sc >= 0) v[i] = __builtin_nontemporal_load((const f32x4*)(it.W + (size_t)(it.k0 + 4 * i + kl) * it.Ns + col)); }
}
DI void tr_store(const TrItem& it, const f32x4 (&v)[16], LAS float* scr, int lane) {
    const int cl = lane & 15, kl = lane >> 4;
#pragma unroll
    for (int i = 0; i < 16; ++i) { const int kk = 4 * i + kl; f32x4 x = v[i] * it.mul; if (it.kscale) x *= it.kscale[it.k0 + kk]; LAS float* p = scr + kk * 65 + 4 * cl; p[0] = x[0]; p[1] = x[1]; p[2] = x[2]; p[3] = x[3]; }
    asm volatile("s_waitcnt lgkmcnt(0)" ::: "memory");
    if (it.fp8) { const int c = lane & 3; unsigned char* dst = (unsigned char*)it.dst;
#pragma unroll
        for (int j = 0; j < 4; ++j) { const int n = (lane >> 2) + 16 * j; const LAS float* s = scr + (16 * c) * 65 + n;
            u32x4 o; o.x = pk4_fp8(s[0 * 65], s[1 * 65], s[2 * 65], s[3 * 65]); o.y = pk4_fp8(s[4 * 65], s[5 * 65], s[6 * 65], s[7 * 65]);
            o.z = pk4_fp8(s[8 * 65], s[9 * 65], s[10 * 65], s[11 * 65]); o.w = pk4_fp8(s[12 * 65], s[13 * 65], s[14 * 65], s[15 * 65]);
            *(u32x4*)(dst + (size_t)n * it.dpitch + 16 * c) = o; }
    } else { const int c = lane & 7; bf16_t* dst = (bf16_t*)it.dst;
#pragma unroll
        for (int j = 0; j < 8; ++j) { const int n = (lane >> 3) + 8 * j; const LAS float* s = scr + (8 * c) * 65 + n;
            u32x4 o; o.x = pk2(s[0 * 65], s[1 * 65]); o.y = pk2(s[2 * 65], s[3 * 65]); o.z = pk2(s[4 * 65], s[5 * 65]); o.w = pk2(s[6 * 65], s[7 * 65]);
            *(u32x4*)(dst + (size_t)n * it.dpitch + 8 * c) = o; }
    }
    asm volatile("s_waitcnt lgkmcnt(0)" ::: "memory");
}
template <class MK> DI void tr_run(const MK& mk, int nitems, int gw, int NGW, LAS float* scr, int lane) {
    f32x4 va[16], vb[16]; TrItem ia, ib; int it = gw;
    if (it < nitems) { ia = mk(it); tr_load(ia, va, lane); }
    while (it < nitems) {
        const int i2 = it + NGW; if (i2 < nitems) { ib = mk(i2); tr_load(ib, vb, lane); }
        tr_store(ia, va, scr, lane);
        if (i2 >= nitems) break;
        const int i3 = i2 + NGW; if (i3 < nitems) { ia = mk(i3); tr_load(ia, va, lane); }
        tr_store(ib, vb, scr, lane);
        it = i3; }
}
DI int win_src_col(int nb) {
    const int tile = nb >> 3, sub = nb & 7;
    if (tile < TL_V) { const int base = tile < TL_K ? 256 * tile : 1024 + 256 * (tile - TL_K); return base + 32 * (2 * (sub & 3) + (sub >> 2)); }
    if (tile < TL_Z) return 2048 + 256 * (tile - TL_V) + 32 * sub;
    if (tile < TL_XBC) return 3072 + 256 * (tile - TL_Z) + 32 * sub;
    if (tile < TL_DT) return 5120 + 256 * (tile - TL_XBC) + 32 * sub;
    if (tile == TL_DT) return sub == 0 ? 8192 : -1;
    if (tile < TL_G) return 8224 + 256 * (tile - TL_QX) + 32 * sub;
    return 9248 + 256 * (tile - TL_G) + 32 * sub;
}
template <int NR> DI void rms_rows_to_bf16(const float* x, bf16_t* o, size_t row_stride, const float* gain, int lane) {
    f32x4 v[NR][4]; float s[NR];
#pragma unroll
    for (int r = 0; r < NR; ++r) { const f32x4* xr = (const f32x4*)(x + (size_t)r * row_stride * 1024) + lane; s[r] = 0.f;
#pragma unroll
        for (int j = 0; j < 4; ++j) { v[r][j] = __builtin_nontemporal_load(xr + 64 * j); } }
#pragma unroll
    for (int r = 0; r < NR; ++r) {
#pragma unroll
        for (int j = 0; j < 4; ++j) s[r] += (v[r][j].x * v[r][j].x + v[r][j].y * v[r][j].y) + (v[r][j].z * v[r][j].z + v[r][j].w * v[r][j].w);
        s[r] = __builtin_amdgcn_rsqf(wave_sum(s[r]) * (1.f / 1024.f) + EPS); }
    const f32x4* gr = (const f32x4*)gain + lane;
#pragma unroll
    for (int j = 0; j < 4; ++j) { const f32x4 g = gr[64 * j];
#pragma unroll
        for (int r = 0; r < NR; ++r) { u32x2 w; w.x = pk2(v[r][j].x * s[r] * g.x, v[r][j].y * s[r] * g.y); w.y = pk2(v[r][j].z * s[r] * g.z, v[r][j].w * s[r] * g.w); ((u32x2*)(o + (size_t)r * row_stride * 1024) + lane)[64 * j] = w; } }
}


template <int NR> DI void rms_rows_to_fp8(const float* x, unsigned char* o, const float* gain, int lane) {
    f32x4 v[NR][4]; float s[NR];
#pragma unroll
    for (int r = 0; r < NR; ++r) { const f32x4* xr = (const f32x4*)(x + (size_t)r * 1024) + lane; s[r] = 0.f;
#pragma unroll
        for (int j = 0; j < 4; ++j) { v[r][j] = xr[64 * j]; } }
#pragma unroll
    for (int r = 0; r < NR; ++r) {
#pragma unroll
        for (int j = 0; j < 4; ++j) s[r] += (v[r][j].x * v[r][j].x + v[r][j].y * v[r][j].y) + (v[r][j].z * v[r][j].z + v[r][j].w * v[r][j].w);
        s[r] = __builtin_amdgcn_rsqf(wave_sum(s[r]) * (1.f / 1024.f) + EPS); }
    const f32x4* gr = (const f32x4*)gain + lane;
#pragma unroll
    for (int j = 0; j < 4; ++j) { const f32x4 g = gr[64 * j];
#pragma unroll
        for (int r = 0; r < NR; ++r) ((unsigned*)(o + (size_t)r * 1024) + lane)[64 * j] = pk4_fp8(v[r][j].x * s[r] * g.x, v[r][j].y * s[r] * g.y, v[r][j].z * s[r] * g.z, v[r][j].w * s[r] * g.w); }
}

DI int crow(int r, int hi) { return (r & 3) + 8 * (r >> 2) + 4 * hi; }
DI s16x4 vtr(const LAS unsigned char* p) { return __builtin_bit_cast(s16x4, __builtin_amdgcn_ds_read_tr16_b64_v4i16((LAS v4i16_t*)p)); }
#define MFMA32(a, b, c) __builtin_amdgcn_mfma_f32_32x32x16_bf16((a), (b), (c), 0, 0, 0)
#define MFMA16(a, b, c) __builtin_amdgcn_mfma_f32_16x16x32_bf16((a), (b), (c), 0, 0, 0)
DI void tile_load(u32x4 (&r)[4], const bf16_t* g, size_t pitch, int tid) {
#pragma unroll
    for (int i = 0; i < 4; ++i) { const int q = tid + 512 * i, row = q >> 5, ch = q & 31; r[i] = *(const u32x4*)(g + (size_t)row * pitch + ch * 8); }
}
DI void tile_store_k(LAS unsigned char* dst, const u32x4 (&r)[4], int tid) {
#pragma unroll
    for (int i = 0; i < 4; ++i) { const int q = tid + 512 * i, row = q >> 5, ch = q & 31; *(LAS u32x4*)(dst + row * 512 + ((ch ^ (row & 15)) << 4)) = r[i]; }
}
DI void tile_store_v(LAS unsigned char* dst, const u32x4 (&r)[4], int tid) {
#pragma unroll
    for (int i = 0; i < 4; ++i) { const int q = tid + 512 * i, row = q >> 5, ch = q & 31; *(LAS u32x4*)(dst + row * 512 + ((((ch >> 2) ^ (row & 3)) * 4 + (ch & 3)) << 4)) = r[i]; }
}
constexpr int AT_K = 0, AT_V = 32768, AT_BIAS = 65536, AT_BIAS_STRIDE = 260;

constexpr float SM_THR = 8.0f;
DI bool softmax_tile(f32x16& s0, f32x16& s1, float& m, float& l, bf16x8 (&pa)[4], float& alpha) {
    float mx = fmaxf(s0[0], s1[0]);
#pragma unroll
    for (int r = 1; r < 16; ++r) mx = fmaxf(mx, fmaxf(s0[r], s1[r]));
    mx = fmaxf(mx, __shfl_xor(mx, 32));
    bool moved = false; alpha = 1.0f;
    if (__builtin_expect(__any(mx > SM_THR), 0)) {
        const float dl = fmaxf(mx, 0.f); m += dl; alpha = fast_exp2(-dl); l *= alpha; moved = true;
#pragma unroll
        for (int r = 0; r < 16; ++r) { s0[r] -= dl; s1[r] -= dl; }
    }
    float sum = 0.f;
#pragma unroll
    for (int r = 0; r < 16; ++r) { s0[r] = fast_exp2(s0[r]); s1[r] = fast_exp2(s1[r]); sum += s0[r] + s1[r]; }
    l += sum;
    u32x4 w;
    w.x = pk2(s0[0], s0[1]); w.y = pk2(s0[2], s0[3]); w.z = pk2(s0[4], s0[5]); w.w = pk2(s0[6], s0[7]); pa[0] = __builtin_bit_cast(bf16x8, w);
    w.x = pk2(s0[8], s0[9]); w.y = pk2(s0[10], s0[11]); w.z = pk2(s0[12], s0[13]); w.w = pk2(s0[14], s0[15]); pa[1] = __builtin_bit_cast(bf16x8, w);
    w.x = pk2(s1[0], s1[1]); w.y = pk2(s1[2], s1[3]); w.z = pk2(s1[4], s1[5]); w.w = pk2(s1[6], s1[7]); pa[2] = __builtin_bit_cast(bf16x8, w);
    w.x = pk2(s1[8], s1[9]); w.y = pk2(s1[10], s1[11]); w.z = pk2(s1[12], s1[13]); w.w = pk2(s1[14], s1[15]); pa[3] = __builtin_bit_cast(bf16x8, w);
    return moved;
}
DI bf16x8 v_frag(const LAS unsigned char* vt, int s, int colbyte0, int lane) {
    const int hi = lane >> 5, q_ = (lane & 15) >> 2, p_ = lane & 3, blk = (lane >> 4) & 1;
    const int cb = colbyte0 + blk * 32 + p_ * 8, u = cb >> 6, within = cb & 63;
    const int R = 16 * s + 4 * hi + q_;
    const s16x4 lo = vtr(vt + R * 512 + ((u ^ q_) << 6) + within);
    const s16x4 h4 = vtr(vt + (R + 8) * 512 + ((u ^ q_) << 6) + within);
    return __builtin_shufflevector(lo, h4, 0, 1, 2, 3, 4, 5, 6, 7);
}

DI void attnA_unit(LAS unsigned char* lds, int b, int cp, int hq, bf16_t* act, const bf16_t* ka, const bf16_t* va, bf16_t* outp, size_t opitch) {
    const int tid = threadIdx.x, lane = tid & 63, wid = __builtin_amdgcn_readfirstlane(tid >> 6), hl = wid >> 1, qh = wid & 1, head = 4 * hq + hl, l31 = lane & 31, hi = lane >> 5;
    const int c0 = 2 * cp, c1 = c0 + 1;
    const size_t trow0 = (size_t)b * SEQ + 64 * c0 + 32 * qh + l31;
    bf16x8 qf[2][4];
#pragma unroll
    for (int i = 0; i < 2; ++i) { const bf16_t* qp = act + (trow0 + 64 * i) * ACT_P + 64 * head;
#pragma unroll
        for (int d0 = 0; d0 < 4; ++d0) qf[i][d0] = *(const bf16x8*)(qp + 16 * d0 + 8 * hi); }
    f32x16 o0[2], o1[2];
#pragma unroll
    for (int i = 0; i < 2; ++i)
#pragma unroll
        for (int r = 0; r < 16; ++r) { o0[i][r] = 0.f; o1[i][r] = 0.f; }
    float m[2] = {0.f, 0.f}, l[2] = {0.f, 0.f};
    const int kc0 = c0 < 8 ? 0 : c0 - 8;
    const LAS float* bias = (const LAS float*)(lds + AT_BIAS) + head * AT_BIAS_STRIDE;
    const float b256 = bias[256];
    u32x4 rk[4], rv[4];
    const bf16_t* kb = ka + ((size_t)b * SEQ + 64 * kc0) * 1024 + 256 * hq; const bf16_t* vb = va + ((size_t)b * SEQ + 64 * kc0) * 1024 + 256 * hq;
    tile_load(rk, kb, 1024, tid); tile_load(rv, vb, 1024, tid);
    const int qi = 32 * qh + l31;
    for (int kc = kc0; kc <= c1; ++kc) {
        __syncthreads();
        tile_store_k(lds + AT_K, rk, tid); tile_store_v(lds + AT_V, rv, tid);
        if (kc < c1) { kb += 64 * 1024; vb += 64 * 1024; tile_load(rk, kb, 1024, tid); tile_load(rv, vb, 1024, tid); }
        __syncthreads();
#pragma unroll
        for (int i = 0; i < 2; ++i) {
            const int j = c0 + i - kc;
            if (j < 0 || j > 8) continue;
            f32x16 s0, s1;
            if (j >= 3) { const float cc = b256 - m[i];
#pragma unroll
                for (int r = 0; r < 16; ++r) { s0[r] = cc; s1[r] = cc; }
            } else {
#pragma unroll
                for (int r = 0; r < 16; ++r) { const int rel0 = 64 * j + qi - crow(r, hi); s0[r] = bias[min(rel0, 128) + 128] - m[i]; s1[r] = bias[min(rel0 - 32, 128) + 128] - m[i]; }
            }
#pragma unroll
            for (int d0 = 0; d0 < 4; ++d0) {
                const int ch = 8 * hl + 2 * d0 + hi;
                const bf16x8 k0 = *(const LAS bf16x8*)(lds + AT_K + l31 * 512 + ((ch ^ (l31 & 15)) << 4));
                const bf16x8 k1 = *(const LAS bf16x8*)(lds + AT_K + (32 + l31) * 512 + ((ch ^ (l31 & 15)) << 4));
                s0 = MFMA32(k0, qf[i][d0], s0); s1 = MFMA32(k1, qf[i][d0], s1);
            }
            bf16x8 pa[4]; float alpha;
            if (softmax_tile(s0, s1, m[i], l[i], pa, alpha)) {
#pragma unroll
                for (int r = 0; r < 16; ++r) { o0[i][r] *= alpha; o1[i][r] *= alpha; } }
#pragma unroll
            for (int s = 0; s < 4; ++s) {
                const bf16x8 v0 = v_frag(lds + AT_V, s, (64 * hl) * 2, lane), v1 = v_frag(lds + AT_V, s, (64 * hl + 32) * 2, lane);
                o0[i] = MFMA32(v0, pa[s], o0[i]); o1[i] = MFMA32(v1, pa[s], o1[i]);
            }
        }
    }
#pragma unroll
    for (int i = 0; i < 2; ++i) {
        const float lt = l[i] + __shfl_xor(l[i], 32), inv = fast_rcp(lt);
#pragma unroll
        for (int rg = 0; rg < 4; ++rg) {
            u32x2 w0, w1; w0.x = pk2(o0[i][4 * rg] * inv, o0[i][4 * rg + 1] * inv); w0.y = pk2(o0[i][4 * rg + 2] * inv, o0[i][4 * rg + 3] * inv);
            w1.x = pk2(o1[i][4 * rg] * inv, o1[i][4 * rg + 1] * inv); w1.y = pk2(o1[i][4 * rg + 2] * inv, o1[i][4 * rg + 3] * inv);
            bf16_t* op = outp + (trow0 + 64 * i) * opitch + 64 * head; *(u32x2*)(op + 8 * rg + 4 * hi) = w0; *(u32x2*)(op + 32 + 8 * rg + 4 * hi) = w1;
        }
    }
}

constexpr int AT_Q = 65536;
DI void attnC_phase(LAS unsigned char* lds, int vcu, int G, bf16_t* act, const bf16_t* kx, const bf16_t* memkv, bf16_t* outp, size_t opitch) {
    const int tid = threadIdx.x, lane = tid & 63, wid = __builtin_amdgcn_readfirstlane(tid >> 6), rg = wid >> 1, dh = wid & 1, l31 = lane & 31, hi = lane >> 5;
    constexpr int NU = NBATCH * 4 * 32;
    const int upw = (NU + G - 1) / G, u0 = vcu * upw, u1 = (u0 + upw < NU) ? u0 + upw : NU;
    if (u0 >= NU) return;
    const int nsteps = (u1 - u0) * 4;
    u32x4 rk[4], rv[4];
    { const int b = u0 >> 7, hx = (u0 >> 5) & 3;
      tile_load(rk, kx + ((size_t)b * MEMLEN) * 1024 + 256 * hx, 1024, tid); tile_load(rv, memkv + ((size_t)b * MEMLEN) * 2048 + 1024 + 256 * hx, 2048, tid); }
    f32x16 o[4]; float m = 0.f, l = 0.f, rstd = 1.f;
    for (int n = 0; n < nsteps; ++n) {
        const int u = u0 + (n >> 2), j = n & 3, rb = u & 31, hx = (u >> 5) & 3, b = u >> 7;
        const size_t trow = (size_t)b * SEQ + 128 * rb + 32 * rg + l31;
        u32x4 rq[8];
        if (j == 0) {
#pragma unroll
            for (int i = 0; i < 8; ++i) { const int q = tid + 512 * i, row = q >> 5, ch = q & 31; rq[i] = *(const u32x4*)(act + ((size_t)b * SEQ + 128 * rb + row) * ACT_P + 3072 + 256 * hx + ch * 8); }
#pragma unroll
            for (int i = 0; i < 4; ++i)
#pragma unroll
                for (int r = 0; r < 16; ++r) o[i][r] = 0.f;
            m = 0.f; l = 0.f;
        }
        __syncthreads();
        tile_store_k(lds + AT_K, rk, tid); tile_store_v(lds + AT_V, rv, tid);
        if (j == 0) {
#pragma unroll
            for (int i = 0; i < 8; ++i) { const int q = tid + 512 * i, row = q >> 5, ch = q & 31; *(LAS u32x4*)(lds + AT_Q + row * 512 + ((ch ^ (row & 15)) << 4)) = rq[i]; }
        }
        if (n + 1 < nsteps) { const int un = u0 + ((n + 1) >> 2), jn = (n + 1) & 3, hxn = (un >> 5) & 3, bn = un >> 7;
            tile_load(rk, kx + ((size_t)bn * MEMLEN + 64 * jn) * 1024 + 256 * hxn, 1024, tid); tile_load(rv, memkv + ((size_t)bn * MEMLEN + 64 * jn) * 2048 + 1024 + 256 * hxn, 2048, tid); }
        __syncthreads();
        f32x16 s0, s1;
#pragma unroll
        for (int r = 0; r < 16; ++r) { s0[r] = 0.f; s1[r] = 0.f; }
        float ssq = 0.f;
#pragma unroll
        for (int d0 = 0; d0 < 16; ++d0) {
            const int ch = 2 * d0 + hi;
            const bf16x8 qfr = *(const LAS bf16x8*)(lds + AT_Q + (32 * rg + l31) * 512 + ((ch ^ (l31 & 15)) << 4));
            const bf16x8 k0 = *(const LAS bf16x8*)(lds + AT_K + l31 * 512 + ((ch ^ (l31 & 15)) << 4));
            const bf16x8 k1 = *(const LAS bf16x8*)(lds + AT_K + (32 + l31) * 512 + ((ch ^ (l31 & 15)) << 4));
            if (j == 0) {
#pragma unroll
                for (int e = 0; e < 8; ++e) { const float v = bf2f((bf16_t)qfr[e]); ssq += v * v; } }
            s0 = MFMA32(k0, qfr, s0); s1 = MFMA32(k1, qfr, s1);
        }
        if (j == 0) { ssq += __shfl_xor(ssq, 32); rstd = __builtin_amdgcn_rsqf(ssq * (1.f / 256.f) + EPS); }
#pragma unroll
        for (int r = 0; r < 16; ++r) { s0[r] = s0[r] * rstd - m; s1[r] = s1[r] * rstd - m; }
        bf16x8 pa[4]; float alpha;
        if (softmax_tile(s0, s1, m, l, pa, alpha)) {
#pragma unroll
            for (int i = 0; i < 4; ++i)
#pragma unroll
                for (int r = 0; r < 16; ++r) o[i][r] *= alpha; }
#pragma unroll
        for (int s = 0; s < 4; ++s)
#pragma unroll
            for (int i = 0; i < 4; ++i) { const bf16x8 vf = v_frag(lds + AT_V, s, (128 * dh + 32 * i) * 2, lane); o[i] = MFMA32(vf, pa[s], o[i]); }
        if (j == 3) {
            const float lt = l + __shfl_xor(l, 32), inv = fast_rcp(lt);
            bf16_t* op = outp + trow * opitch + 256 * hx + 128 * dh;
#pragma unroll
            for (int i = 0; i < 4; ++i)
#pragma unroll
                for (int g4 = 0; g4 < 4; ++g4) { u32x2 w; w.x = pk2(o[i][4 * g4] * inv, o[i][4 * g4 + 1] * inv); w.y = pk2(o[i][4 * g4 + 2] * inv, o[i][4 * g4 + 3] * inv);
                    *(u32x2*)(op + 32 * i + 8 * g4 + 4 * hi) = w; }
        }
    }
    __syncthreads();
}

constexpr int MB_XDT = 0, MB_XDTW = 9216, MB_BM = 18432, MB_CM = 35840, MB_YD = 53248, MB_YO = 70656, MB_ACS = 88064, MB_YSTR = 272;
DI int mb_b256(int row, int col) { return row * 272 + col * 2; }
DI int mb_b128(int row, int col) { return row * 144 + col * 2; }
template <bool W256> DI bf16x8 tr_pair(const LAS unsigned char* base, int row_lo, int row_hi, int col0, int lane) {
    const int i = lane & 15, r = i >> 2, c = col0 + 4 * (i & 3);
    const s16x4 lo = vtr(base + (W256 ? mb_b256(row_lo + r, c) : mb_b128(row_lo + r, c))), h4 = vtr(base + (W256 ? mb_b256(row_hi + r, c) : mb_b128(row_hi + r, c)));
    return __builtin_shufflevector(lo, h4, 0, 1, 2, 3, 4, 5, 6, 7);
}
DI void bcconv_phase(int vcu, int G, const bf16_t* xbc, bf16_t* bc, const float* conv_w, const float* conv_b, const float* dtp, float* acsp, const float* a_log) {
    {
        const int lane = threadIdx.x & 63, wv = threadIdx.x >> 6;
        for (int ck = vcu * 8 + wv; ck < T / 64; ck += G * 8) {
            const float* dr = dtp + ((size_t)ck * 64 + lane) * 32; float* orow = acsp + ((size_t)ck * 64 + lane) * 32;
#pragma unroll
            for (int q = 0; q < 8; ++q) { f32x4 v = *(const f32x4*)(dr + 4 * q); const f32x4 al = *(const f32x4*)(a_log + 4 * q);
#pragma unroll
                for (int e = 0; e < 4; ++e) { float a = -v[e] * __expf(al[e]);
#pragma unroll
                    for (int o = 1; o < 64; o <<= 1) { const float u = __shfl_up(a, o); if (lane >= o) a += u; }
                    v[e] = a; }
                *(f32x4*)(orow + 4 * q) = v; }
        }
    }
    for (int task = vcu * 512 + threadIdx.x; task < (T / 16) * 128; task += G * 512) {
        const int cc = task & 127, run = task >> 7, g = cc >> 5, w = cc & 31;
        const int scol = (w < 16 ? 2048 + 128 * g + 8 * w : 2560 + 128 * g + 8 * (w - 16));
        const int t0 = run * 16, pos0 = t0 & (SEQ - 1);
        float cw[4][8], cb[8];
#pragma unroll
        for (int e = 0; e < 8; ++e) { cb[e] = conv_b[scol + e];
#pragma unroll
            for (int i = 0; i < 4; ++i) cw[i][e] = conv_w[i * 3072 + scol + e]; }
        float win[3][8];
#pragma unroll
        for (int k = 0; k < 3; ++k) { u32x4 wv = (u32x4){0u, 0u, 0u, 0u}; if (pos0 + k - 3 >= 0) wv = *(const u32x4*)(xbc + (size_t)(t0 + k - 3) * 3072 + scol);
            win[k][0] = bf_lo(wv.x); win[k][1] = bf_hi(wv.x); win[k][2] = bf_lo(wv.y); win[k][3] = bf_hi(wv.y); win[k][4] = bf_lo(wv.z); win[k][5] = bf_hi(wv.z); win[k][6] = bf_lo(wv.w); win[k][7] = bf_hi(wv.w); }
#pragma unroll 4
        for (int k = 0; k < 16; ++k) {
            const u32x4 wv = __builtin_nontemporal_load((const u32x4*)(xbc + (size_t)(t0 + k) * 3072 + scol));
            const float cur[8] = {bf_lo(wv.x), bf_hi(wv.x), bf_lo(wv.y), bf_hi(wv.y), bf_lo(wv.z), bf_hi(wv.z), bf_lo(wv.w), bf_hi(wv.w)};
            float o[8];
#pragma unroll
            for (int e = 0; e < 8; ++e) { o[e] = silu_(cb[e] + cw[0][e] * win[0][e] + cw[1][e] * win[1][e] + cw[2][e] * win[2][e] + cw[3][e] * cur[e]); win[0][e] = win[1][e]; win[1][e] = win[2][e]; win[2][e] = cur[e]; }
            u32x4 ov; ov.x = pk2(o[0], o[1]); ov.y = pk2(o[2], o[3]); ov.z = pk2(o[4], o[5]); ov.w = pk2(o[6], o[7]);
            *(u32x4*)(bc + (size_t)(t0 + k) * 1024 + 8 * cc) = ov;
        }
    }
}
constexpr int MP_IMG = 44800, MP_XDT = 0, MP_BM = 9216, MP_CM = 26624, MP_ACS = 44032, MP_W = 44288, MP_Y0 = 2 * MP_IMG, MP_YSZ = 34816, MP_YD = 0, MP_YO = 17408, MP_CW = MP_Y0 + 2 * MP_YSZ;
DI void mamba_unit(LAS unsigned char* lds, int b, int h, const bf16_t* xbc, const bf16_t* bc, const float* dtp, const float* acsp, bf16_t* act, float* ssq_out, bf16_t* outp, size_t opitch,
                   const float* conv_w, const float* conv_b, const float* a_log, const float* d_skip) {
    const int tid = threadIdx.x, lane = tid & 63, wid = __builtin_amdgcn_readfirstlane(tid >> 6), fr = lane & 15, fq = lane >> 4, g = h >> 3;
    const float D_h = d_skip[h];
    const int l = tid >> 3, pc = tid & 7, xcol = 64 * h + 8 * pc;
    LAS float* cwl = (LAS float*)(lds + MP_CW);
    if (tid < 256) cwl[tid] = conv_w[(tid >> 6) * 3072 + 64 * h + (tid & 63)]; else if (tid < 320) cwl[tid] = conv_b[64 * h + (tid & 63)];
    f32x4 Z[8];
#pragma unroll
    for (int i = 0; i < 8; ++i) Z[i] = (f32x4){0.f, 0.f, 0.f, 0.f};
    const int frow0 = tid >> 4, fch = tid & 15;
    const size_t tb = (size_t)b * SEQ;
    u32x4 xr[4], bcr[4]; float dt_l, acs_l, acs63;
#define MB_LOAD(c_) do { const int p0_ = 64 * (c_); \
        _Pragma("unroll") for (int i_ = 0; i_ < 4; ++i_) { const int pos_ = p0_ + l - 3 + i_; xr[i_] = (u32x4){0u, 0u, 0u, 0u}; if (pos_ >= 0) xr[i_] = *(const u32x4*)(xbc + (tb + pos_) * 3072 + xcol); } \
        _Pragma("unroll") for (int i_ = 0; i_ < 4; ++i_) bcr[i_] = *(const u32x4*)(bc + (tb + p0_ + frow0 + 32 * (i_ & 1)) * 1024 + 256 * g + 128 * (i_ >> 1) + 8 * fch); \
        dt_l = dtp[(tb + p0_ + l) * 32 + h]; acs_l = acsp[(tb + p0_ + l) * 32 + h]; acs63 = acsp[(tb + p0_ + 63) * 32 + h]; } while (0)
    auto S1 = [&](const int cn, float (&xs)[8]) __attribute__((always_inline)) {
        LAS unsigned char* img = lds + (cn & 1) * MP_IMG;
        if (pc == 0) { ((LAS float*)(img + MP_ACS))[l] = acs_l; ((LAS float*)(img + MP_W))[l] = __expf(acs63 - acs_l); }
        { float r[4][8];
#pragma unroll
          for (int i = 0; i < 4; ++i) { r[i][0] = bf_lo(xr[i].x); r[i][1] = bf_hi(xr[i].x); r[i][2] = bf_lo(xr[i].y); r[i][3] = bf_hi(xr[i].y); r[i][4] = bf_lo(xr[i].z); r[i][5] = bf_hi(xr[i].z); r[i][6] = bf_lo(xr[i].w); r[i][7] = bf_hi(xr[i].w); }
          const f32x4 b0 = *(const LAS f32x4*)(cwl + 256 + 8 * pc), b1 = *(const LAS f32x4*)(cwl + 256 + 8 * pc + 4);
          float a[8] = {b0[0], b0[1], b0[2], b0[3], b1[0], b1[1], b1[2], b1[3]};
#pragma unroll
          for (int i = 0; i < 4; ++i) { const f32x4 w0 = *(const LAS f32x4*)(cwl + 64 * i + 8 * pc), w1 = *(const LAS f32x4*)(cwl + 64 * i + 8 * pc + 4);
              a[0] += w0[0] * r[i][0]; a[1] += w0[1] * r[i][1]; a[2] += w0[2] * r[i][2]; a[3] += w0[3] * r[i][3]; a[4] += w1[0] * r[i][4]; a[5] += w1[1] * r[i][5]; a[6] += w1[2] * r[i][6]; a[7] += w1[3] * r[i][7]; }
#pragma unroll
          for (int e = 0; e < 8; ++e) xs[e] = silu_(a[e]); }
        { const float d = dt_l; u32x4 av; av.x = pk2(xs[0] * d, xs[1] * d); av.y = pk2(xs[2] * d, xs[3] * d); av.z = pk2(xs[4] * d, xs[5] * d); av.w = pk2(xs[6] * d, xs[7] * d);
          *(LAS u32x4*)(img + MP_XDT + mb_b128(l, 8 * pc)) = av; }
#pragma unroll
        for (int i = 0; i < 4; ++i) *(LAS u32x4*)(img + (i < 2 ? MP_BM : MP_CM) + mb_b256(frow0 + 32 * (i & 1), 8 * fch)) = bcr[i];
        { const int cq = cn < 63 ? cn + 1 : 63; MB_LOAD(cq); }
    };
    auto S2 = [&](const int c) __attribute__((always_inline)) {
        const LAS unsigned char* img = lds + (c & 1) * MP_IMG; LAS unsigned char* yb = lds + MP_Y0 + (c & 1) * MP_YSZ;
        const LAS float* acs = (const LAS float*)(img + MP_ACS);
        if (wid >= 4) {
            const int d = wid - 4; const float la = acs[16 * d + fr];
            f32x4 X[4];
            bf16x8 cf[4];
#pragma unroll
            for (int ks = 0; ks < 4; ++ks) cf[ks] = *(const LAS bf16x8*)(img + MP_CM + mb_b256(16 * d + fr, 32 * ks + 8 * fq));
#pragma unroll
            for (int si = 0; si < 4; ++si) { X[si] = (f32x4){0.f, 0.f, 0.f, 0.f};
                if (si <= d) {
                    bf16x8 af[4];
#pragma unroll
                    for (int ks = 0; ks < 4; ++ks) af[ks] = *(const LAS bf16x8*)(img + MP_BM + mb_b256(16 * si + fr, 32 * ks + 8 * fq));
#pragma unroll
                    for (int ks = 0; ks < 4; ++ks) X[si] = MFMA16(af[ks], cf[ks], X[si]);
                    const f32x4 sa = *(const LAS f32x4*)(acs + 16 * si + 4 * fq);
#pragma unroll
                    for (int r = 0; r < 4; ++r) { const int s_abs = 16 * si + 4 * fq + r, l_abs = 16 * d + fr; X[si][r] = (s_abs <= l_abs) ? X[si][r] * __expf(la - sa[r]) : 0.f; }
                } }
            bf16x8 Xp[2];
#pragma unroll
            for (int sb = 0; sb < 2; ++sb) { u32x4 w; w.x = pk2(X[2 * sb][0], X[2 * sb][1]); w.y = pk2(X[2 * sb][2], X[2 * sb][3]); w.z = pk2(X[2 * sb + 1][0], X[2 * sb + 1][1]); w.w = pk2(X[2 * sb + 1][2], X[2 * sb + 1][3]); Xp[sb] = __builtin_bit_cast(bf16x8, w); }
#pragma unroll
            for (int ph = 0; ph < 2; ++ph) { bf16x8 xa[2][2];
#pragma unroll
                for (int q = 0; q < 2; ++q)
#pragma unroll
                    for (int sb = 0; sb < 2; ++sb) if (2 * sb <= d) xa[q][sb] = tr_pair<false>(img + MP_XDT, 32 * sb + 4 * fq, 32 * sb + 16 + 4 * fq, 16 * (2 * ph + q), lane);
#pragma unroll
                for (int q = 0; q < 2; ++q) { f32x4 y = (f32x4){0.f, 0.f, 0.f, 0.f};
#pragma unroll
                    for (int sb = 0; sb < 2; ++sb) { if (2 * sb <= d) y = MFMA16(xa[q][sb], Xp[sb], y); }
                    *(LAS f32x4*)(yb + MP_YD + (16 * d + fr) * MB_YSTR + (16 * (2 * ph + q) + 4 * fq) * 4) = y; } }
        } else {
            const int pw = wid;
            bf16x8 Zp[4];
#pragma unroll
            for (int nb = 0; nb < 4; ++nb) { u32x4 w; w.x = pk2(Z[2 * nb][0], Z[2 * nb][1]); w.y = pk2(Z[2 * nb][2], Z[2 * nb][3]); w.z = pk2(Z[2 * nb + 1][0], Z[2 * nb + 1][1]); w.w = pk2(Z[2 * nb + 1][2], Z[2 * nb + 1][3]); Zp[nb] = __builtin_bit_cast(bf16x8, w); }
#pragma unroll
            for (int lt = 0; lt < 4; ++lt) { f32x4 y = (f32x4){0.f, 0.f, 0.f, 0.f};
                bf16x8 bfr[4];
#pragma unroll
                for (int nb = 0; nb < 4; ++nb) { const s16x4 lo = *(const LAS s16x4*)(img + MP_CM + mb_b256(16 * lt + fr, 32 * nb + 4 * fq)), h4 = *(const LAS s16x4*)(img + MP_CM + mb_b256(16 * lt + fr, 32 * nb + 16 + 4 * fq));
                    bfr[nb] = __builtin_shufflevector(lo, h4, 0, 1, 2, 3, 4, 5, 6, 7); }
#pragma unroll
                for (int nb = 0; nb < 4; ++nb) y = MFMA16(Zp[nb], bfr[nb], y);
                const float ea = __expf(acs[16 * lt + fr]); y *= ea;
                *(LAS f32x4*)(yb + MP_YO + (16 * lt + fr) * MB_YSTR + (16 * pw + 4 * fq) * 4) = y; }
            const float dec = __expf(acs[63]);
            bf16x8 xw[2];
#pragma unroll
            for (int lb = 0; lb < 2; ++lb) { const bf16x8 xf = tr_pair<false>(img + MP_XDT, 32 * lb + 8 * fq, 32 * lb + 8 * fq + 4, 16 * pw, lane);
                const f32x4 w0 = *(const LAS f32x4*)((const LAS float*)(img + MP_W) + 32 * lb + 8 * fq), w1 = *(const LAS f32x4*)((const LAS float*)(img + MP_W) + 32 * lb + 8 * fq + 4);
                u32x4 o; o.x = pk2(bf2f((bf16_t)xf[0]) * w0[0], bf2f((bf16_t)xf[1]) * w0[1]); o.y = pk2(bf2f((bf16_t)xf[2]) * w0[2], bf2f((bf16_t)xf[3]) * w0[3]);
                o.z = pk2(bf2f((bf16_t)xf[4]) * w1[0], bf2f((bf16_t)xf[5]) * w1[1]); o.w = pk2(bf2f((bf16_t)xf[6]) * w1[2], bf2f((bf16_t)xf[7]) * w1[3]); xw[lb] = __builtin_bit_cast(bf16x8, o); }
#pragma unroll
            for (int np = 0; np < 4; ++np) { bf16x8 av[2][2];
#pragma unroll
                for (int q = 0; q < 2; ++q)
#pragma unroll
                    for (int lb = 0; lb < 2; ++lb) av[q][lb] = tr_pair<true>(img + MP_BM, 32 * lb + 8 * fq, 32 * lb + 8 * fq + 4, 16 * (2 * np + q), lane);
#pragma unroll
                for (int q = 0; q < 2; ++q) { Z[2 * np + q] *= dec;
#pragma unroll
                    for (int lb = 0; lb < 2; ++lb) Z[2 * np + q] = MFMA16(av[q][lb], xw[lb], Z[2 * np + q]); } }
        }
    };
    auto S3 = [&](const int cp, const float (&xs)[8], const u32x4 zw) __attribute__((always_inline)) {
        const LAS unsigned char* yb = lds + MP_Y0 + (cp & 1) * MP_YSZ; const size_t t0 = tb + 64 * cp;
        const f32x4 a0 = *(const LAS f32x4*)(yb + MP_YD + l * MB_YSTR + pc * 32), a1 = *(const LAS f32x4*)(yb + MP_YD + l * MB_YSTR + pc * 32 + 16);
        const f32x4 b0 = *(const LAS f32x4*)(yb + MP_YO + l * MB_YSTR + pc * 32), b1 = *(const LAS f32x4*)(yb + MP_YO + l * MB_YSTR + pc * 32 + 16);
        float y[8];
        y[0] = (a0[0] + b0[0] + D_h * xs[0]) * bf_lo(zw.x); y[1] = (a0[1] + b0[1] + D_h * xs[1]) * bf_hi(zw.x);
        y[2] = (a0[2] + b0[2] + D_h * xs[2]) * bf_lo(zw.y); y[3] = (a0[3] + b0[3] + D_h * xs[3]) * bf_hi(zw.y);
        y[4] = (a1[0] + b1[0] + D_h * xs[4]) * bf_lo(zw.z); y[5] = (a1[1] + b1[1] + D_h * xs[5]) * bf_hi(zw.z);
        y[6] = (a1[2] + b1[2] + D_h * xs[6]) * bf_lo(zw.w); y[7] = (a1[3] + b1[3] + D_h * xs[7]) * bf_hi(zw.w);
        float ss = 0.f;
#pragma unroll
        for (int e = 0; e < 8; ++e) ss += y[e] * y[e];
        ss += __shfl_xor(ss, 1); ss += __shfl_xor(ss, 2); ss += __shfl_xor(ss, 4);
        if (pc == 0) ssq_out[(t0 + l) * 32 + h] = ss;
        u32x4 w; w.x = pk2(y[0], y[1]); w.y = pk2(y[2], y[3]); w.z = pk2(y[4], y[5]); w.w = pk2(y[6], y[7]); *(u32x4*)(outp + (t0 + l) * opitch + 64 * h + 8 * pc) = w;
    };
#define MB_Z(c_) __builtin_nontemporal_load((const u32x4*)(act + (tb + 64 * (c_) + l) * ACT_P + 1024 + 64 * h + 8 * pc))
    float xsA[8], xsB[8]; u32x4 zA, zB;
    MB_LOAD(0);
    __syncthreads();
    S1(0, xsA); zA = MB_Z(0);
    __syncthreads();
#pragma unroll 1
    for (int c = 0; c < 64; c += 2) {
        if (wid < 4) S2(c);
        if (c > 0) S3(c - 1, xsB, zB);
        S1(c + 1, xsB); zB = MB_Z(c + 1);
        if (wid >= 4) S2(c);
        __syncthreads();
        if (wid < 4) S2(c + 1);
        S3(c, xsA, zA);
        if (c + 2 < 64) { S1(c + 2, xsA); zA = MB_Z(c + 2); }
        if (wid >= 4) S2(c + 1);
        __syncthreads();
    }
    S3(63, xsB, zB);
#undef MB_LOAD
#undef MB_Z
    __syncthreads();
}
constexpr int RT_W = 0, RT_CNT = 131072, RT_BASE = 131072 + 128;
constexpr int MO_TS = 131072 + 256, MO_CNT = 131072 + 512;

DI void router_phase(LAS unsigned char* lds, int vcu, int G, const float* x1, const float* norm_ffn, const float* w_router, const float* b_router,
                     unsigned char* h2, int* sel_e, int* sel_r, float* sel_w, int* tokl, unsigned* gcnt) {
    const int tid = threadIdx.x, lane = tid & 63, wid = __builtin_amdgcn_readfirstlane(tid >> 6), l31 = lane & 31, hi = lane >> 5;
    LAS float* Wl = (LAS float*)(lds + RT_W); LAS unsigned* lcnt = (LAS unsigned*)(lds + RT_CNT); LAS unsigned* lbase = (LAS unsigned*)(lds + RT_BASE);
    for (int idx = tid; idx < 1024 * 8; idx += 512) { const f32x4 w = *(const f32x4*)(w_router + 4 * idx); const float gk = norm_ffn[idx >> 3]; LAS float* p = Wl + 4 * idx; p[0] = w[0] * gk; p[1] = w[1] * gk; p[2] = w[2] * gk; p[3] = w[3] * gk; }
    if (tid < 32) lcnt[tid] = 0u;
    __syncthreads();
    if (wid >= 4) {
        for (int m = (vcu * 4 + (wid - 4)) * 4; m < T; m += G * 16) rms_rows_to_fp8<4>(x1 + (size_t)m * 1024, h2 + (size_t)m * 1024, norm_ffn, lane);
    } else
    for (int tile = vcu + G * wid; tile < T / 32; tile += G * 4) {
        const int t0 = tile * 32;
        f32x16 acc;
#pragma unroll
        for (int r = 0; r < 16; ++r) acc[r] = 0.f;
        float ssq = 0.f;
        const float* xr = x1 + (size_t)(t0 + l31) * 1024 + 4 * hi;
#pragma unroll 4
        for (int c = 0; c < 128; ++c) {
            const f32x4 xv = *(const f32x4*)(xr + 8 * c);
            ssq += (xv[0] * xv[0] + xv[1] * xv[1]) + (xv[2] * xv[2] + xv[3] * xv[3]);
#pragma unroll
            for (int u = 0; u < 4; ++u) { const float a = Wl[(8 * c + 4 * hi + u) * 32 + l31]; acc = __builtin_amdgcn_mfma_f32_32x32x2f32(a, xv[u], acc, 0, 0, 0); }
        }
        ssq += __shfl_xor(ssq, 32);
        const float rstd = __builtin_amdgcn_rsqf(ssq * (1.f / 1024.f) + EPS);
        float lg[16];
#pragma unroll
        for (int r = 0; r < 16; ++r) lg[r] = acc[r] * rstd + b_router[crow(r, hi)];
        float sv[4]; int si[4];
#pragma unroll
        for (int k = 0; k < 4; ++k) {
            float bv = lg[0]; int bi = crow(0, hi);
#pragma unroll
            for (int r = 1; r < 16; ++r) { const int id = crow(r, hi); if (lg[r] > bv) { bv = lg[r]; bi = id; } }
            const float pv = __shfl_xor(bv, 32); const int pi = __shfl_xor(bi, 32);
            if (pv > bv || (pv == bv && pi < bi)) { bv = pv; bi = pi; }
            sv[k] = bv; si[k] = bi;
#pragma unroll
            for (int r = 0; r < 16; ++r) if (crow(r, hi) == bi) lg[r] = -INFINITY;
        }
        const float e1 = __expf(sv[1] - sv[0]), e2 = __expf(sv[2] - sv[0]), e3 = __expf(sv[3] - sv[0]), inv = 1.0f / (1.0f + e1 + e2 + e3);
        if (hi == 0) {
            const int t = t0 + l31; const float wv[4] = {inv, e1 * inv, e2 * inv, e3 * inv};
#pragma unroll
            for (int k = 0; k < 4; ++k) { const unsigned lr = atomicAdd((unsigned*)&lcnt[si[k]], 1u); sel_e[t * 4 + k] = si[k]; sel_r[t * 4 + k] = (int)lr; sel_w[t * 4 + k] = wv[k]; }
        }
    }
    __syncthreads();
    if (tid < 32) lbase[tid] = atomicAdd(&gcnt[tid], lcnt[tid]);
    __syncthreads();
    if (wid < 4) for (int tile = vcu + G * wid; tile < T / 32; tile += G * 4) {
        if (hi == 0) { const int t = tile * 32 + l31;
#pragma unroll
            for (int k = 0; k < 4; ++k) { const int e = sel_e[t * 4 + k]; const int r = sel_r[t * 4 + k] + (int)lbase[e]; sel_r[t * 4 + k] = r; tokl[(size_t)e * T + r] = t; } }
    }
}

DI int moe_tables(LAS unsigned char* lds, const unsigned* gcnt) {
    LAS int* ts = (LAS int*)(lds + MO_TS); LAS int* cn = (LAS int*)(lds + MO_CNT);
    __syncthreads();
    if (threadIdx.x < 32) cn[threadIdx.x] = (int)gcnt[threadIdx.x];
    __syncthreads();
    if (threadIdx.x == 0) { int s = 0; for (int e = 0; e < NEXP; ++e) { ts[e] = s; s += (cn[e] + 255) >> 8; } ts[NEXP] = s; }
    __syncthreads();
    return ts[NEXP];
}

DI void combine_phase(LAS unsigned char* lds, int vcu, int G, int tlo, int thi, const bf16_t* y, const int* sel_e, const int* sel_r, const float* sel_w, const float* x1, float* out, float wscale) {
    const int lane = threadIdx.x & 63, wid = threadIdx.x >> 6; const LAS int* ts = (const LAS int*)(lds + MO_TS);
    for (int tb = (vcu * 8 + wid) * 4; tb < T; tb += G * 32) {
        int rowi[4][4]; float wv[4][4];
#pragma unroll
        for (int q = 0; q < 4; ++q) { const int4 e4 = *(const int4*)(sel_e + (tb + q) * 4), r4 = *(const int4*)(sel_r + (tb + q) * 4); const f32x4 w4 = *(const f32x4*)(sel_w + (tb + q) * 4);
            const int ee[4] = {e4.x, e4.y, e4.z, e4.w}, rr[4] = {r4.x, r4.y, r4.z, r4.w};
#pragma unroll
            for (int k = 0; k < 4; ++k) { const int row = ts[ee[k]] * 256 + rr[k], tile = row >> 8; const bool in = tile >= tlo && tile < thi; rowi[q][k] = in ? row - tlo * 256 : -1; wv[q][k] = w4[k] * wscale; } }
#pragma unroll
        for (int q = 0; q < 4; ++q) {
            float* op = out + (size_t)(tb + q) * 1024 + 8 * lane; const float* xp = x1 + (size_t)(tb + q) * 1024 + 8 * lane;
            f32x4 a0 = __builtin_nontemporal_load((const f32x4*)xp), a1 = __builtin_nontemporal_load((const f32x4*)(xp + 4)), a2 = __builtin_nontemporal_load((const f32x4*)(xp + 512)), a3 = __builtin_nontemporal_load((const f32x4*)(xp + 516));
            u32x4 v0[4], v1[4];
#pragma unroll
            for (int k = 0; k < 4; ++k) { v0[k] = (u32x4){0u, 0u, 0u, 0u}; v1[k] = v0[k]; if (rowi[q][k] >= 0) { const bf16_t* yp = y + (size_t)rowi[q][k] * 1024 + 8 * lane; v0[k] = __builtin_nontemporal_load((const u32x4*)yp); v1[k] = __builtin_nontemporal_load((const u32x4*)(yp + 512)); } }
#pragma unroll
            for (int k = 0; k < 4; ++k) { const float w = wv[q][k];
                a0[0] += w * bf_lo(v0[k].x); a0[1] += w * bf_hi(v0[k].x); a0[2] += w * bf_lo(v0[k].y); a0[3] += w * bf_hi(v0[k].y);
                a1[0] += w * bf_lo(v0[k].z); a1[1] += w * bf_hi(v0[k].z); a1[2] += w * bf_lo(v0[k].w); a1[3] += w * bf_hi(v0[k].w);
                a2[0] += w * bf_lo(v1[k].x); a2[1] += w * bf_hi(v1[k].x); a2[2] += w * bf_lo(v1[k].y); a2[3] += w * bf_hi(v1[k].y);
                a3[0] += w * bf_lo(v1[k].z); a3[1] += w * bf_hi(v1[k].z); a3[2] += w * bf_lo(v1[k].w); a3[3] += w * bf_hi(v1[k].w); }
            __builtin_nontemporal_store(a0, (f32x4*)op); __builtin_nontemporal_store(a1, (f32x4*)(op + 4)); __builtin_nontemporal_store(a2, (f32x4*)(op + 512)); __builtin_nontemporal_store(a3, (f32x4*)(op + 516));
        }
    }
}
#define XB_TMO      128
#define XB_XCNT(j)  (256  + 64 * (j))
#define XB_XSUB(j)  (1280 + 64 * (j))
#define XB_XGEN(j)  (2304 + 64 * (j))
#define XB_TOP      3328
#define XB_TOPGEN   3392
#define XCD_BAR_WORDS 3456
#define XB_SPIN_CAP (1u << 18)

__device__ __forceinline__ unsigned xb_ld(unsigned* p)              { return __hip_atomic_load(p, __ATOMIC_RELAXED, __HIP_MEMORY_SCOPE_AGENT); }
__device__ __forceinline__ unsigned xb_add(unsigned* p, unsigned v) { return __hip_atomic_fetch_add(p, v, __ATOMIC_RELAXED, __HIP_MEMORY_SCOPE_AGENT); }
__device__ __forceinline__ unsigned xb_xcc_id() { return (unsigned)__builtin_amdgcn_s_getreg((3 << 11) | 20) & 0xFu; }
#define XB_SPIN(cond, bar) do { unsigned _sp = 0; while (cond) { __builtin_amdgcn_s_sleep(1); \
    if ((++_sp & 255u) == 0u) { if (xb_ld(&(bar)[XB_TMO])) break; if (_sp > XB_SPIN_CAP) { atomicAdd(&(bar)[XB_TMO], 1u); break; } } } } while (0)

struct XcdBarrier {
    unsigned* bar; unsigned x;
    volatile LAS unsigned* st;
};

__device__ __forceinline__ XcdBarrier xcd_barrier_post(unsigned* bar, volatile LAS unsigned* st) {
    XcdBarrier b; b.bar = bar; b.x = xb_xcc_id(); b.st = st;
    if (threadIdx.x == 0) (void)xb_add(&bar[XB_XCNT(b.x)], 1u);
    return b;
}
__device__ __forceinline__ void xcd_barrier_complete(unsigned* bar, unsigned x, unsigned& nloc, unsigned& nx) {
    const unsigned G = gridDim.x * gridDim.y * gridDim.z;
    unsigned sum, cnt, mine, sp = 0u;
    for (;;) {
        sum = 0u; cnt = 0u; mine = 0u;
#pragma unroll
        for (unsigned j = 0; j < 16; ++j) { const unsigned c = xb_ld(&bar[XB_XCNT(j)]); sum += c; cnt += (c > 0u) ? 1u : 0u; mine = (j == x) ? c : mine; }
        if (sum == G) break;
        __builtin_amdgcn_s_sleep(1);
        if ((++sp & 255u) == 0u) { if (xb_ld(&bar[XB_TMO])) break; if (sp > XB_SPIN_CAP) { atomicAdd(&bar[XB_TMO], 1u); break; } }
    }
    nloc = mine > 0u ? mine : 1u; nx = cnt > 0u ? cnt : 1u;
}

__device__ __forceinline__ void xcd_barrier(const XcdBarrier& b) {
    asm volatile("s_waitcnt vmcnt(0)" ::: "memory");
    __syncthreads();
    if (threadIdx.x == 0) {
        unsigned* bar = b.bar;
        __builtin_amdgcn_s_waitcnt(0);
        unsigned nloc = b.st[0], nx = b.st[1];
        if (nloc == 0u) { xcd_barrier_complete(bar, b.x, nloc, nx); b.st[0] = nloc; b.st[1] = nx; }
        const unsigned old = xb_add(&bar[XB_XSUB(b.x)], 1u);
        const unsigned gen = old / nloc;
        if (old + 1u == (gen + 1u) * nloc) {
            __builtin_amdgcn_fence(__ATOMIC_RELEASE, "agent");
            asm volatile("s_waitcnt vmcnt(0)" ::: "memory");
            const unsigned og = xb_add(&bar[XB_TOP], 1u);
            const unsigned tg = og / nx;
            if (og + 1u == (tg + 1u) * nx) xb_add(&bar[XB_TOPGEN], 1u);
            else XB_SPIN(xb_ld(&bar[XB_TOPGEN]) == tg, bar);
            __builtin_amdgcn_fence(__ATOMIC_ACQUIRE, "agent");
            xb_add(&bar[XB_XGEN(b.x)], 1u);
            asm volatile("s_waitcnt vmcnt(0)" ::: "memory");
        } else {
            XB_SPIN(xb_ld(&bar[XB_XGEN(b.x)]) == gen, bar);
            __builtin_amdgcn_fence(__ATOMIC_ACQUIRE, "agent");
            asm volatile("s_waitcnt vmcnt(0)" ::: "memory");
        }
    }
    __syncthreads();
}


#ifndef MK_N_LAUNCHES
#define MK_N_LAUNCHES 1
#endif
#ifndef MK_BRANCHES
#define MK_BRANCHES 15
#endif
constexpr int N_PHASES = 12;
#ifndef MK_PROBE_BLOCK
#define MK_PROBE_BLOCK 65
#endif
#ifndef MK_USE_CG
#define MK_USE_CG 0
#endif
constexpr int LDS_BARST = 163840 - 64;
constexpr int CW_BAR = 4096;
constexpr int LDS_BYTES = 163840;
constexpr int NTHREADS = 512;

struct Args { const float* in[30]; float* out; unsigned char* ws; int ph_lo, ph_hi; };
enum { I_x = 0, I_mem = 1, I_norm_mix = 2, I_w_in = 3, I_a_q_gain = 4, I_a_k_gain = 5, I_a_rel_bias = 6, I_conv_w = 7, I_conv_b = 8, I_dt_bias = 9, I_a_log = 10, I_d_skip = 11, I_ssm_norm = 12, I_norm_mem = 13, I_w_mem_kv = 14, I_x_q_gain = 15, I_x_k_gain = 16, I_w_br_a = 17, I_w_br_b = 18, I_w_br_c = 19, I_w_out = 20, I_norm_ffn = 21, I_w_router = 22, I_b_router = 23, I_w_gate = 24, I_b_gate = 25, I_w_up = 26, I_b_up = 27, I_w_down = 28, I_b_down = 29 };

#define WIN WSP(bf16_t, WS_WIN)
#define WCAT WSP(bf16_t, WS_WCAT)
#define WOUT WSP(bf16_t, WS_WOUT)
#define WMEM WSP(bf16_t, WS_WMEM)
#define DTB WSP(float, WS_DT)
#define SSQ WSP(float, WS_SSQ)
#define RSTD WSP(float, WS_RSTD)
#define KX WSP(bf16_t, WS_KX)
#define MEMKV WSP(bf16_t, WS_MEMKV)
#define XN WSP(bf16_t, WS_XN)
#define MEMN WSP(bf16_t, WS_MEMN)
#define ACT WSP(bf16_t, WS_ACT)
#define KA WSP(bf16_t, WS_KA)
#define VA WSP(bf16_t, WS_VA)
#define XBC WSP(bf16_t, WS_XBC)
#define GATES WSP(bf16_t, WS_GATES)
#define MERGED WSP(bf16_t, WS_MERGED)
#define H2 WSP(unsigned char, MOE_H2)
#define WGU ((unsigned char*)(GAS unsigned char*)kq[30] + OUT_WGU)
#define WD ((unsigned char*)(GAS unsigned char*)kq[30] + OUT_WD)
#define X1 WSP(float, WS_X1)
#define ACTM WSP(unsigned char, MOE_ACTM)
#define YB WSP(bf16_t, MOE_Y)
#define SELE WSP(int, MOE_SELE)
#define SELR WSP(int, MOE_SELR)
#define SELW WSP(float, MOE_SELW)
#define TOKL WSP(int, MOE_TOKL)
#define GCNT (WSP(unsigned, WS_CTL) + CW_CNT)
#define ACSB ((float*)(GAS float*)kq[30] + (size_t)T * 512)
#define BCC ((bf16_t*)(GAS bf16_t*)kq[30])
#define EI_INIT const EpiIn EI{ws, AP(a_q_gain), AP(a_k_gain), AP(dt_bias)}
typedef const __attribute__((address_space(4))) unsigned long long* KW;
DI KW launder(KW p) { asm volatile("" : "+s"(p)); return p; }
#define AP(name) ((const float*)(const GAS float*)kq[I_##name])
#define PHASE_ARGS const KW kq = launder(kp); unsigned char* const ws = (unsigned char*)(GAS unsigned char*)kq[31]; (void)ws
#define WSP(type, off) ((type*)(ws + (off)))
__global__ void __launch_bounds__(NTHREADS, 2) mega_fwd(Args a_unused) {
    extern __shared__ __attribute__((aligned(16))) unsigned char lds_raw[];
    LAS unsigned char* lds = (LAS unsigned char*)lds_raw;
    const KW kp = (KW)__builtin_amdgcn_kernarg_segment_ptr();
    const int tid = threadIdx.x, lane = tid & 63, wid = __builtin_amdgcn_readfirstlane(tid >> 6);
    const int G = gridDim.x, bx = blockIdx.x, vcu = (G % 8 == 0) ? (bx % 8) * (G / 8) + bx / 8 : bx;
    const int lo = (int)(unsigned)kp[32], hi = (int)(kp[32] >> 32);
#ifndef MK_PHASE_MASK
#define MK_PHASE_MASK 0x7fff
#endif
#define IN(k) (((MK_PHASE_MASK >> (k)) & 1) && lo <= (k) && (k) < hi)
#ifndef MK_REP_MASK
#define MK_REP_MASK 0
#endif
#define REPS(k) (((MK_REP_MASK >> (k)) & 1) + 1)
#if MK_USE_CG
#define SEAM(k) do { if (IN(k) && IN((k) + 1)) { cg::this_grid().sync(); } } while (0)
#else
#define GEMM_SEAM(k) ((k) == 1 || (k) == 3 || (k) == 5 || (k) == 6 || (k) == 7 || (k) == 9 || (k) == 10)
#define SEAM(k) do { if (IN(k) && IN((k) + 1)) { const bool pr_ = (MK_PROBE == 901 && GEMM_SEAM(k)) || (MK_PROBE == 902 && !GEMM_SEAM(k)) || (MK_PROBE == 910 + (k)); unsigned long long t0_ = 0; if (pr_) t0_ = rtc(); xcd_barrier(bar); if (pr_) pacc += rtc() - t0_; } } while (0)
#endif
    const int gw = vcu * 8 + wid, NGW = G * 8;
    unsigned long long pacc = 0;
    for (int u = tid; u < 16; u += NTHREADS) ((LAS unsigned*)(lds + LDS_BARST))[u] = 0u;
    __syncthreads();
    XcdBarrier bar = xcd_barrier_post((unsigned*)(GAS unsigned*)(kp[31]) + CW_BAR, (volatile LAS unsigned*)(lds + LDS_BARST));
    LAS float* scr = (LAS float*)(lds + wid * 16896);

    if (IN(0)) { PHASE_ARGS;
        constexpr int I_IN = 16 * 196, I_MEM = 16 * 32, I_A = 16 * 16, I_B = 32 * 16, I_C = 16 * 16, I_O = 16 * 16, NIT = I_IN + I_MEM + I_A + I_B + I_C + I_O;
        auto mk = [&](int it0) -> TrItem { int r = it0 % NIT; TrItem t; t.kscale = nullptr; t.mul = 1.0f; t.fp8 = 0;
            if (r < I_IN) { const int kb = r / 196, nb = r % 196; t.W = AP(w_in); t.Ns = IN_COLS; t.k0 = 64 * kb; t.sc0 = win_src_col(2 * nb); t.sc1 = win_src_col(2 * nb + 1); t.dst = WIN + (size_t)(64 * nb) * 1024 + 64 * kb; t.dpitch = 1024; return t; } r -= I_IN;
            if (r < I_MEM) { const int kb = r / 32, nb = r % 32; t.W = AP(w_mem_kv); t.Ns = 2048; t.k0 = 64 * kb; t.sc0 = 64 * nb; t.sc1 = 64 * nb + 32; t.dst = WMEM + (size_t)(64 * nb) * 1024 + 64 * kb; t.dpitch = 1024; return t; } r -= I_MEM;
            if (r < I_A) { const int kb = r / 16, nb = r % 16; t.W = AP(w_br_a); t.Ns = 1024; t.k0 = 64 * kb; t.sc0 = 64 * nb; t.sc1 = 64 * nb + 32; t.dst = WCAT + (size_t)(64 * nb) * 4096 + 64 * kb; t.dpitch = 4096; return t; } r -= I_A;
            if (r < I_B) { const int kb = r / 16, nb = r % 16; t.W = AP(w_br_b); t.Ns = 1024; t.k0 = 64 * kb; t.sc0 = 64 * nb; t.sc1 = 64 * nb + 32; t.dst = WCAT + (size_t)(64 * nb) * 4096 + 1024 + 64 * kb; t.dpitch = 4096; t.kscale = AP(ssm_norm); return t; } r -= I_B;
            if (r < I_C) { const int kb = r / 16, nb = r % 16; t.W = AP(w_br_c); t.Ns = 1024; t.k0 = 64 * kb; t.sc0 = 64 * nb; t.sc1 = 64 * nb + 32; t.dst = WCAT + (size_t)(64 * nb) * 4096 + 3072 + 64 * kb; t.dpitch = 4096; return t; } r -= I_C;
            { const int kb = r / 16, nb = r % 16; t.W = AP(w_out); t.Ns = 1024; t.k0 = 64 * kb; t.sc0 = 64 * nb; t.sc1 = 64 * nb + 32; t.dst = WOUT + (size_t)(64 * nb) * 1024 + 64 * kb; t.dpitch = 1024; return t; } };
        { const int nitems = NIT * REPS(0); f32x4 va[16], vb[16]; TrItem ia, ib; int it = gw;
          if (it < nitems) { ia = mk(it); tr_load(ia, va, lane); }
          while (it < nitems) {
              const int i2 = it + NGW; if (i2 < nitems) { ib = mk(i2); tr_load(ib, vb, lane); }
              tr_store(ia, va, scr, lane);
              if (i2 >= nitems) break;
              const int i3 = i2 + NGW; if (i3 < nitems) { ia = mk(i3); tr_load(ia, va, lane); }
              tr_store(ib, vb, scr, lane);
              it = i3; } }
        for (int m0 = gw * 4; m0 < T * REPS(0); m0 += NGW * 4) { const int m = m0 % T; rms_rows_to_bf16<4>(AP(x) + (size_t)m * 1024, XN + (size_t)m * 1024, 1, AP(norm_mix), lane); }
        for (int m = gw; m < NBATCH * MEMLEN; m += NGW) rms_rows_to_bf16<1>(AP(mem) + (size_t)m * 1024, MEMN + (size_t)m * 1024, 1, AP(norm_mem), lane);
    }
    SEAM(0);
    if (IN(1)) { PHASE_ARGS; EI_INIT;
        const SchedIn S{G, bx, 16, TL_Q, 12, TL_QX, 0, (const char*)WIN, (const char*)WMEM, REPS(1), 0, 1 << 30};
        pg8::gemm_phase<false>(lds, (const char*)XN, 2048, 2048, S, EI);
    }
    SEAM(1);
    if (IN(2)) { PHASE_ARGS;
        if (MK_BRANCHES & 1) {
            LAS float* bl = (LAS float*)(lds + AT_BIAS);
            for (int i = tid; i < 16 * 257; i += NTHREADS) bl[(i / 257) * AT_BIAS_STRIDE + (i % 257)] = AP(a_rel_bias)[i] * LOG2E;
            __syncthreads();
            for (int u = vcu; u < 4 * NBATCH * 32; u += G) { const int cp = u & 31, b = (u >> 5) & 7, hq = u >> 8; attnA_unit(lds, b, cp, hq, ACT, KA, VA, ACT, ACT_P); }
        } else {
            for (int idx = vcu * NTHREADS + tid; idx < T * 128; idx += G * NTHREADS) { const int t = idx >> 7, ch = idx & 127; *(u32x4*)(ACT + (size_t)t * ACT_P + ch * 8) = (u32x4){0u, 0u, 0u, 0u}; }
        }
    }
    SEAM(2);
    if (IN(3)) { PHASE_ARGS; EI_INIT;
        const SchedIn S{G, bx, 21, TL_Z, 21, 0, 64, (const char*)WIN, (const char*)WMEM, REPS(3), 0, 1 << 30};
        pg8::gemm_phase<false>(lds, (const char*)XN, 2048, 2048, S, EI);
    }
    SEAM(3);
    if (IN(4)) { PHASE_ARGS;
        if (MK_BRANCHES & 2) bcconv_phase(vcu, G, XBC, BCC, AP(conv_w), AP(conv_b), DTB, ACSB, AP(a_log));
        for (int w = gw; w < NBATCH * MEMLEN * 4; w += NGW) {
            const int row = w >> 2, hx = w & 3; const u32x2 kv = *(const u32x2*)(MEMKV + (size_t)row * 2048 + 256 * hx + 4 * lane);
            const float k0 = bf_lo(kv.x), k1 = bf_hi(kv.x), k2 = bf_lo(kv.y), k3 = bf_hi(kv.y);
            const float rs = __builtin_amdgcn_rsqf(wave_sum(k0 * k0 + k1 * k1 + k2 * k2 + k3 * k3) * (1.f / 256.f) + EPS) * (0.0625f * LOG2E);
            const f32x4 gk = *(const f32x4*)(AP(x_k_gain) + 4 * lane), gq = *(const f32x4*)(AP(x_q_gain) + 4 * lane);
            u32x2 o; o.x = pk2(k0 * rs * gk.x * gq.x, k1 * rs * gk.y * gq.y); o.y = pk2(k2 * rs * gk.z * gq.z, k3 * rs * gk.w * gq.w);
            *(u32x2*)(KX + (size_t)row * 1024 + 256 * hx + 4 * lane) = o;
        }
        xcd_barrier(bar);
        if (MK_BRANCHES & 4) attnC_phase(lds, vcu, G, ACT, KX, MEMKV, ACT + 3072, ACT_P);
        if (MK_BRANCHES & 2) { int nrep = 1 + (MK_REP_MASK >> 4 & 1); asm volatile("" : "+s"(nrep));
#pragma unroll 1
            for (int rep = 0; rep < nrep; ++rep) { const bool real = rep == nrep - 1;
                for (int u = vcu; u < NBATCH * 32; u += G) mamba_unit(lds, u >> 5, u & 31, XBC, BCC, DTB, ACSB, ACT, SSQ, real ? ACT + 1024 : (bf16_t*)RSTD, real ? (size_t)ACT_P : (size_t)0, AP(conv_w), AP(conv_b), AP(a_log), AP(d_skip)); } }
    }
    SEAM(4);
    if (IN(5)) { PHASE_ARGS; EI_INIT;
        for (int idx = vcu * NTHREADS + tid; idx < T * 4; idx += G * NTHREADS) { const int t = idx >> 2, g = idx & 3; const f32x4 s0 = *(const f32x4*)(SSQ + (size_t)t * 32 + 8 * g), s1 = *(const f32x4*)(SSQ + (size_t)t * 32 + 8 * g + 4);
            RSTD[idx] = __builtin_amdgcn_rsqf(((s0[0] + s0[1]) + (s0[2] + s0[3]) + (s1[0] + s1[1]) + (s1[2] + s1[3])) * (1.f / 512.f) + EPS); }
        int jslot = (bx >> 3) % 7; asm volatile("" : "+s"(jslot));
        { const SchedIn S{G, bx, 12, TL_G, 12, 0, 0, (const char*)WIN, (const char*)WMEM, REPS(5), 0, jslot};
          pg8::gemm_phase<false>(lds, (const char*)XN, 2048, 2048, S, EI); }
        if (MK_BRANCHES & 8) {
            auto mk = [&](int it) -> TrItem { const int e = it / 768, r = it % 768, which = r >> 8, kb = (r & 255) >> 4, nb = r & 15; TrItem t;
                t.W = (which == 0 ? AP(w_gate) : which == 1 ? AP(w_up) : AP(w_down)) + (size_t)e * 1024 * 1024; t.Ns = 1024; t.k0 = 64 * kb; t.sc0 = 64 * nb; t.sc1 = 64 * nb + 32; t.dpitch = 1024; t.kscale = nullptr; t.mul = 32.0f; t.fp8 = 1;
                t.dst = which == 2 ? (void*)(WD + ((size_t)e * 1024 + 64 * nb) * 1024 + 64 * kb) : (void*)(WGU + ((size_t)e * 2048 + 256 * (nb >> 1) + 128 * which + 64 * (nb & 1)) * 1024 + 64 * kb); return t; };
            __syncthreads(); tr_run(mk, NEXP * 768, gw, NGW, scr, lane); __syncthreads();
        }
        { const KW kq2 = launder(kp); int js2 = (bx >> 3) % 7; asm volatile("" : "+s"(js2));
          const EpiIn EI2{(unsigned char*)(GAS unsigned char*)kq2[31], (const float*)(const GAS float*)kq2[I_a_q_gain], (const float*)(const GAS float*)kq2[I_a_k_gain], (const float*)(const GAS float*)kq2[I_dt_bias]};
          const SchedIn S{G, bx, 12, TL_G, 12, 0, 0, (const char*)((unsigned char*)(GAS unsigned char*)kq2[31] + WS_WIN), (const char*)((unsigned char*)(GAS unsigned char*)kq2[31] + WS_WMEM), REPS(5), js2, 1 << 30};
          pg8::gemm_phase<false>(lds, (const char*)((unsigned char*)(GAS unsigned char*)kq2[31] + WS_XN), 2048, 2048, S, EI2); }
    }
    SEAM(5);
    if (IN(6)) { PHASE_ARGS;
        constexpr int LASTSEG = (MK_BRANCHES & 4) ? 2 : ((MK_BRANCHES & 2) ? 1 : 0);
        constexpr int KM = LASTSEG == 2 ? 4096 : (LASTSEG == 1 ? 3072 : 1024);
        const SchedDense S{G, bx, T / 256, 4, 4096, (const char*)WCAT, REPS(6)};
        const EpiMerge E{GATES, RSTD, MERGED, LASTSEG};
        pg8::gemm_phase<false>(lds, (const char*)ACT, KM * 2, 8192, S, E);
    }
    SEAM(6);
    if (IN(7)) { PHASE_ARGS;
        const SchedDense S{G, bx, T / 256, 4, 1024, (const char*)WOUT, REPS(7)};
        const EpiOut E{AP(x), X1};
        pg8::gemm_phase<false>(lds, (const char*)MERGED, 2048, 2048, S, E);
    }
    SEAM(7);
    if (IN(8) && (MK_BRANCHES & 8)) { PHASE_ARGS;
        { int nrep = 1 + (MK_REP_MASK >> 11 & 1); asm volatile("" : "+s"(nrep));
#pragma unroll 1
          for (int rep = 0; rep < nrep; ++rep) { const bool real = rep == nrep - 1; const size_t dm = real ? 0 : (MOE_ACTM - MOE_SELE);
            router_phase(lds, vcu, G, X1, AP(norm_ffn), AP(w_router), AP(b_router), H2, (int*)((char*)SELE + dm), (int*)((char*)SELR + dm), (float*)((char*)SELW + dm), (int*)((char*)TOKL + dm), GCNT + (real ? 0 : 64));
            __syncthreads(); } }
    }
    SEAM(8);
    {
        if ((MK_BRANCHES & 8) && (IN(9) || IN(10) || IN(11))) { PHASE_ARGS;
            const int total = moe_tables(lds, GCNT), tlo = 0, thi = total;
            const LAS int* ts = (const LAS int*)(lds + MO_TS); const LAS int* cn = (const LAS int*)(lds + MO_CNT);
            if (IN(9)) { const SchedMoE S{G, bx, 8, tlo, thi, ts, cn, TOKL, (const char*)WGU, (size_t)2048 * 1024, REPS(9), 1024u, 1024u}; const EpiGU E{ACTM, AP(b_gate), AP(b_up), tlo};
                pg8::gemm_phase<true>(lds, (const char*)H2, 1024, 1024, S, E); }
            SEAM(9);
            if (IN(10)) { const SchedMoE S{G, bx, 4, tlo, thi, ts, cn, nullptr, (const char*)WD, (size_t)1024 * 1024, REPS(10), 1024u, 1024u}; const EpiDown E{YB, AP(b_down), tlo};
                pg8::gemm_phase<true>(lds, (const char*)ACTM, 1024, 1024, S, E); }
            SEAM(10);
            if (IN(11)) { int nrep = 1 + (MK_REP_MASK >> 12 & 1); asm volatile("" : "+s"(nrep));
#pragma unroll 1
                for (int rep = 0; rep < nrep; ++rep) combine_phase(lds, vcu, G, tlo, thi, YB, SELE, SELR, SELW, X1, ((float*)(GAS float*)kq[30]), 1.0f / (float)nrep); }
        } else { SEAM(9); SEAM(10); }
    }
    if (MK_PROBE && blockIdx.x == MK_PROBE_BLOCK && wid == 0) { const unsigned long long t_end = rtc() + pacc * 10ull; while (rtc() < t_end) __builtin_amdgcn_s_sleep(8); }
#undef IN
#undef SEAM
}

extern "C" void kernel_launch(void* const* d_in, const int* in_sizes, int n_in, void* d_out, int out_size, void* d_ws, size_t ws_size, hipStream_t stream) {
    static int grid = 0;
    if (grid == 0) {
        if (n_in != 30 || ws_size < WS_MIX_END || ws_size < WS_END) { fprintf(stderr, "kernel_launch: unexpected n_in %d / ws_size %zu\n", n_in, ws_size); grid = -1; return; }
        int dev = 0, cus = 0, per_cu = 0;
        (void)hipGetDevice(&dev); (void)hipDeviceGetAttribute(&cus, hipDeviceAttributeMultiprocessorCount, dev);
        (void)hipFuncSetAttribute((const void*)mega_fwd, hipFuncAttributeMaxDynamicSharedMemorySize, LDS_BYTES);
        (void)hipOccupancyMaxActiveBlocksPerMultiprocessor(&per_cu, (const void*)mega_fwd, NTHREADS, LDS_BYTES);
        if (per_cu < 1) { fprintf(stderr, "kernel_launch: occupancy query reports %d blocks per CU\n", per_cu); grid = -1; return; }
        grid = cus;
    }
    if (grid < 0) return;
    (void)hipMemsetAsync((char*)d_ws + WS_CTL, 0, 65536, stream);
    Args a{};
    for (int i = 0; i < 30; ++i) a.in[i] = (const float*)d_in[i];
    a.out = (float*)d_out; a.ws = (unsigned char*)d_ws;
    if (MK_N_LAUNCHES == 1) {
        a.ph_lo = 0; a.ph_hi = N_PHASES;
        void* args[] = {&a};
        hipError_t e = hipLaunchCooperativeKernel((void*)mega_fwd, dim3(grid), dim3(NTHREADS), args, LDS_BYTES, stream);
        if (e != hipSuccess) fprintf(stderr, "cooperative launch failed: %s (grid %d)\n", hipGetErrorString(e), grid);
    } else {
        for (int ph = 0; ph < N_PHASES; ++ph) { a.ph_lo = ph; a.ph_hi = ph + 1; hipLaunchKernelGGL(mega_fwd, dim3(grid), dim3(NTHREADS), LDS_BYTES, stream, a); }
    }
}
```
